# Optimizing an MI355X kernel written in HIP

```python
import math
import jax
import jax.numpy as jnp
from jax import lax
import numpy as np

D_MODEL = 2048
BATCH = 8
SEQ = 2048
DEPTH = 2

BRANCH_WIDTH = D_MODEL // 2
MIX_WIDTH = 3 * BRANCH_WIDTH
NORM_EPS = 1e-6

A_QK_DIM = 64
A_V_DIM = 2 * A_QK_DIM
A_HEADS = BRANCH_WIDTH // A_V_DIM
A_SUBLN_EPS = 1e-5
Q_BLOCK = 128
NUM_BUCKETS = 32
MAX_DISTANCE = 128

B_HEAD_SIZE = 64
B_HEADS = BRANCH_WIDTH // B_HEAD_SIZE
B_LORA = 64
B_LNX_EPS = 64e-5
B_SHIFT_WIDTH = 3 * BRANCH_WIDTH + 4 * B_LORA

C_DK = 128
C_DV = 128
C_HEADS = BRANCH_WIDTH // C_DV
C_CHUNK = 32
LB_FLOOR = 1e-30

PROJ_SIZES = (
    A_HEADS * 2 * A_QK_DIM,
    A_HEADS * 2 * A_QK_DIM,
    A_HEADS * A_V_DIM,
    BRANCH_WIDTH,
    B_SHIFT_WIDTH,
    BRANCH_WIDTH,
    C_HEADS * C_DK,
    C_HEADS * C_DV,
    2 * C_HEADS * C_DK,
    BRANCH_WIDTH,
)
PROJ_WIDTH = sum(PROJ_SIZES)

kernel_name = "hybrid_diffattn_rwkv7_hgrn2_encoder"


def _split(t, sizes):
    parts, start = [], 0
    for size in sizes:
        parts.append(t[..., start:start + size])
        start += size
    return parts


def rmsnorm(x, g, eps=NORM_EPS):
    xf = x.astype(jnp.float32)
    y = xf * lax.rsqrt(jnp.mean(xf * xf, axis=-1, keepdims=True) + eps)
    return (y * g.astype(jnp.float32)).astype(x.dtype)


def t5_bucket(rel):
    half = NUM_BUCKETS // 2
    max_exact = half // 2
    n = jnp.abs(rel)
    nf = jnp.maximum(n, max_exact).astype(jnp.float32)
    large = max_exact + (jnp.log(nf / max_exact) / math.log(MAX_DISTANCE / max_exact)
                         * (half - max_exact)).astype(jnp.int32)
    large = jnp.minimum(large, half - 1)
    return jnp.where(rel > 0, half, 0) + jnp.where(n < max_exact, n, large)


def diff_attention(q, k, v, rel_bias, lam_q1, lam_k1, lam_q2, lam_k2, subln_g, layer_idx):
    f32 = jnp.float32
    bsz, seq = q.shape[0], q.shape[1]
    n_blocks = seq // Q_BLOCK
    lambda_init = 0.8 - 0.6 * math.exp(-0.3 * layer_idx)
    lam = (jnp.exp(jnp.sum(lam_q1.astype(f32) * lam_k1.astype(f32)))
           - jnp.exp(jnp.sum(lam_q2.astype(f32) * lam_k2.astype(f32))) + lambda_init)
    scale = A_QK_DIM ** -0.5
    key_pos = jnp.arange(seq, dtype=jnp.int32)
    q_blocks = q.reshape(bsz, n_blocks, Q_BLOCK, A_HEADS, 2, A_QK_DIM).swapaxes(0, 1)

    def one_block(args):
        q_blk, blk = args
        q_pos = blk * Q_BLOCK + jnp.arange(Q_BLOCK, dtype=jnp.int32)
        bias = rel_bias[t5_bucket(key_pos[None, :] - q_pos[:, None])]
        bias = jnp.transpose(bias, (2, 0, 1)).astype(f32)
        logits = jnp.einsum('bqhmd,bkhmd->bhmqk', q_blk, k).astype(f32) * scale
        probs = jax.nn.softmax(logits + bias[None, :, None], axis=-1)
        weights = probs[:, :, 0] - lam * probs[:, :, 1]
        return jnp.einsum('bhqk,bkhd->bqhd', weights.astype(v.dtype), v)

    out = lax.map(one_block, (q_blocks, jnp.arange(n_blocks, dtype=jnp.int32)))
    out = out.swapaxes(0, 1).reshape(bsz, seq, A_HEADS, A_V_DIM)
    out = rmsnorm(out, subln_g, eps=A_SUBLN_EPS) * (1.0 - lambda_init)
    return out.reshape(bsz, seq, A_HEADS * A_V_DIM)


def centred_shift(p, mu):
    prev = jnp.pad(p, ((0, 0), (1, 0), (0, 0)))[:, :-1]
    nxt = jnp.pad(p, ((0, 0), (0, 1), (0, 0)))[:, 1:]
    return p + mu[0] * (prev - p) + mu[1] * (nxt - p)


def _directional(t):
    bsz, seq = t.shape[0], t.shape[1]
    both = jnp.stack([t[:, :, 0], jnp.flip(t[:, :, 1], axis=1)], axis=0)
    return both.reshape(2, bsz, seq, B_HEADS, B_HEAD_SIZE).transpose(2, 0, 1, 3, 4)


def rwkv7_step(state, inp):
    r, w, kk, kk_a, v, k = inp
    sa = jnp.einsum('dbhij,dbhj->dbhi', state, -kk)
    state = (state * w[..., None, :] + sa[..., :, None] * kk_a[..., None, :]
             + v[..., :, None] * k[..., None, :])
    return state, jnp.einsum('dbhij,dbhj->dbhi', state, r)


def rwkv7_bidir(r, k, v, w_down, a_down, w0, w_up, a0, a_up, k_k, k_a, r_k, lnx_g, lnx_b):
    f32 = jnp.float32
    bsz, seq, width = r.shape
    r, k, v = r.astype(f32), k.astype(f32), v.astype(f32)
    decay = jnp.exp(-math.exp(-0.5) * jax.nn.sigmoid(
        w0.astype(f32) + jnp.einsum('bsdl,dlc->bsdc', jnp.tanh(w_down.astype(f32)), w_up.astype(f32))))
    a = jax.nn.sigmoid(a0.astype(f32) + jnp.einsum('bsdl,dlc->bsdc', a_down.astype(f32), a_up.astype(f32)))
    kk = (k * k_k.astype(f32)).reshape(bsz, seq, B_HEADS, B_HEAD_SIZE)
    kk = kk / jnp.maximum(jnp.linalg.norm(kk, axis=-1, keepdims=True), 1e-12)
    kk = kk.reshape(bsz, seq, 1, width)
    k_mod = k[:, :, None] * (1.0 + (a - 1.0) * k_a.astype(f32))
    both = lambda t: jnp.broadcast_to(t, (bsz, seq, 2, width))
    xs = (_directional(both(r[:, :, None])), _directional(decay), _directional(both(kk)),
          _directional(kk * a), _directional(both(v[:, :, None])), _directional(k_mod))
    state0 = jnp.zeros((2, bsz, B_HEADS, B_HEAD_SIZE, B_HEAD_SIZE), f32)
    _, ys = lax.scan(rwkv7_step, state0, xs)
    y = (ys[:, 0] + jnp.flip(ys[:, 1], axis=0)).transpose(1, 0, 2, 3)
    mu = jnp.mean(y, axis=-1, keepdims=True)
    var = jnp.mean(jnp.square(y - mu), axis=-1, keepdims=True)
    y = ((y - mu) * lax.rsqrt(var + B_LNX_EPS)).reshape(bsz, seq, width)
    y = y * lnx_g.astype(f32) + lnx_b.astype(f32)
    bonus = jnp.einsum('bshn,bsdhn,hn->bsh', r.reshape(bsz, seq, B_HEADS, B_HEAD_SIZE),
                       k_mod.reshape(bsz, seq, 2, B_HEADS, B_HEAD_SIZE),
                       r_k.astype(f32).reshape(B_HEADS, B_HEAD_SIZE))
    return y + (bonus[..., None] * v.reshape(bsz, seq, B_HEADS, B_HEAD_SIZE)).reshape(bsz, seq, width)


def gla_chunkwise(q, k, v, log_f):
    nbat, heads, seq, dk = q.shape
    dv = v.shape[-1]
    n_chunks = seq // C_CHUNK
    to_chunks = lambda t: t.reshape(nbat, heads, n_chunks, C_CHUNK, t.shape[-1]).transpose(2, 0, 1, 3, 4)
    mask = jnp.tril(jnp.ones((C_CHUNK, C_CHUNK), dtype=bool))[:, :, None]

    def step(state, inp):
        q_c, k_c, v_c, lf_c = inp
        cum = jnp.cumsum(lf_c, axis=-2)
        diff = cum[..., :, None, :] - cum[..., None, :, :]
        pair_decay = jnp.where(mask, jnp.exp(jnp.where(mask, diff, 0.0)), 0.0)
        scores = jnp.einsum('bhtk,bhsk,bhtsk->bhts', q_c, k_c, pair_decay)
        o_c = (jnp.einsum('bhts,bhsv->bhtv', scores, v_c)
               + jnp.einsum('bhtk,bhkv->bhtv', q_c * jnp.exp(cum), state))
        last = cum[..., -1:, :]
        state = (state * jnp.exp(last)[..., 0, :, None]
                 + jnp.einsum('bhsk,bhsv->bhkv', k_c * jnp.exp(last - cum), v_c))
        return state, o_c

    state0 = jnp.zeros((nbat, heads, dk, dv), q.dtype)
    _, o = lax.scan(step, state0, (to_chunks(q), to_chunks(k), to_chunks(v), to_chunks(log_f)))
    return o.transpose(1, 2, 0, 3, 4).reshape(nbat, heads, seq, dv)


def hgrn2_bidir(q, i, f_logits, lower_bound, norm_g):
    f32 = jnp.float32
    bsz, seq = q.shape[0], q.shape[1]
    z = f_logits.astype(f32)
    log_sig = jax.nn.log_sigmoid(z)
    log_lb = jnp.log(jnp.maximum(lower_bound, LB_FLOOR))
    log_f = jnp.where(lower_bound > 0.0,
                      jnp.logaddexp(log_lb, jnp.log1p(-lower_bound) + log_sig), log_sig)
    k = (1.0 - lower_bound) * jax.nn.sigmoid(-z)
    heads = lambda t, d: t.reshape(t.shape[0], seq, C_HEADS, d).transpose(0, 2, 1, 3)
    both = lambda t_f, t_b: jnp.concatenate([t_f, jnp.flip(t_b, axis=1)], axis=0)
    qf, vf = q.astype(f32), i.astype(f32)
    o = gla_chunkwise(heads(both(qf, qf), C_DK), heads(both(k[:, :, 0], k[:, :, 1]), C_DK),
                      heads(both(vf, vf), C_DV), heads(both(log_f[:, :, 0], log_f[:, :, 1]), C_DK))
    o = o.transpose(0, 2, 1, 3)
    o = o[:bsz] + jnp.flip(o[bsz:], axis=1)
    return rmsnorm(o, norm_g).reshape(bsz, seq, C_HEADS * C_DV)


def setup_inputs(seed: int = 0) -> dict:
    key = jax.random.key(seed)
    ks = iter(jax.random.split(key, 24))
    f32 = jnp.float32
    nrm = lambda shape, scale: scale * jax.random.normal(next(ks), shape, f32)
    gain = lambda shape: 1.0 + 0.05 * jax.random.normal(next(ks), shape, f32)
    return {
        "x": nrm((BATCH, SEQ, D_MODEL), 1.0),
        "rel_bias": nrm((NUM_BUCKETS, A_HEADS), 0.5),
        "pre_norm_g": gain((DEPTH, D_MODEL)),
        "post_norm_g": gain((DEPTH, D_MODEL)),
        "w_in": nrm((DEPTH, D_MODEL, PROJ_WIDTH), D_MODEL ** -0.5),
        "w_out": nrm((DEPTH, MIX_WIDTH, D_MODEL), MIX_WIDTH ** -0.5),
        "lambda_q1": nrm((DEPTH, A_QK_DIM), 0.1),
        "lambda_k1": nrm((DEPTH, A_QK_DIM), 0.1),
        "lambda_q2": nrm((DEPTH, A_QK_DIM), 0.1),
        "lambda_k2": nrm((DEPTH, A_QK_DIM), 0.1),
        "subln_g": gain((DEPTH, A_V_DIM)),
        "rwkv_shift_mu": jax.random.uniform(next(ks), (DEPTH, 2, B_SHIFT_WIDTH), f32, 0.0, 0.5),
        "rwkv_w0": jax.random.uniform(next(ks), (DEPTH, 2, BRANCH_WIDTH), f32, -2.0, 2.0),
        "rwkv_w_up": nrm((DEPTH, 2, B_LORA, BRANCH_WIDTH), 0.1),
        "rwkv_a0": nrm((DEPTH, 2, BRANCH_WIDTH), 0.5),
        "rwkv_a_up": nrm((DEPTH, 2, B_LORA, BRANCH_WIDTH), B_LORA ** -0.5),
        "rwkv_k_k": 0.85 + 0.05 * jax.random.normal(next(ks), (DEPTH, BRANCH_WIDTH), f32),
        "rwkv_k_a": gain((DEPTH, BRANCH_WIDTH)),
        "rwkv_r_k": nrm((DEPTH, BRANCH_WIDTH), 0.1),
        "rwkv_lnx_g": gain((DEPTH, BRANCH_WIDTH)),
        "rwkv_lnx_b": nrm((DEPTH, BRANCH_WIDTH), 0.01),
        "hgrn_lb_logits": nrm((2, DEPTH, C_HEADS * C_DK), 0.5),
        "hgrn_norm_g": gain((DEPTH, C_DV)),
    }


def reference(x, rel_bias, pre_norm_g, post_norm_g, w_in, w_out, lambda_q1, lambda_k1, lambda_q2,
              lambda_k2, subln_g, rwkv_shift_mu, rwkv_w0, rwkv_w_up, rwkv_a0, rwkv_a_up, rwkv_k_k,
              rwkv_k_a, rwkv_r_k, rwkv_lnx_g, rwkv_lnx_b, hgrn_lb_logits, hgrn_norm_g):
    bsz, seq, _ = x.shape
    lb = jax.nn.softmax(hgrn_lb_logits.astype(jnp.float32), axis=1)
    lb = jnp.cumsum(lb, axis=1) - lb[:, :1]
    for l in range(DEPTH):
        u = rmsnorm(x, pre_norm_g[l])
        proj = jnp.einsum('bsd,dp->bsp', u, w_in[l])
        aq, ak, av, ag, b_streams, bg, cq, ci, cf, cg = _split(proj, PROJ_SIZES)
        y_a = diff_attention(
            aq.reshape(bsz, seq, A_HEADS, 2, A_QK_DIM), ak.reshape(bsz, seq, A_HEADS, 2, A_QK_DIM),
            av.reshape(bsz, seq, A_HEADS, A_V_DIM), rel_bias, lambda_q1[l], lambda_k1[l],
            lambda_q2[l], lambda_k2[l], subln_g[l], l)
        br, bk, bv, bw, ba = _split(centred_shift(b_streams, rwkv_shift_mu[l]),
                                    (BRANCH_WIDTH, BRANCH_WIDTH, BRANCH_WIDTH, 2 * B_LORA, 2 * B_LORA))
        y_b = rwkv7_bidir(br, bk, bv, bw.reshape(bsz, seq, 2, B_LORA), ba.reshape(bsz, seq, 2, B_LORA),
                          rwkv_w0[l], rwkv_w_up[l], rwkv_a0[l], rwkv_a_up[l], rwkv_k_k[l], rwkv_k_a[l],
                          rwkv_r_k[l], rwkv_lnx_g[l], rwkv_lnx_b[l])
        y_c = hgrn2_bidir(cq, ci, cf.reshape(bsz, seq, 2, C_HEADS * C_DK), lb[:, l], hgrn_norm_g[l])
        mixed = jnp.concatenate([(y_a * jax.nn.silu(ag)).astype(u.dtype),
                                 (y_b * jax.nn.silu(bg)).astype(u.dtype),
                                 (y_c * jax.nn.silu(cg)).astype(u.dtype)], axis=-1)
        x = x + rmsnorm(jnp.einsum('bsm,md->bsd', mixed, w_out[l]), post_norm_g[l])
    return x
```

```cpp
#include <hip/hip_runtime.h>
#include <hip/hip_cooperative_groups.h>
#include <cstdio>
#include <cstdint>
namespace cg = cooperative_groups;
namespace pg8 {
#define PG8_LAS __attribute__((address_space(3)))
typedef unsigned short bf16_t;
typedef short bf16x8 __attribute__((ext_vector_type(8)));
typedef float f32x4 __attribute__((ext_vector_type(4)));
typedef unsigned u32x4 __attribute__((ext_vector_type(4)));
constexpr int BM = 256, BK = 64, HALF = 128, HTB = HALF * BK * 2  , STAGE_BYTES = 8 * HTB, NXCD = 8, WGM = 8;

__host__ __device__ __forceinline__ int lds_byte(int r, int c) { const int st = (r >> 4) * 2 + (c >> 5), rr = r & 15, cc = c & 31, ob = rr * 64 + cc * 2; return st * 1024 + (ob ^ (((ob >> 9) & 1) << 5)); }
__host__ __device__ __forceinline__ void stage_rc(int b, int& R, int& C) { const int st = b / 1024, sb = b % 1024, swz = sb ^ (((sb >> 9) & 1) << 5); R = (st >> 1) * 16 + swz / 64; C = (st & 1) * 32 + (swz % 64) / 2; }
__host__ __device__ __forceinline__ int perm32(int rho) { const int n = rho >> 4, i = rho & 15; return 8 * (i >> 2) + 4 * n + (i & 3); }

struct Unit { int pm, pn; };
struct Gemm { const bf16_t* A; const bf16_t* Bt; int M, N, K; };

struct StaticOrder {
    int nM, nN, nwg, G, c;
    __host__ __device__ void init(int M, int N, int G_, int c_) { nM = M / BM; nN = N / BM; nwg = nM * nN; G = G_; c = c_; }
    __host__ __device__ bool next(int i, Unit& u) const {
        const long L = (long)i * G + c; if (L >= nwg) return false;
        int wgid = (int)L; { const int q = nwg / NXCD, r = nwg % NXCD, xcd = wgid % NXCD, off = wgid / NXCD; wgid = (xcd < r ? xcd * (q + 1) : r * (q + 1) + (xcd - r) * q) + off; }
        const int nig = WGM * nN, gid = wgid / nig, fm = gid * WGM, gsz = (nM - fm) < WGM ? (nM - fm) : WGM;
        u.pm = fm + ((wgid % nig) % gsz); u.pn = (wgid % nig) / gsz; return true;
    }
    __device__ __forceinline__ void a_ready(const Unit&) const {}
    __device__ __forceinline__ void done(const Unit&) const {}
};
struct CountedOrder : StaticOrder {
    const unsigned* ready; unsigned need; unsigned* tmo;
    __device__ __forceinline__ void a_ready(const Unit& u) const {
        if (threadIdx.x < 64) {
            const unsigned long long t0 = __builtin_amdgcn_s_memrealtime(); unsigned polls = 0;
            while ((unsigned)__builtin_amdgcn_readfirstlane(__hip_atomic_load(ready + 64 * u.pm, __ATOMIC_RELAXED, __HIP_MEMORY_SCOPE_AGENT)) < need) {
                if ((++polls & 255u) == 0u && __builtin_amdgcn_readfirstlane(__hip_atomic_load(tmo, __ATOMIC_RELAXED, __HIP_MEMORY_SCOPE_AGENT)) != 0u) break;
                if (__builtin_amdgcn_s_memrealtime() - t0 > 2000000ull) {
                    if (threadIdx.x == 0) { unsigned expect = 0u; __hip_atomic_compare_exchange_strong(tmo + 1, &expect, 0x600u | (unsigned)(u.pm & 0xff), __ATOMIC_RELAXED, __ATOMIC_RELAXED, __HIP_MEMORY_SCOPE_AGENT); __hip_atomic_store(tmo, 1u, __ATOMIC_RELAXED, __HIP_MEMORY_SCOPE_AGENT); }
                    break; }
                __builtin_amdgcn_s_sleep(2); }
            __builtin_amdgcn_fence(__ATOMIC_ACQUIRE, "agent");
            asm volatile("s_waitcnt vmcnt(0)" ::: "memory");
        }
#if !defined(BROKEN_HOOK_NO_BARRIER)
        asm volatile("" ::: "memory"); __builtin_amdgcn_s_barrier(); asm volatile("" ::: "memory");
#endif
    }
};

__device__ __forceinline__ unsigned cvt_pk_bf16(float lo, float hi) { unsigned r; asm volatile("v_cvt_pk_bf16_f32 %0, %1, %2" : "=v"(r) : "v"(lo), "v"(hi)); return r; }
typedef float f32x2 __attribute__((ext_vector_type(2)));
__device__ __forceinline__ f32x2 gelu_pk(f32x2 v) {
    const f32x2 av = __builtin_elementwise_abs(v), d = av * 0.2316418882f + 1.0f;
    f32x2 t; t.x = __builtin_amdgcn_rcpf(d.x); t.y = __builtin_amdgcn_rcpf(d.y);
    f32x2 q = t * 0.5307027145f + (-0.7265760135f); q = q * t + 0.7107068705f; q = q * t + (-0.142248368f); q = q * t + 0.127414796f; q = q * t;
    const f32x2 s = (v * v) * (-0.72134752044f);
    f32x2 e; e.x = __builtin_amdgcn_exp2f(s.x); e.y = __builtin_amdgcn_exp2f(s.y);
    const f32x2 m = v * (q * e), r = v - m;
    f32x2 o; o.x = v.x < 0.f ? m.x : r.x; o.y = v.y < 0.f ? m.y : r.y; return o;
}

struct EpiF32 {
    static constexpr bool PERM = false, AFTER_DRAIN = false;
    float* C; int ldc; const float* bias;
    __device__ __forceinline__ void operator()(const f32x4 (&acc)[2][2][4][2], const Unit& u, int wr, int wc, int fr, int fq) const {
        const int row0 = u.pm * BM + wr * 64 + fr, col0 = u.pn * BM + wc * 32 + 4 * fq;
        f32x4 bv[2][2];
#pragma unroll
        for (int bj = 0; bj < 2; ++bj)
#pragma unroll
            for (int n = 0; n < 2; ++n) bv[bj][n] = bias ? *(const f32x4*)(bias + col0 + bj * HALF + n * 16) : (f32x4){0.f, 0.f, 0.f, 0.f};
#pragma unroll
        for (int ai = 0; ai < 2; ++ai)
#pragma unroll
            for (int m = 0; m < 4; ++m) { float* rowp = C + (size_t)(row0 + ai * HALF + m * 16) * ldc + col0;
#pragma unroll
                for (int bj = 0; bj < 2; ++bj)
#pragma unroll
                    for (int n = 0; n < 2; ++n) *(f32x4*)(rowp + bj * HALF + n * 16) = acc[ai][bj][m][n] + bv[bj][n]; }
    }
};
template <int ACT  > struct EpiBf16 {
    static constexpr bool PERM = true, AFTER_DRAIN = false;
    bf16_t* O; int ldc; const float* bias; int split_cols; size_t split_stride;
    __device__ __forceinline__ void operator()(const f32x4 (&acc)[2][2][4][2], const Unit& u, int wr, int wc, int fr, int fq) const {
        const int row0 = u.pm * BM + wr * 64 + fr; int colt = u.pn * BM; bf16_t* base = O;
        if (split_cols) { const int t = colt / split_cols; base += (size_t)t * split_stride; colt -= t * split_cols; }
        const int col0 = colt + wc * 32 + 8 * fq, bcol0 = u.pn * BM + wc * 32 + 8 * fq;
        f32x4 bv[2][2];
#pragma unroll
        for (int bj = 0; bj < 2; ++bj)
#pragma unroll
            for (int n = 0; n < 2; ++n) bv[bj][n] = bias ? *(const f32x4*)(bias + bcol0 + bj * HALF + 4 * n) : (f32x4){0.f, 0.f, 0.f, 0.f};
#pragma unroll
        for (int ai = 0; ai < 2; ++ai)
#pragma unroll
            for (int m = 0; m < 4; ++m) { bf16_t* rowp = base + (size_t)(row0 + ai * HALF + m * 16) * ldc + col0;
#pragma unroll
                for (int bj = 0; bj < 2; ++bj) { f32x4 v0 = acc[ai][bj][m][0] + bv[bj][0], v1 = acc[ai][bj][m][1] + bv[bj][1];
                    if (ACT == 1) { f32x2 a = gelu_pk((f32x2){v0[0], v0[1]}), b = gelu_pk((f32x2){v0[2], v0[3]}), c = gelu_pk((f32x2){v1[0], v1[1]}), d = gelu_pk((f32x2){v1[2], v1[3]});
                        v0 = (f32x4){a.x, a.y, b.x, b.y}; v1 = (f32x4){c.x, c.y, d.x, d.y}; }
                    if (ACT == 2) {
#pragma unroll
                        for (int j = 0; j < 4; ++j) { v0[j] = 0.5f * v0[j] * (1.0f + erff(v0[j] * 0.70710678f)); v1[j] = 0.5f * v1[j] * (1.0f + erff(v1[j] * 0.70710678f)); } }
                    u32x4 w; w.x = cvt_pk_bf16(v0[0], v0[1]); w.y = cvt_pk_bf16(v0[2], v0[3]); w.z = cvt_pk_bf16(v1[0], v1[1]); w.w = cvt_pk_bf16(v1[2], v1[3]);
                    *(u32x4*)(rowp + bj * HALF) = w; } }
    }
};


template <class Epi, class Sched, bool STAMP = false>
__device__ __forceinline__ void gemm_phase(PG8_LAS unsigned char* lds, const Gemm g, const Sched& S, const Epi& E, unsigned long long* stamps) {
    int tid_o = threadIdx.x; asm volatile("" : "+v"(tid_o));
    const int tid = tid_o, wid = __builtin_amdgcn_readfirstlane(tid >> 6), lane = tid & 63, wr = wid >> 2, wc = wid & 3, fr = lane & 15, fq = lane >> 4;
    const int K = g.K, nt = K / BK;
    int ts_lo = 0, ts_hi = 0, nts = 0; const unsigned long long rt_entry = STAMP ? (unsigned long long)wall_clock64() : 0ull;
#define PG8_STAMP() do { if (STAMP && wid == 0 && nts < 64) { const unsigned long long _c = (unsigned long long)clock64(); \
        ts_lo = (lane == nts) ? (int)(unsigned)_c : ts_lo; ts_hi = (lane == nts) ? (int)(unsigned)(_c >> 32) : ts_hi; ++nts; } } while (0)
    PG8_STAMP();
    unsigned voffA[2], voffB[2];
#pragma unroll
    for (int i = 0; i < 2; ++i) { int R, C; stage_rc(tid * 16 + i * 8192, R, C); const int Rb = Epi::PERM ? ((R & ~31) + perm32(R & 31)) : R;
        voffA[i] = (unsigned)(R * K + C) * 2u; voffB[i] = (unsigned)(Rb * K + C) * 2u; }
    const size_t kstep = (size_t)(BK * 2);
    const size_t hstep = (size_t)HALF * K * 2;
    const size_t tstep = 2 * hstep;
    const unsigned ldsw = (unsigned)wid * 1024u;
    const int aoff = lds_byte(wr * 64 + fr, fq * 8), boff = lds_byte(wc * 32 + fr, fq * 8);
#define PG8_SA(b, h) (((b) * 2 + (h)) * HTB)
#define PG8_SB(b, h) ((4 + (b) * 2 + (h)) * HTB)
#define PG8_STAGE(bufoff, gbase, voff) do { _Pragma("unroll") for (int _i = 0; _i < 2; ++_i) \
        __builtin_amdgcn_global_load_lds((const unsigned*)((const char*)(gbase) + (voff)[_i]), (PG8_LAS unsigned*)(lds + (bufoff) + ldsw + _i * 8192), 16, 0, 0); } while (0)
#define PG8_LDA(dst, b, h) do { _Pragma("unroll") for (int m = 0; m < 4; ++m) _Pragma("unroll") for (int k = 0; k < 2; ++k) dst[m][k] = *(const PG8_LAS bf16x8*)(lds + PG8_SA(b, h) + aoff + m * 2048 + k * 1024); } while (0)
#define PG8_LDB(dst, b, h) do { _Pragma("unroll") for (int n = 0; n < 2; ++n) _Pragma("unroll") for (int k = 0; k < 2; ++k) dst[n][k] = *(const PG8_LAS bf16x8*)(lds + PG8_SB(b, h) + boff + n * 2048 + k * 1024); } while (0)
#define PG8_MMA(ai, bj, At, Bt) do { __builtin_amdgcn_s_setprio(1); _Pragma("unroll") for (int m = 0; m < 4; ++m) _Pragma("unroll") for (int n = 0; n < 2; ++n) _Pragma("unroll") for (int k = 0; k < 2; ++k) \
        acc[ai][bj][m][n] = __builtin_amdgcn_mfma_f32_16x16x32_bf16(Bt[n][k], At[m][k], acc[ai][bj][m][n], 0, 0, 0); __builtin_amdgcn_s_setprio(0); } while (0)
#define PG8_WAIT_V(n) asm volatile("s_waitcnt vmcnt(" #n ")" ::: "memory")
#define PG8_WAIT_L(n) asm volatile("s_waitcnt lgkmcnt(" #n ")" ::: "memory")
#define PG8_BAR __builtin_amdgcn_s_barrier()
#define PG8_SCHED __builtin_amdgcn_sched_barrier(0)
    Unit cur, nxt; int ui = 0;
    if (!S.next(0, cur)) return;
    f32x4 acc[2][2][4][2];
#pragma unroll
    for (int a = 0; a < 2; ++a)
#pragma unroll
        for (int b = 0; b < 2; ++b)
#pragma unroll
            for (int m = 0; m < 4; ++m)
#pragma unroll
                for (int n = 0; n < 2; ++n) acc[a][b][m][n] = (f32x4){0.f, 0.f, 0.f, 0.f};
    bf16x8 At[4][2], B0[2][2], B1[2][2];
    const char* cA = (const char*)g.A + (size_t)cur.pm * tstep; const char* cB = (const char*)g.Bt + (size_t)cur.pn * tstep;
    S.a_ready(cur);
    PG8_STAGE(PG8_SB(0, 0), cB, voffB); PG8_STAGE(PG8_SA(0, 0), cA, voffA); PG8_STAGE(PG8_SB(0, 1), cB + hstep, voffB); PG8_STAGE(PG8_SA(0, 1), cA + hstep, voffA);
    if (wr == 1) PG8_BAR;
    PG8_WAIT_V(4); PG8_BAR;
    PG8_STAGE(PG8_SB(1, 0), cB + kstep, voffB); PG8_STAGE(PG8_SA(1, 0), cA + kstep, voffA); PG8_STAGE(PG8_SB(1, 1), cB + hstep + kstep, voffB);
    PG8_WAIT_V(6); PG8_BAR;
    PG8_STAMP();
    for (;;) {
        const bool has_next = S.next(ui + 1, nxt);
        const char* nA = has_next ? (const char*)g.A + (size_t)nxt.pm * tstep : cA; const char* nB = has_next ? (const char*)g.Bt + (size_t)nxt.pn * tstep : cB;
        for (int t = 0; t < nt; t += 2) {
            const bool last = (t == nt - 2);
            const char* a1 = cA + (size_t)(t + 1) * kstep;
            const char* a2 = last ? nA : cA + (size_t)(t + 2) * kstep; const char* b2 = last ? nB : cB + (size_t)(t + 2) * kstep;
            const char* a3 = a2 + kstep; const char* b3 = b2 + kstep;
            if (last && has_next) S.a_ready(nxt);
            PG8_LDB(B0, 0, 0); PG8_SCHED; PG8_LDA(At, 0, 0); PG8_STAGE(PG8_SA(1, 1), a1 + hstep, voffA);
            PG8_WAIT_L(8); PG8_BAR; PG8_WAIT_L(0); PG8_MMA(0, 0, At, B0); PG8_BAR; PG8_SCHED;
            PG8_LDB(B1, 0, 1); PG8_STAGE(PG8_SB(0, 0), b2, voffB);
            PG8_BAR; PG8_WAIT_L(0); PG8_MMA(0, 1, At, B1); PG8_BAR;
            PG8_LDA(At, 0, 1); PG8_STAGE(PG8_SA(0, 0), a2, voffA);
            PG8_BAR; PG8_WAIT_L(0); PG8_MMA(1, 0, At, B0); PG8_BAR; PG8_SCHED;
            PG8_STAGE(PG8_SB(0, 1), b2 + hstep, voffB);
            PG8_WAIT_V(6); PG8_BAR; PG8_MMA(1, 1, At, B1); PG8_BAR;
            PG8_LDB(B0, 1, 0); PG8_SCHED; PG8_LDA(At, 1, 0); PG8_STAGE(PG8_SA(0, 1), a2 + hstep, voffA);
            PG8_WAIT_L(8); PG8_BAR; PG8_WAIT_L(0); PG8_MMA(0, 0, At, B0); PG8_BAR; PG8_SCHED;
            PG8_LDB(B1, 1, 1); PG8_STAGE(PG8_SB(1, 0), b3, voffB);
            PG8_BAR; PG8_WAIT_L(0); PG8_MMA(0, 1, At, B1); PG8_BAR;
            PG8_LDA(At, 1, 1); PG8_STAGE(PG8_SA(1, 0), a3, voffA);
            PG8_BAR; PG8_WAIT_L(0); PG8_MMA(1, 0, At, B0); PG8_BAR; PG8_SCHED;
            PG8_STAGE(PG8_SB(1, 1), b3 + hstep, voffB);
            PG8_WAIT_V(6); PG8_BAR; PG8_MMA(1, 1, At, B1); PG8_BAR;
        }
        PG8_STAMP();
        if constexpr (!Epi::AFTER_DRAIN) { E(acc, cur, wr, wc, fr, fq); S.done(cur); }
        PG8_STAMP();
        if (!has_next) break;
#pragma unroll
        for (int a = 0; a < 2; ++a)
#pragma unroll
            for (int b = 0; b < 2; ++b)
#pragma unroll
                for (int m = 0; m < 4; ++m)
#pragma unroll
                    for (int n = 0; n < 2; ++n) acc[a][b][m][n] = (f32x4){0.f, 0.f, 0.f, 0.f};
        cur = nxt; cA = nA; cB = nB; ++ui;
    }
    PG8_WAIT_V(0);
    if (wr == 0) PG8_BAR;
    PG8_BAR;
    if constexpr (Epi::AFTER_DRAIN) { E.fused(acc, cur, wr, wc, fr, fq, lds, wid, lane); S.done(cur); }
    PG8_STAMP();
    if (STAMP && wid == 0) { stamps[lane] = lane < nts ? (((unsigned long long)(unsigned)ts_hi << 32) | (unsigned)ts_lo) : 0ull;
        if (lane == 62) stamps[62] = rt_entry; if (lane == 63) stamps[63] = (unsigned long long)wall_clock64(); }
#undef PG8_STAMP
#undef PG8_SA
#undef PG8_SB
#undef PG8_STAGE
#undef PG8_LDA
#undef PG8_LDB
#undef PG8_MMA
#undef PG8_WAIT_V
#undef PG8_WAIT_L
#undef PG8_BAR
#undef PG8_SCHED
}
}

namespace mk {
using pg8::bf16_t; using pg8::bf16x8; using pg8::f32x4; using pg8::u32x4;
typedef short s16x4 __attribute__((ext_vector_type(4)));
typedef unsigned u32x2 __attribute__((ext_vector_type(2)));

constexpr int D = 2048, NB = 8, S = 2048, M = NB * S, BW = 1024, MIXW = 3072, PW = 13568, DEPTH = 2;
constexpr int C_AQ = 0, C_AK = 1024, C_AV = 2048, C_AG = 3072, C_B = 4096, C_BG = 7424, C_CQ = 8448, C_CI = 9472, C_CF = 10496, C_CG = 12544;
constexpr int NTHR = 512;
constexpr int LDS_BYTES = 147456;
constexpr float LOG2E = 1.4426950408889634f;

constexpr size_t OFF_CTL = 0;
constexpr size_t OFF_WIN = 4096;
constexpr size_t OFF_WOUT = OFF_WIN + (size_t)PW * D * 2;
constexpr size_t OFF_U = OFF_WOUT + (size_t)D * MIXW * 2;
constexpr size_t OFF_PROJ = OFF_U + (size_t)M * D * 2;
constexpr size_t OFF_MIXED = OFF_PROJ + (size_t)M * PW * 2;
constexpr size_t OFF_OC = OFF_MIXED + (size_t)M * MIXW * 2;
constexpr size_t OFF_AO = OFF_OC + (size_t)2 * M * BW * 2;
constexpr size_t OFF_BON = OFF_AO + (size_t)2 * M * BW * 2;
constexpr size_t WS_END = OFF_BON + (size_t)2 * M * 16 * 4;

struct Params { const float* in[23]; float* out; unsigned char* ws; };
__device__ __forceinline__ int opaque_tid() { int t = threadIdx.x; asm volatile("" : "+v"(t)); return t; }
__device__ __forceinline__ int opaque_s(int t) { asm volatile("" : "+s"(t)); return t; }
__device__ __forceinline__ int opaque_bid() { int t = blockIdx.x; asm volatile("" : "+s"(t)); return t; }


__device__ __forceinline__ float bf2f(bf16_t v) { return __uint_as_float(((unsigned)v) << 16); }
__device__ __forceinline__ bf16_t f2bf(float f) { unsigned u = __float_as_uint(f); u += 0x7FFFu + ((u >> 16) & 1u); return (bf16_t)(u >> 16); }
__device__ __forceinline__ unsigned pk2(float lo, float hi) { unsigned r; asm("v_cvt_pk_bf16_f32 %0, %1, %2" : "=v"(r) : "v"(lo), "v"(hi)); return r; }
__device__ __forceinline__ float wave_sum(float v) {
#pragma unroll
    for (int o = 1; o < 64; o <<= 1) v += __shfl_xor(v, o);
    return v;
}
__device__ __forceinline__ float sigmoidf_(float x) { return 1.f / (1.f + __expf(-x)); }
__device__ __forceinline__ float siluf_(float x) { return x / (1.f + __expf(-x)); }
__device__ __forceinline__ float dpp_xor1(float v) { return __int_as_float(__builtin_amdgcn_mov_dpp(__float_as_int(v), 0xB1, 0xF, 0xF, true)); }
__device__ __forceinline__ float dpp_xor2(float v) { return __int_as_float(__builtin_amdgcn_mov_dpp(__float_as_int(v), 0x4E, 0xF, 0xF, true)); }
#define MFMA16(a, b, c) __builtin_amdgcn_mfma_f32_16x16x32_bf16((a), (b), (c), 0, 0, 0)
__device__ __forceinline__ bf16x8 join8(s16x4 lo, s16x4 hi) { return __builtin_shufflevector(lo, hi, 0, 1, 2, 3, 4, 5, 6, 7); }
__device__ __forceinline__ bf16x8 pack8(f32x4 a, f32x4 b) {
    u32x4 w; w.x = pk2(a[0], a[1]); w.y = pk2(a[2], a[3]); w.z = pk2(b[0], b[1]); w.w = pk2(b[2], b[3]);
    return __builtin_bit_cast(bf16x8, w);
}

__device__ __forceinline__ void transpose_tile(const float* __restrict__ W, int K, int N, bf16_t* __restrict__ WT, float* tile, int it) {
    const int tid = opaque_tid();
    const int ntn = N >> 6; const int kb = it / ntn, nbk = it - kb * ntn; const int k0 = kb * 64, n0 = nbk * 64;
#pragma unroll
    for (int rr = 0; rr < 2; ++rr) { const int idx = tid + rr * 512; const int kk = idx >> 4, n4 = (idx & 15) * 4;
        const float4 v = *(const float4*)(W + (size_t)(k0 + kk) * N + n0 + n4);
        float* tp = tile + kk * 65 + n4; tp[0] = v.x; tp[1] = v.y; tp[2] = v.z; tp[3] = v.w; }
    __syncthreads();
    { const int n = tid >> 3, kc = (tid & 7) * 8; const float* tp = tile + kc * 65 + n;
      u32x4 o; o.x = pk2(tp[0], tp[65]); o.y = pk2(tp[2 * 65], tp[3 * 65]); o.z = pk2(tp[4 * 65], tp[5 * 65]); o.w = pk2(tp[6 * 65], tp[7 * 65]);
      *(u32x4*)(WT + (size_t)(n0 + n) * K + k0 + kc) = o; }
    __syncthreads();
}
__device__ __forceinline__ void convert_weights(const Params& P, int layer, unsigned char* smem) {
    float* tile = (float*)smem;
    const float* win = P.in[4] + (size_t)layer * D * PW; const float* wout = P.in[5] + (size_t)layer * MIXW * D;
    bf16_t* WinT = (bf16_t*)(P.ws + OFF_WIN); bf16_t* WoutT = (bf16_t*)(P.ws + OFF_WOUT);
    constexpr int T_IN = (D / 64) * (PW / 64), T_OUT = (MIXW / 64) * (D / 64);
    for (int it = opaque_bid(); it < T_IN + T_OUT; it += gridDim.x) {
        if (it < T_IN) transpose_tile(win, D, PW, WinT, tile, it);
        else transpose_tile(wout, MIXW, D, WoutT, tile, it - T_IN);
    }
}
__device__ __forceinline__ void prenorm_rows(const float* __restrict__ x, const float* __restrict__ g, bf16_t* __restrict__ U) {
    const int tid_ = opaque_tid(); const int lane = tid_ & 63, gw = opaque_bid() * 8 + (tid_ >> 6), ngw = gridDim.x * 8;
    for (int row = gw; row < M; row += ngw) {
        const float4* xr = (const float4*)(x + (size_t)row * D) + lane;
        float4 v[8]; float ss = 0.f;
#pragma unroll
        for (int j = 0; j < 8; ++j) { v[j] = xr[64 * j]; ss += v[j].x * v[j].x + v[j].y * v[j].y + v[j].z * v[j].z + v[j].w * v[j].w; }
        const float rstd = rsqrtf(wave_sum(ss) * (1.f / D) + 1e-6f);
        u32x2* o = (u32x2*)(U + (size_t)row * D) + lane;
#pragma unroll
        for (int j = 0; j < 8; ++j) { const float4 gg = ((const float4*)g)[64 * j + lane];
            u32x2 w; w.x = pk2(v[j].x * rstd * gg.x, v[j].y * rstd * gg.y); w.y = pk2(v[j].z * rstd * gg.z, v[j].w * rstd * gg.w); o[64 * j] = w; }
    }
}
__device__ __forceinline__ void postnorm_rows(const float* __restrict__ y, const float* xin, float* xout, const float* __restrict__ gpost, const float* __restrict__ gpre, bf16_t* __restrict__ U) {
    const int tid_ = opaque_tid(); const int lane = tid_ & 63, gw = opaque_bid() * 8 + (tid_ >> 6), ngw = gridDim.x * 8;
    for (int row = gw; row < M; row += ngw) {
        const float4* yr = (const float4*)(y + (size_t)row * D) + lane;
        const float4* xr = (const float4*)(xin + (size_t)row * D) + lane;
        float4* xo = (float4*)(xout + (size_t)row * D) + lane;
        float4 v[8]; float ss = 0.f;
#pragma unroll
        for (int j = 0; j < 8; ++j) { v[j] = yr[64 * j]; ss += v[j].x * v[j].x + v[j].y * v[j].y + v[j].z * v[j].z + v[j].w * v[j].w; }
        const float rstd = rsqrtf(wave_sum(ss) * (1.f / D) + 1e-6f);
        float s2 = 0.f;
#pragma unroll
        for (int j = 0; j < 8; ++j) { const float4 gg = ((const float4*)gpost)[64 * j + lane]; const float4 xv = xr[64 * j];
            v[j].x = xv.x + v[j].x * rstd * gg.x; v[j].y = xv.y + v[j].y * rstd * gg.y; v[j].z = xv.z + v[j].z * rstd * gg.z; v[j].w = xv.w + v[j].w * rstd * gg.w;
            xo[64 * j] = v[j]; s2 += v[j].x * v[j].x + v[j].y * v[j].y + v[j].z * v[j].z + v[j].w * v[j].w; }
        if (gpre) {
            const float r2 = rsqrtf(wave_sum(s2) * (1.f / D) + 1e-6f);
            u32x2* o = (u32x2*)(U + (size_t)row * D) + lane;
#pragma unroll
            for (int j = 0; j < 8; ++j) { const float4 gg = ((const float4*)gpre)[64 * j + lane];
                u32x2 w; w.x = pk2(v[j].x * r2 * gg.x, v[j].y * r2 * gg.y); w.y = pk2(v[j].z * r2 * gg.z, v[j].w * r2 * gg.w); o[64 * j] = w; }
        }
    }
}

__device__ __forceinline__ void rwkv_phase(const Params& P, int layer, unsigned char* smem) {
    float* VEC = (float*)smem;
    bf16_t* UPT = (bf16_t*)(smem + 98304);
    unsigned char* pbase = smem + 98304 + 18432;
    const int tid = opaque_tid(), wid = tid >> 6, lane = tid & 63, r16 = lane & 15, quad = lane >> 4;
    const bf16_t* proj = (const bf16_t*)(P.ws + OFF_PROJ);
    bf16_t* YB = (bf16_t*)(P.ws + OFF_U);
    float* BON = (float*)(P.ws + OFF_BON);
    const float* mu = P.in[11] + (size_t)layer * 2 * 3328;
    for (int chain = opaque_bid(); chain < 256; chain += gridDim.x) {
        const int d = chain >> 7, b = (chain >> 4) & 7, h = chain & 15;
        __syncthreads();
        { const float* wup = P.in[13] + ((size_t)(layer * 2 + d) * 64) * 1024 + h * 64; const float* aup = P.in[15] + ((size_t)(layer * 2 + d) * 64) * 1024 + h * 64;
#pragma unroll
          for (int it = 0; it < 16; ++it) { const int e = tid + 512 * it; const int mat = e >> 12, lora = (e >> 6) & 63, ch = e & 63;
              const float v = (mat ? aup : wup)[(size_t)lora * 1024 + ch]; UPT[mat * 4608 + ch * 72 + lora] = f2bf(v); } }
        __syncthreads();
        if (wid < 4) {
            const int i = tid >> 2, q = tid & 3;
            float Sx[16];
#pragma unroll
            for (int j = 0; j < 16; ++j) Sx[j] = 0.f;
            __syncthreads();
            for (int c = 0; c < 64; ++c) {
                const float* vb = VEC + (c & 1) * (32 * 384);
#pragma unroll 2
                for (int s = 0; s < 32; ++s) {
                    const float4* V4 = (const float4*)(vb + s * 384) + q * 4;
                    float4 nk[4], w[4], ka[4], km[4], rv[4];
#pragma unroll
                    for (int e = 0; e < 4; ++e) { nk[e] = V4[e]; w[e] = V4[16 + e]; ka[e] = V4[32 + e]; km[e] = V4[48 + e]; rv[e] = V4[64 + e]; }
                    const float vi = vb[s * 384 + 320 + i];
                    float sa = 0.f;
#pragma unroll
                    for (int e = 0; e < 4; ++e) { sa += Sx[4 * e] * nk[e].x; sa += Sx[4 * e + 1] * nk[e].y; sa += Sx[4 * e + 2] * nk[e].z; sa += Sx[4 * e + 3] * nk[e].w; }
                    sa += dpp_xor1(sa); sa += dpp_xor2(sa);
                    float y = 0.f;
#pragma unroll
                    for (int e = 0; e < 4; ++e) {
                        Sx[4 * e]     = Sx[4 * e]     * w[e].x + (sa * ka[e].x + vi * km[e].x); y += Sx[4 * e]     * rv[e].x;
                        Sx[4 * e + 1] = Sx[4 * e + 1] * w[e].y + (sa * ka[e].y + vi * km[e].y); y += Sx[4 * e + 1] * rv[e].y;
                        Sx[4 * e + 2] = Sx[4 * e + 2] * w[e].z + (sa * ka[e].z + vi * km[e].z); y += Sx[4 * e + 2] * rv[e].z;
                        Sx[4 * e + 3] = Sx[4 * e + 3] * w[e].w + (sa * ka[e].w + vi * km[e].w); y += Sx[4 * e + 3] * rv[e].w;
                    }
                    y += dpp_xor1(y); y += dpp_xor2(y);
                    const int n = c * 32 + s; const int t = d ? (S - 1 - n) : n;
                    if (q == 0) YB[((size_t)d * M + (size_t)b * S + t) * 1024 + h * 64 + i] = f2bf(y);
                }
                __syncthreads();
            }
        } else {
            const int pw = wid - 4;
            bf16_t* Aw = (bf16_t*)(pbase + pw * 6400); bf16_t* Aa = Aw + 8 * 72; float* X = (float*)(pbase + pw * 6400 + 2304);
            const int cr = h * 64 + lane, ck = 1024 + h * 64 + lane, cv = 2048 + h * 64 + lane, cw = 3072 + d * 64 + lane, ca = 3200 + d * 64 + lane;
            const float mr0 = mu[cr], mr1 = mu[3328 + cr], mk0 = mu[ck], mk1 = mu[3328 + ck], mv0 = mu[cv], mv1 = mu[3328 + cv];
            const float mw0 = mu[cw], mw1 = mu[3328 + cw], ma0 = mu[ca], ma1 = mu[3328 + ca];
            const int chn = h * 64 + lane;
            const float w0v = P.in[12][(size_t)(layer * 2 + d) * 1024 + chn], a0v = P.in[14][(size_t)(layer * 2 + d) * 1024 + chn];
            const float kkw = P.in[16][(size_t)layer * 1024 + chn], kaw = P.in[17][(size_t)layer * 1024 + chn], rkw = P.in[18][(size_t)layer * 1024 + chn];
            for (int c = 0; c < 65; ++c) {
                if (c < 64) {
                    float* vb = VEC + (c & 1) * (32 * 384);
                    float rr[8], kv[8], vv[8], kk[8];
#pragma unroll
                    for (int i = 0; i < 8; ++i) {
                        const int n = c * 32 + pw * 8 + i; const int t = d ? (S - 1 - n) : n;
                        const bf16_t* row = proj + ((size_t)b * S + t) * PW + C_B;
                        const bool hp = t > 0, hn = t < S - 1;
                        const bf16_t* rowp = hp ? row - PW : row; const bf16_t* rown = hn ? row + PW : row;
                        const float fp = hp ? 1.f : 0.f, fn = hn ? 1.f : 0.f;
                        float p0, pm, pn;
                        p0 = bf2f(row[cr]); pm = fp * bf2f(rowp[cr]); pn = fn * bf2f(rown[cr]); rr[i] = p0 + mr0 * (pm - p0) + mr1 * (pn - p0);
                        p0 = bf2f(row[ck]); pm = fp * bf2f(rowp[ck]); pn = fn * bf2f(rown[ck]); kv[i] = p0 + mk0 * (pm - p0) + mk1 * (pn - p0);
                        p0 = bf2f(row[cv]); pm = fp * bf2f(rowp[cv]); pn = fn * bf2f(rown[cv]); vv[i] = p0 + mv0 * (pm - p0) + mv1 * (pn - p0);
                        p0 = bf2f(row[cw]); pm = fp * bf2f(rowp[cw]); pn = fn * bf2f(rown[cw]); const float wd = p0 + mw0 * (pm - p0) + mw1 * (pn - p0);
                        p0 = bf2f(row[ca]); pm = fp * bf2f(rowp[ca]); pn = fn * bf2f(rown[ca]); const float ad = p0 + ma0 * (pm - p0) + ma1 * (pn - p0);
                        Aw[i * 72 + lane] = f2bf(tanhf(wd)); Aa[i * 72 + lane] = f2bf(ad);
                        const float k2 = kv[i] * kkw; const float n2 = wave_sum(k2 * k2);
                        kk[i] = k2 / fmaxf(sqrtf(n2), 1e-12f);
                    }
                    asm volatile("s_waitcnt lgkmcnt(0)" ::: "memory");
#pragma unroll
                    for (int mat = 0; mat < 2; ++mat) {
                        const bf16_t* A = mat ? Aa : Aw;
                        const bf16x8 a0f = *(const bf16x8*)(A + (r16 & 7) * 72 + quad * 8), a1f = *(const bf16x8*)(A + (r16 & 7) * 72 + 32 + quad * 8);
#pragma unroll
                        for (int nt = 0; nt < 4; ++nt) {
                            const bf16_t* B = UPT + mat * 4608 + (nt * 16 + r16) * 72 + quad * 8;
                            f32x4 acc = {0.f, 0.f, 0.f, 0.f};
                            acc = MFMA16(a0f, *(const bf16x8*)B, acc); acc = MFMA16(a1f, *(const bf16x8*)(B + 32), acc);
                            if (quad < 2) {
#pragma unroll
                                for (int rg = 0; rg < 4; ++rg) X[mat * 512 + (quad * 4 + rg) * 64 + nt * 16 + r16] = acc[rg];
                            }
                        }
                    }
                    asm volatile("s_waitcnt lgkmcnt(0)" ::: "memory");
#pragma unroll
                    for (int i = 0; i < 8; ++i) {
                        const int s = pw * 8 + i; const int n = c * 32 + s; const int t = d ? (S - 1 - n) : n;
                        const float xw = X[i * 64 + lane] + w0v, xa = X[512 + i * 64 + lane] + a0v;
                        const float dec = __expf(-0.6065306597126334f * sigmoidf_(xw)); const float av = sigmoidf_(xa);
                        const float kmod = kv[i] * (1.f + (av - 1.f) * kaw); const float kka = kk[i] * av;
                        float* o = vb + s * 384 + lane;
                        o[0] = -kk[i]; o[64] = dec; o[128] = kka; o[192] = kmod; o[256] = rr[i]; o[320] = vv[i];
                        const float bon = wave_sum(rr[i] * kmod * rkw);
                        if (lane == 0) BON[((size_t)d * M + (size_t)b * S + t) * 16 + h] = bon;
                    }
                }
                __syncthreads();
            }
        }
    }
}

__device__ __forceinline__ void hgrn_phase(const Params& P, int layer, unsigned char* smem) {
    bf16_t* QE = (bf16_t*)smem; bf16_t* KE = (bf16_t*)(smem + 8704); bf16_t* KLT = (bf16_t*)(smem + 17408); bf16_t* VT = (bf16_t*)(smem + 27648);
    float* CUMF = (float*)(smem + 37888); float* KV = (float*)(smem + 54272); float* EL = (float*)(smem + 70656);
    const int tid = opaque_tid(), wid = tid >> 6, lane = tid & 63, r16 = lane & 15, quad = lane >> 4;
    const bf16_t* proj = (const bf16_t*)(P.ws + OFF_PROJ);
    bf16_t* OC = (bf16_t*)(P.ws + OFF_OC);
    for (int chain = opaque_bid(); chain < 128; chain += gridDim.x) {
        const int d = chain >> 6, b = (chain >> 3) & 7, h = chain & 7;
        float lb = 0.f;
        if (layer > 0 && tid < 128) { const float l0 = P.in[21][(size_t)(d * 2 + 0) * 1024 + h * 128 + tid], l1 = P.in[21][(size_t)(d * 2 + 1) * 1024 + h * 128 + tid]; lb = 1.f / (1.f + __expf(l0 - l1)); }
        f32x4 Sacc[8];
#pragma unroll
        for (int mt = 0; mt < 8; ++mt) Sacc[mt] = (f32x4){0.f, 0.f, 0.f, 0.f};
        for (int c = 0; c < 64; ++c) {
            __syncthreads();
            if (tid < 128) {
                float zz[32];
#pragma unroll
                for (int s = 0; s < 32; ++s) { const int n = c * 32 + s; const int t = d ? (S - 1 - n) : n; zz[s] = bf2f(proj[((size_t)b * S + t) * PW + C_CF + d * 1024 + h * 128 + tid]); }
                float cum = 0.f;
#pragma unroll
                for (int s = 0; s < 32; ++s) {
                    const float z = zz[s];
                    const float ls = fminf(z, 0.f) - log1pf(__expf(-fabsf(z)));
                    const float lf = (lb > 0.f) ? __logf(lb + (1.f - lb) * __expf(ls)) : ls;
                    cum += lf; CUMF[s * 128 + tid] = cum; KV[s * 128 + tid] = (1.f - lb) / (1.f + __expf(z));
                }
                EL[tid] = __expf(cum);
            } else {
                for (int e = tid - 128; e < 4096; e += 384) { const int s = e >> 7, v = e & 127; const int n = c * 32 + s; const int t = d ? (S - 1 - n) : n;
                    VT[v * 40 + s] = proj[((size_t)b * S + t) * PW + C_CI + h * 128 + v]; }
            }
            __syncthreads();
#pragma unroll
            for (int it = 0; it < 8; ++it) { const int e = tid + 512 * it; const int s = e >> 7, k = e & 127; const int n = c * 32 + s; const int t = d ? (S - 1 - n) : n;
                const float qv = bf2f(proj[((size_t)b * S + t) * PW + C_CQ + h * 128 + k]);
                const float cum = CUMF[s * 128 + k], last = CUMF[31 * 128 + k], kval = KV[s * 128 + k];
                QE[s * 136 + k] = f2bf(qv * __expf(cum)); KE[s * 136 + k] = f2bf(kval * __expf(-cum)); KLT[k * 40 + s] = f2bf(kval * __expf(last - cum)); }
            __syncthreads();
            f32x4 sc00 = {0.f, 0.f, 0.f, 0.f}, sc01 = sc00, sc11 = sc00;
#pragma unroll
            for (int ks = 0; ks < 4; ++ks) {
                const bf16x8 ke0 = *(const bf16x8*)(KE + r16 * 136 + ks * 32 + quad * 8), ke1 = *(const bf16x8*)(KE + (16 + r16) * 136 + ks * 32 + quad * 8);
                const bf16x8 qe0 = *(const bf16x8*)(QE + r16 * 136 + ks * 32 + quad * 8), qe1 = *(const bf16x8*)(QE + (16 + r16) * 136 + ks * 32 + quad * 8);
                sc00 = MFMA16(ke0, qe0, sc00); sc01 = MFMA16(ke0, qe1, sc01); sc11 = MFMA16(ke1, qe1, sc11);
            }
#pragma unroll
            for (int rg = 0; rg < 4; ++rg) { if (quad * 4 + rg > r16) { sc00[rg] = 0.f; sc11[rg] = 0.f; } }
            const f32x4 zero4 = {0.f, 0.f, 0.f, 0.f};
            const bf16x8 p0 = pack8(sc00, zero4), p1 = pack8(sc01, sc11);
            const bf16_t* vrow = VT + (wid * 16 + r16) * 40;
            const bf16x8 vperm = join8(*(const s16x4*)(vrow + quad * 4), *(const s16x4*)(vrow + 16 + quad * 4));
            f32x4 o0 = MFMA16(p0, vperm, zero4), o1 = MFMA16(p1, vperm, zero4);
#pragma unroll
            for (int ks = 0; ks < 4; ++ks) {
                const bf16x8 sb = pack8(Sacc[2 * ks], Sacc[2 * ks + 1]);
                const bf16_t* q0p = QE + r16 * 136 + ks * 32 + quad * 4; const bf16_t* q1p = QE + (16 + r16) * 136 + ks * 32 + quad * 4;
                const bf16x8 qa0 = join8(*(const s16x4*)q0p, *(const s16x4*)(q0p + 16)), qa1 = join8(*(const s16x4*)q1p, *(const s16x4*)(q1p + 16));
                o0 = MFMA16(qa0, sb, o0); o1 = MFMA16(qa1, sb, o1);
            }
#pragma unroll
            for (int rg = 0; rg < 4; ++rg) {
                { const int n = c * 32 + quad * 4 + rg; const int t = d ? (S - 1 - n) : n; OC[((size_t)d * M + (size_t)b * S + t) * 1024 + h * 128 + wid * 16 + r16] = f2bf(o0[rg]); }
                { const int n = c * 32 + 16 + quad * 4 + rg; const int t = d ? (S - 1 - n) : n; OC[((size_t)d * M + (size_t)b * S + t) * 1024 + h * 128 + wid * 16 + r16] = f2bf(o1[rg]); }
            }
            const bf16x8 vnat = *(const bf16x8*)(vrow + quad * 8);
#pragma unroll
            for (int mt = 0; mt < 8; ++mt) {
                const f32x4 el = *(const f32x4*)(EL + mt * 16 + quad * 4);
                f32x4 sa = Sacc[mt] * el;
                const bf16x8 kl = *(const bf16x8*)(KLT + (mt * 16 + r16) * 40 + quad * 8);
                Sacc[mt] = MFMA16(kl, vnat, sa);
            }
        }
    }
}

__device__ __forceinline__ void attn_phase(const Params& P, int layer, unsigned char* smem, unsigned* counter) {
    float* TAB = (float*)smem; bf16_t* KT = (bf16_t*)(smem + 16384); bf16_t* VTt = (bf16_t*)(smem + 16384 + 9216); int* sh_unit = (int*)(smem + 16384 + 9216 + 18432);
    const int tid = opaque_tid(), wid = tid >> 6, lane = tid & 63, r16 = lane & 15, quad = lane >> 4;
    const bf16_t* proj = (const bf16_t*)(P.ws + OFF_PROJ);
    bf16_t* AO = (bf16_t*)(P.ws + OFF_AO);
    const float* rel_bias = P.in[1];
    const float c1 = 0.125f * LOG2E;
    for (;;) {
        __syncthreads();
        if (tid == 0) *sh_unit = (int)atomicAdd(counter, 1u);
        __syncthreads();
        const int u = *sh_unit;
        if (u >= 1024) break;
        const int qb = u & 7, m = (u >> 3) & 1, h = (u >> 4) & 7, b = u >> 7;
        for (int e = tid; e < 4095; e += 512) { const int rel = e - 2047; const int n = rel < 0 ? -rel : rel; int bk;
            if (n < 8) bk = n; else { const int lg = 31 - __clz(n * n); bk = 2 + lg; if (bk > 15) bk = 15; }
            if (rel > 0) bk += 16; TAB[e] = rel_bias[bk * 8 + h] * LOG2E; }
        const int qrow0 = qb * 256 + wid * 32;
        bf16x8 Qf[2][2];
#pragma unroll
        for (int nq = 0; nq < 2; ++nq)
#pragma unroll
            for (int ks = 0; ks < 2; ++ks) Qf[nq][ks] = *(const bf16x8*)(proj + ((size_t)b * S + qrow0 + nq * 16 + r16) * PW + C_AQ + h * 128 + m * 64 + ks * 32 + quad * 8);
        f32x4 O[2][8];
#pragma unroll
        for (int nq = 0; nq < 2; ++nq)
#pragma unroll
            for (int dt = 0; dt < 8; ++dt) O[nq][dt] = (f32x4){0.f, 0.f, 0.f, 0.f};
        float mrun[2] = {-1e30f, -1e30f}, lrun[2] = {0.f, 0.f};
        const int kkey = tid >> 3, kchunk = tid & 7;
        const int vkp = tid & 31, vchunk = tid >> 5;
        const bf16_t* kbase = proj + ((size_t)b * S + kkey) * PW + C_AK + h * 128 + m * 64 + kchunk * 8;
        const bf16_t* vbase = proj + ((size_t)b * S + 2 * vkp) * PW + C_AV + h * 128 + vchunk * 8;
        u32x4 kreg = *(const u32x4*)kbase, vreg0 = *(const u32x4*)vbase, vreg1 = *(const u32x4*)(vbase + PW);
        for (int kt = 0; kt < 32; ++kt) {
            __syncthreads();
            *(u32x4*)(KT + kkey * 72 + kchunk * 8) = kreg;
            { unsigned* vd = (unsigned*)(VTt + (vchunk * 8) * 72 + 2 * vkp);
#pragma unroll
              for (int i2 = 0; i2 < 4; ++i2) { const unsigned a = vreg0[i2], bq = vreg1[i2];
                  vd[(2 * i2) * 36] = (a & 0xFFFFu) | (bq << 16); vd[(2 * i2 + 1) * 36] = (a >> 16) | (bq & 0xFFFF0000u); } }
            __syncthreads();
            if (kt + 1 < 32) { const size_t adv = (size_t)(kt + 1) * 64 * PW; kreg = *(const u32x4*)(kbase + adv); vreg0 = *(const u32x4*)(vbase + adv); vreg1 = *(const u32x4*)(vbase + adv + PW); }
            const int k0 = kt * 64;
            f32x4 st[2][4];
#pragma unroll
            for (int mt = 0; mt < 4; ++mt) {
                const bf16x8 ka = *(const bf16x8*)(KT + (mt * 16 + r16) * 72 + quad * 8), kb2 = *(const bf16x8*)(KT + (mt * 16 + r16) * 72 + 32 + quad * 8);
#pragma unroll
                for (int nq = 0; nq < 2; ++nq) { f32x4 a = {0.f, 0.f, 0.f, 0.f}; a = MFMA16(ka, Qf[nq][0], a); a = MFMA16(kb2, Qf[nq][1], a); st[nq][mt] = a; }
            }
            const bool posfar = (k0 - (qrow0 + 31)) >= 96, negfar = (qrow0 - (k0 + 63)) >= 96;
            if (posfar || negfar) {
                const float cb = posfar ? TAB[2047 + 128] : TAB[2047 - 128];
#pragma unroll
                for (int nq = 0; nq < 2; ++nq)
#pragma unroll
                    for (int mt = 0; mt < 4; ++mt) st[nq][mt] = st[nq][mt] * c1 + cb;
            } else {
#pragma unroll
                for (int nq = 0; nq < 2; ++nq)
#pragma unroll
                    for (int mt = 0; mt < 4; ++mt) { const float* tp = TAB + (k0 + mt * 16 + quad * 4) - (qrow0 + nq * 16 + r16) + 2047;
#pragma unroll
                        for (int rg = 0; rg < 4; ++rg) st[nq][mt][rg] = st[nq][mt][rg] * c1 + tp[rg]; }
            }
            bf16x8 pf[2][2];
#pragma unroll
            for (int nq = 0; nq < 2; ++nq) {
                float mx = st[nq][0][0];
#pragma unroll
                for (int mt = 0; mt < 4; ++mt)
#pragma unroll
                    for (int rg = 0; rg < 4; ++rg) mx = fmaxf(mx, st[nq][mt][rg]);
                mx = fmaxf(mx, __shfl_xor(mx, 16)); mx = fmaxf(mx, __shfl_xor(mx, 32));
                const float mnew = fmaxf(mrun[nq], mx); const float alpha = __builtin_amdgcn_exp2f(mrun[nq] - mnew); mrun[nq] = mnew;
                float ps = 0.f;
#pragma unroll
                for (int mt = 0; mt < 4; ++mt)
#pragma unroll
                    for (int rg = 0; rg < 4; ++rg) { const float pv = __builtin_amdgcn_exp2f(st[nq][mt][rg] - mnew); st[nq][mt][rg] = pv; ps += pv; }
                lrun[nq] = lrun[nq] * alpha + ps;
#pragma unroll
                for (int dt = 0; dt < 8; ++dt) O[nq][dt] = O[nq][dt] * alpha;
                pf[nq][0] = pack8(st[nq][0], st[nq][1]); pf[nq][1] = pack8(st[nq][2], st[nq][3]);
            }
#pragma unroll
            for (int dt = 0; dt < 8; ++dt) {
                const bf16_t* vr = VTt + (dt * 16 + r16) * 72 + quad * 4;
                const bf16x8 va0 = join8(*(const s16x4*)vr, *(const s16x4*)(vr + 16)), va1 = join8(*(const s16x4*)(vr + 32), *(const s16x4*)(vr + 48));
#pragma unroll
                for (int nq = 0; nq < 2; ++nq) { O[nq][dt] = MFMA16(va0, pf[nq][0], O[nq][dt]); O[nq][dt] = MFMA16(va1, pf[nq][1], O[nq][dt]); }
            }
        }
#pragma unroll
        for (int nq = 0; nq < 2; ++nq) {
            float l = lrun[nq]; l += __shfl_xor(l, 16); l += __shfl_xor(l, 32);
            const float inv = 1.f / l;
            bf16_t* orow = AO + ((size_t)m * M + (size_t)b * S + qrow0 + nq * 16 + r16) * 1024 + h * 128 + quad * 4;
#pragma unroll
            for (int dt = 0; dt < 8; ++dt) { u32x2 w; w.x = pk2(O[nq][dt][0] * inv, O[nq][dt][1] * inv); w.y = pk2(O[nq][dt][2] * inv, O[nq][dt][3] * inv); *(u32x2*)(orow + dt * 16) = w; }
        }
    }
}

__device__ __forceinline__ void load16(const bf16_t* p, float* o) {
    const u32x4 a = *(const u32x4*)p, b = *(const u32x4*)(p + 8);
#pragma unroll
    for (int i = 0; i < 4; ++i) { o[2 * i] = __uint_as_float(a[i] << 16); o[2 * i + 1] = __uint_as_float(a[i] & 0xFFFF0000u); o[8 + 2 * i] = __uint_as_float(b[i] << 16); o[8 + 2 * i + 1] = __uint_as_float(b[i] & 0xFFFF0000u); }
}
__device__ __forceinline__ void store16(bf16_t* p, const float* v) {
    u32x4 a, b; a.x = pk2(v[0], v[1]); a.y = pk2(v[2], v[3]); a.z = pk2(v[4], v[5]); a.w = pk2(v[6], v[7]); b.x = pk2(v[8], v[9]); b.y = pk2(v[10], v[11]); b.z = pk2(v[12], v[13]); b.w = pk2(v[14], v[15]);
    *(u32x4*)p = a; *(u32x4*)(p + 8) = b;
}
__device__ __forceinline__ void loadf16(const float* p, float* o) {
#pragma unroll
    for (int i = 0; i < 4; ++i) { const float4 v = ((const float4*)p)[i]; o[4 * i] = v.x; o[4 * i + 1] = v.y; o[4 * i + 2] = v.z; o[4 * i + 3] = v.w; }
}
__device__ __forceinline__ void finish_phase(const Params& P, int layer) {
    const int tid_ = opaque_tid(); const int lane = tid_ & 63, gw = opaque_bid() * 8 + (tid_ >> 6), ngw = gridDim.x * 8;
    const bf16_t* proj = (const bf16_t*)(P.ws + OFF_PROJ);
    const bf16_t* AO = (const bf16_t*)(P.ws + OFF_AO); const bf16_t* YB = (const bf16_t*)(P.ws + OFF_U); const bf16_t* OC = (const bf16_t*)(P.ws + OFF_OC);
    const float* BON = (const float*)(P.ws + OFF_BON);
    bf16_t* MIX = (bf16_t*)(P.ws + OFF_MIXED);
    const float lam_init = 0.8f - 0.6f * expf(-0.3f * (float)layer);
    const float s1 = wave_sum(P.in[6][layer * 64 + lane] * P.in[7][layer * 64 + lane]), s2 = wave_sum(P.in[8][layer * 64 + lane] * P.in[9][layer * 64 + lane]);
    const float lam = expf(s1) - expf(s2) + lam_init;
    const int c0 = lane * 16;
    const float* mu0p = P.in[11] + (size_t)layer * 2 * 3328 + 2048 + c0; const float* mu1p = mu0p + 3328;
    for (int tok = gw; tok < M; tok += ngw) {
        const bf16_t* prow = proj + (size_t)tok * PW;
        bf16_t* mrow = MIX + (size_t)tok * MIXW;
        float a[16], bb[16], g[16], pr[16];
        load16(AO + (size_t)tok * 1024 + c0, a); load16(AO + ((size_t)M + tok) * 1024 + c0, bb); load16(prow + C_AG + c0, g);
        { float ss = 0.f;
#pragma unroll
          for (int i = 0; i < 16; ++i) { a[i] = a[i] - lam * bb[i]; ss += a[i] * a[i]; }
          ss += __shfl_xor(ss, 1); ss += __shfl_xor(ss, 2); ss += __shfl_xor(ss, 4);
          const float rstd = rsqrtf(ss * (1.f / 128.f) + 1e-5f) * (1.f - lam_init);
          loadf16(P.in[10] + layer * 128 + (c0 & 127), pr);
#pragma unroll
          for (int i = 0; i < 16; ++i) a[i] = a[i] * rstd * pr[i] * siluf_(g[i]);
          store16(mrow + c0, a); }
        load16(YB + (size_t)tok * 1024 + c0, a); load16(YB + ((size_t)M + tok) * 1024 + c0, bb); load16(prow + C_BG + c0, g);
        { float sm = 0.f;
#pragma unroll
          for (int i = 0; i < 16; ++i) { a[i] += bb[i]; sm += a[i]; }
          sm += __shfl_xor(sm, 1); sm += __shfl_xor(sm, 2);
          const float mean = sm * (1.f / 64.f); float vs = 0.f;
#pragma unroll
          for (int i = 0; i < 16; ++i) { a[i] -= mean; vs += a[i] * a[i]; }
          vs += __shfl_xor(vs, 1); vs += __shfl_xor(vs, 2);
          const float rstd = rsqrtf(vs * (1.f / 64.f) + 64e-5f);
          const int head = lane >> 2;
          const float bon = BON[(size_t)tok * 16 + head] + BON[((size_t)M + tok) * 16 + head];
          const int sp = tok & (S - 1);
          loadf16(P.in[19] + layer * 1024 + c0, pr);
#pragma unroll
          for (int i = 0; i < 16; ++i) a[i] = a[i] * rstd * pr[i];
          loadf16(P.in[20] + layer * 1024 + c0, pr);
#pragma unroll
          for (int i = 0; i < 16; ++i) a[i] += pr[i];
          load16(prow + C_B + 2048 + c0, bb);
          float vsft[16];
          { float nb[16];
            if (sp > 0) load16(prow - PW + C_B + 2048 + c0, nb); else {
#pragma unroll
                for (int i = 0; i < 16; ++i) nb[i] = 0.f; }
            loadf16(mu0p, pr);
#pragma unroll
            for (int i = 0; i < 16; ++i) vsft[i] = bb[i] + pr[i] * (nb[i] - bb[i]);
            if (sp < S - 1) load16(prow + PW + C_B + 2048 + c0, nb); else {
#pragma unroll
                for (int i = 0; i < 16; ++i) nb[i] = 0.f; }
            loadf16(mu1p, pr);
#pragma unroll
            for (int i = 0; i < 16; ++i) vsft[i] += pr[i] * (nb[i] - bb[i]); }
#pragma unroll
          for (int i = 0; i < 16; ++i) a[i] = (a[i] + bon * vsft[i]) * siluf_(g[i]);
          store16(mrow + 1024 + c0, a); }
        load16(OC + (size_t)tok * 1024 + c0, a); load16(OC + ((size_t)M + tok) * 1024 + c0, bb); load16(prow + C_CG + c0, g);
        { float ss = 0.f;
#pragma unroll
          for (int i = 0; i < 16; ++i) { a[i] += bb[i]; ss += a[i] * a[i]; }
          ss += __shfl_xor(ss, 1); ss += __shfl_xor(ss, 2); ss += __shfl_xor(ss, 4);
          const float rstd = rsqrtf(ss * (1.f / 128.f) + 1e-6f);
          loadf16(P.in[22] + layer * 128 + (c0 & 127), pr);
#pragma unroll
          for (int i = 0; i < 16; ++i) a[i] = a[i] * rstd * pr[i] * siluf_(g[i]);
          store16(mrow + 2048 + c0, a); }
    }
}

__global__ void __launch_bounds__(NTHR, 2) fwd_megakernel(Params P) {
    extern __shared__ __attribute__((aligned(16))) unsigned char smem[];
    cg::grid_group grid = cg::this_grid();
    unsigned* ctl = (unsigned*)(P.ws + OFF_CTL);
    bf16_t* U = (bf16_t*)(P.ws + OFF_U);
    float* Y = (float*)(P.ws + OFF_PROJ);
    convert_weights(P, 0, smem);
    prenorm_rows(P.in[0], P.in[2], U);
    grid.sync();
#pragma unroll 1
    for (int layer = 0; layer < DEPTH; ++layer) {
        { pg8::Gemm g; g.A = U; g.Bt = (const bf16_t*)(P.ws + OFF_WIN); g.M = opaque_s(M); g.N = opaque_s(PW); g.K = opaque_s(D);
          pg8::StaticOrder So; So.init(g.M, g.N, (int)gridDim.x, opaque_bid());
          pg8::EpiBf16<0> E; E.O = (bf16_t*)(P.ws + OFF_PROJ); E.ldc = g.N; E.bias = nullptr; E.split_cols = 0; E.split_stride = 0;
          pg8::gemm_phase<pg8::EpiBf16<0>, pg8::StaticOrder, false>((PG8_LAS unsigned char*)smem, g, So, E, nullptr); }
        grid.sync();
        rwkv_phase(P, layer, smem);
        hgrn_phase(P, layer, smem);
        attn_phase(P, layer, smem, ctl + 64 * layer);
        grid.sync();
        finish_phase(P, layer);
        grid.sync();
        { pg8::Gemm g; g.A = (const bf16_t*)(P.ws + OFF_MIXED); g.Bt = (const bf16_t*)(P.ws + OFF_WOUT); g.M = opaque_s(M); g.N = opaque_s(D); g.K = opaque_s(MIXW);
          pg8::StaticOrder So; So.init(g.M, g.N, (int)gridDim.x, opaque_bid());
          pg8::EpiF32 E; E.C = Y; E.ldc = g.N; E.bias = nullptr;
          pg8::gemm_phase<pg8::EpiF32, pg8::StaticOrder, false>((PG8_LAS unsigned char*)smem, g, So, E, nullptr); }
        grid.sync();
        if (layer + 1 < DEPTH) {
            postnorm_rows(Y, layer == 0 ? P.in[0] : P.out, P.out, P.in[3] + layer * D, P.in[2] + (layer + 1) * D, U);
            convert_weights(P, layer + 1, smem);
            grid.sync();
        } else {
            postnorm_rows(Y, layer == 0 ? P.in[0] : P.out, P.out, P.in[3] + layer * D, nullptr, U);
        }
    }
}
}

extern "C" void kernel_launch(void* const* d_in, const int* in_sizes, int n_in, void* d_out, int out_size, void* d_ws, size_t ws_size, hipStream_t stream) {
    static int grid_blocks = 0;
    if (grid_blocks == 0) {
        int dev = 0, cus = 0, per_cu = 0;
        hipGetDevice(&dev);
        hipDeviceGetAttribute(&cus, hipDeviceAttributeMultiprocessorCount, dev);
        if (hipFuncSetAttribute((const void*)mk::fwd_megakernel, hipFuncAttributeMaxDynamicSharedMemorySize, mk::LDS_BYTES) != hipSuccess) fprintf(stderr, "hipFuncSetAttribute failed\n");
        if (hipOccupancyMaxActiveBlocksPerMultiprocessor(&per_cu, (const void*)mk::fwd_megakernel, mk::NTHR, mk::LDS_BYTES) != hipSuccess || per_cu < 1) { fprintf(stderr, "occupancy query: %d\n", per_cu); per_cu = 1; }
        (void)hipGetLastError();
        grid_blocks = cus * 1;
        if (ws_size < mk::WS_END) fprintf(stderr, "workspace too small: %zu < %zu\n", ws_size, (size_t)mk::WS_END);
    }
    hipMemsetAsync((unsigned char*)d_ws + mk::OFF_CTL, 0, 4096, stream);
    mk::Params p{};
    for (int i = 0; i < 23; ++i) p.in[i] = (const float*)d_in[i];
    p.out = (float*)d_out; p.ws = (unsigned char*)d_ws;
    void* args[] = {&p};
    hipError_t e = hipLaunchCooperativeKernel((const void*)mk::fwd_megakernel, dim3(grid_blocks), dim3(mk::NTHR), args, mk::LDS_BYTES, stream);
    if (e != hipSuccess) fprintf(stderr, "cooperative launch failed: %s (grid %d)\n", hipGetErrorString(e), grid_blocks);
}
```

```cpp
#include <hip/hip_runtime.h>
#include <hip/hip_cooperative_groups.h>
#include <cstdio>
#include <cstdint>
namespace cg = cooperative_groups;
namespace pg8 {
#define PG8_LAS __attribute__((address_space(3)))
typedef unsigned short bf16_t;
typedef short bf16x8 __attribute__((ext_vector_type(8)));
typedef float f32x4 __attribute__((ext_vector_type(4)));
typedef unsigned u32x4 __attribute__((ext_vector_type(4)));
constexpr int BM = 256, BK = 64, HALF = 128, HTB = HALF * BK * 2  , STAGE_BYTES = 8 * HTB, NXCD = 8, WGM = 8;

__host__ __device__ __forceinline__ int lds_byte(int r, int c) { const int st = (r >> 4) * 2 + (c >> 5), rr = r & 15, cc = c & 31, ob = rr * 64 + cc * 2; return st * 1024 + (ob ^ (((ob >> 9) & 1) << 5)); }
__host__ __device__ __forceinline__ void stage_rc(int b, int& R, int& C) { const int st = b / 1024, sb = b % 1024, swz = sb ^ (((sb >> 9) & 1) << 5); R = (st >> 1) * 16 + swz / 64; C = (st & 1) * 32 + (swz % 64) / 2; }
__host__ __device__ __forceinline__ int perm32(int rho) { const int n = rho >> 4, i = rho & 15; return 8 * (i >> 2) + 4 * n + (i & 3); }

struct Unit { int pm, pn; };
struct Gemm { const bf16_t* A; const bf16_t* Bt; int M, N, K; };

struct StaticOrder {
    int nM, nN, nwg, G, c;
    __host__ __device__ void init(int M, int N, int G_, int c_) { nM = M / BM; nN = N / BM; nwg = nM * nN; G = G_; c = c_; }
    __host__ __device__ bool next(int i, Unit& u) const {
        const long L = (long)i * G + c; if (L >= nwg) return false;
        int wgid = (int)L; { const int q = nwg / NXCD, r = nwg % NXCD, xcd = wgid % NXCD, off = wgid / NXCD; wgid = (xcd < r ? xcd * (q + 1) : r * (q + 1) + (xcd - r) * q) + off; }
        const int nig = WGM * nN, gid = wgid / nig, fm = gid * WGM, gsz = (nM - fm) < WGM ? (nM - fm) : WGM;
        u.pm = fm + ((wgid % nig) % gsz); u.pn = (wgid % nig) / gsz; return true;
    }
    __device__ __forceinline__ void a_ready(const Unit&) const {}
    __device__ __forceinline__ void done(const Unit&) const {}
};
struct CountedOrder : StaticOrder {
    const unsigned* ready; unsigned need; unsigned* tmo;
    __device__ __forceinline__ void a_ready(const Unit& u) const {
        if (threadIdx.x < 64) {
            const unsigned long long t0 = __builtin_amdgcn_s_memrealtime(); unsigned polls = 0;
            while ((unsigned)__builtin_amdgcn_readfirstlane(__hip_atomic_load(ready + 64 * u.pm, __ATOMIC_RELAXED, __HIP_MEMORY_SCOPE_AGENT)) < need) {
                if ((++polls & 255u) == 0u && __builtin_amdgcn_readfirstlane(__hip_atomic_load(tmo, __ATOMIC_RELAXED, __HIP_MEMORY_SCOPE_AGENT)) != 0u) break;
                if (__builtin_amdgcn_s_memrealtime() - t0 > 2000000ull) {
                    if (threadIdx.x == 0) { unsigned expect = 0u; __hip_atomic_compare_exchange_strong(tmo + 1, &expect, 0x600u | (unsigned)(u.pm & 0xff), __ATOMIC_RELAXED, __ATOMIC_RELAXED, __HIP_MEMORY_SCOPE_AGENT); __hip_atomic_store(tmo, 1u, __ATOMIC_RELAXED, __HIP_MEMORY_SCOPE_AGENT); }
                    break; }
                __builtin_amdgcn_s_sleep(2); }
            __builtin_amdgcn_fence(__ATOMIC_ACQUIRE, "agent");
            asm volatile("s_waitcnt vmcnt(0)" ::: "memory");
        }
#if !defined(BROKEN_HOOK_NO_BARRIER)
        asm volatile("" ::: "memory"); __builtin_amdgcn_s_barrier(); asm volatile("" ::: "memory");
#endif
    }
};

typedef __bf16 bf16x2_t __attribute__((ext_vector_type(2)));
typedef float f32x2c __attribute__((ext_vector_type(2)));
__device__ __forceinline__ unsigned cvt_pk_bf16(float lo, float hi) { f32x2c v = {lo, hi}; bf16x2_t b = __builtin_convertvector(v, bf16x2_t); return __builtin_bit_cast(unsigned, b); }
typedef float f32x2 __attribute__((ext_vector_type(2)));
__device__ __forceinline__ f32x2 gelu_pk(f32x2 v) {
    const f32x2 av = __builtin_elementwise_abs(v), d = av * 0.2316418882f + 1.0f;
    f32x2 t; t.x = __builtin_amdgcn_rcpf(d.x); t.y = __builtin_amdgcn_rcpf(d.y);
    f32x2 q = t * 0.5307027145f + (-0.7265760135f); q = q * t + 0.7107068705f; q = q * t + (-0.142248368f); q = q * t + 0.127414796f; q = q * t;
    const f32x2 s = (v * v) * (-0.72134752044f);
    f32x2 e; e.x = __builtin_amdgcn_exp2f(s.x); e.y = __builtin_amdgcn_exp2f(s.y);
    const f32x2 m = v * (q * e), r = v - m;
    f32x2 o; o.x = v.x < 0.f ? m.x : r.x; o.y = v.y < 0.f ? m.y : r.y; return o;
}

struct EpiF32 {
    static constexpr bool PERM = false, AFTER_DRAIN = false;
    float* C; int ldc; const float* bias;
    __device__ __forceinline__ void operator()(const f32x4 (&acc)[2][2][4][2], const Unit& u, int wr, int wc, int fr, int fq) const {
        const int row0 = u.pm * BM + wr * 64 + fr, col0 = u.pn * BM + wc * 32 + 4 * fq;
        f32x4 bv[2][2];
#pragma unroll
        for (int bj = 0; bj < 2; ++bj)
#pragma unroll
            for (int n = 0; n < 2; ++n) bv[bj][n] = bias ? *(const f32x4*)(bias + col0 + bj * HALF + n * 16) : (f32x4){0.f, 0.f, 0.f, 0.f};
#pragma unroll
        for (int ai = 0; ai < 2; ++ai)
#pragma unroll
            for (int m = 0; m < 4; ++m) { float* rowp = C + (size_t)(row0 + ai * HALF + m * 16) * ldc + col0;
#pragma unroll
                for (int bj = 0; bj < 2; ++bj)
#pragma unroll
                    for (int n = 0; n < 2; ++n) *(f32x4*)(rowp + bj * HALF + n * 16) = acc[ai][bj][m][n] + bv[bj][n]; }
    }
};
template <int ACT  > struct EpiBf16 {
    static constexpr bool PERM = true, AFTER_DRAIN = false;
    bf16_t* O; int ldc; const float* bias; int split_cols; size_t split_stride;
    __device__ __forceinline__ void operator()(const f32x4 (&acc)[2][2][4][2], const Unit& u, int wr, int wc, int fr, int fq) const {
        const int row0 = u.pm * BM + wr * 64 + fr; int colt = u.pn * BM; bf16_t* base = O;
        if (split_cols) { const int t = colt / split_cols; base += (size_t)t * split_stride; colt -= t * split_cols; }
        const int col0 = colt + wc * 32 + 8 * fq, bcol0 = u.pn * BM + wc * 32 + 8 * fq;
        f32x4 bv[2][2];
#pragma unroll
        for (int bj = 0; bj < 2; ++bj)
#pragma unroll
            for (int n = 0; n < 2; ++n) bv[bj][n] = bias ? *(const f32x4*)(bias + bcol0 + bj * HALF + 4 * n) : (f32x4){0.f, 0.f, 0.f, 0.f};
#pragma unroll
        for (int ai = 0; ai < 2; ++ai)
#pragma unroll
            for (int m = 0; m < 4; ++m) { bf16_t* rowp = base + (size_t)(row0 + ai * HALF + m * 16) * ldc + col0;
#pragma unroll
                for (int bj = 0; bj < 2; ++bj) { f32x4 v0 = acc[ai][bj][m][0] + bv[bj][0], v1 = acc[ai][bj][m][1] + bv[bj][1];
                    if (ACT == 1) { f32x2 a = gelu_pk((f32x2){v0[0], v0[1]}), b = gelu_pk((f32x2){v0[2], v0[3]}), c = gelu_pk((f32x2){v1[0], v1[1]}), d = gelu_pk((f32x2){v1[2], v1[3]});
                        v0 = (f32x4){a.x, a.y, b.x, b.y}; v1 = (f32x4){c.x, c.y, d.x, d.y}; }
                    if (ACT == 2) {
#pragma unroll
                        for (int j = 0; j < 4; ++j) { v0[j] = 0.5f * v0[j] * (1.0f + erff(v0[j] * 0.70710678f)); v1[j] = 0.5f * v1[j] * (1.0f + erff(v1[j] * 0.70710678f)); } }
                    u32x4 w; w.x = cvt_pk_bf16(v0[0], v0[1]); w.y = cvt_pk_bf16(v0[2], v0[3]); w.z = cvt_pk_bf16(v1[0], v1[1]); w.w = cvt_pk_bf16(v1[2], v1[3]);
                    *(u32x4*)(rowp + bj * HALF) = w; } }
    }
};


template <class Epi, class Sched, bool STAMP = false>
__device__ __forceinline__ void gemm_phase(PG8_LAS unsigned char* lds, const Gemm g, const Sched& S, const Epi& E, unsigned long long* stamps) {
    int tid_o = threadIdx.x; asm volatile("" : "+v"(tid_o));
    const int tid = tid_o, wid = __builtin_amdgcn_readfirstlane(tid >> 6), lane = tid & 63, wr = wid >> 2, wc = wid & 3, fr = lane & 15, fq = lane >> 4;
    const int K = g.K, nt = K / BK;
    int ts_lo = 0, ts_hi = 0, nts = 0; const unsigned long long rt_entry = STAMP ? (unsigned long long)wall_clock64() : 0ull;
#define PG8_STAMP() do { if (STAMP && wid == 0 && nts < 64) { const unsigned long long _c = (unsigned long long)clock64(); \
        ts_lo = (lane == nts) ? (int)(unsigned)_c : ts_lo; ts_hi = (lane == nts) ? (int)(unsigned)(_c >> 32) : ts_hi; ++nts; } } while (0)
    PG8_STAMP();
    unsigned voffA[2], voffB[2];
#pragma unroll
    for (int i = 0; i < 2; ++i) { int R, C; stage_rc(tid * 16 + i * 8192, R, C); const int Rb = Epi::PERM ? ((R & ~31) + perm32(R & 31)) : R;
        voffA[i] = (unsigned)(R * K + C) * 2u; voffB[i] = (unsigned)(Rb * K + C) * 2u; }
    const size_t kstep = (size_t)(BK * 2);
    const size_t hstep = (size_t)HALF * K * 2;
    const size_t tstep = 2 * hstep;
    const unsigned ldsw = (unsigned)wid * 1024u;
    const int aoff = lds_byte(wr * 64 + fr, fq * 8), boff = lds_byte(wc * 32 + fr, fq * 8);
#define PG8_SA(b, h) (((b) * 2 + (h)) * HTB)
#define PG8_SB(b, h) ((4 + (b) * 2 + (h)) * HTB)
#define PG8_STAGE(bufoff, gbase, voff) do { _Pragma("unroll") for (int _i = 0; _i < 2; ++_i) \
        __builtin_amdgcn_global_load_lds((const unsigned*)((const char*)(gbase) + (voff)[_i]), (PG8_LAS unsigned*)(lds + (bufoff) + ldsw + _i * 8192), 16, 0, 0); } while (0)
#define PG8_LDA(dst, b, h) do { _Pragma("unroll") for (int m = 0; m < 4; ++m) _Pragma("unroll") for (int k = 0; k < 2; ++k) dst[m][k] = *(const PG8_LAS bf16x8*)(lds + PG8_SA(b, h) + aoff + m * 2048 + k * 1024); } while (0)
#define PG8_LDB(dst, b, h) do { _Pragma("unroll") for (int n = 0; n < 2; ++n) _Pragma("unroll") for (int k = 0; k < 2; ++k) dst[n][k] = *(const PG8_LAS bf16x8*)(lds + PG8_SB(b, h) + boff + n * 2048 + k * 1024); } while (0)
#define PG8_MMA(ai, bj, At, Bt) do { __builtin_amdgcn_s_setprio(1); _Pragma("unroll") for (int m = 0; m < 4; ++m) _Pragma("unroll") for (int n = 0; n < 2; ++n) _Pragma("unroll") for (int k = 0; k < 2; ++k) \
        acc[ai][bj][m][n] = __builtin_amdgcn_mfma_f32_16x16x32_bf16(Bt[n][k], At[m][k], acc[ai][bj][m][n], 0, 0, 0); __builtin_amdgcn_s_setprio(0); } while (0)
#define PG8_WAIT_V(n) asm volatile("s_waitcnt vmcnt(" #n ")" ::: "memory")
#define PG8_WAIT_L(n) asm volatile("s_waitcnt lgkmcnt(" #n ")" ::: "memory")
#define PG8_BAR __builtin_amdgcn_s_barrier()
#define PG8_SCHED __builtin_amdgcn_sched_barrier(0)
    Unit cur, nxt; int ui = 0;
    if (!S.next(0, cur)) return;
    f32x4 acc[2][2][4][2];
#pragma unroll
    for (int a = 0; a < 2; ++a)
#pragma unroll
        for (int b = 0; b < 2; ++b)
#pragma unroll
            for (int m = 0; m < 4; ++m)
#pragma unroll
                for (int n = 0; n < 2; ++n) acc[a][b][m][n] = (f32x4){0.f, 0.f, 0.f, 0.f};
    bf16x8 At[4][2], B0[2][2], B1[2][2];
    const char* cA = (const char*)g.A + (size_t)cur.pm * tstep; const char* cB = (const char*)g.Bt + (size_t)cur.pn * tstep;
    S.a_ready(cur);
    PG8_STAGE(PG8_SB(0, 0), cB, voffB); PG8_STAGE(PG8_SA(0, 0), cA, voffA); PG8_STAGE(PG8_SB(0, 1), cB + hstep, voffB); PG8_STAGE(PG8_SA(0, 1), cA + hstep, voffA);
    if (wr == 1) PG8_BAR;
    PG8_WAIT_V(4); PG8_BAR;
    PG8_STAGE(PG8_SB(1, 0), cB + kstep, voffB); PG8_STAGE(PG8_SA(1, 0), cA + kstep, voffA); PG8_STAGE(PG8_SB(1, 1), cB + hstep + kstep, voffB);
    PG8_WAIT_V(6); PG8_BAR;
    PG8_STAMP();
    for (;;) {
        const bool has_next = S.next(ui + 1, nxt);
        const char* nA = has_next ? (const char*)g.A + (size_t)nxt.pm * tstep : cA; const char* nB = has_next ? (const char*)g.Bt + (size_t)nxt.pn * tstep : cB;
        for (int t = 0; t < nt; t += 2) {
            const bool last = (t == nt - 2);
            const char* a1 = cA + (size_t)(t + 1) * kstep;
            const char* a2 = last ? nA : cA + (size_t)(t + 2) * kstep; const char* b2 = last ? nB : cB + (size_t)(t + 2) * kstep;
            const char* a3 = a2 + kstep; const char* b3 = b2 + kstep;
            if (last && has_next) S.a_ready(nxt);
            PG8_LDB(B0, 0, 0); PG8_SCHED; PG8_LDA(At, 0, 0); PG8_STAGE(PG8_SA(1, 1), a1 + hstep, voffA);
            PG8_WAIT_L(8); PG8_BAR; PG8_WAIT_L(0); PG8_MMA(0, 0, At, B0); PG8_BAR; PG8_SCHED;
            PG8_LDB(B1, 0, 1); PG8_STAGE(PG8_SB(0, 0), b2, voffB);
            PG8_BAR; PG8_WAIT_L(0); PG8_MMA(0, 1, At, B1); PG8_BAR;
            PG8_LDA(At, 0, 1); PG8_STAGE(PG8_SA(0, 0), a2, voffA);
            PG8_BAR; PG8_WAIT_L(0); PG8_MMA(1, 0, At, B0); PG8_BAR; PG8_SCHED;
            PG8_STAGE(PG8_SB(0, 1), b2 + hstep, voffB);
            PG8_WAIT_V(6); PG8_BAR; PG8_MMA(1, 1, At, B1); PG8_BAR;
            PG8_LDB(B0, 1, 0); PG8_SCHED; PG8_LDA(At, 1, 0); PG8_STAGE(PG8_SA(0, 1), a2 + hstep, voffA);
            PG8_WAIT_L(8); PG8_BAR; PG8_WAIT_L(0); PG8_MMA(0, 0, At, B0); PG8_BAR; PG8_SCHED;
            PG8_LDB(B1, 1, 1); PG8_STAGE(PG8_SB(1, 0), b3, voffB);
            PG8_BAR; PG8_WAIT_L(0); PG8_MMA(0, 1, At, B1); PG8_BAR;
            PG8_LDA(At, 1, 1); PG8_STAGE(PG8_SA(1, 0), a3, voffA);
            PG8_BAR; PG8_WAIT_L(0); PG8_MMA(1, 0, At, B0); PG8_BAR; PG8_SCHED;
            PG8_STAGE(PG8_SB(1, 1), b3 + hstep, voffB);
            PG8_WAIT_V(6); PG8_BAR; PG8_MMA(1, 1, At, B1); PG8_BAR;
        }
        PG8_STAMP();
        if constexpr (!Epi::AFTER_DRAIN) { E(acc, cur, wr, wc, fr, fq); S.done(cur); }
        PG8_STAMP();
        if (!has_next) break;
#pragma unroll
        for (int a = 0; a < 2; ++a)
#pragma unroll
            for (int b = 0; b < 2; ++b)
#pragma unroll
                for (int m = 0; m < 4; ++m)
#pragma unroll
                    for (int n = 0; n < 2; ++n) acc[a][b][m][n] = (f32x4){0.f, 0.f, 0.f, 0.f};
        cur = nxt; cA = nA; cB = nB; ++ui;
    }
    PG8_WAIT_V(0);
    if (wr == 0) PG8_BAR;
    PG8_BAR;
    if constexpr (Epi::AFTER_DRAIN) { E.fused(acc, cur, wr, wc, fr, fq, lds, wid, lane); S.done(cur); }
    PG8_STAMP();
    if (STAMP && wid == 0) { stamps[lane] = lane < nts ? (((unsigned long long)(unsigned)ts_hi << 32) | (unsigned)ts_lo) : 0ull;
        if (lane == 62) stamps[62] = rt_entry; if (lane == 63) stamps[63] = (unsigned long long)wall_clock64(); }
#undef PG8_STAMP
#undef PG8_SA
#undef PG8_SB
#undef PG8_STAGE
#undef PG8_LDA
#undef PG8_LDB
#undef PG8_MMA
#undef PG8_WAIT_V
#undef PG8_WAIT_L
#undef PG8_BAR
#undef PG8_SCHED
}
}

namespace mk {
using pg8::bf16_t; using pg8::bf16x8; using pg8::f32x4; using pg8::u32x4;
typedef short s16x4 __attribute__((ext_vector_type(4)));
typedef unsigned u32x2 __attribute__((ext_vector_type(2)));

constexpr int D = 2048, NB = 8, S = 2048, M = NB * S, BW = 1024, MIXW = 3072, PW = 13568, DEPTH = 2;
constexpr int C_AQ = 0, C_AK = 1024, C_AV = 2048, C_AG = 3072, C_B = 4096, C_BG = 7424, C_CQ = 8448, C_CI = 9472, C_CF = 10496, C_CG = 12544;
constexpr int NTHR = 512;
constexpr int LDS_BYTES = 147456;
constexpr float LOG2E = 1.4426950408889634f;

constexpr size_t OFF_CTL = 0;
constexpr size_t OFF_WIN = 4096;
constexpr size_t OFF_WOUT = OFF_WIN + (size_t)PW * D * 2;
constexpr size_t OFF_U = OFF_WOUT + (size_t)D * MIXW * 2;
constexpr size_t OFF_PROJ = OFF_U + (size_t)M * D * 2;
constexpr size_t OFF_MIXED = OFF_PROJ + (size_t)M * PW * 2;
constexpr size_t OFF_OC = OFF_MIXED + (size_t)M * MIXW * 2;
constexpr size_t OFF_AO = OFF_OC + (size_t)2 * M * BW * 2;
constexpr size_t OFF_BON = OFF_AO + (size_t)2 * M * BW * 2;
constexpr size_t WS_END = OFF_BON + (size_t)2 * M * 16 * 4;

struct Params { const float* in[23]; float* out; unsigned char* ws; };
__device__ __forceinline__ int opaque_tid() { int t = threadIdx.x; asm volatile("" : "+v"(t)); return t; }
__device__ __forceinline__ int opaque_s(int t) { asm volatile("" : "+s"(t)); return t; }
__device__ __forceinline__ int opaque_bid() { int t = blockIdx.x; asm volatile("" : "+s"(t)); return t; }


__device__ __forceinline__ float bf2f(bf16_t v) { return __uint_as_float(((unsigned)v) << 16); }
__device__ __forceinline__ bf16_t f2bf(float f) { unsigned u = __float_as_uint(f); u += 0x7FFFu + ((u >> 16) & 1u); return (bf16_t)(u >> 16); }
typedef __bf16 bf16x2_t __attribute__((ext_vector_type(2)));
typedef float f32x2c __attribute__((ext_vector_type(2)));
__device__ __forceinline__ unsigned pk2(float lo, float hi) { f32x2c v = {lo, hi}; bf16x2_t b = __builtin_convertvector(v, bf16x2_t); return __builtin_bit_cast(unsigned, b); }
__device__ __forceinline__ float wave_sum(float v) {
#pragma unroll
    for (int o = 1; o < 64; o <<= 1) v += __shfl_xor(v, o);
    return v;
}
__device__ __forceinline__ float sigmoidf_(float x) { return 1.f / (1.f + __expf(-x)); }
__device__ __forceinline__ float siluf_(float x) { return x / (1.f + __expf(-x)); }
__device__ __forceinline__ float dpp_xor1(float v) { return __int_as_float(__builtin_amdgcn_mov_dpp(__float_as_int(v), 0xB1, 0xF, 0xF, true)); }
__device__ __forceinline__ float dpp_xor2(float v) { return __int_as_float(__builtin_amdgcn_mov_dpp(__float_as_int(v), 0x4E, 0xF, 0xF, true)); }
__device__ __forceinline__ float dpp_hmir(float v) { return __int_as_float(__builtin_amdgcn_mov_dpp(__float_as_int(v), 0x141, 0xF, 0xF, true)); }
__device__ __forceinline__ float dpp_mir(float v) { return __int_as_float(__builtin_amdgcn_mov_dpp(__float_as_int(v), 0x140, 0xF, 0xF, true)); }
__device__ __forceinline__ float wave_sum_fast(float v) {
    v += dpp_xor1(v); v += dpp_xor2(v); v += dpp_hmir(v); v += dpp_mir(v);
    v += __shfl_xor(v, 16); v += __shfl_xor(v, 32);
    return v;
}
__device__ __forceinline__ float fast_tanh(float x) { return 1.f - 2.f * __builtin_amdgcn_rcpf(1.f + __expf(2.f * x)); }
__device__ __forceinline__ float fast_sigmoid(float x) { return __builtin_amdgcn_rcpf(1.f + __expf(-x)); }
typedef float f32x2 __attribute__((ext_vector_type(2)));
#define MFMA16(a, b, c) __builtin_amdgcn_mfma_f32_16x16x32_bf16((a), (b), (c), 0, 0, 0)
__device__ __forceinline__ bf16x8 join8(s16x4 lo, s16x4 hi) { return __builtin_shufflevector(lo, hi, 0, 1, 2, 3, 4, 5, 6, 7); }
__device__ __forceinline__ bf16x8 pack8(f32x4 a, f32x4 b) {
    u32x4 w; w.x = pk2(a[0], a[1]); w.y = pk2(a[2], a[3]); w.z = pk2(b[0], b[1]); w.w = pk2(b[2], b[3]);
    return __builtin_bit_cast(bf16x8, w);
}

__device__ __forceinline__ void transpose_tile(const float* __restrict__ W, int K, int N, bf16_t* __restrict__ WT, float* tile, int it) {
    const int tid = opaque_tid();
    const int ntn = N >> 6; const int kb = it / ntn, nbk = it - kb * ntn; const int k0 = kb * 64, n0 = nbk * 64;
#pragma unroll
    for (int rr = 0; rr < 2; ++rr) { const int idx = tid + rr * 512; const int kk = idx >> 4, n4 = (idx & 15) * 4;
        const float4 v = *(const float4*)(W + (size_t)(k0 + kk) * N + n0 + n4);
        float* tp = tile + kk * 65 + n4; tp[0] = v.x; tp[1] = v.y; tp[2] = v.z; tp[3] = v.w; }
    __syncthreads();
    { const int n = tid >> 3, kc = (tid & 7) * 8; const float* tp = tile + kc * 65 + n;
      u32x4 o; o.x = pk2(tp[0], tp[65]); o.y = pk2(tp[2 * 65], tp[3 * 65]); o.z = pk2(tp[4 * 65], tp[5 * 65]); o.w = pk2(tp[6 * 65], tp[7 * 65]);
      *(u32x4*)(WT + (size_t)(n0 + n) * K + k0 + kc) = o; }
    __syncthreads();
}
__device__ __forceinline__ void convert_weights(const Params& P, int layer, unsigned char* smem) {
    float* tile = (float*)smem;
    const float* win = P.in[4] + (size_t)layer * D * PW; const float* wout = P.in[5] + (size_t)layer * MIXW * D;
    bf16_t* WinT = (bf16_t*)(P.ws + OFF_WIN); bf16_t* WoutT = (bf16_t*)(P.ws + OFF_WOUT);
    constexpr int T_IN = (D / 64) * (PW / 64), T_OUT = (MIXW / 64) * (D / 64);
    for (int it = opaque_bid(); it < T_IN + T_OUT; it += gridDim.x) {
        if (it < T_IN) transpose_tile(win, D, PW, WinT, tile, it);
        else transpose_tile(wout, MIXW, D, WoutT, tile, it - T_IN);
    }
}
__device__ __forceinline__ void prenorm_rows(const float* __restrict__ x, const float* __restrict__ g, bf16_t* __restrict__ U) {
    const int tid_ = opaque_tid(); const int lane = tid_ & 63, gw = opaque_bid() * 8 + (tid_ >> 6), ngw = gridDim.x * 8;
    for (int row = gw; row < M; row += ngw) {
        const float4* xr = (const float4*)(x + (size_t)row * D) + lane;
        float4 v[8]; float ss = 0.f;
#pragma unroll
        for (int j = 0; j < 8; ++j) { v[j] = xr[64 * j]; ss += v[j].x * v[j].x + v[j].y * v[j].y + v[j].z * v[j].z + v[j].w * v[j].w; }
        const float rstd = rsqrtf(wave_sum(ss) * (1.f / D) + 1e-6f);
        u32x2* o = (u32x2*)(U + (size_t)row * D) + lane;
#pragma unroll
        for (int j = 0; j < 8; ++j) { const float4 gg = ((const float4*)g)[64 * j + lane];
            u32x2 w; w.x = pk2(v[j].x * rstd * gg.x, v[j].y * rstd * gg.y); w.y = pk2(v[j].z * rstd * gg.z, v[j].w * rstd * gg.w); o[64 * j] = w; }
    }
}
__device__ __forceinline__ void postnorm_rows(const float* __restrict__ y, const float* xin, float* xout, const float* __restrict__ gpost, const float* __restrict__ gpre, bf16_t* __restrict__ U) {
    const int tid_ = opaque_tid(); const int lane = tid_ & 63, gw = opaque_bid() * 8 + (tid_ >> 6), ngw = gridDim.x * 8;
    for (int row = gw; row < M; row += ngw) {
        const float4* yr = (const float4*)(y + (size_t)row * D) + lane;
        const float4* xr = (const float4*)(xin + (size_t)row * D) + lane;
        float4* xo = (float4*)(xout + (size_t)row * D) + lane;
        float4 v[8]; float ss = 0.f;
#pragma unroll
        for (int j = 0; j < 8; ++j) { v[j] = yr[64 * j]; ss += v[j].x * v[j].x + v[j].y * v[j].y + v[j].z * v[j].z + v[j].w * v[j].w; }
        const float rstd = rsqrtf(wave_sum(ss) * (1.f / D) + 1e-6f);
        float s2 = 0.f;
#pragma unroll
        for (int j = 0; j < 8; ++j) { const float4 gg = ((const float4*)gpost)[64 * j + lane]; const float4 xv = xr[64 * j];
            v[j].x = xv.x + v[j].x * rstd * gg.x; v[j].y = xv.y + v[j].y * rstd * gg.y; v[j].z = xv.z + v[j].z * rstd * gg.z; v[j].w = xv.w + v[j].w * rstd * gg.w;
            xo[64 * j] = v[j]; s2 += v[j].x * v[j].x + v[j].y * v[j].y + v[j].z * v[j].z + v[j].w * v[j].w; }
        if (gpre) {
            const float r2 = rsqrtf(wave_sum(s2) * (1.f / D) + 1e-6f);
            u32x2* o = (u32x2*)(U + (size_t)row * D) + lane;
#pragma unroll
            for (int j = 0; j < 8; ++j) { const float4 gg = ((const float4*)gpre)[64 * j + lane];
                u32x2 w; w.x = pk2(v[j].x * r2 * gg.x, v[j].y * r2 * gg.y); w.y = pk2(v[j].z * r2 * gg.z, v[j].w * r2 * gg.w); o[64 * j] = w; }
        }
    }
}

__device__ __forceinline__ void rwkv_phase(const Params& P, int layer, unsigned char* smem) {
    float* VEC = (float*)smem;
    bf16_t* UPT = (bf16_t*)(smem + 98304);
    unsigned char* pbase = smem + 98304 + 18432;
    const int tid = opaque_tid(), wid = __builtin_amdgcn_readfirstlane(tid >> 6), lane = tid & 63, r16 = lane & 15, quad = lane >> 4;
    const bf16_t* proj = (const bf16_t*)(P.ws + OFF_PROJ);
    bf16_t* YB = (bf16_t*)(P.ws + OFF_U);
    float* BON = (float*)(P.ws + OFF_BON);
    const float* mu = P.in[11] + (size_t)layer * 2 * 3328;
    for (int chain = opaque_bid(); chain < 256; chain += gridDim.x) {
        const int d = chain >> 7, b = (chain >> 4) & 7, h = chain & 15;
        __syncthreads();
        { const float* wup = P.in[13] + ((size_t)(layer * 2 + d) * 64) * 1024 + h * 64; const float* aup = P.in[15] + ((size_t)(layer * 2 + d) * 64) * 1024 + h * 64;
#pragma unroll
          for (int it = 0; it < 16; ++it) { const int e = tid + 512 * it; const int mat = e >> 12, lora = (e >> 6) & 63, ch = e & 63;
              const float v = (mat ? aup : wup)[(size_t)lora * 1024 + ch]; UPT[mat * 4608 + ch * 72 + lora] = f2bf(v); } }
        __syncthreads();
        if (wid < 4) {
            const int i = tid >> 2, q = tid & 3;
            float Sx[16];
#pragma unroll
            for (int j = 0; j < 16; ++j) Sx[j] = 0.f;
            __syncthreads();
            for (int c = 0; c < 64; ++c) {
                const float* vb = VEC + (c & 1) * (32 * 384);
#pragma unroll 2
                for (int s = 0; s < 32; ++s) {
                    const float4* V4 = (const float4*)(vb + s * 384) + q * 4;
                    float4 nk[4], w[4], ka[4], km[4], rv[4];
#pragma unroll
                    for (int e = 0; e < 4; ++e) { nk[e] = V4[e]; w[e] = V4[16 + e]; ka[e] = V4[32 + e]; km[e] = V4[48 + e]; rv[e] = V4[64 + e]; }
                    const float vi = vb[s * 384 + 320 + i];
                    float sa = 0.f;
#pragma unroll
                    for (int e = 0; e < 4; ++e) { sa += Sx[4 * e] * nk[e].x; sa += Sx[4 * e + 1] * nk[e].y; sa += Sx[4 * e + 2] * nk[e].z; sa += Sx[4 * e + 3] * nk[e].w; }
                    sa += dpp_xor1(sa); sa += dpp_xor2(sa);
                    float y = 0.f;
#pragma unroll
                    for (int e = 0; e < 4; ++e) {
                        Sx[4 * e]     = Sx[4 * e]     * w[e].x + (sa * ka[e].x + vi * km[e].x); y += Sx[4 * e]     * rv[e].x;
                        Sx[4 * e + 1] = Sx[4 * e + 1] * w[e].y + (sa * ka[e].y + vi * km[e].y); y += Sx[4 * e + 1] * rv[e].y;
                        Sx[4 * e + 2] = Sx[4 * e + 2] * w[e].z + (sa * ka[e].z + vi * km[e].z); y += Sx[4 * e + 2] * rv[e].z;
                        Sx[4 * e + 3] = Sx[4 * e + 3] * w[e].w + (sa * ka[e].w + vi * km[e].w); y += Sx[4 * e + 3] * rv[e].w;
                    }
                    y += dpp_xor1(y); y += dpp_xor2(y);
                    const int n = c * 32 + s; const int t = d ? (S - 1 - n) : n;
                    if (q == 0) YB[((size_t)d * M + (size_t)b * S + t) * 1024 + h * 64 + i] = f2bf(y);
                }
                __syncthreads();
            }
        } else {
            const int pw = wid - 4;
            bf16_t* Aw = (bf16_t*)(pbase + pw * 6400); bf16_t* Aa = Aw + 8 * 72; float* X = (float*)(pbase + pw * 6400 + 2304);
            const int cr = h * 64 + lane, ck = 1024 + h * 64 + lane, cv = 2048 + h * 64 + lane, cw = 3072 + d * 64 + lane, ca = 3200 + d * 64 + lane;
            const int mo0 = d ? 3328 : 0, mo1 = d ? 0 : 3328;
            const float mr0 = mu[mo0 + cr], mr1 = mu[mo1 + cr], mk0 = mu[mo0 + ck], mk1 = mu[mo1 + ck], mv0 = mu[mo0 + cv], mv1 = mu[mo1 + cv];
            const float mw0 = mu[mo0 + cw], mw1 = mu[mo1 + cw], ma0 = mu[mo0 + ca], ma1 = mu[mo1 + ca];
            const int chn = h * 64 + lane;
            const float w0v = P.in[12][(size_t)(layer * 2 + d) * 1024 + chn], a0v = P.in[14][(size_t)(layer * 2 + d) * 1024 + chn];
            const float kkw = P.in[16][(size_t)layer * 1024 + chn], kaw = P.in[17][(size_t)layer * 1024 + chn], rkw = P.in[18][(size_t)layer * 1024 + chn];
            for (int c = 0; c < 65; ++c) {
                if (c < 64) {
                    float* vb = VEC + (c & 1) * (32 * 384);
                    float rr[8], kv[8], vv[8], kk[8];
                    {
                        const int n0 = c * 32 + pw * 8; const int T0 = d ? (S - 1 - n0) : n0; const int dstep = d ? -1 : 1;
                        unsigned short raw[10][5];
#pragma unroll
                        for (int j = 0; j < 10; ++j) {
                            const int tj = T0 + (j - 1) * dstep; const bool ok = (tj >= 0) && (tj < S);
                            const bf16_t* row = proj + ((size_t)b * S + (ok ? tj : T0)) * PW + C_B;
                            raw[j][0] = row[cr]; raw[j][1] = row[ck]; raw[j][2] = row[cv]; raw[j][3] = row[cw]; raw[j][4] = row[ca];
                            if (!ok) { raw[j][0] = 0; raw[j][1] = 0; raw[j][2] = 0; raw[j][3] = 0; raw[j][4] = 0; }
                        }
#pragma unroll
                        for (int i = 0; i < 8; ++i) {
                            float p0, pa, pb;
                            p0 = bf2f(raw[i + 1][0]); pa = bf2f(raw[i][0]); pb = bf2f(raw[i + 2][0]); rr[i] = p0 + mr0 * (pa - p0) + mr1 * (pb - p0);
                            p0 = bf2f(raw[i + 1][1]); pa = bf2f(raw[i][1]); pb = bf2f(raw[i + 2][1]); kv[i] = p0 + mk0 * (pa - p0) + mk1 * (pb - p0);
                            p0 = bf2f(raw[i + 1][2]); pa = bf2f(raw[i][2]); pb = bf2f(raw[i + 2][2]); vv[i] = p0 + mv0 * (pa - p0) + mv1 * (pb - p0);
                            p0 = bf2f(raw[i + 1][3]); pa = bf2f(raw[i][3]); pb = bf2f(raw[i + 2][3]); const float wd = p0 + mw0 * (pa - p0) + mw1 * (pb - p0);
                            p0 = bf2f(raw[i + 1][4]); pa = bf2f(raw[i][4]); pb = bf2f(raw[i + 2][4]); const float ad = p0 + ma0 * (pa - p0) + ma1 * (pb - p0);
                            Aw[i * 72 + lane] = f2bf(fast_tanh(wd)); Aa[i * 72 + lane] = f2bf(ad);
                            const float k2 = kv[i] * kkw; const float n2 = wave_sum_fast(k2 * k2);
                            kk[i] = k2 * __builtin_amdgcn_rsqf(fmaxf(n2, 1e-24f));
                        }
                    }
                    asm volatile("s_waitcnt lgkmcnt(0)" ::: "memory");
#pragma unroll
                    for (int mat = 0; mat < 2; ++mat) {
                        const bf16_t* A = mat ? Aa : Aw;
                        const bf16x8 a0f = *(const bf16x8*)(A + (r16 & 7) * 72 + quad * 8), a1f = *(const bf16x8*)(A + (r16 & 7) * 72 + 32 + quad * 8);
#pragma unroll
                        for (int nt = 0; nt < 4; ++nt) {
                            const bf16_t* B = UPT + mat * 4608 + (nt * 16 + r16) * 72 + quad * 8;
                            f32x4 acc = {0.f, 0.f, 0.f, 0.f};
                            acc = MFMA16(a0f, *(const bf16x8*)B, acc); acc = MFMA16(a1f, *(const bf16x8*)(B + 32), acc);
                            if (quad < 2) {
#pragma unroll
                                for (int rg = 0; rg < 4; ++rg) X[mat * 512 + (quad * 4 + rg) * 64 + nt * 16 + r16] = acc[rg];
                            }
                        }
                    }
                    asm volatile("s_waitcnt lgkmcnt(0)" ::: "memory");
#pragma unroll
                    for (int i = 0; i < 8; ++i) {
                        const int s = pw * 8 + i; const int n = c * 32 + s; const int t = d ? (S - 1 - n) : n;
                        const float xw = X[i * 64 + lane] + w0v, xa = X[512 + i * 64 + lane] + a0v;
                        const float dec = __expf(-0.6065306597126334f * fast_sigmoid(xw)); const float av = fast_sigmoid(xa);
                        const float kmod = kv[i] * (1.f + (av - 1.f) * kaw); const float kka = kk[i] * av;
                        float* o = vb + s * 384 + lane;
                        o[0] = -kk[i]; o[64] = dec; o[128] = kka; o[192] = kmod; o[256] = rr[i]; o[320] = vv[i];
                        const float bon = wave_sum_fast(rr[i] * kmod * rkw);
                        if (lane == 0) BON[(((size_t)d * NB + b) * 16 + h) * S + t] = bon;
                    }
                }
                __syncthreads();
            }
        }
    }
}

__device__ __forceinline__ int swz40(int row, int s) { return row * 40 + ((((s >> 3) ^ (row >> 3)) & 3) << 3) + (s & 7); }
__device__ __forceinline__ void hgrn_phase(const Params& P, int layer, unsigned char* smem) {
    bf16_t* QE = (bf16_t*)smem; bf16_t* KE = (bf16_t*)(smem + 8704); bf16_t* KLT = (bf16_t*)(smem + 17408); bf16_t* VT = (bf16_t*)(smem + 27648);
    float* LF = (float*)(smem + 37888); float* EL = (float*)(smem + 54272);
    const int tid = opaque_tid(), wid = __builtin_amdgcn_readfirstlane(tid >> 6), lane = tid & 63, r16 = lane & 15, quad = lane >> 4;
    const bf16_t* proj = (const bf16_t*)(P.ws + OFF_PROJ);
    bf16_t* OC = (bf16_t*)(P.ws + OFF_OC);
    const int es = tid >> 4, ekc = (tid & 15) * 8;
    for (int chain = opaque_bid(); chain < 128; chain += gridDim.x) {
        const int d = chain >> 6, b = (chain >> 3) & 7, h = chain & 7;
        float lb[8];
#pragma unroll
        for (int j = 0; j < 8; ++j) lb[j] = 0.f;
        if (layer > 0) {
#pragma unroll
            for (int j = 0; j < 8; ++j) { const float l0 = P.in[21][(size_t)(d * 2 + 0) * 1024 + h * 128 + ekc + j], l1 = P.in[21][(size_t)(d * 2 + 1) * 1024 + h * 128 + ekc + j]; lb[j] = 1.f / (1.f + __expf(l0 - l1)); }
        }
        f32x4 Sacc[8];
#pragma unroll
        for (int mt = 0; mt < 8; ++mt) Sacc[mt] = (f32x4){0.f, 0.f, 0.f, 0.f};
        u32x4 zraw, qraw, vraw;
        { const int t = d ? (S - 1 - es) : es; const bf16_t* row = proj + ((size_t)b * S + t) * PW + h * 128 + ekc;
          zraw = *(const u32x4*)(row + C_CF + d * 1024); qraw = *(const u32x4*)(row + C_CQ); vraw = *(const u32x4*)(row + C_CI); }
        for (int c = 0; c < 64; ++c) {
            __syncthreads();
            { const int n = c * 32 + es; const int t = d ? (S - 1 - n) : n; const bf16_t* row = proj + ((size_t)b * S + t) * PW + h * 128 + ekc;
              zraw = *(const u32x4*)(row + C_CF + d * 1024); qraw = *(const u32x4*)(row + C_CQ); vraw = *(const u32x4*)(row + C_CI); }
            float kval[8];
            {
                float lf[8];
#pragma unroll
                for (int j = 0; j < 8; ++j) {
                    const unsigned wv = zraw[j >> 1]; const float z = (j & 1) ? __uint_as_float(wv & 0xFFFF0000u) : __uint_as_float(wv << 16);
                    const float e = __expf(-fabsf(z));
                    const float ls = fminf(z, 0.f) - __logf(1.f + e);
                    const float sg = (z >= 0.f ? 1.f : e) * __builtin_amdgcn_rcpf(1.f + e);
                    lf[j] = (lb[j] > 0.f) ? __logf(lb[j] + (1.f - lb[j]) * sg) : ls;
                    kval[j] = (1.f - lb[j]) * (1.f - sg);
                }
                *(f32x4*)(LF + es * 128 + ekc) = (f32x4){lf[0], lf[1], lf[2], lf[3]}; *(f32x4*)(LF + es * 128 + ekc + 4) = (f32x4){lf[4], lf[5], lf[6], lf[7]};
#pragma unroll
                for (int j = 0; j < 8; ++j) { const unsigned wv = vraw[j >> 1]; VT[swz40(ekc + j, es)] = (bf16_t)((j & 1) ? (wv >> 16) : (wv & 0xFFFFu)); }
            }
            __syncthreads();
            if (tid < 128) {
                float cum = 0.f;
#pragma unroll
                for (int s = 0; s < 32; ++s) { cum += LF[s * 128 + tid]; LF[s * 128 + tid] = cum; }
                EL[tid] = __expf(cum);
            }
            __syncthreads();
            {
                const f32x4 c0 = *(const f32x4*)(LF + es * 128 + ekc), c1v = *(const f32x4*)(LF + es * 128 + ekc + 4);
                const f32x4 l0 = *(const f32x4*)(LF + 31 * 128 + ekc), l1 = *(const f32x4*)(LF + 31 * 128 + ekc + 4);
                float qe[8], ke[8];
#pragma unroll
                for (int j = 0; j < 8; ++j) {
                    const unsigned wv = qraw[j >> 1]; const float qv = (j & 1) ? __uint_as_float(wv & 0xFFFF0000u) : __uint_as_float(wv << 16);
                    const float cum = (j < 4) ? c0[j & 3] : c1v[j & 3], last = (j < 4) ? l0[j & 3] : l1[j & 3];
                    qe[j] = qv * __expf(cum); ke[j] = kval[j] * __expf(-cum);
                    KLT[swz40(ekc + j, es)] = f2bf(kval[j] * __expf(last - cum));
                }
                u32x4 w; w.x = pk2(qe[0], qe[1]); w.y = pk2(qe[2], qe[3]); w.z = pk2(qe[4], qe[5]); w.w = pk2(qe[6], qe[7]); *(u32x4*)(QE + es * 136 + ekc) = w;
                w.x = pk2(ke[0], ke[1]); w.y = pk2(ke[2], ke[3]); w.z = pk2(ke[4], ke[5]); w.w = pk2(ke[6], ke[7]); *(u32x4*)(KE + es * 136 + ekc) = w;
            }
            if (false) { const int n = (c + 1) * 32 + es; const int t = d ? (S - 1 - n) : n; const bf16_t* row = proj + ((size_t)b * S + t) * PW + h * 128 + ekc;
                zraw = *(const u32x4*)(row + C_CF + d * 1024); qraw = *(const u32x4*)(row + C_CQ); vraw = *(const u32x4*)(row + C_CI); }
            __syncthreads();
            f32x4 sc00 = {0.f, 0.f, 0.f, 0.f}, sc01 = sc00, sc11 = sc00;
#pragma unroll
            for (int ks = 0; ks < 4; ++ks) {
                const bf16x8 ke0 = *(const bf16x8*)(KE + r16 * 136 + ks * 32 + quad * 8), ke1 = *(const bf16x8*)(KE + (16 + r16) * 136 + ks * 32 + quad * 8);
                const bf16x8 qe0 = *(const bf16x8*)(QE + r16 * 136 + ks * 32 + quad * 8), qe1 = *(const bf16x8*)(QE + (16 + r16) * 136 + ks * 32 + quad * 8);
                sc00 = MFMA16(ke0, qe0, sc00); sc01 = MFMA16(ke0, qe1, sc01); sc11 = MFMA16(ke1, qe1, sc11);
            }
#pragma unroll
            for (int rg = 0; rg < 4; ++rg) { if (quad * 4 + rg > r16) { sc00[rg] = 0.f; sc11[rg] = 0.f; } }
            const f32x4 zero4 = {0.f, 0.f, 0.f, 0.f};
            const bf16x8 p0 = pack8(sc00, zero4), p1 = pack8(sc01, sc11);
            const int vrow_i = wid * 16 + r16;
            const bf16x8 vperm = join8(*(const s16x4*)(VT + swz40(vrow_i, quad * 4)), *(const s16x4*)(VT + swz40(vrow_i, 16 + quad * 4)));
            f32x4 o0 = MFMA16(p0, vperm, zero4), o1 = MFMA16(p1, vperm, zero4);
#pragma unroll
            for (int ks = 0; ks < 4; ++ks) {
                const bf16x8 sb = pack8(Sacc[2 * ks], Sacc[2 * ks + 1]);
                const bf16_t* q0p = QE + r16 * 136 + ks * 32 + quad * 4; const bf16_t* q1p = QE + (16 + r16) * 136 + ks * 32 + quad * 4;
                const bf16x8 qa0 = join8(*(const s16x4*)q0p, *(const s16x4*)(q0p + 16)), qa1 = join8(*(const s16x4*)q1p, *(const s16x4*)(q1p + 16));
                o0 = MFMA16(qa0, sb, o0); o1 = MFMA16(qa1, sb, o1);
            }
#pragma unroll
            for (int rg = 0; rg < 4; ++rg) {
                { const int n = c * 32 + quad * 4 + rg; const int t = d ? (S - 1 - n) : n; OC[((size_t)d * M + (size_t)b * S + t) * 1024 + h * 128 + wid * 16 + r16] = f2bf(o0[rg]); }
                { const int n = c * 32 + 16 + quad * 4 + rg; const int t = d ? (S - 1 - n) : n; OC[((size_t)d * M + (size_t)b * S + t) * 1024 + h * 128 + wid * 16 + r16] = f2bf(o1[rg]); }
            }
            const bf16x8 vnat = *(const bf16x8*)(VT + swz40(vrow_i, quad * 8));
#pragma unroll
            for (int mt = 0; mt < 8; ++mt) {
                const f32x4 el = *(const f32x4*)(EL + mt * 16 + quad * 4);
                f32x4 sa = Sacc[mt] * el;
                const bf16x8 kl = *(const bf16x8*)(KLT + swz40(mt * 16 + r16, quad * 8));
                Sacc[mt] = MFMA16(kl, vnat, sa);
            }
        }
    }
}

__device__ __forceinline__ void attn_phase(const Params& P, int layer, unsigned char* smem, unsigned* counter) {
    float* TAB = (float*)smem; bf16_t* KT = (bf16_t*)(smem + 16384); bf16_t* VTt = (bf16_t*)(smem + 16384 + 9216); int* sh_unit = (int*)(smem + 16384 + 9216 + 18432);
    const int tid = opaque_tid(), wid = __builtin_amdgcn_readfirstlane(tid >> 6), lane = tid & 63, r16 = lane & 15, quad = lane >> 4;
    const bf16_t* proj = (const bf16_t*)(P.ws + OFF_PROJ);
    bf16_t* AO = (bf16_t*)(P.ws + OFF_AO);
    const float* rel_bias = P.in[1];
    const float c1 = 0.125f * LOG2E;
    for (;;) {
        __syncthreads();
        if (tid == 0) *sh_unit = (int)atomicAdd(counter, 1u);
        __syncthreads();
        const int u = *sh_unit;
        if (u >= 1024) break;
        const int qb = u & 7, m = (u >> 3) & 1, h = (u >> 4) & 7, b = u >> 7;
        for (int e = tid; e < 4095; e += 512) { const int rel = e - 2047; const int n = rel < 0 ? -rel : rel; int bk;
            if (n < 8) bk = n; else { const int lg = 31 - __clz(n * n); bk = 2 + lg; if (bk > 15) bk = 15; }
            if (rel > 0) bk += 16; TAB[e] = rel_bias[bk * 8 + h] * LOG2E; }
        const int qrow0 = qb * 256 + wid * 32;
        bf16x8 Qf[2][2];
#pragma unroll
        for (int nq = 0; nq < 2; ++nq)
#pragma unroll
            for (int ks = 0; ks < 2; ++ks) Qf[nq][ks] = *(const bf16x8*)(proj + ((size_t)b * S + qrow0 + nq * 16 + r16) * PW + C_AQ + h * 128 + m * 64 + ks * 32 + quad * 8);
        f32x4 O[2][8];
#pragma unroll
        for (int nq = 0; nq < 2; ++nq)
#pragma unroll
            for (int dt = 0; dt < 8; ++dt) O[nq][dt] = (f32x4){0.f, 0.f, 0.f, 0.f};
        float mrun[2] = {-1e30f, -1e30f}, lrun[2] = {0.f, 0.f};
        const int kkey = tid >> 3, kchunk = tid & 7;
        const int vkp = tid & 31, vchunk = tid >> 5;
        const bf16_t* kbase = proj + ((size_t)b * S + kkey) * PW + C_AK + h * 128 + m * 64 + kchunk * 8;
        const bf16_t* vbase = proj + ((size_t)b * S + 2 * vkp) * PW + C_AV + h * 128 + vchunk * 8;
        u32x4 kreg = *(const u32x4*)kbase, vreg0 = *(const u32x4*)vbase, vreg1 = *(const u32x4*)(vbase + PW);
        for (int kt = 0; kt < 32; ++kt) {
            __syncthreads();
            *(u32x4*)(KT + kkey * 72 + kchunk * 8) = kreg;
            { unsigned* vd = (unsigned*)(VTt + (vchunk * 8) * 72 + 2 * vkp);
#pragma unroll
              for (int i2 = 0; i2 < 4; ++i2) { const unsigned a = vreg0[i2], bq = vreg1[i2];
                  vd[(2 * i2) * 36] = (a & 0xFFFFu) | (bq << 16); vd[(2 * i2 + 1) * 36] = (a >> 16) | (bq & 0xFFFF0000u); } }
            __syncthreads();
            if (kt + 1 < 32) { const size_t adv = (size_t)(kt + 1) * 64 * PW; kreg = *(const u32x4*)(kbase + adv); vreg0 = *(const u32x4*)(vbase + adv); vreg1 = *(const u32x4*)(vbase + adv + PW); }
            const int k0 = kt * 64;
            f32x4 st[2][4];
#pragma unroll
            for (int mt = 0; mt < 4; ++mt) {
                const bf16x8 ka = *(const bf16x8*)(KT + (mt * 16 + r16) * 72 + quad * 8), kb2 = *(const bf16x8*)(KT + (mt * 16 + r16) * 72 + 32 + quad * 8);
#pragma unroll
                for (int nq = 0; nq < 2; ++nq) { f32x4 a = {0.f, 0.f, 0.f, 0.f}; a = MFMA16(ka, Qf[nq][0], a); a = MFMA16(kb2, Qf[nq][1], a); st[nq][mt] = a; }
            }
            const bool posfar = (k0 - (qrow0 + 31)) >= 96, negfar = (qrow0 - (k0 + 63)) >= 96;
            if (posfar || negfar) {
                const float cb = posfar ? TAB[2047 + 128] : TAB[2047 - 128];
#pragma unroll
                for (int nq = 0; nq < 2; ++nq)
#pragma unroll
                    for (int mt = 0; mt < 4; ++mt) st[nq][mt] = st[nq][mt] * c1 + cb;
            } else {
#pragma unroll
                for (int nq = 0; nq < 2; ++nq)
#pragma unroll
                    for (int mt = 0; mt < 4; ++mt) { const float* tp = TAB + (k0 + mt * 16 + quad * 4) - (qrow0 + nq * 16 + r16) + 2047;
#pragma unroll
                        for (int rg = 0; rg < 4; ++rg) st[nq][mt][rg] = st[nq][mt][rg] * c1 + tp[rg]; }
            }
            bf16x8 pf[2][2];
#pragma unroll
            for (int nq = 0; nq < 2; ++nq) {
                float mx = st[nq][0][0];
#pragma unroll
                for (int mt = 0; mt < 4; ++mt)
#pragma unroll
                    for (int rg = 0; rg < 4; ++rg) mx = fmaxf(mx, st[nq][mt][rg]);
                mx = fmaxf(mx, __shfl_xor(mx, 16)); mx = fmaxf(mx, __shfl_xor(mx, 32));
                const float mnew = fmaxf(mrun[nq], mx); const float alpha = __builtin_amdgcn_exp2f(mrun[nq] - mnew); mrun[nq] = mnew;
                float ps = 0.f;
#pragma unroll
                for (int mt = 0; mt < 4; ++mt)
#pragma unroll
                    for (int rg = 0; rg < 4; ++rg) { const float pv = __builtin_amdgcn_exp2f(st[nq][mt][rg] - mnew); st[nq][mt][rg] = pv; ps += pv; }
                lrun[nq] = lrun[nq] * alpha + ps;
#pragma unroll
                for (int dt = 0; dt < 8; ++dt) O[nq][dt] = O[nq][dt] * alpha;
                pf[nq][0] = pack8(st[nq][0], st[nq][1]); pf[nq][1] = pack8(st[nq][2], st[nq][3]);
            }
#pragma unroll
            for (int dt = 0; dt < 8; ++dt) {
                const bf16_t* vr = VTt + (dt * 16 + r16) * 72 + quad * 4;
                const bf16x8 va0 = join8(*(const s16x4*)vr, *(const s16x4*)(vr + 16)), va1 = join8(*(const s16x4*)(vr + 32), *(const s16x4*)(vr + 48));
#pragma unroll
                for (int nq = 0; nq < 2; ++nq) { O[nq][dt] = MFMA16(va0, pf[nq][0], O[nq][dt]); O[nq][dt] = MFMA16(va1, pf[nq][1], O[nq][dt]); }
            }
        }
#pragma unroll
        for (int nq = 0; nq < 2; ++nq) {
            float l = lrun[nq]; l += __shfl_xor(l, 16); l += __shfl_xor(l, 32);
            const float inv = 1.f / l;
            bf16_t* orow = AO + ((size_t)m * M + (size_t)b * S + qrow0 + nq * 16 + r16) * 1024 + h * 128 + quad * 4;
#pragma unroll
            for (int dt = 0; dt < 8; ++dt) { u32x2 w; w.x = pk2(O[nq][dt][0] * inv, O[nq][dt][1] * inv); w.y = pk2(O[nq][dt][2] * inv, O[nq][dt][3] * inv); *(u32x2*)(orow + dt * 16) = w; }
        }
    }
}

__device__ __forceinline__ void load16(const bf16_t* p, float* o) {
    const u32x4 a = *(const u32x4*)p, b = *(const u32x4*)(p + 8);
#pragma unroll
    for (int i = 0; i < 4; ++i) { o[2 * i] = __uint_as_float(a[i] << 16); o[2 * i + 1] = __uint_as_float(a[i] & 0xFFFF0000u); o[8 + 2 * i] = __uint_as_float(b[i] << 16); o[8 + 2 * i + 1] = __uint_as_float(b[i] & 0xFFFF0000u); }
}
__device__ __forceinline__ void store16(bf16_t* p, const float* v) {
    u32x4 a, b; a.x = pk2(v[0], v[1]); a.y = pk2(v[2], v[3]); a.z = pk2(v[4], v[5]); a.w = pk2(v[6], v[7]); b.x = pk2(v[8], v[9]); b.y = pk2(v[10], v[11]); b.z = pk2(v[12], v[13]); b.w = pk2(v[14], v[15]);
    *(u32x4*)p = a; *(u32x4*)(p + 8) = b;
}
__device__ __forceinline__ void loadf16(const float* p, float* o) {
#pragma unroll
    for (int i = 0; i < 4; ++i) { const float4 v = ((const float4*)p)[i]; o[4 * i] = v.x; o[4 * i + 1] = v.y; o[4 * i + 2] = v.z; o[4 * i + 3] = v.w; }
}
__device__ __forceinline__ void finish_phase(const Params& P, int layer) {
    const int tid_ = opaque_tid(); const int lane = tid_ & 63, gw = opaque_bid() * 8 + (tid_ >> 6), ngw = gridDim.x * 8;
    const bf16_t* proj = (const bf16_t*)(P.ws + OFF_PROJ);
    const bf16_t* AO = (const bf16_t*)(P.ws + OFF_AO); const bf16_t* YB = (const bf16_t*)(P.ws + OFF_U); const bf16_t* OC = (const bf16_t*)(P.ws + OFF_OC);
    const float* BON = (const float*)(P.ws + OFF_BON);
    bf16_t* MIX = (bf16_t*)(P.ws + OFF_MIXED);
    const float lam_init = 0.8f - 0.6f * expf(-0.3f * (float)layer);
    const float s1 = wave_sum(P.in[6][layer * 64 + lane] * P.in[7][layer * 64 + lane]), s2 = wave_sum(P.in[8][layer * 64 + lane] * P.in[9][layer * 64 + lane]);
    const float lam = expf(s1) - expf(s2) + lam_init;
    const int c0 = lane * 16;
    const float* mu0p = P.in[11] + (size_t)layer * 2 * 3328 + 2048 + c0; const float* mu1p = mu0p + 3328;
    for (int tok = gw; tok < M; tok += ngw) {
        const bf16_t* prow = proj + (size_t)tok * PW;
        bf16_t* mrow = MIX + (size_t)tok * MIXW;
        float a[16], bb[16], g[16], pr[16];
        load16(AO + (size_t)tok * 1024 + c0, a); load16(AO + ((size_t)M + tok) * 1024 + c0, bb); load16(prow + C_AG + c0, g);
        { float ss = 0.f;
#pragma unroll
          for (int i = 0; i < 16; ++i) { a[i] = a[i] - lam * bb[i]; ss += a[i] * a[i]; }
          ss += __shfl_xor(ss, 1); ss += __shfl_xor(ss, 2); ss += __shfl_xor(ss, 4);
          const float rstd = rsqrtf(ss * (1.f / 128.f) + 1e-5f) * (1.f - lam_init);
          loadf16(P.in[10] + layer * 128 + (c0 & 127), pr);
#pragma unroll
          for (int i = 0; i < 16; ++i) a[i] = a[i] * rstd * pr[i] * siluf_(g[i]);
          store16(mrow + c0, a); }
        load16(YB + (size_t)tok * 1024 + c0, a); load16(YB + ((size_t)M + tok) * 1024 + c0, bb); load16(prow + C_BG + c0, g);
        { float sm = 0.f;
#pragma unroll
          for (int i = 0; i < 16; ++i) { a[i] += bb[i]; sm += a[i]; }
          sm += __shfl_xor(sm, 1); sm += __shfl_xor(sm, 2);
          const float mean = sm * (1.f / 64.f); float vs = 0.f;
#pragma unroll
          for (int i = 0; i < 16; ++i) { a[i] -= mean; vs += a[i] * a[i]; }
          vs += __shfl_xor(vs, 1); vs += __shfl_xor(vs, 2);
          const float rstd = rsqrtf(vs * (1.f / 64.f) + 64e-5f);
          const int head = lane >> 2;
          const float bon = BON[(((size_t)(tok >> 11)) * 16 + head) * S + (tok & (S - 1))] + BON[(((size_t)NB + (tok >> 11)) * 16 + head) * S + (tok & (S - 1))];
          const int sp = tok & (S - 1);
          loadf16(P.in[19] + layer * 1024 + c0, pr);
#pragma unroll
          for (int i = 0; i < 16; ++i) a[i] = a[i] * rstd * pr[i];
          loadf16(P.in[20] + layer * 1024 + c0, pr);
#pragma unroll
          for (int i = 0; i < 16; ++i) a[i] += pr[i];
          load16(prow + C_B + 2048 + c0, bb);
          float vsft[16];
          { float nb[16];
            if (sp > 0) load16(prow - PW + C_B + 2048 + c0, nb); else {
#pragma unroll
                for (int i = 0; i < 16; ++i) nb[i] = 0.f; }
            loadf16(mu0p, pr);
#pragma unroll
            for (int i = 0; i < 16; ++i) vsft[i] = bb[i] + pr[i] * (nb[i] - bb[i]);
            if (sp < S - 1) load16(prow + PW + C_B + 2048 + c0, nb); else {
#pragma unroll
                for (int i = 0; i < 16; ++i) nb[i] = 0.f; }
            loadf16(mu1p, pr);
#pragma unroll
            for (int i = 0; i < 16; ++i) vsft[i] += pr[i] * (nb[i] - bb[i]); }
#pragma unroll
          for (int i = 0; i < 16; ++i) a[i] = (a[i] + bon * vsft[i]) * siluf_(g[i]);
          store16(mrow + 1024 + c0, a); }
        load16(OC + (size_t)tok * 1024 + c0, a); load16(OC + ((size_t)M + tok) * 1024 + c0, bb); load16(prow + C_CG + c0, g);
        { float ss = 0.f;
#pragma unroll
          for (int i = 0; i < 16; ++i) { a[i] += bb[i]; ss += a[i] * a[i]; }
          ss += __shfl_xor(ss, 1); ss += __shfl_xor(ss, 2); ss += __shfl_xor(ss, 4);
          const float rstd = rsqrtf(ss * (1.f / 128.f) + 1e-6f);
          loadf16(P.in[22] + layer * 128 + (c0 & 127), pr);
#pragma unroll
          for (int i = 0; i < 16; ++i) a[i] = a[i] * rstd * pr[i] * siluf_(g[i]);
          store16(mrow + 2048 + c0, a); }
    }
}

__global__ void __launch_bounds__(NTHR, 2) fwd_megakernel(Params P) {
    extern __shared__ __attribute__((aligned(16))) unsigned char smem[];
    cg::grid_group grid = cg::this_grid();
    unsigned* ctl = (unsigned*)(P.ws + OFF_CTL);
    bf16_t* U = (bf16_t*)(P.ws + OFF_U);
    float* Y = (float*)(P.ws + OFF_PROJ);
#ifndef REP_P0
#define REP_P0 1
#endif
#pragma unroll 1
    for (int rep = 0; rep < REP_P0; ++rep) { convert_weights(P, 0, smem);
    prenorm_rows(P.in[0], P.in[2], U); }
    grid.sync();
#pragma unroll 1
    for (int layer = 0; layer < DEPTH; ++layer) {
#ifndef REP_G1
#define REP_G1 1
#endif
#pragma unroll 1
        for (int rep = 0; rep < REP_G1; ++rep) { pg8::Gemm g; g.A = U; g.Bt = (const bf16_t*)(P.ws + OFF_WIN); g.M = opaque_s(M); g.N = opaque_s(PW); g.K = opaque_s(D);
          pg8::StaticOrder So; So.init(g.M, g.N, (int)gridDim.x, opaque_bid());
          pg8::EpiBf16<0> E; E.O = (bf16_t*)(P.ws + OFF_PROJ); E.ldc = g.N; E.bias = nullptr; E.split_cols = 0; E.split_stride = 0;
          pg8::gemm_phase<pg8::EpiBf16<0>, pg8::StaticOrder, false>((PG8_LAS unsigned char*)smem, g, So, E, nullptr); }
        grid.sync();
#ifndef REP_RWKV
#define REP_RWKV 1
#endif
#ifndef REP_HGRN
#define REP_HGRN 1
#endif
#ifndef REP_ATTN
#define REP_ATTN 1
#endif
#pragma unroll 1
        for (int rep = 0; rep < REP_RWKV; ++rep) rwkv_phase(P, layer, smem);
#pragma unroll 1
        for (int rep = 0; rep < REP_HGRN; ++rep) hgrn_phase(P, layer, smem);
#pragma unroll 1
        for (int rep = 0; rep < REP_ATTN; ++rep) attn_phase(P, layer, smem, ctl + 64 * layer + 128 * rep);
        grid.sync();
#ifndef REP_FIN
#define REP_FIN 1
#endif
#pragma unroll 1
        for (int rep = 0; rep < REP_FIN; ++rep) finish_phase(P, layer);
        grid.sync();
#ifndef REP_G2
#define REP_G2 1
#endif
#pragma unroll 1
        for (int rep = 0; rep < REP_G2; ++rep) { pg8::Gemm g; g.A = (const bf16_t*)(P.ws + OFF_MIXED); g.Bt = (const bf16_t*)(P.ws + OFF_WOUT); g.M = opaque_s(M); g.N = opaque_s(D); g.K = opaque_s(MIXW);
          pg8::StaticOrder So; So.init(g.M, g.N, (int)gridDim.x, opaque_bid());
          pg8::EpiF32 E; E.C = Y; E.ldc = g.N; E.bias = nullptr;
          pg8::gemm_phase<pg8::EpiF32, pg8::StaticOrder, false>((PG8_LAS unsigned char*)smem, g, So, E, nullptr); }
        grid.sync();
        if (layer + 1 < DEPTH) {
            postnorm_rows(Y, layer == 0 ? P.in[0] : P.out, P.out, P.in[3] + layer * D, P.in[2] + (layer + 1) * D, U);
            convert_weights(P, layer + 1, smem);
            grid.sync();
        } else {
            postnorm_rows(Y, layer == 0 ? P.in[0] : P.out, P.out, P.in[3] + layer * D, nullptr, U);
        }
    }
}
}

extern "C" void kernel_launch(void* const* d_in, const int* in_sizes, int n_in, void* d_out, int out_size, void* d_ws, size_t ws_size, hipStream_t stream) {
    static int grid_blocks = 0;
    if (grid_blocks == 0) {
        int dev = 0, cus = 0, per_cu = 0;
        hipGetDevice(&dev);
        hipDeviceGetAttribute(&cus, hipDeviceAttributeMultiprocessorCount, dev);
        if (hipFuncSetAttribute((const void*)mk::fwd_megakernel, hipFuncAttributeMaxDynamicSharedMemorySize, mk::LDS_BYTES) != hipSuccess) fprintf(stderr, "hipFuncSetAttribute failed\n");
        if (hipOccupancyMaxActiveBlocksPerMultiprocessor(&per_cu, (const void*)mk::fwd_megakernel, mk::NTHR, mk::LDS_BYTES) != hipSuccess || per_cu < 1) { fprintf(stderr, "occupancy query: %d\n", per_cu); per_cu = 1; }
        (void)hipGetLastError();
        grid_blocks = cus * 1;
        if (ws_size < mk::WS_END) fprintf(stderr, "workspace too small: %zu < %zu\n", ws_size, (size_t)mk::WS_END);
    }
    hipMemsetAsync((unsigned char*)d_ws + mk::OFF_CTL, 0, 4096, stream);
    mk::Params p{};
    for (int i = 0; i < 23; ++i) p.in[i] = (const float*)d_in[i];
    p.out = (float*)d_out; p.ws = (unsigned char*)d_ws;
    void* args[] = {&p};
    hipError_t e = hipLaunchCooperativeKernel((const void*)mk::fwd_megakernel, dim3(grid_blocks), dim3(mk::NTHR), args, mk::LDS_BYTES, stream);
    if (e != hipSuccess) fprintf(stderr, "cooperative launch failed: %s (grid %d)\n", hipGetErrorString(e), grid_blocks);
}
```

```cpp
#include <hip/hip_runtime.h>
#include <hip/hip_cooperative_groups.h>
#include <cstdio>
#include <cstdint>
namespace cg = cooperative_groups;
namespace pg8 {
#define PG8_LAS __attribute__((address_space(3)))
typedef unsigned short bf16_t;
typedef short bf16x8 __attribute__((ext_vector_type(8)));
typedef float f32x4 __attribute__((ext_vector_type(4)));
typedef unsigned u32x4 __attribute__((ext_vector_type(4)));
constexpr int BM = 256, BK = 64, HALF = 128, HTB = HALF * BK * 2  , STAGE_BYTES = 8 * HTB, NXCD = 8, WGM = 8;

__host__ __device__ __forceinline__ int lds_byte(int r, int c) { const int st = (r >> 4) * 2 + (c >> 5), rr = r & 15, cc = c & 31, ob = rr * 64 + cc * 2; return st * 1024 + (ob ^ (((ob >> 9) & 1) << 5)); }
__host__ __device__ __forceinline__ void stage_rc(int b, int& R, int& C) { const int st = b / 1024, sb = b % 1024, swz = sb ^ (((sb >> 9) & 1) << 5); R = (st >> 1) * 16 + swz / 64; C = (st & 1) * 32 + (swz % 64) / 2; }
__host__ __device__ __forceinline__ int perm32(int rho) { const int n = rho >> 4, i = rho & 15; return 8 * (i >> 2) + 4 * n + (i & 3); }

struct Unit { int pm, pn; };
struct Gemm { const bf16_t* A; const bf16_t* Bt; int M, N, K; };

struct StaticOrder {
    int nM, nN, nwg, G, c;
    __host__ __device__ void init(int M, int N, int G_, int c_) { nM = M / BM; nN = N / BM; nwg = nM * nN; G = G_; c = c_; }
    __host__ __device__ bool next(int i, Unit& u) const {
        const long L = (long)i * G + c; if (L >= nwg) return false;
        int wgid = (int)L; { const int q = nwg / NXCD, r = nwg % NXCD, xcd = wgid % NXCD, off = wgid / NXCD; wgid = (xcd < r ? xcd * (q + 1) : r * (q + 1) + (xcd - r) * q) + off; }
        const int nig = WGM * nN, gid = wgid / nig, fm = gid * WGM, gsz = (nM - fm) < WGM ? (nM - fm) : WGM;
        u.pm = fm + ((wgid % nig) % gsz); u.pn = (wgid % nig) / gsz; return true;
    }
    __device__ __forceinline__ void a_ready(const Unit&) const {}
    __device__ __forceinline__ void done(const Unit&) const {}
};
struct CountedOrder : StaticOrder {
    const unsigned* ready; unsigned need; unsigned* tmo;
    __device__ __forceinline__ void a_ready(const Unit& u) const {
        if (threadIdx.x < 64) {
            const unsigned long long t0 = __builtin_amdgcn_s_memrealtime(); unsigned polls = 0;
            while ((unsigned)__builtin_amdgcn_readfirstlane(__hip_atomic_load(ready + 64 * u.pm, __ATOMIC_RELAXED, __HIP_MEMORY_SCOPE_AGENT)) < need) {
                if ((++polls & 255u) == 0u && __builtin_amdgcn_readfirstlane(__hip_atomic_load(tmo, __ATOMIC_RELAXED, __HIP_MEMORY_SCOPE_AGENT)) != 0u) break;
                if (__builtin_amdgcn_s_memrealtime() - t0 > 2000000ull) {
                    if (threadIdx.x == 0) { unsigned expect = 0u; __hip_atomic_compare_exchange_strong(tmo + 1, &expect, 0x600u | (unsigned)(u.pm & 0xff), __ATOMIC_RELAXED, __ATOMIC_RELAXED, __HIP_MEMORY_SCOPE_AGENT); __hip_atomic_store(tmo, 1u, __ATOMIC_RELAXED, __HIP_MEMORY_SCOPE_AGENT); }
                    break; }
                __builtin_amdgcn_s_sleep(2); }
            __builtin_amdgcn_fence(__ATOMIC_ACQUIRE, "agent");
            asm volatile("s_waitcnt vmcnt(0)" ::: "memory");
        }
#if !defined(BROKEN_HOOK_NO_BARRIER)
        asm volatile("" ::: "memory"); __builtin_amdgcn_s_barrier(); asm volatile("" ::: "memory");
#endif
    }
};

typedef __bf16 bf16x2_t __attribute__((ext_vector_type(2)));
typedef float f32x2c __attribute__((ext_vector_type(2)));
__device__ __forceinline__ unsigned cvt_pk_bf16(float lo, float hi) { f32x2c v = {lo, hi}; bf16x2_t b = __builtin_convertvector(v, bf16x2_t); return __builtin_bit_cast(unsigned, b); }
typedef float f32x2 __attribute__((ext_vector_type(2)));
__device__ __forceinline__ f32x2 gelu_pk(f32x2 v) {
    const f32x2 av = __builtin_elementwise_abs(v), d = av * 0.2316418882f + 1.0f;
    f32x2 t; t.x = __builtin_amdgcn_rcpf(d.x); t.y = __builtin_amdgcn_rcpf(d.y);
    f32x2 q = t * 0.5307027145f + (-0.7265760135f); q = q * t + 0.7107068705f; q = q * t + (-0.142248368f); q = q * t + 0.127414796f; q = q * t;
    const f32x2 s = (v * v) * (-0.72134752044f);
    f32x2 e; e.x = __builtin_amdgcn_exp2f(s.x); e.y = __builtin_amdgcn_exp2f(s.y);
    const f32x2 m = v * (q * e), r = v - m;
    f32x2 o; o.x = v.x < 0.f ? m.x : r.x; o.y = v.y < 0.f ? m.y : r.y; return o;
}

struct EpiF32 {
    static constexpr bool PERM = false, AFTER_DRAIN = false;
    float* C; int ldc; const float* bias;
    __device__ __forceinline__ void operator()(const f32x4 (&acc)[2][2][4][2], const Unit& u, int wr, int wc, int fr, int fq) const {
        const int row0 = u.pm * BM + wr * 64 + fr, col0 = u.pn * BM + wc * 32 + 4 * fq;
        f32x4 bv[2][2];
#pragma unroll
        for (int bj = 0; bj < 2; ++bj)
#pragma unroll
            for (int n = 0; n < 2; ++n) bv[bj][n] = bias ? *(const f32x4*)(bias + col0 + bj * HALF + n * 16) : (f32x4){0.f, 0.f, 0.f, 0.f};
#pragma unroll
        for (int ai = 0; ai < 2; ++ai)
#pragma unroll
            for (int m = 0; m < 4; ++m) { float* rowp = C + (size_t)(row0 + ai * HALF + m * 16) * ldc + col0;
#pragma unroll
                for (int bj = 0; bj < 2; ++bj)
#pragma unroll
                    for (int n = 0; n < 2; ++n) *(f32x4*)(rowp + bj * HALF + n * 16) = acc[ai][bj][m][n] + bv[bj][n]; }
    }
};
template <int ACT  > struct EpiBf16 {
    static constexpr bool PERM = true, AFTER_DRAIN = false;
    bf16_t* O; int ldc; const float* bias; int split_cols; size_t split_stride;
    __device__ __forceinline__ void operator()(const f32x4 (&acc)[2][2][4][2], const Unit& u, int wr, int wc, int fr, int fq) const {
        const int row0 = u.pm * BM + wr * 64 + fr; int colt = u.pn * BM; bf16_t* base = O;
        if (split_cols) { const int t = colt / split_cols; base += (size_t)t * split_stride; colt -= t * split_cols; }
        const int col0 = colt + wc * 32 + 8 * fq, bcol0 = u.pn * BM + wc * 32 + 8 * fq;
        f32x4 bv[2][2];
#pragma unroll
        for (int bj = 0; bj < 2; ++bj)
#pragma unroll
            for (int n = 0; n < 2; ++n) bv[bj][n] = bias ? *(const f32x4*)(bias + bcol0 + bj * HALF + 4 * n) : (f32x4){0.f, 0.f, 0.f, 0.f};
#pragma unroll
        for (int ai = 0; ai < 2; ++ai)
#pragma unroll
            for (int m = 0; m < 4; ++m) { bf16_t* rowp = base + (size_t)(row0 + ai * HALF + m * 16) * ldc + col0;
#pragma unroll
                for (int bj = 0; bj < 2; ++bj) { f32x4 v0 = acc[ai][bj][m][0] + bv[bj][0], v1 = acc[ai][bj][m][1] + bv[bj][1];
                    if (ACT == 1) { f32x2 a = gelu_pk((f32x2){v0[0], v0[1]}), b = gelu_pk((f32x2){v0[2], v0[3]}), c = gelu_pk((f32x2){v1[0], v1[1]}), d = gelu_pk((f32x2){v1[2], v1[3]});
                        v0 = (f32x4){a.x, a.y, b.x, b.y}; v1 = (f32x4){c.x, c.y, d.x, d.y}; }
                    if (ACT == 2) {
#pragma unroll
                        for (int j = 0; j < 4; ++j) { v0[j] = 0.5f * v0[j] * (1.0f + erff(v0[j] * 0.70710678f)); v1[j] = 0.5f * v1[j] * (1.0f + erff(v1[j] * 0.70710678f)); } }
                    u32x4 w; w.x = cvt_pk_bf16(v0[0], v0[1]); w.y = cvt_pk_bf16(v0[2], v0[3]); w.z = cvt_pk_bf16(v1[0], v1[1]); w.w = cvt_pk_bf16(v1[2], v1[3]);
                    *(u32x4*)(rowp + bj * HALF) = w; } }
    }
};


template <class Epi, class Sched, bool STAMP = false>
__device__ __forceinline__ void gemm_phase(PG8_LAS unsigned char* lds, const Gemm g, const Sched& S, const Epi& E, unsigned long long* stamps) {
    int tid_o = threadIdx.x; asm volatile("" : "+v"(tid_o));
    const int tid = tid_o, wid = __builtin_amdgcn_readfirstlane(tid >> 6), lane = tid & 63, wr = wid >> 2, wc = wid & 3, fr = lane & 15, fq = lane >> 4;
    const int K = g.K, nt = K / BK;
    int ts_lo = 0, ts_hi = 0, nts = 0; const unsigned long long rt_entry = STAMP ? (unsigned long long)wall_clock64() : 0ull;
#define PG8_STAMP() do { if (STAMP && wid == 0 && nts < 64) { const unsigned long long _c = (unsigned long long)clock64(); \
        ts_lo = (lane == nts) ? (int)(unsigned)_c : ts_lo; ts_hi = (lane == nts) ? (int)(unsigned)(_c >> 32) : ts_hi; ++nts; } } while (0)
    PG8_STAMP();
    unsigned voffA[2], voffB[2];
#pragma unroll
    for (int i = 0; i < 2; ++i) { int R, C; stage_rc(tid * 16 + i * 8192, R, C); const int Rb = Epi::PERM ? ((R & ~31) + perm32(R & 31)) : R;
        voffA[i] = (unsigned)(R * K + C) * 2u; voffB[i] = (unsigned)(Rb * K + C) * 2u; }
    const size_t kstep = (size_t)(BK * 2);
    const size_t hstep = (size_t)HALF * K * 2;
    const size_t tstep = 2 * hstep;
    const unsigned ldsw = (unsigned)wid * 1024u;
    const int aoff = lds_byte(wr * 64 + fr, fq * 8), boff = lds_byte(wc * 32 + fr, fq * 8);
#define PG8_SA(b, h) (((b) * 2 + (h)) * HTB)
#define PG8_SB(b, h) ((4 + (b) * 2 + (h)) * HTB)
#define PG8_STAGE(bufoff, gbase, voff) do { _Pragma("unroll") for (int _i = 0; _i < 2; ++_i) \
        __builtin_amdgcn_global_load_lds((const unsigned*)((const char*)(gbase) + (voff)[_i]), (PG8_LAS unsigned*)(lds + (bufoff) + ldsw + _i * 8192), 16, 0, 0); } while (0)
#define PG8_LDA(dst, b, h) do { _Pragma("unroll") for (int m = 0; m < 4; ++m) _Pragma("unroll") for (int k = 0; k < 2; ++k) dst[m][k] = *(const PG8_LAS bf16x8*)(lds + PG8_SA(b, h) + aoff + m * 2048 + k * 1024); } while (0)
#define PG8_LDB(dst, b, h) do { _Pragma("unroll") for (int n = 0; n < 2; ++n) _Pragma("unroll") for (int k = 0; k < 2; ++k) dst[n][k] = *(const PG8_LAS bf16x8*)(lds + PG8_SB(b, h) + boff + n * 2048 + k * 1024); } while (0)
#define PG8_MMA(ai, bj, At, Bt) do { __builtin_amdgcn_s_setprio(1); _Pragma("unroll") for (int m = 0; m < 4; ++m) _Pragma("unroll") for (int n = 0; n < 2; ++n) _Pragma("unroll") for (int k = 0; k < 2; ++k) \
        acc[ai][bj][m][n] = __builtin_amdgcn_mfma_f32_16x16x32_bf16(Bt[n][k], At[m][k], acc[ai][bj][m][n], 0, 0, 0); __builtin_amdgcn_s_setprio(0); } while (0)
#define PG8_WAIT_V(n) asm volatile("s_waitcnt vmcnt(" #n ")" ::: "memory")
#define PG8_WAIT_L(n) asm volatile("s_waitcnt lgkmcnt(" #n ")" ::: "memory")
#define PG8_BAR __builtin_amdgcn_s_barrier()
#define PG8_SCHED __builtin_amdgcn_sched_barrier(0)
    Unit cur, nxt; int ui = 0;
    if (!S.next(0, cur)) return;
    f32x4 acc[2][2][4][2];
#pragma unroll
    for (int a = 0; a < 2; ++a)
#pragma unroll
        for (int b = 0; b < 2; ++b)
#pragma unroll
            for (int m = 0; m < 4; ++m)
#pragma unroll
                for (int n = 0; n < 2; ++n) acc[a][b][m][n] = (f32x4){0.f, 0.f, 0.f, 0.f};
    bf16x8 At[4][2], B0[2][2], B1[2][2];
    const char* cA = (const char*)g.A + (size_t)cur.pm * tstep; const char* cB = (const char*)g.Bt + (size_t)cur.pn * tstep;
    S.a_ready(cur);
    PG8_STAGE(PG8_SB(0, 0), cB, voffB); PG8_STAGE(PG8_SA(0, 0), cA, voffA); PG8_STAGE(PG8_SB(0, 1), cB + hstep, voffB); PG8_STAGE(PG8_SA(0, 1), cA + hstep, voffA);
    if (wr == 1) PG8_BAR;
    PG8_WAIT_V(4); PG8_BAR;
    PG8_STAGE(PG8_SB(1, 0), cB + kstep, voffB); PG8_STAGE(PG8_SA(1, 0), cA + kstep, voffA); PG8_STAGE(PG8_SB(1, 1), cB + hstep + kstep, voffB);
    PG8_WAIT_V(6); PG8_BAR;
    PG8_STAMP();
    for (;;) {
        const bool has_next = S.next(ui + 1, nxt);
        const char* nA = has_next ? (const char*)g.A + (size_t)nxt.pm * tstep : cA; const char* nB = has_next ? (const char*)g.Bt + (size_t)nxt.pn * tstep : cB;
        for (int t = 0; t < nt; t += 2) {
            const bool last = (t == nt - 2);
            const char* a1 = cA + (size_t)(t + 1) * kstep;
            const char* a2 = last ? nA : cA + (size_t)(t + 2) * kstep; const char* b2 = last ? nB : cB + (size_t)(t + 2) * kstep;
            const char* a3 = a2 + kstep; const char* b3 = b2 + kstep;
            if (last && has_next) S.a_ready(nxt);
            PG8_LDB(B0, 0, 0); PG8_SCHED; PG8_LDA(At, 0, 0); PG8_STAGE(PG8_SA(1, 1), a1 + hstep, voffA);
            PG8_WAIT_L(8); PG8_BAR; PG8_WAIT_L(0); PG8_MMA(0, 0, At, B0); PG8_BAR; PG8_SCHED;
            PG8_LDB(B1, 0, 1); PG8_STAGE(PG8_SB(0, 0), b2, voffB);
            PG8_BAR; PG8_WAIT_L(0); PG8_MMA(0, 1, At, B1); PG8_BAR;
            PG8_LDA(At, 0, 1); PG8_STAGE(PG8_SA(0, 0), a2, voffA);
            PG8_BAR; PG8_WAIT_L(0); PG8_MMA(1, 0, At, B0); PG8_BAR; PG8_SCHED;
            PG8_STAGE(PG8_SB(0, 1), b2 + hstep, voffB);
            PG8_WAIT_V(6); PG8_BAR; PG8_MMA(1, 1, At, B1); PG8_BAR;
            PG8_LDB(B0, 1, 0); PG8_SCHED; PG8_LDA(At, 1, 0); PG8_STAGE(PG8_SA(0, 1), a2 + hstep, voffA);
            PG8_WAIT_L(8); PG8_BAR; PG8_WAIT_L(0); PG8_MMA(0, 0, At, B0); PG8_BAR; PG8_SCHED;
            PG8_LDB(B1, 1, 1); PG8_STAGE(PG8_SB(1, 0), b3, voffB);
            PG8_BAR; PG8_WAIT_L(0); PG8_MMA(0, 1, At, B1); PG8_BAR;
            PG8_LDA(At, 1, 1); PG8_STAGE(PG8_SA(1, 0), a3, voffA);
            PG8_BAR; PG8_WAIT_L(0); PG8_MMA(1, 0, At, B0); PG8_BAR; PG8_SCHED;
            PG8_STAGE(PG8_SB(1, 1), b3 + hstep, voffB);
            PG8_WAIT_V(6); PG8_BAR; PG8_MMA(1, 1, At, B1); PG8_BAR;
        }
        PG8_STAMP();
        if constexpr (!Epi::AFTER_DRAIN) { E(acc, cur, wr, wc, fr, fq); S.done(cur); }
        PG8_STAMP();
        if (!has_next) break;
#pragma unroll
        for (int a = 0; a < 2; ++a)
#pragma unroll
            for (int b = 0; b < 2; ++b)
#pragma unroll
                for (int m = 0; m < 4; ++m)
#pragma unroll
                    for (int n = 0; n < 2; ++n) acc[a][b][m][n] = (f32x4){0.f, 0.f, 0.f, 0.f};
        cur = nxt; cA = nA; cB = nB; ++ui;
    }
    PG8_WAIT_V(0);
    if (wr == 0) PG8_BAR;
    PG8_BAR;
    if constexpr (Epi::AFTER_DRAIN) { E.fused(acc, cur, wr, wc, fr, fq, lds, wid, lane); S.done(cur); }
    PG8_STAMP();
    if (STAMP && wid == 0) { stamps[lane] = lane < nts ? (((unsigned long long)(unsigned)ts_hi << 32) | (unsigned)ts_lo) : 0ull;
        if (lane == 62) stamps[62] = rt_entry; if (lane == 63) stamps[63] = (unsigned long long)wall_clock64(); }
#undef PG8_STAMP
#undef PG8_SA
#undef PG8_SB
#undef PG8_STAGE
#undef PG8_LDA
#undef PG8_LDB
#undef PG8_MMA
#undef PG8_WAIT_V
#undef PG8_WAIT_L
#undef PG8_BAR
#undef PG8_SCHED
}
}

namespace mk {
using pg8::bf16_t; using pg8::bf16x8; using pg8::f32x4; using pg8::u32x4;
typedef short s16x4 __attribute__((ext_vector_type(4)));
typedef unsigned u32x2 __attribute__((ext_vector_type(2)));

constexpr int D = 2048, NB = 8, S = 2048, M = NB * S, BW = 1024, MIXW = 3072, PW = 13568, DEPTH = 2;
constexpr int C_AQ = 0, C_AK = 1024, C_AV = 2048, C_AG = 3072, C_B = 4096, C_BG = 7424, C_CQ = 8448, C_CI = 9472, C_CF = 10496, C_CG = 12544;
constexpr int NTHR = 512;
constexpr int LDS_BYTES = 147456;
constexpr float LOG2E = 1.4426950408889634f;

constexpr size_t OFF_CTL = 0;
constexpr size_t OFF_WIN = 4096;
constexpr size_t OFF_WOUT = OFF_WIN + (size_t)PW * D * 2;
constexpr size_t OFF_U = OFF_WOUT + (size_t)D * MIXW * 2;
constexpr size_t OFF_PROJ = OFF_U + (size_t)M * D * 2;
constexpr size_t OFF_MIXED = OFF_PROJ + (size_t)M * PW * 2;
constexpr size_t OFF_OC = OFF_MIXED + (size_t)M * MIXW * 2;
constexpr size_t OFF_AO = OFF_OC + (size_t)2 * M * BW * 2;
constexpr size_t OFF_BON = OFF_AO + (size_t)2 * M * BW * 2;
constexpr size_t WS_END = OFF_BON + (size_t)2 * M * 16 * 4;

struct Params { const float* in[23]; float* out; unsigned char* ws; };
__device__ __forceinline__ int opaque_tid() { int t = threadIdx.x; asm volatile("" : "+v"(t)); return t; }
__device__ __forceinline__ int opaque_s(int t) { asm volatile("" : "+s"(t)); return t; }
__device__ __forceinline__ int opaque_bid() { int t = blockIdx.x; asm volatile("" : "+s"(t)); return t; }


__device__ __forceinline__ float bf2f(bf16_t v) { return __uint_as_float(((unsigned)v) << 16); }
__device__ __forceinline__ bf16_t f2bf(float f) { unsigned u = __float_as_uint(f); u += 0x7FFFu + ((u >> 16) & 1u); return (bf16_t)(u >> 16); }
typedef __bf16 bf16x2_t __attribute__((ext_vector_type(2)));
typedef float f32x2c __attribute__((ext_vector_type(2)));
__device__ __forceinline__ unsigned pk2(float lo, float hi) { f32x2c v = {lo, hi}; bf16x2_t b = __builtin_convertvector(v, bf16x2_t); return __builtin_bit_cast(unsigned, b); }
__device__ __forceinline__ float wave_sum(float v) {
#pragma unroll
    for (int o = 1; o < 64; o <<= 1) v += __shfl_xor(v, o);
    return v;
}
__device__ __forceinline__ float sigmoidf_(float x) { return 1.f / (1.f + __expf(-x)); }
__device__ __forceinline__ float siluf_(float x) { return x / (1.f + __expf(-x)); }
__device__ __forceinline__ float dpp_xor1(float v) { return __int_as_float(__builtin_amdgcn_mov_dpp(__float_as_int(v), 0xB1, 0xF, 0xF, true)); }
__device__ __forceinline__ float dpp_xor2(float v) { return __int_as_float(__builtin_amdgcn_mov_dpp(__float_as_int(v), 0x4E, 0xF, 0xF, true)); }
__device__ __forceinline__ float dpp_hmir(float v) { return __int_as_float(__builtin_amdgcn_mov_dpp(__float_as_int(v), 0x141, 0xF, 0xF, true)); }
__device__ __forceinline__ float dpp_mir(float v) { return __int_as_float(__builtin_amdgcn_mov_dpp(__float_as_int(v), 0x140, 0xF, 0xF, true)); }
__device__ __forceinline__ float wave_sum_fast(float v) {
    v += dpp_xor1(v); v += dpp_xor2(v); v += dpp_hmir(v); v += dpp_mir(v);
    v += __shfl_xor(v, 16); v += __shfl_xor(v, 32);
    return v;
}
__device__ __forceinline__ float fast_tanh(float x) { return 1.f - 2.f * __builtin_amdgcn_rcpf(1.f + __expf(2.f * x)); }
__device__ __forceinline__ float fast_sigmoid(float x) { return __builtin_amdgcn_rcpf(1.f + __expf(-x)); }
typedef float f32x2 __attribute__((ext_vector_type(2)));
#define MFMA16(a, b, c) __builtin_amdgcn_mfma_f32_16x16x32_bf16((a), (b), (c), 0, 0, 0)
__device__ __forceinline__ bf16x8 join8(s16x4 lo, s16x4 hi) { return __builtin_shufflevector(lo, hi, 0, 1, 2, 3, 4, 5, 6, 7); }
__device__ __forceinline__ bf16x8 pack8(f32x4 a, f32x4 b) {
    u32x4 w; w.x = pk2(a[0], a[1]); w.y = pk2(a[2], a[3]); w.z = pk2(b[0], b[1]); w.w = pk2(b[2], b[3]);
    return __builtin_bit_cast(bf16x8, w);
}

__device__ __forceinline__ void transpose_tile(const float* __restrict__ W, int K, int N, bf16_t* __restrict__ WT, float* tile, int it) {
    const int tid = opaque_tid();
    const int ntn = N >> 6; const int kb = it / ntn, nbk = it - kb * ntn; const int k0 = kb * 64, n0 = nbk * 64;
#pragma unroll
    for (int rr = 0; rr < 2; ++rr) { const int idx = tid + rr * 512; const int kk = idx >> 4, n4 = (idx & 15) * 4;
        const float4 v = *(const float4*)(W + (size_t)(k0 + kk) * N + n0 + n4);
        float* tp = tile + kk * 65 + n4; tp[0] = v.x; tp[1] = v.y; tp[2] = v.z; tp[3] = v.w; }
    __syncthreads();
    { const int n = tid >> 3, kc = (tid & 7) * 8; const float* tp = tile + kc * 65 + n;
      u32x4 o; o.x = pk2(tp[0], tp[65]); o.y = pk2(tp[2 * 65], tp[3 * 65]); o.z = pk2(tp[4 * 65], tp[5 * 65]); o.w = pk2(tp[6 * 65], tp[7 * 65]);
      *(u32x4*)(WT + (size_t)(n0 + n) * K + k0 + kc) = o; }
    __syncthreads();
}
__device__ __forceinline__ void convert_weights(const Params& P, int layer, unsigned char* smem) {
    float* tile = (float*)smem;
    const float* win = P.in[4] + (size_t)layer * D * PW; const float* wout = P.in[5] + (size_t)layer * MIXW * D;
    bf16_t* WinT = (bf16_t*)(P.ws + OFF_WIN); bf16_t* WoutT = (bf16_t*)(P.ws + OFF_WOUT);
    constexpr int T_IN = (D / 64) * (PW / 64), T_OUT = (MIXW / 64) * (D / 64);
    for (int it = opaque_bid(); it < T_IN + T_OUT; it += gridDim.x) {
        if (it < T_IN) transpose_tile(win, D, PW, WinT, tile, it);
        else transpose_tile(wout, MIXW, D, WoutT, tile, it - T_IN);
    }
}
__device__ __forceinline__ void prenorm_rows(const float* __restrict__ x, const float* __restrict__ g, bf16_t* __restrict__ U) {
    const int tid_ = opaque_tid(); const int lane = tid_ & 63, gw = opaque_bid() * 8 + (tid_ >> 6), ngw = gridDim.x * 8;
    for (int row = gw; row < M; row += ngw) {
        const float4* xr = (const float4*)(x + (size_t)row * D) + lane;
        float4 v[8]; float ss = 0.f;
#pragma unroll
        for (int j = 0; j < 8; ++j) { v[j] = xr[64 * j]; ss += v[j].x * v[j].x + v[j].y * v[j].y + v[j].z * v[j].z + v[j].w * v[j].w; }
        const float rstd = rsqrtf(wave_sum(ss) * (1.f / D) + 1e-6f);
        u32x2* o = (u32x2*)(U + (size_t)row * D) + lane;
#pragma unroll
        for (int j = 0; j < 8; ++j) { const float4 gg = ((const float4*)g)[64 * j + lane];
            u32x2 w; w.x = pk2(v[j].x * rstd * gg.x, v[j].y * rstd * gg.y); w.y = pk2(v[j].z * rstd * gg.z, v[j].w * rstd * gg.w); o[64 * j] = w; }
    }
}
__device__ __forceinline__ void postnorm_rows(const float* __restrict__ y, const float* xin, float* xout, const float* __restrict__ gpost, const float* __restrict__ gpre, bf16_t* __restrict__ U) {
    const int tid_ = opaque_tid(); const int lane = tid_ & 63, gw = opaque_bid() * 8 + (tid_ >> 6), ngw = gridDim.x * 8;
    for (int row = gw; row < M; row += ngw) {
        const float4* yr = (const float4*)(y + (size_t)row * D) + lane;
        const float4* xr = (const float4*)(xin + (size_t)row * D) + lane;
        float4* xo = (float4*)(xout + (size_t)row * D) + lane;
        float4 v[8]; float ss = 0.f;
#pragma unroll
        for (int j = 0; j < 8; ++j) { v[j] = yr[64 * j]; ss += v[j].x * v[j].x + v[j].y * v[j].y + v[j].z * v[j].z + v[j].w * v[j].w; }
        const float rstd = rsqrtf(wave_sum(ss) * (1.f / D) + 1e-6f);
        float s2 = 0.f;
#pragma unroll
        for (int j = 0; j < 8; ++j) { const float4 gg = ((const float4*)gpost)[64 * j + lane]; const float4 xv = xr[64 * j];
            v[j].x = xv.x + v[j].x * rstd * gg.x; v[j].y = xv.y + v[j].y * rstd * gg.y; v[j].z = xv.z + v[j].z * rstd * gg.z; v[j].w = xv.w + v[j].w * rstd * gg.w;
            xo[64 * j] = v[j]; s2 += v[j].x * v[j].x + v[j].y * v[j].y + v[j].z * v[j].z + v[j].w * v[j].w; }
        if (gpre) {
            const float r2 = rsqrtf(wave_sum(s2) * (1.f / D) + 1e-6f);
            u32x2* o = (u32x2*)(U + (size_t)row * D) + lane;
#pragma unroll
            for (int j = 0; j < 8; ++j) { const float4 gg = ((const float4*)gpre)[64 * j + lane];
                u32x2 w; w.x = pk2(v[j].x * r2 * gg.x, v[j].y * r2 * gg.y); w.y = pk2(v[j].z * r2 * gg.z, v[j].w * r2 * gg.w); o[64 * j] = w; }
        }
    }
}

#define RWKV_LOAD_RAW(cc) do { const int n0_ = (cc) * TCH + pw * TPW; const int T0_ = d ? (S - 1 - n0_) : n0_; const int dstep_ = d ? -1 : 1; \
    _Pragma("unroll") for (int j = 0; j < TPW + 2; ++j) { const int tj = T0_ + (j - 1) * dstep_; const bool ok = (tj >= 0) && (tj < S); \
        const bf16_t* row = proj + ((size_t)b * S + (ok ? tj : T0_)) * PW + C_B; \
        raw[j][0] = row[cr]; raw[j][1] = row[ck]; raw[j][2] = row[cv]; raw[j][3] = row[cw]; raw[j][4] = row[ca]; \
        if (!ok) { raw[j][0] = 0; raw[j][1] = 0; raw[j][2] = 0; raw[j][3] = 0; raw[j][4] = 0; } } } while (0)
__device__ __forceinline__ void rwkv_phase(const Params& P, int layer, unsigned char* smem) {
    constexpr int TCH = 16, TPW = 4, NCH = S / TCH;
    float* VEC = (float*)smem;
    bf16_t* UPT = (bf16_t*)(smem + 49152);
    unsigned char* pbase = smem + 49152 + 18432;
    unsigned char* cbase = smem + 49152 + 18432 + 12800;
    const int tid = opaque_tid(), wid = __builtin_amdgcn_readfirstlane(tid >> 6), lane = tid & 63, r16 = lane & 15, quad = lane >> 4;
    const bf16_t* proj = (const bf16_t*)(P.ws + OFF_PROJ);
    bf16_t* YB = (bf16_t*)(P.ws + OFF_U);
    float* BON = (float*)(P.ws + OFF_BON);
    const float* mu = P.in[11] + (size_t)layer * 2 * 3328;
    for (int chain = opaque_bid(); chain < 256; chain += gridDim.x) {
        const int d = chain >> 7, b = (chain >> 4) & 7, h = chain & 15;
        __syncthreads();
        { const float* wup = P.in[13] + ((size_t)(layer * 2 + d) * 64) * 1024 + h * 64; const float* aup = P.in[15] + ((size_t)(layer * 2 + d) * 64) * 1024 + h * 64;
#pragma unroll
          for (int it = 0; it < 16; ++it) { const int e = tid + 512 * it; const int mat = e >> 12, lora = (e >> 6) & 63, ch = e & 63;
              const float v = (mat ? aup : wup)[(size_t)lora * 1024 + ch]; UPT[mat * 4608 + ch * 72 + lora] = f2bf(v); } }
        __syncthreads();
        if (wid < 4) {
            const int cw = wid;
            unsigned char* cb = cbase + cw * 16640;
            bf16_t* Pm = (bf16_t*)cb; bf16_t* Rm = (bf16_t*)(cb + 2304); bf16_t* Qm = (bf16_t*)(cb + 4608); bf16_t* Mm = (bf16_t*)(cb + 6912);
            bf16_t* QT = (bf16_t*)(cb + 9216); bf16_t* MT = (bf16_t*)(cb + 12288); float* Nm = (float*)(cb + 15360); float* GT = (float*)(cb + 16384);
            const f32x4 z4 = {0.f, 0.f, 0.f, 0.f};
            f32x4 ST[4];
#pragma unroll
            for (int mt = 0; mt < 4; ++mt) ST[mt] = z4;
            asm volatile("s_waitcnt lgkmcnt(0)" ::: "memory"); __builtin_amdgcn_s_barrier(); asm volatile("" ::: "memory");
            for (int c = 0; c < NCH; ++c) {
                const float* vb = VEC + (c & 1) * (TCH * 384);
                {
                    float g = 1.f;
#pragma unroll
                    for (int t2 = 0; t2 < 8; ++t2) {
                        float pv[2], rv[2], qv[2], mv[2];
#pragma unroll
                        for (int u = 0; u < 2; ++u) {
                            const float* vt = vb + (2 * t2 + u) * 384 + lane;
                            const float nk = vt[0], ww = vt[64], ka = vt[128], km = vt[192], rr = vt[256];
                            pv[u] = g * nk; g *= ww; const float ig = __builtin_amdgcn_rcpf(g);
                            qv[u] = ka * ig; mv[u] = km * ig; rv[u] = g * rr;
                        }
                        const unsigned wp = pk2(pv[0], pv[1]), wr = pk2(rv[0], rv[1]), wq = pk2(qv[0], qv[1]), wm = pk2(mv[0], mv[1]);
                        Pm[(2 * t2) * 72 + lane] = (bf16_t)(wp & 0xFFFFu); Pm[(2 * t2 + 1) * 72 + lane] = (bf16_t)(wp >> 16);
                        Rm[(2 * t2) * 72 + lane] = (bf16_t)(wr & 0xFFFFu); Rm[(2 * t2 + 1) * 72 + lane] = (bf16_t)(wr >> 16);
                        Qm[(2 * t2) * 72 + lane] = (bf16_t)(wq & 0xFFFFu); Qm[(2 * t2 + 1) * 72 + lane] = (bf16_t)(wq >> 16);
                        Mm[(2 * t2) * 72 + lane] = (bf16_t)(wm & 0xFFFFu); Mm[(2 * t2 + 1) * 72 + lane] = (bf16_t)(wm >> 16);
                        ((unsigned*)QT)[lane * 12 + t2] = wq; ((unsigned*)MT)[lane * 12 + t2] = wm;
                    }
                    GT[lane] = g;
                }
                asm volatile("s_waitcnt lgkmcnt(0)" ::: "memory");
                f32x4 Gqp = z4, Gmp = z4, Gqr = z4, Gmr = z4;
#pragma unroll
                for (int ks = 0; ks < 2; ++ks) {
                    const bf16x8 aQ = *(const bf16x8*)(Qm + r16 * 72 + ks * 32 + quad * 8), aM = *(const bf16x8*)(Mm + r16 * 72 + ks * 32 + quad * 8);
                    const bf16x8 bP = *(const bf16x8*)(Pm + r16 * 72 + ks * 32 + quad * 8), bR = *(const bf16x8*)(Rm + r16 * 72 + ks * 32 + quad * 8);
                    Gqp = MFMA16(aQ, bP, Gqp); Gmp = MFMA16(aM, bP, Gmp); Gqr = MFMA16(aQ, bR, Gqr); Gmr = MFMA16(aM, bR, Gmr);
                }
#pragma unroll
                for (int rg = 0; rg < 4; ++rg) { const int sI = quad * 4 + rg;
                    if (sI >= r16) { Gqp[rg] = 0.f; Gmp[rg] = 0.f; }
                    if (sI > r16) { Gqr[rg] = 0.f; Gmr[rg] = 0.f; } }
                *(f32x4*)(Nm + r16 * 16 + quad * 4) = Gqp;
                f32x4 SA0 = z4, Y0 = z4;
#pragma unroll
                for (int ks = 0; ks < 2; ++ks) {
                    const bf16x8 sb = pack8(ST[2 * ks], ST[2 * ks + 1]);
                    const bf16_t* pp = Pm + r16 * 72 + ks * 32 + quad * 4; const bf16_t* rp = Rm + r16 * 72 + ks * 32 + quad * 4;
                    const bf16x8 pa = join8(*(const s16x4*)pp, *(const s16x4*)(pp + 16)), ra = join8(*(const s16x4*)rp, *(const s16x4*)(rp + 16));
                    SA0 = MFMA16(pa, sb, SA0); Y0 = MFMA16(ra, sb, Y0);
                }
                f32x4 Vv;
#pragma unroll
                for (int jj = 0; jj < 4; ++jj) Vv[jj] = vb[(quad * 4 + jj) * 384 + 320 + cw * 16 + r16];
                const f32x4 Cc = MFMA16(pack8(Gmp, z4), pack8(Vv, z4), SA0);
                float x[16];
#pragma unroll
                for (int c2 = 0; c2 < 16; ++c2) x[c2] = (c2 == r16) ? 1.f : 0.f;
#pragma unroll
                for (int sI = 15; sI >= 1; --sI) {
#pragma unroll
                    for (int c2 = 0; c2 < sI; ++c2) x[c2] += x[sI] * Nm[sI * 16 + c2];
                }
                f32x4 xs;
#pragma unroll
                for (int jj = 0; jj < 4; ++jj) xs[jj] = (quad == 0) ? x[jj] : (quad == 1) ? x[4 + jj] : (quad == 2) ? x[8 + jj] : x[12 + jj];
                const f32x4 SAc = MFMA16(pack8(xs, z4), pack8(Cc, z4), z4);
                const bf16x8 Bsv = pack8(SAc, Vv);
                const f32x4 Yc = MFMA16(pack8(Gqr, Gmr), Bsv, Y0);
#pragma unroll
                for (int rg = 0; rg < 4; ++rg) { const int n = c * TCH + quad * 4 + rg; const int t = d ? (S - 1 - n) : n;
                    YB[((size_t)d * M + (size_t)b * S + t) * 1024 + h * 64 + cw * 16 + r16] = f2bf(Yc[rg]); }
#pragma unroll
                for (int mt = 0; mt < 4; ++mt) {
                    const bf16_t* qp = QT + (mt * 16 + r16) * 24 + quad * 4; const bf16_t* mp = MT + (mt * 16 + r16) * 24 + quad * 4;
                    const f32x4 acc = MFMA16(join8(*(const s16x4*)qp, *(const s16x4*)mp), Bsv, ST[mt]);
                    const f32x4 gt = *(const f32x4*)(GT + mt * 16 + quad * 4);
                    ST[mt] = acc * gt;
                }
                asm volatile("s_waitcnt lgkmcnt(0)" ::: "memory"); __builtin_amdgcn_s_barrier(); asm volatile("" ::: "memory");
            }
        } else {
            const int pw = wid - 4;
            bf16_t* Aw = (bf16_t*)(pbase + pw * 3200); bf16_t* Aa = Aw + TPW * 72; float* X = (float*)(pbase + pw * 3200 + 1152);
            const int cr = h * 64 + lane, ck = 1024 + h * 64 + lane, cv = 2048 + h * 64 + lane, cw = 3072 + d * 64 + lane, ca = 3200 + d * 64 + lane;
            const int mo0 = d ? 3328 : 0, mo1 = d ? 0 : 3328;
            const float mr0 = mu[mo0 + cr], mr1 = mu[mo1 + cr], mk0 = mu[mo0 + ck], mk1 = mu[mo1 + ck], mv0 = mu[mo0 + cv], mv1 = mu[mo1 + cv];
            const float mw0 = mu[mo0 + cw], mw1 = mu[mo1 + cw], ma0 = mu[mo0 + ca], ma1 = mu[mo1 + ca];
            const int chn = h * 64 + lane;
            const float w0v = P.in[12][(size_t)(layer * 2 + d) * 1024 + chn], a0v = P.in[14][(size_t)(layer * 2 + d) * 1024 + chn];
            const float kkw = P.in[16][(size_t)layer * 1024 + chn], kaw = P.in[17][(size_t)layer * 1024 + chn], rkw = P.in[18][(size_t)layer * 1024 + chn];
            unsigned short raw[TPW + 2][5];
            RWKV_LOAD_RAW(0);
            for (int c = 0; c < NCH + 1; ++c) {
                if (c < NCH) {
                    float* vb = VEC + (c & 1) * (TCH * 384);
                    float rr[TPW], kv[TPW], vv[TPW], kk[TPW];
                    {
                        float fr[TPW + 2][5];
#pragma unroll
                        for (int j = 0; j < TPW + 2; ++j)
#pragma unroll
                            for (int st = 0; st < 5; ++st) fr[j][st] = bf2f(raw[j][st]);
                        if (c + 1 < NCH) { RWKV_LOAD_RAW(c + 1); }
#pragma unroll
                        for (int i = 0; i < TPW; ++i) {
                            float p0, pa, pb;
                            p0 = fr[i + 1][0]; pa = fr[i][0]; pb = fr[i + 2][0]; rr[i] = p0 + mr0 * (pa - p0) + mr1 * (pb - p0);
                            p0 = fr[i + 1][1]; pa = fr[i][1]; pb = fr[i + 2][1]; kv[i] = p0 + mk0 * (pa - p0) + mk1 * (pb - p0);
                            p0 = fr[i + 1][2]; pa = fr[i][2]; pb = fr[i + 2][2]; vv[i] = p0 + mv0 * (pa - p0) + mv1 * (pb - p0);
                            p0 = fr[i + 1][3]; pa = fr[i][3]; pb = fr[i + 2][3]; const float wd = p0 + mw0 * (pa - p0) + mw1 * (pb - p0);
                            p0 = fr[i + 1][4]; pa = fr[i][4]; pb = fr[i + 2][4]; const float ad = p0 + ma0 * (pa - p0) + ma1 * (pb - p0);
                            Aw[i * 72 + lane] = f2bf(fast_tanh(wd)); Aa[i * 72 + lane] = f2bf(ad);
                            const float k2 = kv[i] * kkw; const float n2 = wave_sum_fast(k2 * k2);
                            kk[i] = k2 * __builtin_amdgcn_rsqf(fmaxf(n2, 1e-24f));
                        }
                    }
                    asm volatile("s_waitcnt lgkmcnt(0)" ::: "memory");
#pragma unroll
                    for (int mat = 0; mat < 2; ++mat) {
                        const bf16_t* A = mat ? Aa : Aw;
                        const bf16x8 a0f = *(const bf16x8*)(A + (r16 & (TPW - 1)) * 72 + quad * 8), a1f = *(const bf16x8*)(A + (r16 & (TPW - 1)) * 72 + 32 + quad * 8);
#pragma unroll
                        for (int nt = 0; nt < 4; ++nt) {
                            const bf16_t* B = UPT + mat * 4608 + (nt * 16 + r16) * 72 + quad * 8;
                            f32x4 acc = {0.f, 0.f, 0.f, 0.f};
                            acc = MFMA16(a0f, *(const bf16x8*)B, acc); acc = MFMA16(a1f, *(const bf16x8*)(B + 32), acc);
                            if (quad == 0) {
#pragma unroll
                                for (int rg = 0; rg < 4; ++rg) X[mat * 256 + rg * 64 + nt * 16 + r16] = acc[rg];
                            }
                        }
                    }
                    asm volatile("s_waitcnt lgkmcnt(0)" ::: "memory");
#pragma unroll
                    for (int i = 0; i < TPW; ++i) {
                        const int s = pw * TPW + i; const int n = c * TCH + s; const int t = d ? (S - 1 - n) : n;
                        const float xw = X[i * 64 + lane] + w0v, xa = X[256 + i * 64 + lane] + a0v;
                        const float dec = __expf(-0.6065306597126334f * fast_sigmoid(xw)); const float av = fast_sigmoid(xa);
                        const float kmod = kv[i] * (1.f + (av - 1.f) * kaw); const float kka = kk[i] * av;
                        float* o = vb + s * 384 + lane;
                        o[0] = -kk[i]; o[64] = dec; o[128] = kka; o[192] = kmod; o[256] = rr[i]; o[320] = vv[i];
                        const float bon = wave_sum_fast(rr[i] * kmod * rkw);
                        if (lane == 0) BON[(((size_t)d * NB + b) * 16 + h) * S + t] = bon;
                    }
                }
                asm volatile("s_waitcnt lgkmcnt(0)" ::: "memory"); __builtin_amdgcn_s_barrier(); asm volatile("" ::: "memory");
            }
        }
    }
}

__device__ __forceinline__ int swz40(int row, int s) { return row * 40 + ((((s >> 3) ^ (row >> 3)) & 3) << 3) + (s & 7); }
__device__ __forceinline__ void hgrn_phase(const Params& P, int layer, unsigned char* smem) {
    bf16_t* QE = (bf16_t*)smem; bf16_t* KE = (bf16_t*)(smem + 8704); bf16_t* KLT = (bf16_t*)(smem + 17408); bf16_t* VT = (bf16_t*)(smem + 27648);
    float* LF = (float*)(smem + 37888); float* EL = (float*)(smem + 54272);
    const int tid = opaque_tid(), wid = __builtin_amdgcn_readfirstlane(tid >> 6), lane = tid & 63, r16 = lane & 15, quad = lane >> 4;
    const bf16_t* proj = (const bf16_t*)(P.ws + OFF_PROJ);
    bf16_t* OC = (bf16_t*)(P.ws + OFF_OC);
    const int es = tid >> 4, ekc = (tid & 15) * 8;
    for (int chain = opaque_bid(); chain < 128; chain += gridDim.x) {
        const int d = chain >> 6, b = (chain >> 3) & 7, h = chain & 7;
        float lb[8];
#pragma unroll
        for (int j = 0; j < 8; ++j) lb[j] = 0.f;
        if (layer > 0) {
#pragma unroll
            for (int j = 0; j < 8; ++j) { const float l0 = P.in[21][(size_t)(d * 2 + 0) * 1024 + h * 128 + ekc + j], l1 = P.in[21][(size_t)(d * 2 + 1) * 1024 + h * 128 + ekc + j]; lb[j] = 1.f / (1.f + __expf(l0 - l1)); }
        }
        f32x4 Sacc[8];
#pragma unroll
        for (int mt = 0; mt < 8; ++mt) Sacc[mt] = (f32x4){0.f, 0.f, 0.f, 0.f};
        u32x4 zraw, qraw, vraw;
        { const int t = d ? (S - 1 - es) : es; const bf16_t* row = proj + ((size_t)b * S + t) * PW + h * 128 + ekc;
          zraw = *(const u32x4*)(row + C_CF + d * 1024); qraw = *(const u32x4*)(row + C_CQ); vraw = *(const u32x4*)(row + C_CI); }
        for (int c = 0; c < 64; ++c) {
            __syncthreads();
            { const int n = c * 32 + es; const int t = d ? (S - 1 - n) : n; const bf16_t* row = proj + ((size_t)b * S + t) * PW + h * 128 + ekc;
              zraw = *(const u32x4*)(row + C_CF + d * 1024); qraw = *(const u32x4*)(row + C_CQ); vraw = *(const u32x4*)(row + C_CI); }
            float kval[8];
            {
                float lf[8];
#pragma unroll
                for (int j = 0; j < 8; ++j) {
                    const unsigned wv = zraw[j >> 1]; const float z = (j & 1) ? __uint_as_float(wv & 0xFFFF0000u) : __uint_as_float(wv << 16);
                    const float e = __expf(-fabsf(z));
                    const float ls = fminf(z, 0.f) - __logf(1.f + e);
                    const float sg = (z >= 0.f ? 1.f : e) * __builtin_amdgcn_rcpf(1.f + e);
                    lf[j] = (lb[j] > 0.f) ? __logf(lb[j] + (1.f - lb[j]) * sg) : ls;
                    kval[j] = (1.f - lb[j]) * (1.f - sg);
                }
                *(f32x4*)(LF + es * 128 + ekc) = (f32x4){lf[0], lf[1], lf[2], lf[3]}; *(f32x4*)(LF + es * 128 + ekc + 4) = (f32x4){lf[4], lf[5], lf[6], lf[7]};
#pragma unroll
                for (int j = 0; j < 8; ++j) { const unsigned wv = vraw[j >> 1]; VT[swz40(ekc + j, es)] = (bf16_t)((j & 1) ? (wv >> 16) : (wv & 0xFFFFu)); }
            }
            __syncthreads();
            if (tid < 128) {
                float cum = 0.f;
#pragma unroll
                for (int s = 0; s < 32; ++s) { cum += LF[s * 128 + tid]; LF[s * 128 + tid] = cum; }
                EL[tid] = __expf(cum);
            }
            __syncthreads();
            {
                const f32x4 c0 = *(const f32x4*)(LF + es * 128 + ekc), c1v = *(const f32x4*)(LF + es * 128 + ekc + 4);
                const f32x4 l0 = *(const f32x4*)(LF + 31 * 128 + ekc), l1 = *(const f32x4*)(LF + 31 * 128 + ekc + 4);
                float qe[8], ke[8];
#pragma unroll
                for (int j = 0; j < 8; ++j) {
                    const unsigned wv = qraw[j >> 1]; const float qv = (j & 1) ? __uint_as_float(wv & 0xFFFF0000u) : __uint_as_float(wv << 16);
                    const float cum = (j < 4) ? c0[j & 3] : c1v[j & 3], last = (j < 4) ? l0[j & 3] : l1[j & 3];
                    qe[j] = qv * __expf(cum); ke[j] = kval[j] * __expf(-cum);
                    KLT[swz40(ekc + j, es)] = f2bf(kval[j] * __expf(last - cum));
                }
                u32x4 w; w.x = pk2(qe[0], qe[1]); w.y = pk2(qe[2], qe[3]); w.z = pk2(qe[4], qe[5]); w.w = pk2(qe[6], qe[7]); *(u32x4*)(QE + es * 136 + ekc) = w;
                w.x = pk2(ke[0], ke[1]); w.y = pk2(ke[2], ke[3]); w.z = pk2(ke[4], ke[5]); w.w = pk2(ke[6], ke[7]); *(u32x4*)(KE + es * 136 + ekc) = w;
            }
            if (false) { const int n = (c + 1) * 32 + es; const int t = d ? (S - 1 - n) : n; const bf16_t* row = proj + ((size_t)b * S + t) * PW + h * 128 + ekc;
                zraw = *(const u32x4*)(row + C_CF + d * 1024); qraw = *(const u32x4*)(row + C_CQ); vraw = *(const u32x4*)(row + C_CI); }
            __syncthreads();
            f32x4 sc00 = {0.f, 0.f, 0.f, 0.f}, sc01 = sc00, sc11 = sc00;
#pragma unroll
            for (int ks = 0; ks < 4; ++ks) {
                const bf16x8 ke0 = *(const bf16x8*)(KE + r16 * 136 + ks * 32 + quad * 8), ke1 = *(const bf16x8*)(KE + (16 + r16) * 136 + ks * 32 + quad * 8);
                const bf16x8 qe0 = *(const bf16x8*)(QE + r16 * 136 + ks * 32 + quad * 8), qe1 = *(const bf16x8*)(QE + (16 + r16) * 136 + ks * 32 + quad * 8);
                sc00 = MFMA16(ke0, qe0, sc00); sc01 = MFMA16(ke0, qe1, sc01); sc11 = MFMA16(ke1, qe1, sc11);
            }
#pragma unroll
            for (int rg = 0; rg < 4; ++rg) { if (quad * 4 + rg > r16) { sc00[rg] = 0.f; sc11[rg] = 0.f; } }
            const f32x4 zero4 = {0.f, 0.f, 0.f, 0.f};
            const bf16x8 p0 = pack8(sc00, zero4), p1 = pack8(sc01, sc11);
            const int vrow_i = wid * 16 + r16;
            const bf16x8 vperm = join8(*(const s16x4*)(VT + swz40(vrow_i, quad * 4)), *(const s16x4*)(VT + swz40(vrow_i, 16 + quad * 4)));
            f32x4 o0 = MFMA16(p0, vperm, zero4), o1 = MFMA16(p1, vperm, zero4);
#pragma unroll
            for (int ks = 0; ks < 4; ++ks) {
                const bf16x8 sb = pack8(Sacc[2 * ks], Sacc[2 * ks + 1]);
                const bf16_t* q0p = QE + r16 * 136 + ks * 32 + quad * 4; const bf16_t* q1p = QE + (16 + r16) * 136 + ks * 32 + quad * 4;
                const bf16x8 qa0 = join8(*(const s16x4*)q0p, *(const s16x4*)(q0p + 16)), qa1 = join8(*(const s16x4*)q1p, *(const s16x4*)(q1p + 16));
                o0 = MFMA16(qa0, sb, o0); o1 = MFMA16(qa1, sb, o1);
            }
#pragma unroll
            for (int rg = 0; rg < 4; ++rg) {
                { const int n = c * 32 + quad * 4 + rg; const int t = d ? (S - 1 - n) : n; OC[((size_t)d * M + (size_t)b * S + t) * 1024 + h * 128 + wid * 16 + r16] = f2bf(o0[rg]); }
                { const int n = c * 32 + 16 + quad * 4 + rg; const int t = d ? (S - 1 - n) : n; OC[((size_t)d * M + (size_t)b * S + t) * 1024 + h * 128 + wid * 16 + r16] = f2bf(o1[rg]); }
            }
            const bf16x8 vnat = *(const bf16x8*)(VT + swz40(vrow_i, quad * 8));
#pragma unroll
            for (int mt = 0; mt < 8; ++mt) {
                const f32x4 el = *(const f32x4*)(EL + mt * 16 + quad * 4);
                f32x4 sa = Sacc[mt] * el;
                const bf16x8 kl = *(const bf16x8*)(KLT + swz40(mt * 16 + r16, quad * 8));
                Sacc[mt] = MFMA16(kl, vnat, sa);
            }
        }
    }
}

__device__ __forceinline__ void attn_phase(const Params& P, int layer, unsigned char* smem, unsigned* counter) {
    float* TAB = (float*)smem; bf16_t* KT = (bf16_t*)(smem + 16384); bf16_t* VTt = (bf16_t*)(smem + 16384 + 9216); int* sh_unit = (int*)(smem + 16384 + 9216 + 18432);
    const int tid = opaque_tid(), wid = __builtin_amdgcn_readfirstlane(tid >> 6), lane = tid & 63, r16 = lane & 15, quad = lane >> 4;
    const bf16_t* proj = (const bf16_t*)(P.ws + OFF_PROJ);
    bf16_t* AO = (bf16_t*)(P.ws + OFF_AO);
    const float* rel_bias = P.in[1];
    const float c1 = 0.125f * LOG2E;
    for (;;) {
        __syncthreads();
        if (tid == 0) *sh_unit = (int)atomicAdd(counter, 1u);
        __syncthreads();
        const int u = *sh_unit;
        if (u >= 1024) break;
        const int qb = u & 7, m = (u >> 3) & 1, h = (u >> 4) & 7, b = u >> 7;
        for (int e = tid; e < 4095; e += 512) { const int rel = e - 2047; const int n = rel < 0 ? -rel : rel; int bk;
            if (n < 8) bk = n; else { const int lg = 31 - __clz(n * n); bk = 2 + lg; if (bk > 15) bk = 15; }
            if (rel > 0) bk += 16; TAB[e] = rel_bias[bk * 8 + h] * LOG2E; }
        const int qrow0 = qb * 256 + wid * 32;
        bf16x8 Qf[2][2];
#pragma unroll
        for (int nq = 0; nq < 2; ++nq)
#pragma unroll
            for (int ks = 0; ks < 2; ++ks) Qf[nq][ks] = *(const bf16x8*)(proj + ((size_t)b * S + qrow0 + nq * 16 + r16) * PW + C_AQ + h * 128 + m * 64 + ks * 32 + quad * 8);
        f32x4 O[2][8];
#pragma unroll
        for (int nq = 0; nq < 2; ++nq)
#pragma unroll
            for (int dt = 0; dt < 8; ++dt) O[nq][dt] = (f32x4){0.f, 0.f, 0.f, 0.f};
        float mrun[2] = {-1e30f, -1e30f}, lrun[2] = {0.f, 0.f};
        const int kkey = tid >> 3, kchunk = tid & 7;
        const int vkp = tid & 31, vchunk = tid >> 5;
        const bf16_t* kbase = proj + ((size_t)b * S + kkey) * PW + C_AK + h * 128 + m * 64 + kchunk * 8;
        const bf16_t* vbase = proj + ((size_t)b * S + 2 * vkp) * PW + C_AV + h * 128 + vchunk * 8;
        u32x4 kreg = *(const u32x4*)kbase, vreg0 = *(const u32x4*)vbase, vreg1 = *(const u32x4*)(vbase + PW);
        for (int kt = 0; kt < 32; ++kt) {
            __syncthreads();
            *(u32x4*)(KT + kkey * 72 + kchunk * 8) = kreg;
            { unsigned* vd = (unsigned*)(VTt + (vchunk * 8) * 72 + 2 * vkp);
#pragma unroll
              for (int i2 = 0; i2 < 4; ++i2) { const unsigned a = vreg0[i2], bq = vreg1[i2];
                  vd[(2 * i2) * 36] = (a & 0xFFFFu) | (bq << 16); vd[(2 * i2 + 1) * 36] = (a >> 16) | (bq & 0xFFFF0000u); } }
            __syncthreads();
            if (kt + 1 < 32) { const size_t adv = (size_t)(kt + 1) * 64 * PW; kreg = *(const u32x4*)(kbase + adv); vreg0 = *(const u32x4*)(vbase + adv); vreg1 = *(const u32x4*)(vbase + adv + PW); }
            const int k0 = kt * 64;
            f32x4 st[2][4];
#pragma unroll
            for (int mt = 0; mt < 4; ++mt) {
                const bf16x8 ka = *(const bf16x8*)(KT + (mt * 16 + r16) * 72 + quad * 8), kb2 = *(const bf16x8*)(KT + (mt * 16 + r16) * 72 + 32 + quad * 8);
#pragma unroll
                for (int nq = 0; nq < 2; ++nq) { f32x4 a = {0.f, 0.f, 0.f, 0.f}; a = MFMA16(ka, Qf[nq][0], a); a = MFMA16(kb2, Qf[nq][1], a); st[nq][mt] = a; }
            }
            const bool posfar = (k0 - (qrow0 + 31)) >= 96, negfar = (qrow0 - (k0 + 63)) >= 96;
            if (posfar || negfar) {
                const float cb = posfar ? TAB[2047 + 128] : TAB[2047 - 128];
#pragma unroll
                for (int nq = 0; nq < 2; ++nq)
#pragma unroll
                    for (int mt = 0; mt < 4; ++mt) st[nq][mt] = st[nq][mt] * c1 + cb;
            } else {
#pragma unroll
                for (int nq = 0; nq < 2; ++nq)
#pragma unroll
                    for (int mt = 0; mt < 4; ++mt) { const float* tp = TAB + (k0 + mt * 16 + quad * 4) - (qrow0 + nq * 16 + r16) + 2047;
#pragma unroll
                        for (int rg = 0; rg < 4; ++rg) st[nq][mt][rg] = st[nq][mt][rg] * c1 + tp[rg]; }
            }
            bf16x8 pf[2][2];
#pragma unroll
            for (int nq = 0; nq < 2; ++nq) {
                float mx = st[nq][0][0];
#pragma unroll
                for (int mt = 0; mt < 4; ++mt)
#pragma unroll
                    for (int rg = 0; rg < 4; ++rg) mx = fmaxf(mx, st[nq][mt][rg]);
                mx = fmaxf(mx, __shfl_xor(mx, 16)); mx = fmaxf(mx, __shfl_xor(mx, 32));
                const float mnew = fmaxf(mrun[nq], mx); const float alpha = __builtin_amdgcn_exp2f(mrun[nq] - mnew); mrun[nq] = mnew;
                float ps = 0.f;
#pragma unroll
                for (int mt = 0; mt < 4; ++mt)
#pragma unroll
                    for (int rg = 0; rg < 4; ++rg) { const float pv = __builtin_amdgcn_exp2f(st[nq][mt][rg] - mnew); st[nq][mt][rg] = pv; ps += pv; }
                lrun[nq] = lrun[nq] * alpha + ps;
#pragma unroll
                for (int dt = 0; dt < 8; ++dt) O[nq][dt] = O[nq][dt] * alpha;
                pf[nq][0] = pack8(st[nq][0], st[nq][1]); pf[nq][1] = pack8(st[nq][2], st[nq][3]);
            }
#pragma unroll
            for (int dt = 0; dt < 8; ++dt) {
                const bf16_t* vr = VTt + (dt * 16 + r16) * 72 + quad * 4;
                const bf16x8 va0 = join8(*(const s16x4*)vr, *(const s16x4*)(vr + 16)), va1 = join8(*(const s16x4*)(vr + 32), *(const s16x4*)(vr + 48));
#pragma unroll
                for (int nq = 0; nq < 2; ++nq) { O[nq][dt] = MFMA16(va0, pf[nq][0], O[nq][dt]); O[nq][dt] = MFMA16(va1, pf[nq][1], O[nq][dt]); }
            }
        }
#pragma unroll
        for (int nq = 0; nq < 2; ++nq) {
            float l = lrun[nq]; l += __shfl_xor(l, 16); l += __shfl_xor(l, 32);
            const float inv = 1.f / l;
            bf16_t* orow = AO + ((size_t)m * M + (size_t)b * S + qrow0 + nq * 16 + r16) * 1024 + h * 128 + quad * 4;
#pragma unroll
            for (int dt = 0; dt < 8; ++dt) { u32x2 w; w.x = pk2(O[nq][dt][0] * inv, O[nq][dt][1] * inv); w.y = pk2(O[nq][dt][2] * inv, O[nq][dt][3] * inv); *(u32x2*)(orow + dt * 16) = w; }
        }
    }
}

__device__ __forceinline__ void load16(const bf16_t* p, float* o) {
    const u32x4 a = *(const u32x4*)p, b = *(const u32x4*)(p + 8);
#pragma unroll
    for (int i = 0; i < 4; ++i) { o[2 * i] = __uint_as_float(a[i] << 16); o[2 * i + 1] = __uint_as_float(a[i] & 0xFFFF0000u); o[8 + 2 * i] = __uint_as_float(b[i] << 16); o[8 + 2 * i + 1] = __uint_as_float(b[i] & 0xFFFF0000u); }
}
__device__ __forceinline__ void store16(bf16_t* p, const float* v) {
    u32x4 a, b; a.x = pk2(v[0], v[1]); a.y = pk2(v[2], v[3]); a.z = pk2(v[4], v[5]); a.w = pk2(v[6], v[7]); b.x = pk2(v[8], v[9]); b.y = pk2(v[10], v[11]); b.z = pk2(v[12], v[13]); b.w = pk2(v[14], v[15]);
    *(u32x4*)p = a; *(u32x4*)(p + 8) = b;
}
__device__ __forceinline__ void loadf16(const float* p, float* o) {
#pragma unroll
    for (int i = 0; i < 4; ++i) { const float4 v = ((const float4*)p)[i]; o[4 * i] = v.x; o[4 * i + 1] = v.y; o[4 * i + 2] = v.z; o[4 * i + 3] = v.w; }
}
__device__ __forceinline__ void finish_phase(const Params& P, int layer) {
    const int tid_ = opaque_tid(); const int lane = tid_ & 63, gw = opaque_bid() * 8 + (tid_ >> 6), ngw = gridDim.x * 8;
    const bf16_t* proj = (const bf16_t*)(P.ws + OFF_PROJ);
    const bf16_t* AO = (const bf16_t*)(P.ws + OFF_AO); const bf16_t* YB = (const bf16_t*)(P.ws + OFF_U); const bf16_t* OC = (const bf16_t*)(P.ws + OFF_OC);
    const float* BON = (const float*)(P.ws + OFF_BON);
    bf16_t* MIX = (bf16_t*)(P.ws + OFF_MIXED);
    const float lam_init = 0.8f - 0.6f * expf(-0.3f * (float)layer);
    const float s1 = wave_sum(P.in[6][layer * 64 + lane] * P.in[7][layer * 64 + lane]), s2 = wave_sum(P.in[8][layer * 64 + lane] * P.in[9][layer * 64 + lane]);
    const float lam = expf(s1) - expf(s2) + lam_init;
    const int c0 = lane * 16;
    const float* mu0p = P.in[11] + (size_t)layer * 2 * 3328 + 2048 + c0; const float* mu1p = mu0p + 3328;
    for (int tok = gw; tok < M; tok += ngw) {
        const bf16_t* prow = proj + (size_t)tok * PW;
        bf16_t* mrow = MIX + (size_t)tok * MIXW;
        float a[16], bb[16], g[16], pr[16];
        load16(AO + (size_t)tok * 1024 + c0, a); load16(AO + ((size_t)M + tok) * 1024 + c0, bb); load16(prow + C_AG + c0, g);
        { float ss = 0.f;
#pragma unroll
          for (int i = 0; i < 16; ++i) { a[i] = a[i] - lam * bb[i]; ss += a[i] * a[i]; }
          ss += __shfl_xor(ss, 1); ss += __shfl_xor(ss, 2); ss += __shfl_xor(ss, 4);
          const float rstd = rsqrtf(ss * (1.f / 128.f) + 1e-5f) * (1.f - lam_init);
          loadf16(P.in[10] + layer * 128 + (c0 & 127), pr);
#pragma unroll
          for (int i = 0; i < 16; ++i) a[i] = a[i] * rstd * pr[i] * siluf_(g[i]);
          store16(mrow + c0, a); }
        load16(YB + (size_t)tok * 1024 + c0, a); load16(YB + ((size_t)M + tok) * 1024 + c0, bb); load16(prow + C_BG + c0, g);
        { float sm = 0.f;
#pragma unroll
          for (int i = 0; i < 16; ++i) { a[i] += bb[i]; sm += a[i]; }
          sm += __shfl_xor(sm, 1); sm += __shfl_xor(sm, 2);
          const float mean = sm * (1.f / 64.f); float vs = 0.f;
#pragma unroll
          for (int i = 0; i < 16; ++i) { a[i] -= mean; vs += a[i] * a[i]; }
          vs += __shfl_xor(vs, 1); vs += __shfl_xor(vs, 2);
          const float rstd = rsqrtf(vs * (1.f / 64.f) + 64e-5f);
          const int head = lane >> 2;
          const float bon = BON[(((size_t)(tok >> 11)) * 16 + head) * S + (tok & (S - 1))] + BON[(((size_t)NB + (tok >> 11)) * 16 + head) * S + (tok & (S - 1))];
          const int sp = tok & (S - 1);
          loadf16(P.in[19] + layer * 1024 + c0, pr);
#pragma unroll
          for (int i = 0; i < 16; ++i) a[i] = a[i] * rstd * pr[i];
          loadf16(P.in[20] + layer * 1024 + c0, pr);
#pragma unroll
          for (int i = 0; i < 16; ++i) a[i] += pr[i];
          load16(prow + C_B + 2048 + c0, bb);
          float vsft[16];
          { float nb[16];
            if (sp > 0) load16(prow - PW + C_B + 2048 + c0, nb); else {
#pragma unroll
                for (int i = 0; i < 16; ++i) nb[i] = 0.f; }
            loadf16(mu0p, pr);
#pragma unroll
            for (int i = 0; i < 16; ++i) vsft[i] = bb[i] + pr[i] * (nb[i] - bb[i]);
            if (sp < S - 1) load16(prow + PW + C_B + 2048 + c0, nb); else {
#pragma unroll
                for (int i = 0; i < 16; ++i) nb[i] = 0.f; }
            loadf16(mu1p, pr);
#pragma unroll
            for (int i = 0; i < 16; ++i) vsft[i] += pr[i] * (nb[i] - bb[i]); }
#pragma unroll
          for (int i = 0; i < 16; ++i) a[i] = (a[i] + bon * vsft[i]) * siluf_(g[i]);
          store16(mrow + 1024 + c0, a); }
        load16(OC + (size_t)tok * 1024 + c0, a); load16(OC + ((size_t)M + tok) * 1024 + c0, bb); load16(prow + C_CG + c0, g);
        { float ss = 0.f;
#pragma unroll
          for (int i = 0; i < 16; ++i) { a[i] += bb[i]; ss += a[i] * a[i]; }
          ss += __shfl_xor(ss, 1); ss += __shfl_xor(ss, 2); ss += __shfl_xor(ss, 4);
          const float rstd = rsqrtf(ss * (1.f / 128.f) + 1e-6f);
          loadf16(P.in[22] + layer * 128 + (c0 & 127), pr);
#pragma unroll
          for (int i = 0; i < 16; ++i) a[i] = a[i] * rstd * pr[i] * siluf_(g[i]);
          store16(mrow + 2048 + c0, a); }
    }
}

__global__ void __launch_bounds__(NTHR, 2) fwd_megakernel(Params P) {
    extern __shared__ __attribute__((aligned(16))) unsigned char smem[];
    cg::grid_group grid = cg::this_grid();
    unsigned* ctl = (unsigned*)(P.ws + OFF_CTL);
    bf16_t* U = (bf16_t*)(P.ws + OFF_U);
    float* Y = (float*)(P.ws + OFF_PROJ);
#ifndef REP_P0
#define REP_P0 1
#endif
#pragma unroll 1
    for (int rep = 0; rep < REP_P0; ++rep) { convert_weights(P, 0, smem);
    prenorm_rows(P.in[0], P.in[2], U); }
    grid.sync();
#pragma unroll 1
    for (int layer = 0; layer < DEPTH; ++layer) {
#ifndef REP_G1
#define REP_G1 1
#endif
#pragma unroll 1
        for (int rep = 0; rep < REP_G1; ++rep) { pg8::Gemm g; g.A = U; g.Bt = (const bf16_t*)(P.ws + OFF_WIN); g.M = opaque_s(M); g.N = opaque_s(PW); g.K = opaque_s(D);
          pg8::StaticOrder So; So.init(g.M, g.N, (int)gridDim.x, opaque_bid());
          pg8::EpiBf16<0> E; E.O = (bf16_t*)(P.ws + OFF_PROJ); E.ldc = g.N; E.bias = nullptr; E.split_cols = 0; E.split_stride = 0;
          pg8::gemm_phase<pg8::EpiBf16<0>, pg8::StaticOrder, false>((PG8_LAS unsigned char*)smem, g, So, E, nullptr); }
        grid.sync();
#ifndef REP_RWKV
#define REP_RWKV 1
#endif
#ifndef REP_HGRN
#define REP_HGRN 1
#endif
#ifndef REP_ATTN
#define REP_ATTN 1
#endif
#pragma unroll 1
        for (int rep = 0; rep < REP_RWKV; ++rep) rwkv_phase(P, layer, smem);
#pragma unroll 1
        for (int rep = 0; rep < REP_HGRN; ++rep) hgrn_phase(P, layer, smem);
#pragma unroll 1
        for (int rep = 0; rep < REP_ATTN; ++rep) attn_phase(P, layer, smem, ctl + 64 * layer + 128 * rep);
        grid.sync();
#ifndef REP_FIN
#define REP_FIN 1
#endif
#pragma unroll 1
        for (int rep = 0; rep < REP_FIN; ++rep) finish_phase(P, layer);
        grid.sync();
#ifndef REP_G2
#define REP_G2 1
#endif
#pragma unroll 1
        for (int rep = 0; rep < REP_G2; ++rep) { pg8::Gemm g; g.A = (const bf16_t*)(P.ws + OFF_MIXED); g.Bt = (const bf16_t*)(P.ws + OFF_WOUT); g.M = opaque_s(M); g.N = opaque_s(D); g.K = opaque_s(MIXW);
          pg8::StaticOrder So; So.init(g.M, g.N, (int)gridDim.x, opaque_bid());
          pg8::EpiF32 E; E.C = Y; E.ldc = g.N; E.bias = nullptr;
          pg8::gemm_phase<pg8::EpiF32, pg8::StaticOrder, false>((PG8_LAS unsigned char*)smem, g, So, E, nullptr); }
        grid.sync();
        if (layer + 1 < DEPTH) {
            postnorm_rows(Y, layer == 0 ? P.in[0] : P.out, P.out, P.in[3] + layer * D, P.in[2] + (layer + 1) * D, U);
            convert_weights(P, layer + 1, smem);
            grid.sync();
        } else {
            postnorm_rows(Y, layer == 0 ? P.in[0] : P.out, P.out, P.in[3] + layer * D, nullptr, U);
        }
    }
}
}

extern "C" void kernel_launch(void* const* d_in, const int* in_sizes, int n_in, void* d_out, int out_size, void* d_ws, size_t ws_size, hipStream_t stream) {
    static int grid_blocks = 0;
    if (grid_blocks == 0) {
        int dev = 0, cus = 0, per_cu = 0;
        hipGetDevice(&dev);
        hipDeviceGetAttribute(&cus, hipDeviceAttributeMultiprocessorCount, dev);
        if (hipFuncSetAttribute((const void*)mk::fwd_megakernel, hipFuncAttributeMaxDynamicSharedMemorySize, mk::LDS_BYTES) != hipSuccess) fprintf(stderr, "hipFuncSetAttribute failed\n");
        if (hipOccupancyMaxActiveBlocksPerMultiprocessor(&per_cu, (const void*)mk::fwd_megakernel, mk::NTHR, mk::LDS_BYTES) != hipSuccess || per_cu < 1) { fprintf(stderr, "occupancy query: %d\n", per_cu); per_cu = 1; }
        (void)hipGetLastError();
        grid_blocks = cus * 1;
        if (ws_size < mk::WS_END) fprintf(stderr, "workspace too small: %zu < %zu\n", ws_size, (size_t)mk::WS_END);
    }
    hipMemsetAsync((unsigned char*)d_ws + mk::OFF_CTL, 0, 4096, stream);
    mk::Params p{};
    for (int i = 0; i < 23; ++i) p.in[i] = (const float*)d_in[i];
    p.out = (float*)d_out; p.ws = (unsigned char*)d_ws;
    void* args[] = {&p};
    hipError_t e = hipLaunchCooperativeKernel((const void*)mk::fwd_megakernel, dim3(grid_blocks), dim3(mk::NTHR), args, mk::LDS_BYTES, stream);
    if (e != hipSuccess) fprintf(stderr, "cooperative launch failed: %s (grid %d)\n", hipGetErrorString(e), grid_blocks);
}
```

```cpp
#include <hip/hip_runtime.h>
#include <hip/hip_cooperative_groups.h>
#include <cstdio>
#include <cstdint>
namespace cg = cooperative_groups;
namespace pg8 {
#define PG8_LAS __attribute__((address_space(3)))
typedef unsigned short bf16_t;
typedef short bf16x8 __attribute__((ext_vector_type(8)));
typedef float f32x4 __attribute__((ext_vector_type(4)));
typedef unsigned u32x4 __attribute__((ext_vector_type(4)));
constexpr int BM = 256, BK = 64, HALF = 128, HTB = HALF * BK * 2  , STAGE_BYTES = 8 * HTB, NXCD = 8, WGM = 8;

__host__ __device__ __forceinline__ int lds_byte(int r, int c) { const int st = (r >> 4) * 2 + (c >> 5), rr = r & 15, cc = c & 31, ob = rr * 64 + cc * 2; return st * 1024 + (ob ^ (((ob >> 9) & 1) << 5)); }
__host__ __device__ __forceinline__ void stage_rc(int b, int& R, int& C) { const int st = b / 1024, sb = b % 1024, swz = sb ^ (((sb >> 9) & 1) << 5); R = (st >> 1) * 16 + swz / 64; C = (st & 1) * 32 + (swz % 64) / 2; }
__host__ __device__ __forceinline__ int perm32(int rho) { const int n = rho >> 4, i = rho & 15; return 8 * (i >> 2) + 4 * n + (i & 3); }

struct Unit { int pm, pn; };
struct Gemm { const bf16_t* A; const bf16_t* Bt; int M, N, K; };

struct StaticOrder {
    int nM, nN, nwg, G, c;
    __host__ __device__ void init(int M, int N, int G_, int c_) { nM = M / BM; nN = N / BM; nwg = nM * nN; G = G_; c = c_; }
    __host__ __device__ bool next(int i, Unit& u) const {
        const long L = (long)i * G + c; if (L >= nwg) return false;
        int wgid = (int)L; { const int q = nwg / NXCD, r = nwg % NXCD, xcd = wgid % NXCD, off = wgid / NXCD; wgid = (xcd < r ? xcd * (q + 1) : r * (q + 1) + (xcd - r) * q) + off; }
        const int nig = WGM * nN, gid = wgid / nig, fm = gid * WGM, gsz = (nM - fm) < WGM ? (nM - fm) : WGM;
        u.pm = fm + ((wgid % nig) % gsz); u.pn = (wgid % nig) / gsz; return true;
    }
    __device__ __forceinline__ void a_ready(const Unit&) const {}
    __device__ __forceinline__ void done(const Unit&) const {}
};
struct CountedOrder : StaticOrder {
    const unsigned* ready; unsigned need; unsigned* tmo;
    __device__ __forceinline__ void a_ready(const Unit& u) const {
        if (threadIdx.x < 64) {
            const unsigned long long t0 = __builtin_amdgcn_s_memrealtime(); unsigned polls = 0;
            while ((unsigned)__builtin_amdgcn_readfirstlane(__hip_atomic_load(ready + 64 * u.pm, __ATOMIC_RELAXED, __HIP_MEMORY_SCOPE_AGENT)) < need) {
                if ((++polls & 255u) == 0u && __builtin_amdgcn_readfirstlane(__hip_atomic_load(tmo, __ATOMIC_RELAXED, __HIP_MEMORY_SCOPE_AGENT)) != 0u) break;
                if (__builtin_amdgcn_s_memrealtime() - t0 > 2000000ull) {
                    if (threadIdx.x == 0) { unsigned expect = 0u; __hip_atomic_compare_exchange_strong(tmo + 1, &expect, 0x600u | (unsigned)(u.pm & 0xff), __ATOMIC_RELAXED, __ATOMIC_RELAXED, __HIP_MEMORY_SCOPE_AGENT); __hip_atomic_store(tmo, 1u, __ATOMIC_RELAXED, __HIP_MEMORY_SCOPE_AGENT); }
                    break; }
                __builtin_amdgcn_s_sleep(2); }
            __builtin_amdgcn_fence(__ATOMIC_ACQUIRE, "agent");
            asm volatile("s_waitcnt vmcnt(0)" ::: "memory");
        }
#if !defined(BROKEN_HOOK_NO_BARRIER)
        asm volatile("" ::: "memory"); __builtin_amdgcn_s_barrier(); asm volatile("" ::: "memory");
#endif
    }
};

typedef __bf16 bf16x2_t __attribute__((ext_vector_type(2)));
typedef float f32x2c __attribute__((ext_vector_type(2)));
__device__ __forceinline__ unsigned cvt_pk_bf16(float lo, float hi) { f32x2c v = {lo, hi}; bf16x2_t b = __builtin_convertvector(v, bf16x2_t); return __builtin_bit_cast(unsigned, b); }
typedef float f32x2 __attribute__((ext_vector_type(2)));
__device__ __forceinline__ f32x2 gelu_pk(f32x2 v) {
    const f32x2 av = __builtin_elementwise_abs(v), d = av * 0.2316418882f + 1.0f;
    f32x2 t; t.x = __builtin_amdgcn_rcpf(d.x); t.y = __builtin_amdgcn_rcpf(d.y);
    f32x2 q = t * 0.5307027145f + (-0.7265760135f); q = q * t + 0.7107068705f; q = q * t + (-0.142248368f); q = q * t + 0.127414796f; q = q * t;
    const f32x2 s = (v * v) * (-0.72134752044f);
    f32x2 e; e.x = __builtin_amdgcn_exp2f(s.x); e.y = __builtin_amdgcn_exp2f(s.y);
    const f32x2 m = v * (q * e), r = v - m;
    f32x2 o; o.x = v.x < 0.f ? m.x : r.x; o.y = v.y < 0.f ? m.y : r.y; return o;
}

struct EpiF32 {
    static constexpr bool PERM = false, AFTER_DRAIN = false;
    float* C; int ldc; const float* bias;
    __device__ __forceinline__ void operator()(const f32x4 (&acc)[2][2][4][2], const Unit& u, int wr, int wc, int fr, int fq) const {
        const int row0 = u.pm * BM + wr * 64 + fr, col0 = u.pn * BM + wc * 32 + 4 * fq;
        f32x4 bv[2][2];
#pragma unroll
        for (int bj = 0; bj < 2; ++bj)
#pragma unroll
            for (int n = 0; n < 2; ++n) bv[bj][n] = bias ? *(const f32x4*)(bias + col0 + bj * HALF + n * 16) : (f32x4){0.f, 0.f, 0.f, 0.f};
#pragma unroll
        for (int ai = 0; ai < 2; ++ai)
#pragma unroll
            for (int m = 0; m < 4; ++m) { float* rowp = C + (size_t)(row0 + ai * HALF + m * 16) * ldc + col0;
#pragma unroll
                for (int bj = 0; bj < 2; ++bj)
#pragma unroll
                    for (int n = 0; n < 2; ++n) *(f32x4*)(rowp + bj * HALF + n * 16) = acc[ai][bj][m][n] + bv[bj][n]; }
    }
};
template <int ACT  > struct EpiBf16 {
    static constexpr bool PERM = true, AFTER_DRAIN = false;
    bf16_t* O; int ldc; const float* bias; int split_cols; size_t split_stride;
    __device__ __forceinline__ void operator()(const f32x4 (&acc)[2][2][4][2], const Unit& u, int wr, int wc, int fr, int fq) const {
        const int row0 = u.pm * BM + wr * 64 + fr; int colt = u.pn * BM; bf16_t* base = O;
        if (split_cols) { const int t = colt / split_cols; base += (size_t)t * split_stride; colt -= t * split_cols; }
        const int col0 = colt + wc * 32 + 8 * fq, bcol0 = u.pn * BM + wc * 32 + 8 * fq;
        f32x4 bv[2][2];
#pragma unroll
        for (int bj = 0; bj < 2; ++bj)
#pragma unroll
            for (int n = 0; n < 2; ++n) bv[bj][n] = bias ? *(const f32x4*)(bias + bcol0 + bj * HALF + 4 * n) : (f32x4){0.f, 0.f, 0.f, 0.f};
#pragma unroll
        for (int ai = 0; ai < 2; ++ai)
#pragma unroll
            for (int m = 0; m < 4; ++m) { bf16_t* rowp = base + (size_t)(row0 + ai * HALF + m * 16) * ldc + col0;
#pragma unroll
                for (int bj = 0; bj < 2; ++bj) { f32x4 v0 = acc[ai][bj][m][0] + bv[bj][0], v1 = acc[ai][bj][m][1] + bv[bj][1];
                    if (ACT == 1) { f32x2 a = gelu_pk((f32x2){v0[0], v0[1]}), b = gelu_pk((f32x2){v0[2], v0[3]}), c = gelu_pk((f32x2){v1[0], v1[1]}), d = gelu_pk((f32x2){v1[2], v1[3]});
                        v0 = (f32x4){a.x, a.y, b.x, b.y}; v1 = (f32x4){c.x, c.y, d.x, d.y}; }
                    if (ACT == 2) {
#pragma unroll
                        for (int j = 0; j < 4; ++j) { v0[j] = 0.5f * v0[j] * (1.0f + erff(v0[j] * 0.70710678f)); v1[j] = 0.5f * v1[j] * (1.0f + erff(v1[j] * 0.70710678f)); } }
                    u32x4 w; w.x = cvt_pk_bf16(v0[0], v0[1]); w.y = cvt_pk_bf16(v0[2], v0[3]); w.z = cvt_pk_bf16(v1[0], v1[1]); w.w = cvt_pk_bf16(v1[2], v1[3]);
                    *(u32x4*)(rowp + bj * HALF) = w; } }
    }
};


template <class Epi, class Sched, bool STAMP = false>
__device__ __forceinline__ void gemm_phase(PG8_LAS unsigned char* lds, const Gemm g, const Sched& S, const Epi& E, unsigned long long* stamps) {
    int tid_o = threadIdx.x; asm volatile("" : "+v"(tid_o));
    const int tid = tid_o, wid = __builtin_amdgcn_readfirstlane(tid >> 6), lane = tid & 63, wr = wid >> 2, wc = wid & 3, fr = lane & 15, fq = lane >> 4;
    const int K = g.K, nt = K / BK;
    int ts_lo = 0, ts_hi = 0, nts = 0; const unsigned long long rt_entry = STAMP ? (unsigned long long)wall_clock64() : 0ull;
#define PG8_STAMP() do { if (STAMP && wid == 0 && nts < 64) { const unsigned long long _c = (unsigned long long)clock64(); \
        ts_lo = (lane == nts) ? (int)(unsigned)_c : ts_lo; ts_hi = (lane == nts) ? (int)(unsigned)(_c >> 32) : ts_hi; ++nts; } } while (0)
    PG8_STAMP();
    unsigned voffA[2], voffB[2];
#pragma unroll
    for (int i = 0; i < 2; ++i) { int R, C; stage_rc(tid * 16 + i * 8192, R, C); const int Rb = Epi::PERM ? ((R & ~31) + perm32(R & 31)) : R;
        voffA[i] = (unsigned)(R * K + C) * 2u; voffB[i] = (unsigned)(Rb * K + C) * 2u; }
    const size_t kstep = (size_t)(BK * 2);
    const size_t hstep = (size_t)HALF * K * 2;
    const size_t tstep = 2 * hstep;
    const unsigned ldsw = (unsigned)wid * 1024u;
    const int aoff = lds_byte(wr * 64 + fr, fq * 8), boff = lds_byte(wc * 32 + fr, fq * 8);
#define PG8_SA(b, h) (((b) * 2 + (h)) * HTB)
#define PG8_SB(b, h) ((4 + (b) * 2 + (h)) * HTB)
#define PG8_STAGE(bufoff, gbase, voff) do { _Pragma("unroll") for (int _i = 0; _i < 2; ++_i) \
        __builtin_amdgcn_global_load_lds((const unsigned*)((const char*)(gbase) + (voff)[_i]), (PG8_LAS unsigned*)(lds + (bufoff) + ldsw + _i * 8192), 16, 0, 0); } while (0)
#define PG8_LDA(dst, b, h) do { _Pragma("unroll") for (int m = 0; m < 4; ++m) _Pragma("unroll") for (int k = 0; k < 2; ++k) dst[m][k] = *(const PG8_LAS bf16x8*)(lds + PG8_SA(b, h) + aoff + m * 2048 + k * 1024); } while (0)
#define PG8_LDB(dst, b, h) do { _Pragma("unroll") for (int n = 0; n < 2; ++n) _Pragma("unroll") for (int k = 0; k < 2; ++k) dst[n][k] = *(const PG8_LAS bf16x8*)(lds + PG8_SB(b, h) + boff + n * 2048 + k * 1024); } while (0)
#define PG8_MMA(ai, bj, At, Bt) do { __builtin_amdgcn_s_setprio(1); _Pragma("unroll") for (int m = 0; m < 4; ++m) _Pragma("unroll") for (int n = 0; n < 2; ++n) _Pragma("unroll") for (int k = 0; k < 2; ++k) \
        acc[ai][bj][m][n] = __builtin_amdgcn_mfma_f32_16x16x32_bf16(Bt[n][k], At[m][k], acc[ai][bj][m][n], 0, 0, 0); __builtin_amdgcn_s_setprio(0); } while (0)
#define PG8_WAIT_V(n) asm volatile("s_waitcnt vmcnt(" #n ")" ::: "memory")
#define PG8_WAIT_L(n) asm volatile("s_waitcnt lgkmcnt(" #n ")" ::: "memory")
#define PG8_BAR __builtin_amdgcn_s_barrier()
#define PG8_SCHED __builtin_amdgcn_sched_barrier(0)
    Unit cur, nxt; int ui = 0;
    if (!S.next(0, cur)) return;
    f32x4 acc[2][2][4][2];
#pragma unroll
    for (int a = 0; a < 2; ++a)
#pragma unroll
        for (int b = 0; b < 2; ++b)
#pragma unroll
            for (int m = 0; m < 4; ++m)
#pragma unroll
                for (int n = 0; n < 2; ++n) acc[a][b][m][n] = (f32x4){0.f, 0.f, 0.f, 0.f};
    bf16x8 At[4][2], B0[2][2], B1[2][2];
    const char* cA = (const char*)g.A + (size_t)cur.pm * tstep; const char* cB = (const char*)g.Bt + (size_t)cur.pn * tstep;
    S.a_ready(cur);
    PG8_STAGE(PG8_SB(0, 0), cB, voffB); PG8_STAGE(PG8_SA(0, 0), cA, voffA); PG8_STAGE(PG8_SB(0, 1), cB + hstep, voffB); PG8_STAGE(PG8_SA(0, 1), cA + hstep, voffA);
    if (wr == 1) PG8_BAR;
    PG8_WAIT_V(4); PG8_BAR;
    PG8_STAGE(PG8_SB(1, 0), cB + kstep, voffB); PG8_STAGE(PG8_SA(1, 0), cA + kstep, voffA); PG8_STAGE(PG8_SB(1, 1), cB + hstep + kstep, voffB);
    PG8_WAIT_V(6); PG8_BAR;
    PG8_STAMP();
    for (;;) {
        const bool has_next = S.next(ui + 1, nxt);
        const char* nA = has_next ? (const char*)g.A + (size_t)nxt.pm * tstep : cA; const char* nB = has_next ? (const char*)g.Bt + (size_t)nxt.pn * tstep : cB;
        for (int t = 0; t < nt; t += 2) {
            const bool last = (t == nt - 2);
            const char* a1 = cA + (size_t)(t + 1) * kstep;
            const char* a2 = last ? nA : cA + (size_t)(t + 2) * kstep; const char* b2 = last ? nB : cB + (size_t)(t + 2) * kstep;
            const char* a3 = a2 + kstep; const char* b3 = b2 + kstep;
            if (last && has_next) S.a_ready(nxt);
            PG8_LDB(B0, 0, 0); PG8_SCHED; PG8_LDA(At, 0, 0); PG8_STAGE(PG8_SA(1, 1), a1 + hstep, voffA);
            PG8_WAIT_L(8); PG8_BAR; PG8_WAIT_L(0); PG8_MMA(0, 0, At, B0); PG8_BAR; PG8_SCHED;
            PG8_LDB(B1, 0, 1); PG8_STAGE(PG8_SB(0, 0), b2, voffB);
            PG8_BAR; PG8_WAIT_L(0); PG8_MMA(0, 1, At, B1); PG8_BAR;
            PG8_LDA(At, 0, 1); PG8_STAGE(PG8_SA(0, 0), a2, voffA);
            PG8_BAR; PG8_WAIT_L(0); PG8_MMA(1, 0, At, B0); PG8_BAR; PG8_SCHED;
            PG8_STAGE(PG8_SB(0, 1), b2 + hstep, voffB);
            PG8_WAIT_V(6); PG8_BAR; PG8_MMA(1, 1, At, B1); PG8_BAR;
            PG8_LDB(B0, 1, 0); PG8_SCHED; PG8_LDA(At, 1, 0); PG8_STAGE(PG8_SA(0, 1), a2 + hstep, voffA);
            PG8_WAIT_L(8); PG8_BAR; PG8_WAIT_L(0); PG8_MMA(0, 0, At, B0); PG8_BAR; PG8_SCHED;
            PG8_LDB(B1, 1, 1); PG8_STAGE(PG8_SB(1, 0), b3, voffB);
            PG8_BAR; PG8_WAIT_L(0); PG8_MMA(0, 1, At, B1); PG8_BAR;
            PG8_LDA(At, 1, 1); PG8_STAGE(PG8_SA(1, 0), a3, voffA);
            PG8_BAR; PG8_WAIT_L(0); PG8_MMA(1, 0, At, B0); PG8_BAR; PG8_SCHED;
            PG8_STAGE(PG8_SB(1, 1), b3 + hstep, voffB);
            PG8_WAIT_V(6); PG8_BAR; PG8_MMA(1, 1, At, B1); PG8_BAR;
        }
        PG8_STAMP();
        if constexpr (!Epi::AFTER_DRAIN) { E(acc, cur, wr, wc, fr, fq); S.done(cur); }
        PG8_STAMP();
        if (!has_next) break;
#pragma unroll
        for (int a = 0; a < 2; ++a)
#pragma unroll
            for (int b = 0; b < 2; ++b)
#pragma unroll
                for (int m = 0; m < 4; ++m)
#pragma unroll
                    for (int n = 0; n < 2; ++n) acc[a][b][m][n] = (f32x4){0.f, 0.f, 0.f, 0.f};
        cur = nxt; cA = nA; cB = nB; ++ui;
    }
    PG8_WAIT_V(0);
    if (wr == 0) PG8_BAR;
    PG8_BAR;
    if constexpr (Epi::AFTER_DRAIN) { E.fused(acc, cur, wr, wc, fr, fq, lds, wid, lane); S.done(cur); }
    PG8_STAMP();
    if (STAMP && wid == 0) { stamps[lane] = lane < nts ? (((unsigned long long)(unsigned)ts_hi << 32) | (unsigned)ts_lo) : 0ull;
        if (lane == 62) stamps[62] = rt_entry; if (lane == 63) stamps[63] = (unsigned long long)wall_clock64(); }
#undef PG8_STAMP
#undef PG8_SA
#undef PG8_SB
#undef PG8_STAGE
#undef PG8_LDA
#undef PG8_LDB
#undef PG8_MMA
#undef PG8_WAIT_V
#undef PG8_WAIT_L
#undef PG8_BAR
#undef PG8_SCHED
}
}

namespace mk {
using pg8::bf16_t; using pg8::bf16x8; using pg8::f32x4; using pg8::u32x4;
typedef short s16x4 __attribute__((ext_vector_type(4)));
typedef unsigned u32x2 __attribute__((ext_vector_type(2)));

constexpr int D = 2048, NB = 8, S = 2048, M = NB * S, BW = 1024, MIXW = 3072, PW = 13568, DEPTH = 2;
constexpr int C_AQ = 0, C_AK = 1024, C_AV = 2048, C_AG = 3072, C_B = 4096, C_BG = 7424, C_CQ = 8448, C_CI = 9472, C_CF = 10496, C_CG = 12544;
constexpr int NTHR = 512;
constexpr int LDS_BYTES = 147456;
constexpr float LOG2E = 1.4426950408889634f;

constexpr size_t OFF_CTL = 0;
constexpr size_t OFF_WIN = 4096;
constexpr size_t OFF_WOUT = OFF_WIN + (size_t)PW * D * 2;
constexpr size_t OFF_U = OFF_WOUT + (size_t)D * MIXW * 2;
constexpr size_t OFF_PROJ = OFF_U + (size_t)M * D * 2;
constexpr size_t OFF_MIXED = OFF_PROJ + (size_t)M * PW * 2;
constexpr size_t OFF_OC = OFF_MIXED + (size_t)M * MIXW * 2;
constexpr size_t OFF_AO = OFF_OC + (size_t)2 * M * BW * 2;
constexpr size_t OFF_BON = OFF_AO + (size_t)2 * M * BW * 2;
constexpr size_t WS_END = OFF_BON + (size_t)2 * M * 16 * 4;

struct Params { const float* in[23]; float* out; unsigned char* ws; };
__device__ __forceinline__ int opaque_tid() { int t = threadIdx.x; asm volatile("" : "+v"(t)); return t; }
__device__ __forceinline__ int opaque_s(int t) { asm volatile("" : "+s"(t)); return t; }
__device__ __forceinline__ int opaque_bid() { int t = blockIdx.x; asm volatile("" : "+s"(t)); return t; }


__device__ __forceinline__ float bf2f(bf16_t v) { return __uint_as_float(((unsigned)v) << 16); }
__device__ __forceinline__ bf16_t f2bf(float f) { unsigned u = __float_as_uint(f); u += 0x7FFFu + ((u >> 16) & 1u); return (bf16_t)(u >> 16); }
typedef __bf16 bf16x2_t __attribute__((ext_vector_type(2)));
typedef float f32x2c __attribute__((ext_vector_type(2)));
__device__ __forceinline__ unsigned pk2(float lo, float hi) { f32x2c v = {lo, hi}; bf16x2_t b = __builtin_convertvector(v, bf16x2_t); return __builtin_bit_cast(unsigned, b); }
__device__ __forceinline__ float wave_sum(float v) {
#pragma unroll
    for (int o = 1; o < 64; o <<= 1) v += __shfl_xor(v, o);
    return v;
}
__device__ __forceinline__ float sigmoidf_(float x) { return 1.f / (1.f + __expf(-x)); }
__device__ __forceinline__ float siluf_(float x) { return x / (1.f + __expf(-x)); }
__device__ __forceinline__ float dpp_xor1(float v) { return __int_as_float(__builtin_amdgcn_mov_dpp(__float_as_int(v), 0xB1, 0xF, 0xF, true)); }
__device__ __forceinline__ float dpp_xor2(float v) { return __int_as_float(__builtin_amdgcn_mov_dpp(__float_as_int(v), 0x4E, 0xF, 0xF, true)); }
__device__ __forceinline__ float dpp_hmir(float v) { return __int_as_float(__builtin_amdgcn_mov_dpp(__float_as_int(v), 0x141, 0xF, 0xF, true)); }
__device__ __forceinline__ float dpp_mir(float v) { return __int_as_float(__builtin_amdgcn_mov_dpp(__float_as_int(v), 0x140, 0xF, 0xF, true)); }
__device__ __forceinline__ float wave_sum_fast(float v) {
    v += dpp_xor1(v); v += dpp_xor2(v); v += dpp_hmir(v); v += dpp_mir(v);
    v += __shfl_xor(v, 16); v += __shfl_xor(v, 32);
    return v;
}
__device__ __forceinline__ float fast_tanh(float x) { return 1.f - 2.f * __builtin_amdgcn_rcpf(1.f + __expf(2.f * x)); }
__device__ __forceinline__ float fast_sigmoid(float x) { return __builtin_amdgcn_rcpf(1.f + __expf(-x)); }
typedef float f32x2 __attribute__((ext_vector_type(2)));
#define MFMA16(a, b, c) __builtin_amdgcn_mfma_f32_16x16x32_bf16((a), (b), (c), 0, 0, 0)
__device__ __forceinline__ bf16x8 join8(s16x4 lo, s16x4 hi) { return __builtin_shufflevector(lo, hi, 0, 1, 2, 3, 4, 5, 6, 7); }
__device__ __forceinline__ bf16x8 pack8(f32x4 a, f32x4 b) {
    u32x4 w; w.x = pk2(a[0], a[1]); w.y = pk2(a[2], a[3]); w.z = pk2(b[0], b[1]); w.w = pk2(b[2], b[3]);
    return __builtin_bit_cast(bf16x8, w);
}

__device__ __forceinline__ void transpose_tile(const float* __restrict__ W, int K, int N, bf16_t* __restrict__ WT, float* tile, int it) {
    const int tid = opaque_tid();
    const int ntn = N >> 6; const int kb = it / ntn, nbk = it - kb * ntn; const int k0 = kb * 64, n0 = nbk * 64;
#pragma unroll
    for (int rr = 0; rr < 2; ++rr) { const int idx = tid + rr * 512; const int kk = idx >> 4, n4 = (idx & 15) * 4;
        const float4 v = *(const float4*)(W + (size_t)(k0 + kk) * N + n0 + n4);
        float* tp = tile + kk * 65 + n4; tp[0] = v.x; tp[1] = v.y; tp[2] = v.z; tp[3] = v.w; }
    __syncthreads();
    { const int n = tid >> 3, kc = (tid & 7) * 8; const float* tp = tile + kc * 65 + n;
      u32x4 o; o.x = pk2(tp[0], tp[65]); o.y = pk2(tp[2 * 65], tp[3 * 65]); o.z = pk2(tp[4 * 65], tp[5 * 65]); o.w = pk2(tp[6 * 65], tp[7 * 65]);
      *(u32x4*)(WT + (size_t)(n0 + n) * K + k0 + kc) = o; }
    __syncthreads();
}
__device__ __forceinline__ void convert_weights(const Params& P, int layer, unsigned char* smem) {
    float* tile = (float*)smem;
    const float* win = P.in[4] + (size_t)layer * D * PW; const float* wout = P.in[5] + (size_t)layer * MIXW * D;
    bf16_t* WinT = (bf16_t*)(P.ws + OFF_WIN); bf16_t* WoutT = (bf16_t*)(P.ws + OFF_WOUT);
    constexpr int T_IN = (D / 64) * (PW / 64), T_OUT = (MIXW / 64) * (D / 64);
    for (int it = opaque_bid(); it < T_IN + T_OUT; it += gridDim.x) {
        if (it < T_IN) transpose_tile(win, D, PW, WinT, tile, it);
        else transpose_tile(wout, MIXW, D, WoutT, tile, it - T_IN);
    }
}
__device__ __forceinline__ void prenorm_rows(const float* __restrict__ x, const float* __restrict__ g, bf16_t* __restrict__ U) {
    const int tid_ = opaque_tid(); const int lane = tid_ & 63, gw = opaque_bid() * 8 + (tid_ >> 6), ngw = gridDim.x * 8;
    for (int row = gw; row < M; row += ngw) {
        const float4* xr = (const float4*)(x + (size_t)row * D) + lane;
        float4 v[8]; float ss = 0.f;
#pragma unroll
        for (int j = 0; j < 8; ++j) { v[j] = xr[64 * j]; ss += v[j].x * v[j].x + v[j].y * v[j].y + v[j].z * v[j].z + v[j].w * v[j].w; }
        const float rstd = rsqrtf(wave_sum(ss) * (1.f / D) + 1e-6f);
        u32x2* o = (u32x2*)(U + (size_t)row * D) + lane;
#pragma unroll
        for (int j = 0; j < 8; ++j) { const float4 gg = ((const float4*)g)[64 * j + lane];
            u32x2 w; w.x = pk2(v[j].x * rstd * gg.x, v[j].y * rstd * gg.y); w.y = pk2(v[j].z * rstd * gg.z, v[j].w * rstd * gg.w); o[64 * j] = w; }
    }
}
__device__ __forceinline__ void postnorm_rows(const float* __restrict__ y, const float* xin, float* xout, const float* __restrict__ gpost, const float* __restrict__ gpre, bf16_t* __restrict__ U) {
    const int tid_ = opaque_tid(); const int lane = tid_ & 63, gw = opaque_bid() * 8 + (tid_ >> 6), ngw = gridDim.x * 8;
    for (int row = gw; row < M; row += ngw) {
        const float4* yr = (const float4*)(y + (size_t)row * D) + lane;
        const float4* xr = (const float4*)(xin + (size_t)row * D) + lane;
        float4* xo = (float4*)(xout + (size_t)row * D) + lane;
        float4 v[8]; float ss = 0.f;
#pragma unroll
        for (int j = 0; j < 8; ++j) { v[j] = yr[64 * j]; ss += v[j].x * v[j].x + v[j].y * v[j].y + v[j].z * v[j].z + v[j].w * v[j].w; }
        const float rstd = rsqrtf(wave_sum(ss) * (1.f / D) + 1e-6f);
        float s2 = 0.f;
#pragma unroll
        for (int j = 0; j < 8; ++j) { const float4 gg = ((const float4*)gpost)[64 * j + lane]; const float4 xv = xr[64 * j];
            v[j].x = xv.x + v[j].x * rstd * gg.x; v[j].y = xv.y + v[j].y * rstd * gg.y; v[j].z = xv.z + v[j].z * rstd * gg.z; v[j].w = xv.w + v[j].w * rstd * gg.w;
            xo[64 * j] = v[j]; s2 += v[j].x * v[j].x + v[j].y * v[j].y + v[j].z * v[j].z + v[j].w * v[j].w; }
        if (gpre) {
            const float r2 = rsqrtf(wave_sum(s2) * (1.f / D) + 1e-6f);
            u32x2* o = (u32x2*)(U + (size_t)row * D) + lane;
#pragma unroll
            for (int j = 0; j < 8; ++j) { const float4 gg = ((const float4*)gpre)[64 * j + lane];
                u32x2 w; w.x = pk2(v[j].x * r2 * gg.x, v[j].y * r2 * gg.y); w.y = pk2(v[j].z * r2 * gg.z, v[j].w * r2 * gg.w); o[64 * j] = w; }
        }
    }
}

#define RWKV_LOAD_RAW(cc) do { const int n0_ = (cc) * TCH + pw * TPW; const int T0_ = d ? (S - 1 - n0_) : n0_; const int dstep_ = d ? -1 : 1; \
    _Pragma("unroll") for (int j = 0; j < TPW + 2; ++j) { const int tj = T0_ + (j - 1) * dstep_; const bool ok = (tj >= 0) && (tj < S); \
        const bf16_t* row = proj + ((size_t)b * S + (ok ? tj : T0_)) * PW + C_B; \
        raw[j][0] = row[cr]; raw[j][1] = row[ck]; raw[j][2] = row[cv]; raw[j][3] = row[cw]; raw[j][4] = row[ca]; \
        if (!ok) { raw[j][0] = 0; raw[j][1] = 0; raw[j][2] = 0; raw[j][3] = 0; raw[j][4] = 0; } } } while (0)
__device__ __forceinline__ void rwkv_phase(const Params& P, int layer, unsigned char* smem) {
    constexpr int TCH = 16, TPW = 4, NCH = S / TCH;
    float* VEC = (float*)smem;
    bf16_t* UPT = (bf16_t*)(smem + 49152);
    unsigned char* pbase = smem + 49152 + 18432;
    unsigned char* obase = smem + 49152 + 18432 + 12800;
    unsigned char* nbase = obase + 2 * 15872;
    const int tid = opaque_tid(), wid = __builtin_amdgcn_readfirstlane(tid >> 6), lane = tid & 63, r16 = lane & 15, quad = lane >> 4;
    const bf16_t* proj = (const bf16_t*)(P.ws + OFF_PROJ);
    bf16_t* YB = (bf16_t*)(P.ws + OFF_U);
    float* BON = (float*)(P.ws + OFF_BON);
    const float* mu = P.in[11] + (size_t)layer * 2 * 3328;
    for (int chain = opaque_bid(); chain < 256; chain += gridDim.x) {
        const int d = chain >> 7, b = (chain >> 4) & 7, h = chain & 15;
        __syncthreads();
        { const float* wup = P.in[13] + ((size_t)(layer * 2 + d) * 64) * 1024 + h * 64; const float* aup = P.in[15] + ((size_t)(layer * 2 + d) * 64) * 1024 + h * 64;
#pragma unroll
          for (int it = 0; it < 16; ++it) { const int e = tid + 512 * it; const int mat = e >> 12, lora = (e >> 6) & 63, ch = e & 63;
              const float v = (mat ? aup : wup)[(size_t)lora * 1024 + ch]; UPT[mat * 4608 + ch * 72 + lora] = f2bf(v); } }
        __syncthreads();
        if (wid < 4) {
            const int cw = wid;
            float* Nm = (float*)(nbase + cw * 1024);
            const int jl = lane & 15, tg = lane >> 4, jcol = cw * 16 + jl;
            const f32x4 z4 = {0.f, 0.f, 0.f, 0.f};
            f32x4 ST[4];
#pragma unroll
            for (int mt = 0; mt < 4; ++mt) ST[mt] = z4;
            asm volatile("s_waitcnt lgkmcnt(0)" ::: "memory"); __builtin_amdgcn_s_barrier(); asm volatile("" ::: "memory");
            asm volatile("s_waitcnt lgkmcnt(0)" ::: "memory"); __builtin_amdgcn_s_barrier(); asm volatile("" ::: "memory");
            for (int c = 0; c < NCH; ++c) {
                const float* vb = VEC + (c & 1) * (TCH * 384);
                unsigned char* ob = obase + (c & 1) * 15872;
                bf16_t* Pm = (bf16_t*)ob; bf16_t* Rm = (bf16_t*)(ob + 2304); bf16_t* Qm = (bf16_t*)(ob + 4608); bf16_t* Mm = (bf16_t*)(ob + 6912);
                bf16_t* QT = (bf16_t*)(ob + 9216); bf16_t* MT = (bf16_t*)(ob + 12288); float* GT = (float*)(ob + 15360);
                {
                    float nk[4], ww[4], ka[4], km[4], rr[4];
#pragma unroll
                    for (int u = 0; u < 4; ++u) { const float* vt = vb + (4 * tg + u) * 384 + jcol; nk[u] = vt[0]; ww[u] = vt[64]; ka[u] = vt[128]; km[u] = vt[192]; rr[u] = vt[256]; }
                    float gl[4];
                    gl[0] = ww[0]; gl[1] = gl[0] * ww[1]; gl[2] = gl[1] * ww[2]; gl[3] = gl[2] * ww[3];
                    const float G0 = __shfl(gl[3], jl), G1 = __shfl(gl[3], jl + 16), G2 = __shfl(gl[3], jl + 32);
                    const float pre = (tg == 0) ? 1.f : (tg == 1) ? G0 : (tg == 2) ? G0 * G1 : (G0 * G1) * G2;
                    float pv[4], rv[4], qv[4], mv[4];
#pragma unroll
                    for (int u = 0; u < 4; ++u) {
                        const float gprev = (u == 0) ? pre : pre * gl[u - 1], gcur = pre * gl[u];
                        const float ig = __builtin_amdgcn_rcpf(gcur);
                        pv[u] = gprev * nk[u]; qv[u] = ka[u] * ig; mv[u] = km[u] * ig; rv[u] = gcur * rr[u];
                    }
                    const unsigned wp0 = pk2(pv[0], pv[1]), wp1 = pk2(pv[2], pv[3]), wr0 = pk2(rv[0], rv[1]), wr1 = pk2(rv[2], rv[3]);
                    const unsigned wq0 = pk2(qv[0], qv[1]), wq1 = pk2(qv[2], qv[3]), wm0 = pk2(mv[0], mv[1]), wm1 = pk2(mv[2], mv[3]);
                    const int t0 = 4 * tg;
                    Pm[(t0) * 72 + jcol] = (bf16_t)(wp0 & 0xFFFFu); Pm[(t0 + 1) * 72 + jcol] = (bf16_t)(wp0 >> 16); Pm[(t0 + 2) * 72 + jcol] = (bf16_t)(wp1 & 0xFFFFu); Pm[(t0 + 3) * 72 + jcol] = (bf16_t)(wp1 >> 16);
                    Rm[(t0) * 72 + jcol] = (bf16_t)(wr0 & 0xFFFFu); Rm[(t0 + 1) * 72 + jcol] = (bf16_t)(wr0 >> 16); Rm[(t0 + 2) * 72 + jcol] = (bf16_t)(wr1 & 0xFFFFu); Rm[(t0 + 3) * 72 + jcol] = (bf16_t)(wr1 >> 16);
                    Qm[(t0) * 72 + jcol] = (bf16_t)(wq0 & 0xFFFFu); Qm[(t0 + 1) * 72 + jcol] = (bf16_t)(wq0 >> 16); Qm[(t0 + 2) * 72 + jcol] = (bf16_t)(wq1 & 0xFFFFu); Qm[(t0 + 3) * 72 + jcol] = (bf16_t)(wq1 >> 16);
                    Mm[(t0) * 72 + jcol] = (bf16_t)(wm0 & 0xFFFFu); Mm[(t0 + 1) * 72 + jcol] = (bf16_t)(wm0 >> 16); Mm[(t0 + 2) * 72 + jcol] = (bf16_t)(wm1 & 0xFFFFu); Mm[(t0 + 3) * 72 + jcol] = (bf16_t)(wm1 >> 16);
                    u32x2 tq; tq.x = wq0; tq.y = wq1; *(u32x2*)(QT + jcol * 24 + t0) = tq;
                    u32x2 tm; tm.x = wm0; tm.y = wm1; *(u32x2*)(MT + jcol * 24 + t0) = tm;
                    if (tg == 3) GT[jcol] = pre * gl[3];
                }
                asm volatile("s_waitcnt lgkmcnt(0)" ::: "memory"); __builtin_amdgcn_s_barrier(); asm volatile("" ::: "memory");
                f32x4 Gqp = z4, Gmp = z4, Gqr = z4, Gmr = z4;
#pragma unroll
                for (int ks = 0; ks < 2; ++ks) {
                    const bf16x8 aQ = *(const bf16x8*)(Qm + r16 * 72 + ks * 32 + quad * 8), aM = *(const bf16x8*)(Mm + r16 * 72 + ks * 32 + quad * 8);
                    const bf16x8 bP = *(const bf16x8*)(Pm + r16 * 72 + ks * 32 + quad * 8), bR = *(const bf16x8*)(Rm + r16 * 72 + ks * 32 + quad * 8);
                    Gqp = MFMA16(aQ, bP, Gqp); Gmp = MFMA16(aM, bP, Gmp); Gqr = MFMA16(aQ, bR, Gqr); Gmr = MFMA16(aM, bR, Gmr);
                }
#pragma unroll
                for (int rg = 0; rg < 4; ++rg) { const int sI = quad * 4 + rg;
                    if (sI >= r16) { Gqp[rg] = 0.f; Gmp[rg] = 0.f; }
                    if (sI > r16) { Gqr[rg] = 0.f; Gmr[rg] = 0.f; } }
                *(f32x4*)(Nm + r16 * 16 + quad * 4) = Gqp;
                f32x4 SA0 = z4, Y0 = z4;
#pragma unroll
                for (int ks = 0; ks < 2; ++ks) {
                    const bf16x8 sb = pack8(ST[2 * ks], ST[2 * ks + 1]);
                    const bf16_t* pp = Pm + r16 * 72 + ks * 32 + quad * 4; const bf16_t* rp = Rm + r16 * 72 + ks * 32 + quad * 4;
                    const bf16x8 pa = join8(*(const s16x4*)pp, *(const s16x4*)(pp + 16)), ra = join8(*(const s16x4*)rp, *(const s16x4*)(rp + 16));
                    SA0 = MFMA16(pa, sb, SA0); Y0 = MFMA16(ra, sb, Y0);
                }
                f32x4 Vv;
#pragma unroll
                for (int jj = 0; jj < 4; ++jj) Vv[jj] = vb[(quad * 4 + jj) * 384 + 320 + cw * 16 + r16];
                const f32x4 Cc = MFMA16(pack8(Gmp, z4), pack8(Vv, z4), SA0);
                float x[16];
#pragma unroll
                for (int c2 = 0; c2 < 16; ++c2) x[c2] = (c2 == r16) ? 1.f : 0.f;
#pragma unroll
                for (int sI = 15; sI >= 1; --sI) {
#pragma unroll
                    for (int c2 = 0; c2 < sI; ++c2) x[c2] += x[sI] * Nm[sI * 16 + c2];
                }
                f32x4 xs;
#pragma unroll
                for (int jj = 0; jj < 4; ++jj) xs[jj] = (quad == 0) ? x[jj] : (quad == 1) ? x[4 + jj] : (quad == 2) ? x[8 + jj] : x[12 + jj];
                const f32x4 SAc = MFMA16(pack8(xs, z4), pack8(Cc, z4), z4);
                const bf16x8 Bsv = pack8(SAc, Vv);
                const f32x4 Yc = MFMA16(pack8(Gqr, Gmr), Bsv, Y0);
#pragma unroll
                for (int rg = 0; rg < 4; ++rg) { const int n = c * TCH + quad * 4 + rg; const int t = d ? (S - 1 - n) : n;
                    YB[((size_t)d * M + (size_t)b * S + t) * 1024 + h * 64 + cw * 16 + r16] = f2bf(Yc[rg]); }
#pragma unroll
                for (int mt = 0; mt < 4; ++mt) {
                    const bf16_t* qp = QT + (mt * 16 + r16) * 24 + quad * 4; const bf16_t* mp = MT + (mt * 16 + r16) * 24 + quad * 4;
                    const f32x4 acc = MFMA16(join8(*(const s16x4*)qp, *(const s16x4*)mp), Bsv, ST[mt]);
                    const f32x4 gt = *(const f32x4*)(GT + mt * 16 + quad * 4);
                    ST[mt] = acc * gt;
                }
                asm volatile("s_waitcnt lgkmcnt(0)" ::: "memory"); __builtin_amdgcn_s_barrier(); asm volatile("" ::: "memory");
            }
        } else {
            const int pw = wid - 4;
            bf16_t* Aw = (bf16_t*)(pbase + pw * 3200); bf16_t* Aa = Aw + TPW * 72; float* X = (float*)(pbase + pw * 3200 + 1152);
            const int cr = h * 64 + lane, ck = 1024 + h * 64 + lane, cv = 2048 + h * 64 + lane, cw = 3072 + d * 64 + lane, ca = 3200 + d * 64 + lane;
            const int mo0 = d ? 3328 : 0, mo1 = d ? 0 : 3328;
            const float mr0 = mu[mo0 + cr], mr1 = mu[mo1 + cr], mk0 = mu[mo0 + ck], mk1 = mu[mo1 + ck], mv0 = mu[mo0 + cv], mv1 = mu[mo1 + cv];
            const float mw0 = mu[mo0 + cw], mw1 = mu[mo1 + cw], ma0 = mu[mo0 + ca], ma1 = mu[mo1 + ca];
            const int chn = h * 64 + lane;
            const float w0v = P.in[12][(size_t)(layer * 2 + d) * 1024 + chn], a0v = P.in[14][(size_t)(layer * 2 + d) * 1024 + chn];
            const float kkw = P.in[16][(size_t)layer * 1024 + chn], kaw = P.in[17][(size_t)layer * 1024 + chn], rkw = P.in[18][(size_t)layer * 1024 + chn];
            unsigned short raw[TPW + 2][5];
            RWKV_LOAD_RAW(0);
            for (int c = 0; c < NCH + 1; ++c) {
                if (c < NCH) {
                    float* vb = VEC + (c & 1) * (TCH * 384);
                    float rr[TPW], kv[TPW], vv[TPW], kk[TPW];
                    {
                        float fr[TPW + 2][5];
#pragma unroll
                        for (int j = 0; j < TPW + 2; ++j)
#pragma unroll
                            for (int st = 0; st < 5; ++st) fr[j][st] = bf2f(raw[j][st]);
                        if (c + 1 < NCH) { RWKV_LOAD_RAW(c + 1); }
#pragma unroll
                        for (int i = 0; i < TPW; ++i) {
                            float p0, pa, pb;
                            p0 = fr[i + 1][0]; pa = fr[i][0]; pb = fr[i + 2][0]; rr[i] = p0 + mr0 * (pa - p0) + mr1 * (pb - p0);
                            p0 = fr[i + 1][1]; pa = fr[i][1]; pb = fr[i + 2][1]; kv[i] = p0 + mk0 * (pa - p0) + mk1 * (pb - p0);
                            p0 = fr[i + 1][2]; pa = fr[i][2]; pb = fr[i + 2][2]; vv[i] = p0 + mv0 * (pa - p0) + mv1 * (pb - p0);
                            p0 = fr[i + 1][3]; pa = fr[i][3]; pb = fr[i + 2][3]; const float wd = p0 + mw0 * (pa - p0) + mw1 * (pb - p0);
                            p0 = fr[i + 1][4]; pa = fr[i][4]; pb = fr[i + 2][4]; const float ad = p0 + ma0 * (pa - p0) + ma1 * (pb - p0);
                            Aw[i * 72 + lane] = f2bf(fast_tanh(wd)); Aa[i * 72 + lane] = f2bf(ad);
                            const float k2 = kv[i] * kkw; const float n2 = wave_sum_fast(k2 * k2);
                            kk[i] = k2 * __builtin_amdgcn_rsqf(fmaxf(n2, 1e-24f));
                        }
                    }
                    asm volatile("s_waitcnt lgkmcnt(0)" ::: "memory"); __builtin_amdgcn_s_barrier(); asm volatile("" ::: "memory");
#pragma unroll
                    for (int mat = 0; mat < 2; ++mat) {
                        const bf16_t* A = mat ? Aa : Aw;
                        const bf16x8 a0f = *(const bf16x8*)(A + (r16 & (TPW - 1)) * 72 + quad * 8), a1f = *(const bf16x8*)(A + (r16 & (TPW - 1)) * 72 + 32 + quad * 8);
#pragma unroll
                        for (int nt = 0; nt < 4; ++nt) {
                            const bf16_t* B = UPT + mat * 4608 + (nt * 16 + r16) * 72 + quad * 8;
                            f32x4 acc = {0.f, 0.f, 0.f, 0.f};
                            acc = MFMA16(a0f, *(const bf16x8*)B, acc); acc = MFMA16(a1f, *(const bf16x8*)(B + 32), acc);
                            if (quad == 0) {
#pragma unroll
                                for (int rg = 0; rg < 4; ++rg) X[mat * 256 + rg * 64 + nt * 16 + r16] = acc[rg];
                            }
                        }
                    }
                    asm volatile("s_waitcnt lgkmcnt(0)" ::: "memory");
#pragma unroll
                    for (int i = 0; i < TPW; ++i) {
                        const int s = pw * TPW + i; const int n = c * TCH + s; const int t = d ? (S - 1 - n) : n;
                        const float xw = X[i * 64 + lane] + w0v, xa = X[256 + i * 64 + lane] + a0v;
                        const float dec = __expf(-0.6065306597126334f * fast_sigmoid(xw)); const float av = fast_sigmoid(xa);
                        const float kmod = kv[i] * (1.f + (av - 1.f) * kaw); const float kka = kk[i] * av;
                        float* o = vb + s * 384 + lane;
                        o[0] = -kk[i]; o[64] = dec; o[128] = kka; o[192] = kmod; o[256] = rr[i]; o[320] = vv[i];
                        const float bon = wave_sum_fast(rr[i] * kmod * rkw);
                        if (lane == 0) BON[(((size_t)d * NB + b) * 16 + h) * S + t] = bon;
                    }
                }
                if (c == NCH) { asm volatile("s_waitcnt lgkmcnt(0)" ::: "memory"); __builtin_amdgcn_s_barrier(); asm volatile("" ::: "memory"); }
                asm volatile("s_waitcnt lgkmcnt(0)" ::: "memory"); __builtin_amdgcn_s_barrier(); asm volatile("" ::: "memory");
            }
        }
    }
}

__device__ __forceinline__ int swz40(int row, int s) { return row * 40 + ((((s >> 3) ^ (row >> 3)) & 3) << 3) + (s & 7); }
__device__ __forceinline__ void hgrn_phase(const Params& P, int layer, unsigned char* smem) {
    bf16_t* QE = (bf16_t*)smem; bf16_t* KE = (bf16_t*)(smem + 8704); bf16_t* KLT = (bf16_t*)(smem + 17408); bf16_t* VT = (bf16_t*)(smem + 27648);
    float* LF = (float*)(smem + 37888); float* EL = (float*)(smem + 54272);
    const int tid = opaque_tid(), wid = __builtin_amdgcn_readfirstlane(tid >> 6), lane = tid & 63, r16 = lane & 15, quad = lane >> 4;
    const bf16_t* proj = (const bf16_t*)(P.ws + OFF_PROJ);
    bf16_t* OC = (bf16_t*)(P.ws + OFF_OC);
    const int es = tid >> 4, ekc = (tid & 15) * 8;
    for (int chain = opaque_bid(); chain < 128; chain += gridDim.x) {
        const int d = chain >> 6, b = (chain >> 3) & 7, h = chain & 7;
        float lb[8];
#pragma unroll
        for (int j = 0; j < 8; ++j) lb[j] = 0.f;
        if (layer > 0) {
#pragma unroll
            for (int j = 0; j < 8; ++j) { const float l0 = P.in[21][(size_t)(d * 2 + 0) * 1024 + h * 128 + ekc + j], l1 = P.in[21][(size_t)(d * 2 + 1) * 1024 + h * 128 + ekc + j]; lb[j] = 1.f / (1.f + __expf(l0 - l1)); }
        }
        f32x4 Sacc[8];
#pragma unroll
        for (int mt = 0; mt < 8; ++mt) Sacc[mt] = (f32x4){0.f, 0.f, 0.f, 0.f};
        u32x4 zraw, qraw, vraw;
        { const int t = d ? (S - 1 - es) : es; const bf16_t* row = proj + ((size_t)b * S + t) * PW + h * 128 + ekc;
          zraw = *(const u32x4*)(row + C_CF + d * 1024); qraw = *(const u32x4*)(row + C_CQ); vraw = *(const u32x4*)(row + C_CI); }
        for (int c = 0; c < 64; ++c) {
            __syncthreads();
            { const int n = c * 32 + es; const int t = d ? (S - 1 - n) : n; const bf16_t* row = proj + ((size_t)b * S + t) * PW + h * 128 + ekc;
              zraw = *(const u32x4*)(row + C_CF + d * 1024); qraw = *(const u32x4*)(row + C_CQ); vraw = *(const u32x4*)(row + C_CI); }
            float kval[8];
            {
                float lf[8];
#pragma unroll
                for (int j = 0; j < 8; ++j) {
                    const unsigned wv = zraw[j >> 1]; const float z = (j & 1) ? __uint_as_float(wv & 0xFFFF0000u) : __uint_as_float(wv << 16);
                    const float e = __expf(-fabsf(z));
                    const float ls = fminf(z, 0.f) - __logf(1.f + e);
                    const float sg = (z >= 0.f ? 1.f : e) * __builtin_amdgcn_rcpf(1.f + e);
                    lf[j] = (lb[j] > 0.f) ? __logf(lb[j] + (1.f - lb[j]) * sg) : ls;
                    kval[j] = (1.f - lb[j]) * (1.f - sg);
                }
                *(f32x4*)(LF + es * 128 + ekc) = (f32x4){lf[0], lf[1], lf[2], lf[3]}; *(f32x4*)(LF + es * 128 + ekc + 4) = (f32x4){lf[4], lf[5], lf[6], lf[7]};
#pragma unroll
                for (int j = 0; j < 8; ++j) { const unsigned wv = vraw[j >> 1]; VT[swz40(ekc + j, es)] = (bf16_t)((j & 1) ? (wv >> 16) : (wv & 0xFFFFu)); }
            }
            __syncthreads();
            if (tid < 128) {
                float cum = 0.f;
#pragma unroll
                for (int s = 0; s < 32; ++s) { cum += LF[s * 128 + tid]; LF[s * 128 + tid] = cum; }
                EL[tid] = __expf(cum);
            }
            __syncthreads();
            {
                const f32x4 c0 = *(const f32x4*)(LF + es * 128 + ekc), c1v = *(const f32x4*)(LF + es * 128 + ekc + 4);
                const f32x4 l0 = *(const f32x4*)(LF + 31 * 128 + ekc), l1 = *(const f32x4*)(LF + 31 * 128 + ekc + 4);
                float qe[8], ke[8];
#pragma unroll
                for (int j = 0; j < 8; ++j) {
                    const unsigned wv = qraw[j >> 1]; const float qv = (j & 1) ? __uint_as_float(wv & 0xFFFF0000u) : __uint_as_float(wv << 16);
                    const float cum = (j < 4) ? c0[j & 3] : c1v[j & 3], last = (j < 4) ? l0[j & 3] : l1[j & 3];
                    qe[j] = qv * __expf(cum); ke[j] = kval[j] * __expf(-cum);
                    KLT[swz40(ekc + j, es)] = f2bf(kval[j] * __expf(last - cum));
                }
                u32x4 w; w.x = pk2(qe[0], qe[1]); w.y = pk2(qe[2], qe[3]); w.z = pk2(qe[4], qe[5]); w.w = pk2(qe[6], qe[7]); *(u32x4*)(QE + es * 136 + ekc) = w;
                w.x = pk2(ke[0], ke[1]); w.y = pk2(ke[2], ke[3]); w.z = pk2(ke[4], ke[5]); w.w = pk2(ke[6], ke[7]); *(u32x4*)(KE + es * 136 + ekc) = w;
            }
            if (false) { const int n = (c + 1) * 32 + es; const int t = d ? (S - 1 - n) : n; const bf16_t* row = proj + ((size_t)b * S + t) * PW + h * 128 + ekc;
                zraw = *(const u32x4*)(row + C_CF + d * 1024); qraw = *(const u32x4*)(row + C_CQ); vraw = *(const u32x4*)(row + C_CI); }
            __syncthreads();
            f32x4 sc00 = {0.f, 0.f, 0.f, 0.f}, sc01 = sc00, sc11 = sc00;
#pragma unroll
            for (int ks = 0; ks < 4; ++ks) {
                const bf16x8 ke0 = *(const bf16x8*)(KE + r16 * 136 + ks * 32 + quad * 8), ke1 = *(const bf16x8*)(KE + (16 + r16) * 136 + ks * 32 + quad * 8);
                const bf16x8 qe0 = *(const bf16x8*)(QE + r16 * 136 + ks * 32 + quad * 8), qe1 = *(const bf16x8*)(QE + (16 + r16) * 136 + ks * 32 + quad * 8);
                sc00 = MFMA16(ke0, qe0, sc00); sc01 = MFMA16(ke0, qe1, sc01); sc11 = MFMA16(ke1, qe1, sc11);
            }
#pragma unroll
            for (int rg = 0; rg < 4; ++rg) { if (quad * 4 + rg > r16) { sc00[rg] = 0.f; sc11[rg] = 0.f; } }
            const f32x4 zero4 = {0.f, 0.f, 0.f, 0.f};
            const bf16x8 p0 = pack8(sc00, zero4), p1 = pack8(sc01, sc11);
            const int vrow_i = wid * 16 + r16;
            const bf16x8 vperm = join8(*(const s16x4*)(VT + swz40(vrow_i, quad * 4)), *(const s16x4*)(VT + swz40(vrow_i, 16 + quad * 4)));
            f32x4 o0 = MFMA16(p0, vperm, zero4), o1 = MFMA16(p1, vperm, zero4);
#pragma unroll
            for (int ks = 0; ks < 4; ++ks) {
                const bf16x8 sb = pack8(Sacc[2 * ks], Sacc[2 * ks + 1]);
                const bf16_t* q0p = QE + r16 * 136 + ks * 32 + quad * 4; const bf16_t* q1p = QE + (16 + r16) * 136 + ks * 32 + quad * 4;
                const bf16x8 qa0 = join8(*(const s16x4*)q0p, *(const s16x4*)(q0p + 16)), qa1 = join8(*(const s16x4*)q1p, *(const s16x4*)(q1p + 16));
                o0 = MFMA16(qa0, sb, o0); o1 = MFMA16(qa1, sb, o1);
            }
#pragma unroll
            for (int rg = 0; rg < 4; ++rg) {
                { const int n = c * 32 + quad * 4 + rg; const int t = d ? (S - 1 - n) : n; OC[((size_t)d * M + (size_t)b * S + t) * 1024 + h * 128 + wid * 16 + r16] = f2bf(o0[rg]); }
                { const int n = c * 32 + 16 + quad * 4 + rg; const int t = d ? (S - 1 - n) : n; OC[((size_t)d * M + (size_t)b * S + t) * 1024 + h * 128 + wid * 16 + r16] = f2bf(o1[rg]); }
            }
            const bf16x8 vnat = *(const bf16x8*)(VT + swz40(vrow_i, quad * 8));
#pragma unroll
            for (int mt = 0; mt < 8; ++mt) {
                const f32x4 el = *(const f32x4*)(EL + mt * 16 + quad * 4);
                f32x4 sa = Sacc[mt] * el;
                const bf16x8 kl = *(const bf16x8*)(KLT + swz40(mt * 16 + r16, quad * 8));
                Sacc[mt] = MFMA16(kl, vnat, sa);
            }
        }
    }
}

__device__ __forceinline__ void attn_phase(const Params& P, int layer, unsigned char* smem, unsigned* counter) {
    float* TAB = (float*)smem; bf16_t* KT = (bf16_t*)(smem + 16384); bf16_t* VTt = (bf16_t*)(smem + 16384 + 9216); int* sh_unit = (int*)(smem + 16384 + 9216 + 18432);
    const int tid = opaque_tid(), wid = __builtin_amdgcn_readfirstlane(tid >> 6), lane = tid & 63, r16 = lane & 15, quad = lane >> 4;
    const bf16_t* proj = (const bf16_t*)(P.ws + OFF_PROJ);
    bf16_t* AO = (bf16_t*)(P.ws + OFF_AO);
    const float* rel_bias = P.in[1];
    const float c1 = 0.125f * LOG2E;
    for (;;) {
        __syncthreads();
        if (tid == 0) *sh_unit = (int)atomicAdd(counter, 1u);
        __syncthreads();
        const int u = *sh_unit;
        if (u >= 1024) break;
        const int qb = u & 7, m = (u >> 3) & 1, h = (u >> 4) & 7, b = u >> 7;
        for (int e = tid; e < 4095; e += 512) { const int rel = e - 2047; const int n = rel < 0 ? -rel : rel; int bk;
            if (n < 8) bk = n; else { const int lg = 31 - __clz(n * n); bk = 2 + lg; if (bk > 15) bk = 15; }
            if (rel > 0) bk += 16; TAB[e] = rel_bias[bk * 8 + h] * LOG2E; }
        const int qrow0 = qb * 256 + wid * 32;
        bf16x8 Qf[2][2];
#pragma unroll
        for (int nq = 0; nq < 2; ++nq)
#pragma unroll
            for (int ks = 0; ks < 2; ++ks) Qf[nq][ks] = *(const bf16x8*)(proj + ((size_t)b * S + qrow0 + nq * 16 + r16) * PW + C_AQ + h * 128 + m * 64 + ks * 32 + quad * 8);
        f32x4 O[2][8];
#pragma unroll
        for (int nq = 0; nq < 2; ++nq)
#pragma unroll
            for (int dt = 0; dt < 8; ++dt) O[nq][dt] = (f32x4){0.f, 0.f, 0.f, 0.f};
        float mrun[2] = {-1e30f, -1e30f}, lrun[2] = {0.f, 0.f};
        const int kkey = tid >> 3, kchunk = tid & 7;
        const int vkp = tid & 31, vchunk = tid >> 5;
        const bf16_t* kbase = proj + ((size_t)b * S + kkey) * PW + C_AK + h * 128 + m * 64 + kchunk * 8;
        const bf16_t* vbase = proj + ((size_t)b * S + 2 * vkp) * PW + C_AV + h * 128 + vchunk * 8;
        u32x4 kreg = *(const u32x4*)kbase, vreg0 = *(const u32x4*)vbase, vreg1 = *(const u32x4*)(vbase + PW);
        for (int kt = 0; kt < 32; ++kt) {
            __syncthreads();
            *(u32x4*)(KT + kkey * 72 + kchunk * 8) = kreg;
            { unsigned* vd = (unsigned*)(VTt + (vchunk * 8) * 72 + 2 * vkp);
#pragma unroll
              for (int i2 = 0; i2 < 4; ++i2) { const unsigned a = vreg0[i2], bq = vreg1[i2];
                  vd[(2 * i2) * 36] = (a & 0xFFFFu) | (bq << 16); vd[(2 * i2 + 1) * 36] = (a >> 16) | (bq & 0xFFFF0000u); } }
            __syncthreads();
            if (kt + 1 < 32) { const size_t adv = (size_t)(kt + 1) * 64 * PW; kreg = *(const u32x4*)(kbase + adv); vreg0 = *(const u32x4*)(vbase + adv); vreg1 = *(const u32x4*)(vbase + adv + PW); }
            const int k0 = kt * 64;
            f32x4 st[2][4];
#pragma unroll
            for (int mt = 0; mt < 4; ++mt) {
                const bf16x8 ka = *(const bf16x8*)(KT + (mt * 16 + r16) * 72 + quad * 8), kb2 = *(const bf16x8*)(KT + (mt * 16 + r16) * 72 + 32 + quad * 8);
#pragma unroll
                for (int nq = 0; nq < 2; ++nq) { f32x4 a = {0.f, 0.f, 0.f, 0.f}; a = MFMA16(ka, Qf[nq][0], a); a = MFMA16(kb2, Qf[nq][1], a); st[nq][mt] = a; }
            }
            const bool posfar = (k0 - (qrow0 + 31)) >= 96, negfar = (qrow0 - (k0 + 63)) >= 96;
            if (posfar || negfar) {
                const float cb = posfar ? TAB[2047 + 128] : TAB[2047 - 128];
#pragma unroll
                for (int nq = 0; nq < 2; ++nq)
#pragma unroll
                    for (int mt = 0; mt < 4; ++mt) st[nq][mt] = st[nq][mt] * c1 + cb;
            } else {
#pragma unroll
                for (int nq = 0; nq < 2; ++nq)
#pragma unroll
                    for (int mt = 0; mt < 4; ++mt) { const float* tp = TAB + (k0 + mt * 16 + quad * 4) - (qrow0 + nq * 16 + r16) + 2047;
#pragma unroll
                        for (int rg = 0; rg < 4; ++rg) st[nq][mt][rg] = st[nq][mt][rg] * c1 + tp[rg]; }
            }
            bf16x8 pf[2][2];
#pragma unroll
            for (int nq = 0; nq < 2; ++nq) {
                float mx = st[nq][0][0];
#pragma unroll
                for (int mt = 0; mt < 4; ++mt)
#pragma unroll
                    for (int rg = 0; rg < 4; ++rg) mx = fmaxf(mx, st[nq][mt][rg]);
                mx = fmaxf(mx, __shfl_xor(mx, 16)); mx = fmaxf(mx, __shfl_xor(mx, 32));
                const float mnew = fmaxf(mrun[nq], mx); const float alpha = __builtin_amdgcn_exp2f(mrun[nq] - mnew); mrun[nq] = mnew;
                float ps = 0.f;
#pragma unroll
                for (int mt = 0; mt < 4; ++mt)
#pragma unroll
                    for (int rg = 0; rg < 4; ++rg) { const float pv = __builtin_amdgcn_exp2f(st[nq][mt][rg] - mnew); st[nq][mt][rg] = pv; ps += pv; }
                lrun[nq] = lrun[nq] * alpha + ps;
#pragma unroll
                for (int dt = 0; dt < 8; ++dt) O[nq][dt] = O[nq][dt] * alpha;
                pf[nq][0] = pack8(st[nq][0], st[nq][1]); pf[nq][1] = pack8(st[nq][2], st[nq][3]);
            }
#pragma unroll
            for (int dt = 0; dt < 8; ++dt) {
                const bf16_t* vr = VTt + (dt * 16 + r16) * 72 + quad * 4;
                const bf16x8 va0 = join8(*(const s16x4*)vr, *(const s16x4*)(vr + 16)), va1 = join8(*(const s16x4*)(vr + 32), *(const s16x4*)(vr + 48));
#pragma unroll
                for (int nq = 0; nq < 2; ++nq) { O[nq][dt] = MFMA16(va0, pf[nq][0], O[nq][dt]); O[nq][dt] = MFMA16(va1, pf[nq][1], O[nq][dt]); }
            }
        }
#pragma unroll
        for (int nq = 0; nq < 2; ++nq) {
            float l = lrun[nq]; l += __shfl_xor(l, 16); l += __shfl_xor(l, 32);
            const float inv = 1.f / l;
            bf16_t* orow = AO + ((size_t)m * M + (size_t)b * S + qrow0 + nq * 16 + r16) * 1024 + h * 128 + quad * 4;
#pragma unroll
            for (int dt = 0; dt < 8; ++dt) { u32x2 w; w.x = pk2(O[nq][dt][0] * inv, O[nq][dt][1] * inv); w.y = pk2(O[nq][dt][2] * inv, O[nq][dt][3] * inv); *(u32x2*)(orow + dt * 16) = w; }
        }
    }
}

__device__ __forceinline__ void load16(const bf16_t* p, float* o) {
    const u32x4 a = *(const u32x4*)p, b = *(const u32x4*)(p + 8);
#pragma unroll
    for (int i = 0; i < 4; ++i) { o[2 * i] = __uint_as_float(a[i] << 16); o[2 * i + 1] = __uint_as_float(a[i] & 0xFFFF0000u); o[8 + 2 * i] = __uint_as_float(b[i] << 16); o[8 + 2 * i + 1] = __uint_as_float(b[i] & 0xFFFF0000u); }
}
__device__ __forceinline__ void store16(bf16_t* p, const float* v) {
    u32x4 a, b; a.x = pk2(v[0], v[1]); a.y = pk2(v[2], v[3]); a.z = pk2(v[4], v[5]); a.w = pk2(v[6], v[7]); b.x = pk2(v[8], v[9]); b.y = pk2(v[10], v[11]); b.z = pk2(v[12], v[13]); b.w = pk2(v[14], v[15]);
    *(u32x4*)p = a; *(u32x4*)(p + 8) = b;
}
__device__ __forceinline__ void loadf16(const float* p, float* o) {
#pragma unroll
    for (int i = 0; i < 4; ++i) { const float4 v = ((const float4*)p)[i]; o[4 * i] = v.x; o[4 * i + 1] = v.y; o[4 * i + 2] = v.z; o[4 * i + 3] = v.w; }
}
__device__ __forceinline__ void finish_phase(const Params& P, int layer) {
    const int tid_ = opaque_tid(); const int lane = tid_ & 63, gw = opaque_bid() * 8 + (tid_ >> 6), ngw = gridDim.x * 8;
    const bf16_t* proj = (const bf16_t*)(P.ws + OFF_PROJ);
    const bf16_t* AO = (const bf16_t*)(P.ws + OFF_AO); const bf16_t* YB = (const bf16_t*)(P.ws + OFF_U); const bf16_t* OC = (const bf16_t*)(P.ws + OFF_OC);
    const float* BON = (const float*)(P.ws + OFF_BON);
    bf16_t* MIX = (bf16_t*)(P.ws + OFF_MIXED);
    const float lam_init = 0.8f - 0.6f * expf(-0.3f * (float)layer);
    const float s1 = wave_sum(P.in[6][layer * 64 + lane] * P.in[7][layer * 64 + lane]), s2 = wave_sum(P.in[8][layer * 64 + lane] * P.in[9][layer * 64 + lane]);
    const float lam = expf(s1) - expf(s2) + lam_init;
    const int c0 = lane * 16;
    const float* mu0p = P.in[11] + (size_t)layer * 2 * 3328 + 2048 + c0; const float* mu1p = mu0p + 3328;
    for (int tok = gw; tok < M; tok += ngw) {
        const bf16_t* prow = proj + (size_t)tok * PW;
        bf16_t* mrow = MIX + (size_t)tok * MIXW;
        float a[16], bb[16], g[16], pr[16];
        load16(AO + (size_t)tok * 1024 + c0, a); load16(AO + ((size_t)M + tok) * 1024 + c0, bb); load16(prow + C_AG + c0, g);
        { float ss = 0.f;
#pragma unroll
          for (int i = 0; i < 16; ++i) { a[i] = a[i] - lam * bb[i]; ss += a[i] * a[i]; }
          ss += __shfl_xor(ss, 1); ss += __shfl_xor(ss, 2); ss += __shfl_xor(ss, 4);
          const float rstd = rsqrtf(ss * (1.f / 128.f) + 1e-5f) * (1.f - lam_init);
          loadf16(P.in[10] + layer * 128 + (c0 & 127), pr);
#pragma unroll
          for (int i = 0; i < 16; ++i) a[i] = a[i] * rstd * pr[i] * siluf_(g[i]);
          store16(mrow + c0, a); }
        load16(YB + (size_t)tok * 1024 + c0, a); load16(YB + ((size_t)M + tok) * 1024 + c0, bb); load16(prow + C_BG + c0, g);
        { float sm = 0.f;
#pragma unroll
          for (int i = 0; i < 16; ++i) { a[i] += bb[i]; sm += a[i]; }
          sm += __shfl_xor(sm, 1); sm += __shfl_xor(sm, 2);
          const float mean = sm * (1.f / 64.f); float vs = 0.f;
#pragma unroll
          for (int i = 0; i < 16; ++i) { a[i] -= mean; vs += a[i] * a[i]; }
          vs += __shfl_xor(vs, 1); vs += __shfl_xor(vs, 2);
          const float rstd = rsqrtf(vs * (1.f / 64.f) + 64e-5f);
          const int head = lane >> 2;
          const float bon = BON[(((size_t)(tok >> 11)) * 16 + head) * S + (tok & (S - 1))] + BON[(((size_t)NB + (tok >> 11)) * 16 + head) * S + (tok & (S - 1))];
          const int sp = tok & (S - 1);
          loadf16(P.in[19] + layer * 1024 + c0, pr);
#pragma unroll
          for (int i = 0; i < 16; ++i) a[i] = a[i] * rstd * pr[i];
          loadf16(P.in[20] + layer * 1024 + c0, pr);
#pragma unroll
          for (int i = 0; i < 16; ++i) a[i] += pr[i];
          load16(prow + C_B + 2048 + c0, bb);
          float vsft[16];
          { float nb[16];
            if (sp > 0) load16(prow - PW + C_B + 2048 + c0, nb); else {
#pragma unroll
                for (int i = 0; i < 16; ++i) nb[i] = 0.f; }
            loadf16(mu0p, pr);
#pragma unroll
            for (int i = 0; i < 16; ++i) vsft[i] = bb[i] + pr[i] * (nb[i] - bb[i]);
            if (sp < S - 1) load16(prow + PW + C_B + 2048 + c0, nb); else {
#pragma unroll
                for (int i = 0; i < 16; ++i) nb[i] = 0.f; }
            loadf16(mu1p, pr);
#pragma unroll
            for (int i = 0; i < 16; ++i) vsft[i] += pr[i] * (nb[i] - bb[i]); }
#pragma unroll
          for (int i = 0; i < 16; ++i) a[i] = (a[i] + bon * vsft[i]) * siluf_(g[i]);
          store16(mrow + 1024 + c0, a); }
        load16(OC + (size_t)tok * 1024 + c0, a); load16(OC + ((size_t)M + tok) * 1024 + c0, bb); load16(prow + C_CG + c0, g);
        { float ss = 0.f;
#pragma unroll
          for (int i = 0; i < 16; ++i) { a[i] += bb[i]; ss += a[i] * a[i]; }
          ss += __shfl_xor(ss, 1); ss += __shfl_xor(ss, 2); ss += __shfl_xor(ss, 4);
          const float rstd = rsqrtf(ss * (1.f / 128.f) + 1e-6f);
          loadf16(P.in[22] + layer * 128 + (c0 & 127), pr);
#pragma unroll
          for (int i = 0; i < 16; ++i) a[i] = a[i] * rstd * pr[i] * siluf_(g[i]);
          store16(mrow + 2048 + c0, a); }
    }
}

__global__ void __launch_bounds__(NTHR, 2) fwd_megakernel(Params P) {
    extern __shared__ __attribute__((aligned(16))) unsigned char smem[];
    cg::grid_group grid = cg::this_grid();
    unsigned* ctl = (unsigned*)(P.ws + OFF_CTL);
    bf16_t* U = (bf16_t*)(P.ws + OFF_U);
    float* Y = (float*)(P.ws + OFF_PROJ);
#ifndef REP_P0
#define REP_P0 1
#endif
#pragma unroll 1
    for (int rep = 0; rep < REP_P0; ++rep) { convert_weights(P, 0, smem);
    prenorm_rows(P.in[0], P.in[2], U); }
    grid.sync();
#pragma unroll 1
    for (int layer = 0; layer < DEPTH; ++layer) {
#ifndef REP_G1
#define REP_G1 1
#endif
#pragma unroll 1
        for (int rep = 0; rep < REP_G1; ++rep) { pg8::Gemm g; g.A = U; g.Bt = (const bf16_t*)(P.ws + OFF_WIN); g.M = opaque_s(M); g.N = opaque_s(PW); g.K = opaque_s(D);
          pg8::StaticOrder So; So.init(g.M, g.N, (int)gridDim.x, opaque_bid());
          pg8::EpiBf16<0> E; E.O = (bf16_t*)(P.ws + OFF_PROJ); E.ldc = g.N; E.bias = nullptr; E.split_cols = 0; E.split_stride = 0;
          pg8::gemm_phase<pg8::EpiBf16<0>, pg8::StaticOrder, false>((PG8_LAS unsigned char*)smem, g, So, E, nullptr); }
        grid.sync();
#ifndef REP_RWKV
#define REP_RWKV 1
#endif
#ifndef REP_HGRN
#define REP_HGRN 1
#endif
#ifndef REP_ATTN
#define REP_ATTN 1
#endif
#pragma unroll 1
        for (int rep = 0; rep < REP_RWKV; ++rep) rwkv_phase(P, layer, smem);
#pragma unroll 1
        for (int rep = 0; rep < REP_HGRN; ++rep) hgrn_phase(P, layer, smem);
#pragma unroll 1
        for (int rep = 0; rep < REP_ATTN; ++rep) attn_phase(P, layer, smem, ctl + 64 * layer + 128 * rep);
        grid.sync();
#ifndef REP_FIN
#define REP_FIN 1
#endif
#pragma unroll 1
        for (int rep = 0; rep < REP_FIN; ++rep) finish_phase(P, layer);
        grid.sync();
#ifndef REP_G2
#define REP_G2 1
#endif
#pragma unroll 1
        for (int rep = 0; rep < REP_G2; ++rep) { pg8::Gemm g; g.A = (const bf16_t*)(P.ws + OFF_MIXED); g.Bt = (const bf16_t*)(P.ws + OFF_WOUT); g.M = opaque_s(M); g.N = opaque_s(D); g.K = opaque_s(MIXW);
          pg8::StaticOrder So; So.init(g.M, g.N, (int)gridDim.x, opaque_bid());
          pg8::EpiF32 E; E.C = Y; E.ldc = g.N; E.bias = nullptr;
          pg8::gemm_phase<pg8::EpiF32, pg8::StaticOrder, false>((PG8_LAS unsigned char*)smem, g, So, E, nullptr); }
        grid.sync();
        if (layer + 1 < DEPTH) {
            postnorm_rows(Y, layer == 0 ? P.in[0] : P.out, P.out, P.in[3] + layer * D, P.in[2] + (layer + 1) * D, U);
            convert_weights(P, layer + 1, smem);
            grid.sync();
        } else {
            postnorm_rows(Y, layer == 0 ? P.in[0] : P.out, P.out, P.in[3] + layer * D, nullptr, U);
        }
    }
}
}

extern "C" void kernel_launch(void* const* d_in, const int* in_sizes, int n_in, void* d_out, int out_size, void* d_ws, size_t ws_size, hipStream_t stream) {
    static int grid_blocks = 0;
    if (grid_blocks == 0) {
        int dev = 0, cus = 0, per_cu = 0;
        hipGetDevice(&dev);
        hipDeviceGetAttribute(&cus, hipDeviceAttributeMultiprocessorCount, dev);
        if (hipFuncSetAttribute((const void*)mk::fwd_megakernel, hipFuncAttributeMaxDynamicSharedMemorySize, mk::LDS_BYTES) != hipSuccess) fprintf(stderr, "hipFuncSetAttribute failed\n");
        if (hipOccupancyMaxActiveBlocksPerMultiprocessor(&per_cu, (const void*)mk::fwd_megakernel, mk::NTHR, mk::LDS_BYTES) != hipSuccess || per_cu < 1) { fprintf(stderr, "occupancy query: %d\n", per_cu); per_cu = 1; }
        (void)hipGetLastError();
        grid_blocks = cus * 1;
        if (ws_size < mk::WS_END) fprintf(stderr, "workspace too small: %zu < %zu\n", ws_size, (size_t)mk::WS_END);
    }
    hipMemsetAsync((unsigned char*)d_ws + mk::OFF_CTL, 0, 4096, stream);
    mk::Params p{};
    for (int i = 0; i < 23; ++i) p.in[i] = (const float*)d_in[i];
    p.out = (float*)d_out; p.ws = (unsigned char*)d_ws;
    void* args[] = {&p};
    hipError_t e = hipLaunchCooperativeKernel((const void*)mk::fwd_megakernel, dim3(grid_blocks), dim3(mk::NTHR), args, mk::LDS_BYTES, stream);
    if (e != hipSuccess) fprintf(stderr, "cooperative launch failed: %s (grid %d)\n", hipGetErrorString(e), grid_blocks);
}
```

```cpp
#include <hip/hip_runtime.h>
#include <hip/hip_cooperative_groups.h>
#include <cstdio>
#include <cstdint>
namespace cg = cooperative_groups;
namespace pg8 {
#define PG8_LAS __attribute__((address_space(3)))
typedef unsigned short bf16_t;
typedef short bf16x8 __attribute__((ext_vector_type(8)));
typedef float f32x4 __attribute__((ext_vector_type(4)));
typedef unsigned u32x4 __attribute__((ext_vector_type(4)));
constexpr int BM = 256, BK = 64, HALF = 128, HTB = HALF * BK * 2  , STAGE_BYTES = 8 * HTB, NXCD = 8, WGM = 8;

__host__ __device__ __forceinline__ int lds_byte(int r, int c) { const int st = (r >> 4) * 2 + (c >> 5), rr = r & 15, cc = c & 31, ob = rr * 64 + cc * 2; return st * 1024 + (ob ^ (((ob >> 9) & 1) << 5)); }
__host__ __device__ __forceinline__ void stage_rc(int b, int& R, int& C) { const int st = b / 1024, sb = b % 1024, swz = sb ^ (((sb >> 9) & 1) << 5); R = (st >> 1) * 16 + swz / 64; C = (st & 1) * 32 + (swz % 64) / 2; }
__host__ __device__ __forceinline__ int perm32(int rho) { const int n = rho >> 4, i = rho & 15; return 8 * (i >> 2) + 4 * n + (i & 3); }

struct Unit { int pm, pn; };
struct Gemm { const bf16_t* A; const bf16_t* Bt; int M, N, K; };

struct StaticOrder {
    int nM, nN, nwg, G, c;
    __host__ __device__ void init(int M, int N, int G_, int c_) { nM = M / BM; nN = N / BM; nwg = nM * nN; G = G_; c = c_; }
    __host__ __device__ bool next(int i, Unit& u) const {
        const long L = (long)i * G + c; if (L >= nwg) return false;
        int wgid = (int)L; { const int q = nwg / NXCD, r = nwg % NXCD, xcd = wgid % NXCD, off = wgid / NXCD; wgid = (xcd < r ? xcd * (q + 1) : r * (q + 1) + (xcd - r) * q) + off; }
        const int nig = WGM * nN, gid = wgid / nig, fm = gid * WGM, gsz = (nM - fm) < WGM ? (nM - fm) : WGM;
        u.pm = fm + ((wgid % nig) % gsz); u.pn = (wgid % nig) / gsz; return true;
    }
    __device__ __forceinline__ void a_ready(const Unit&) const {}
    __device__ __forceinline__ void done(const Unit&) const {}
};
struct CountedOrder : StaticOrder {
    const unsigned* ready; unsigned need; unsigned* tmo;
    __device__ __forceinline__ void a_ready(const Unit& u) const {
        if (threadIdx.x < 64) {
            const unsigned long long t0 = __builtin_amdgcn_s_memrealtime(); unsigned polls = 0;
            while ((unsigned)__builtin_amdgcn_readfirstlane(__hip_atomic_load(ready + 64 * u.pm, __ATOMIC_RELAXED, __HIP_MEMORY_SCOPE_AGENT)) < need) {
                if ((++polls & 255u) == 0u && __builtin_amdgcn_readfirstlane(__hip_atomic_load(tmo, __ATOMIC_RELAXED, __HIP_MEMORY_SCOPE_AGENT)) != 0u) break;
                if (__builtin_amdgcn_s_memrealtime() - t0 > 2000000ull) {
                    if (threadIdx.x == 0) { unsigned expect = 0u; __hip_atomic_compare_exchange_strong(tmo + 1, &expect, 0x600u | (unsigned)(u.pm & 0xff), __ATOMIC_RELAXED, __ATOMIC_RELAXED, __HIP_MEMORY_SCOPE_AGENT); __hip_atomic_store(tmo, 1u, __ATOMIC_RELAXED, __HIP_MEMORY_SCOPE_AGENT); }
                    break; }
                __builtin_amdgcn_s_sleep(2); }
            __builtin_amdgcn_fence(__ATOMIC_ACQUIRE, "agent");
            asm volatile("s_waitcnt vmcnt(0)" ::: "memory");
        }
#if !defined(BROKEN_HOOK_NO_BARRIER)
        asm volatile("" ::: "memory"); __builtin_amdgcn_s_barrier(); asm volatile("" ::: "memory");
#endif
    }
};

typedef __bf16 bf16x2_t __attribute__((ext_vector_type(2)));
typedef float f32x2c __attribute__((ext_vector_type(2)));
__device__ __forceinline__ unsigned cvt_pk_bf16(float lo, float hi) { f32x2c v = {lo, hi}; bf16x2_t b = __builtin_convertvector(v, bf16x2_t); return __builtin_bit_cast(unsigned, b); }
typedef float f32x2 __attribute__((ext_vector_type(2)));
__device__ __forceinline__ f32x2 gelu_pk(f32x2 v) {
    const f32x2 av = __builtin_elementwise_abs(v), d = av * 0.2316418882f + 1.0f;
    f32x2 t; t.x = __builtin_amdgcn_rcpf(d.x); t.y = __builtin_amdgcn_rcpf(d.y);
    f32x2 q = t * 0.5307027145f + (-0.7265760135f); q = q * t + 0.7107068705f; q = q * t + (-0.142248368f); q = q * t + 0.127414796f; q = q * t;
    const f32x2 s = (v * v) * (-0.72134752044f);
    f32x2 e; e.x = __builtin_amdgcn_exp2f(s.x); e.y = __builtin_amdgcn_exp2f(s.y);
    const f32x2 m = v * (q * e), r = v - m;
    f32x2 o; o.x = v.x < 0.f ? m.x : r.x; o.y = v.y < 0.f ? m.y : r.y; return o;
}

struct EpiF32 {
    static constexpr bool PERM = false, AFTER_DRAIN = false;
    float* C; int ldc; const float* bias;
    __device__ __forceinline__ void operator()(const f32x4 (&acc)[2][2][4][2], const Unit& u, int wr, int wc, int fr, int fq) const {
        const int row0 = u.pm * BM + wr * 64 + fr, col0 = u.pn * BM + wc * 32 + 4 * fq;
        f32x4 bv[2][2];
#pragma unroll
        for (int bj = 0; bj < 2; ++bj)
#pragma unroll
            for (int n = 0; n < 2; ++n) bv[bj][n] = bias ? *(const f32x4*)(bias + col0 + bj * HALF + n * 16) : (f32x4){0.f, 0.f, 0.f, 0.f};
#pragma unroll
        for (int ai = 0; ai < 2; ++ai)
#pragma unroll
            for (int m = 0; m < 4; ++m) { float* rowp = C + (size_t)(row0 + ai * HALF + m * 16) * ldc + col0;
#pragma unroll
                for (int bj = 0; bj < 2; ++bj)
#pragma unroll
                    for (int n = 0; n < 2; ++n) *(f32x4*)(rowp + bj * HALF + n * 16) = acc[ai][bj][m][n] + bv[bj][n]; }
    }
};
template <int ACT  > struct EpiBf16 {
    static constexpr bool PERM = true, AFTER_DRAIN = false;
    bf16_t* O; int ldc; const float* bias; int split_cols; size_t split_stride;
    __device__ __forceinline__ void operator()(const f32x4 (&acc)[2][2][4][2], const Unit& u, int wr, int wc, int fr, int fq) const {
        const int row0 = u.pm * BM + wr * 64 + fr; int colt = u.pn * BM; bf16_t* base = O;
        if (split_cols) { const int t = colt / split_cols; base += (size_t)t * split_stride; colt -= t * split_cols; }
        const int col0 = colt + wc * 32 + 8 * fq, bcol0 = u.pn * BM + wc * 32 + 8 * fq;
        f32x4 bv[2][2];
#pragma unroll
        for (int bj = 0; bj < 2; ++bj)
#pragma unroll
            for (int n = 0; n < 2; ++n) bv[bj][n] = bias ? *(const f32x4*)(bias + bcol0 + bj * HALF + 4 * n) : (f32x4){0.f, 0.f, 0.f, 0.f};
#pragma unroll
        for (int ai = 0; ai < 2; ++ai)
#pragma unroll
            for (int m = 0; m < 4; ++m) { bf16_t* rowp = base + (size_t)(row0 + ai * HALF + m * 16) * ldc + col0;
#pragma unroll
                for (int bj = 0; bj < 2; ++bj) { f32x4 v0 = acc[ai][bj][m][0] + bv[bj][0], v1 = acc[ai][bj][m][1] + bv[bj][1];
                    if (ACT == 1) { f32x2 a = gelu_pk((f32x2){v0[0], v0[1]}), b = gelu_pk((f32x2){v0[2], v0[3]}), c = gelu_pk((f32x2){v1[0], v1[1]}), d = gelu_pk((f32x2){v1[2], v1[3]});
                        v0 = (f32x4){a.x, a.y, b.x, b.y}; v1 = (f32x4){c.x, c.y, d.x, d.y}; }
                    if (ACT == 2) {
#pragma unroll
                        for (int j = 0; j < 4; ++j) { v0[j] = 0.5f * v0[j] * (1.0f + erff(v0[j] * 0.70710678f)); v1[j] = 0.5f * v1[j] * (1.0f + erff(v1[j] * 0.70710678f)); } }
                    u32x4 w; w.x = cvt_pk_bf16(v0[0], v0[1]); w.y = cvt_pk_bf16(v0[2], v0[3]); w.z = cvt_pk_bf16(v1[0], v1[1]); w.w = cvt_pk_bf16(v1[2], v1[3]);
                    *(u32x4*)(rowp + bj * HALF) = w; } }
    }
};


template <class Epi, class Sched, bool STAMP = false>
__device__ __forceinline__ void gemm_phase(PG8_LAS unsigned char* lds, const Gemm g, const Sched& S, const Epi& E, unsigned long long* stamps) {
    int tid_o = threadIdx.x; asm volatile("" : "+v"(tid_o));
    const int tid = tid_o, wid = __builtin_amdgcn_readfirstlane(tid >> 6), lane = tid & 63, wr = wid >> 2, wc = wid & 3, fr = lane & 15, fq = lane >> 4;
    const int K = g.K, nt = K / BK;
    int ts_lo = 0, ts_hi = 0, nts = 0; const unsigned long long rt_entry = STAMP ? (unsigned long long)wall_clock64() : 0ull;
#define PG8_STAMP() do { if (STAMP && wid == 0 && nts < 64) { const unsigned long long _c = (unsigned long long)clock64(); \
        ts_lo = (lane == nts) ? (int)(unsigned)_c : ts_lo; ts_hi = (lane == nts) ? (int)(unsigned)(_c >> 32) : ts_hi; ++nts; } } while (0)
    PG8_STAMP();
    unsigned voffA[2], voffB[2];
#pragma unroll
    for (int i = 0; i < 2; ++i) { int R, C; stage_rc(tid * 16 + i * 8192, R, C); const int Rb = Epi::PERM ? ((R & ~31) + perm32(R & 31)) : R;
        voffA[i] = (unsigned)(R * K + C) * 2u; voffB[i] = (unsigned)(Rb * K + C) * 2u; }
    const size_t kstep = (size_t)(BK * 2);
    const size_t hstep = (size_t)HALF * K * 2;
    const size_t tstep = 2 * hstep;
    const unsigned ldsw = (unsigned)wid * 1024u;
    const int aoff = lds_byte(wr * 64 + fr, fq * 8), boff = lds_byte(wc * 32 + fr, fq * 8);
#define PG8_SA(b, h) (((b) * 2 + (h)) * HTB)
#define PG8_SB(b, h) ((4 + (b) * 2 + (h)) * HTB)
#define PG8_STAGE(bufoff, gbase, voff) do { _Pragma("unroll") for (int _i = 0; _i < 2; ++_i) \
        __builtin_amdgcn_global_load_lds((const unsigned*)((const char*)(gbase) + (voff)[_i]), (PG8_LAS unsigned*)(lds + (bufoff) + ldsw + _i * 8192), 16, 0, 0); } while (0)
#define PG8_LDA(dst, b, h) do { _Pragma("unroll") for (int m = 0; m < 4; ++m) _Pragma("unroll") for (int k = 0; k < 2; ++k) dst[m][k] = *(const PG8_LAS bf16x8*)(lds + PG8_SA(b, h) + aoff + m * 2048 + k * 1024); } while (0)
#define PG8_LDB(dst, b, h) do { _Pragma("unroll") for (int n = 0; n < 2; ++n) _Pragma("unroll") for (int k = 0; k < 2; ++k) dst[n][k] = *(const PG8_LAS bf16x8*)(lds + PG8_SB(b, h) + boff + n * 2048 + k * 1024); } while (0)
#define PG8_MMA(ai, bj, At, Bt) do { __builtin_amdgcn_s_setprio(1); _Pragma("unroll") for (int m = 0; m < 4; ++m) _Pragma("unroll") for (int n = 0; n < 2; ++n) _Pragma("unroll") for (int k = 0; k < 2; ++k) \
        acc[ai][bj][m][n] = __builtin_amdgcn_mfma_f32_16x16x32_bf16(Bt[n][k], At[m][k], acc[ai][bj][m][n], 0, 0, 0); __builtin_amdgcn_s_setprio(0); } while (0)
#define PG8_WAIT_V(n) asm volatile("s_waitcnt vmcnt(" #n ")" ::: "memory")
#define PG8_WAIT_L(n) asm volatile("s_waitcnt lgkmcnt(" #n ")" ::: "memory")
#define PG8_BAR __builtin_amdgcn_s_barrier()
#define PG8_SCHED __builtin_amdgcn_sched_barrier(0)
    Unit cur, nxt; int ui = 0;
    if (!S.next(0, cur)) return;
    f32x4 acc[2][2][4][2];
#pragma unroll
    for (int a = 0; a < 2; ++a)
#pragma unroll
        for (int b = 0; b < 2; ++b)
#pragma unroll
            for (int m = 0; m < 4; ++m)
#pragma unroll
                for (int n = 0; n < 2; ++n) acc[a][b][m][n] = (f32x4){0.f, 0.f, 0.f, 0.f};
    bf16x8 At[4][2], B0[2][2], B1[2][2];
    const char* cA = (const char*)g.A + (size_t)cur.pm * tstep; const char* cB = (const char*)g.Bt + (size_t)cur.pn * tstep;
    S.a_ready(cur);
    PG8_STAGE(PG8_SB(0, 0), cB, voffB); PG8_STAGE(PG8_SA(0, 0), cA, voffA); PG8_STAGE(PG8_SB(0, 1), cB + hstep, voffB); PG8_STAGE(PG8_SA(0, 1), cA + hstep, voffA);
    if (wr == 1) PG8_BAR;
    PG8_WAIT_V(4); PG8_BAR;
    PG8_STAGE(PG8_SB(1, 0), cB + kstep, voffB); PG8_STAGE(PG8_SA(1, 0), cA + kstep, voffA); PG8_STAGE(PG8_SB(1, 1), cB + hstep + kstep, voffB);
    PG8_WAIT_V(6); PG8_BAR;
    PG8_STAMP();
    for (;;) {
        const bool has_next = S.next(ui + 1, nxt);
        const char* nA = has_next ? (const char*)g.A + (size_t)nxt.pm * tstep : cA; const char* nB = has_next ? (const char*)g.Bt + (size_t)nxt.pn * tstep : cB;
        for (int t = 0; t < nt; t += 2) {
            const bool last = (t == nt - 2);
            const char* a1 = cA + (size_t)(t + 1) * kstep;
            const char* a2 = last ? nA : cA + (size_t)(t + 2) * kstep; const char* b2 = last ? nB : cB + (size_t)(t + 2) * kstep;
            const char* a3 = a2 + kstep; const char* b3 = b2 + kstep;
            if (last && has_next) S.a_ready(nxt);
            PG8_LDB(B0, 0, 0); PG8_SCHED; PG8_LDA(At, 0, 0); PG8_STAGE(PG8_SA(1, 1), a1 + hstep, voffA);
            PG8_WAIT_L(8); PG8_BAR; PG8_WAIT_L(0); PG8_MMA(0, 0, At, B0); PG8_BAR; PG8_SCHED;
            PG8_LDB(B1, 0, 1); PG8_STAGE(PG8_SB(0, 0), b2, voffB);
            PG8_BAR; PG8_WAIT_L(0); PG8_MMA(0, 1, At, B1); PG8_BAR;
            PG8_LDA(At, 0, 1); PG8_STAGE(PG8_SA(0, 0), a2, voffA);
            PG8_BAR; PG8_WAIT_L(0); PG8_MMA(1, 0, At, B0); PG8_BAR; PG8_SCHED;
            PG8_STAGE(PG8_SB(0, 1), b2 + hstep, voffB);
            PG8_WAIT_V(6); PG8_BAR; PG8_MMA(1, 1, At, B1); PG8_BAR;
            PG8_LDB(B0, 1, 0); PG8_SCHED; PG8_LDA(At, 1, 0); PG8_STAGE(PG8_SA(0, 1), a2 + hstep, voffA);
            PG8_WAIT_L(8); PG8_BAR; PG8_WAIT_L(0); PG8_MMA(0, 0, At, B0); PG8_BAR; PG8_SCHED;
            PG8_LDB(B1, 1, 1); PG8_STAGE(PG8_SB(1, 0), b3, voffB);
            PG8_BAR; PG8_WAIT_L(0); PG8_MMA(0, 1, At, B1); PG8_BAR;
            PG8_LDA(At, 1, 1); PG8_STAGE(PG8_SA(1, 0), a3, voffA);
            PG8_BAR; PG8_WAIT_L(0); PG8_MMA(1, 0, At, B0); PG8_BAR; PG8_SCHED;
            PG8_STAGE(PG8_SB(1, 1), b3 + hstep, voffB);
            PG8_WAIT_V(6); PG8_BAR; PG8_MMA(1, 1, At, B1); PG8_BAR;
        }
        PG8_STAMP();
        if constexpr (!Epi::AFTER_DRAIN) { E(acc, cur, wr, wc, fr, fq); S.done(cur); }
        PG8_STAMP();
        if (!has_next) break;
#pragma unroll
        for (int a = 0; a < 2; ++a)
#pragma unroll
            for (int b = 0; b < 2; ++b)
#pragma unroll
                for (int m = 0; m < 4; ++m)
#pragma unroll
                    for (int n = 0; n < 2; ++n) acc[a][b][m][n] = (f32x4){0.f, 0.f, 0.f, 0.f};
        cur = nxt; cA = nA; cB = nB; ++ui;
    }
    PG8_WAIT_V(0);
    if (wr == 0) PG8_BAR;
    PG8_BAR;
    if constexpr (Epi::AFTER_DRAIN) { E.fused(acc, cur, wr, wc, fr, fq, lds, wid, lane); S.done(cur); }
    PG8_STAMP();
    if (STAMP && wid == 0) { stamps[lane] = lane < nts ? (((unsigned long long)(unsigned)ts_hi << 32) | (unsigned)ts_lo) : 0ull;
        if (lane == 62) stamps[62] = rt_entry; if (lane == 63) stamps[63] = (unsigned long long)wall_clock64(); }
#undef PG8_STAMP
#undef PG8_SA
#undef PG8_SB
#undef PG8_STAGE
#undef PG8_LDA
#undef PG8_LDB
#undef PG8_MMA
#undef PG8_WAIT_V
#undef PG8_WAIT_L
#undef PG8_BAR
#undef PG8_SCHED
}
}

namespace mk {
using pg8::bf16_t; using pg8::bf16x8; using pg8::f32x4; using pg8::u32x4;
typedef short s16x4 __attribute__((ext_vector_type(4)));
typedef unsigned u32x2 __attribute__((ext_vector_type(2)));

constexpr int D = 2048, NB = 8, S = 2048, M = NB * S, BW = 1024, MIXW = 3072, PW = 13568, DEPTH = 2;
constexpr int C_AQ = 0, C_AK = 1024, C_AV = 2048, C_AG = 3072, C_B = 4096, C_BG = 7424, C_CQ = 8448, C_CI = 9472, C_CF = 10496, C_CG = 12544;
constexpr int NTHR = 512;
constexpr int LDS_BYTES = 147456;
constexpr float LOG2E = 1.4426950408889634f;

constexpr size_t OFF_CTL = 0;
constexpr size_t OFF_WIN = 4096;
constexpr size_t OFF_WOUT = OFF_WIN + (size_t)PW * D * 2;
constexpr size_t OFF_U = OFF_WOUT + (size_t)D * MIXW * 2;
constexpr size_t OFF_PROJ = OFF_U + (size_t)M * D * 2;
constexpr size_t OFF_MIXED = OFF_PROJ + (size_t)M * PW * 2;
constexpr size_t OFF_OC = OFF_MIXED + (size_t)M * MIXW * 2;
constexpr size_t OFF_AO = OFF_OC + (size_t)2 * M * BW * 2;
constexpr size_t OFF_BON = OFF_AO + (size_t)2 * M * BW * 2;
constexpr size_t WS_END = OFF_BON + (size_t)2 * M * 16 * 4;

struct Params { const float* in[23]; float* out; unsigned char* ws; };
__device__ __forceinline__ int opaque_tid() { int t = threadIdx.x; asm volatile("" : "+v"(t)); return t; }
__device__ __forceinline__ int opaque_s(int t) { asm volatile("" : "+s"(t)); return t; }
__device__ __forceinline__ int opaque_bid() { int t = blockIdx.x; asm volatile("" : "+s"(t)); return t; }


__device__ __forceinline__ float bf2f(bf16_t v) { return __uint_as_float(((unsigned)v) << 16); }
__device__ __forceinline__ bf16_t f2bf(float f) { unsigned u = __float_as_uint(f); u += 0x7FFFu + ((u >> 16) & 1u); return (bf16_t)(u >> 16); }
typedef __bf16 bf16x2_t __attribute__((ext_vector_type(2)));
typedef float f32x2c __attribute__((ext_vector_type(2)));
__device__ __forceinline__ unsigned pk2(float lo, float hi) { f32x2c v = {lo, hi}; bf16x2_t b = __builtin_convertvector(v, bf16x2_t); return __builtin_bit_cast(unsigned, b); }
__device__ __forceinline__ float wave_sum(float v) {
#pragma unroll
    for (int o = 1; o < 64; o <<= 1) v += __shfl_xor(v, o);
    return v;
}
__device__ __forceinline__ float sigmoidf_(float x) { return 1.f / (1.f + __expf(-x)); }
__device__ __forceinline__ float siluf_(float x) { return x / (1.f + __expf(-x)); }
__device__ __forceinline__ float dpp_xor1(float v) { return __int_as_float(__builtin_amdgcn_mov_dpp(__float_as_int(v), 0xB1, 0xF, 0xF, true)); }
__device__ __forceinline__ float dpp_xor2(float v) { return __int_as_float(__builtin_amdgcn_mov_dpp(__float_as_int(v), 0x4E, 0xF, 0xF, true)); }
__device__ __forceinline__ float dpp_hmir(float v) { return __int_as_float(__builtin_amdgcn_mov_dpp(__float_as_int(v), 0x141, 0xF, 0xF, true)); }
__device__ __forceinline__ float dpp_mir(float v) { return __int_as_float(__builtin_amdgcn_mov_dpp(__float_as_int(v), 0x140, 0xF, 0xF, true)); }
__device__ __forceinline__ float wave_sum_fast(float v) {
    v += dpp_xor1(v); v += dpp_xor2(v); v += dpp_hmir(v); v += dpp_mir(v);
    v += __shfl_xor(v, 16); v += __shfl_xor(v, 32);
    return v;
}
__device__ __forceinline__ float fast_tanh(float x) { return 1.f - 2.f * __builtin_amdgcn_rcpf(1.f + __expf(2.f * x)); }
__device__ __forceinline__ float fast_sigmoid(float x) { return __builtin_amdgcn_rcpf(1.f + __expf(-x)); }
typedef float f32x2 __attribute__((ext_vector_type(2)));
#define MFMA16(a, b, c) __builtin_amdgcn_mfma_f32_16x16x32_bf16((a), (b), (c), 0, 0, 0)
__device__ __forceinline__ bf16x8 join8(s16x4 lo, s16x4 hi) { return __builtin_shufflevector(lo, hi, 0, 1, 2, 3, 4, 5, 6, 7); }
__device__ __forceinline__ bf16x8 pack8(f32x4 a, f32x4 b) {
    u32x4 w; w.x = pk2(a[0], a[1]); w.y = pk2(a[2], a[3]); w.z = pk2(b[0], b[1]); w.w = pk2(b[2], b[3]);
    return __builtin_bit_cast(bf16x8, w);
}

__device__ __forceinline__ void transpose_tile(const float* __restrict__ W, int K, int N, bf16_t* __restrict__ WT, float* tile, int it) {
    const int tid = opaque_tid();
    const int ntn = N >> 6; const int kb = it / ntn, nbk = it - kb * ntn; const int k0 = kb * 64, n0 = nbk * 64;
#pragma unroll
    for (int rr = 0; rr < 2; ++rr) { const int idx = tid + rr * 512; const int kk = idx >> 4, n4 = (idx & 15) * 4;
        const float4 v = *(const float4*)(W + (size_t)(k0 + kk) * N + n0 + n4);
        float* tp = tile + kk * 65 + n4; tp[0] = v.x; tp[1] = v.y; tp[2] = v.z; tp[3] = v.w; }
    __syncthreads();
    { const int n = tid >> 3, kc = (tid & 7) * 8; const float* tp = tile + kc * 65 + n;
      u32x4 o; o.x = pk2(tp[0], tp[65]); o.y = pk2(tp[2 * 65], tp[3 * 65]); o.z = pk2(tp[4 * 65], tp[5 * 65]); o.w = pk2(tp[6 * 65], tp[7 * 65]);
      *(u32x4*)(WT + (size_t)(n0 + n) * K + k0 + kc) = o; }
    __syncthreads();
}
__device__ __forceinline__ void convert_weights(const Params& P, int layer, unsigned char* smem) {
    float* tile = (float*)smem;
    const float* win = P.in[4] + (size_t)layer * D * PW; const float* wout = P.in[5] + (size_t)layer * MIXW * D;
    bf16_t* WinT = (bf16_t*)(P.ws + OFF_WIN); bf16_t* WoutT = (bf16_t*)(P.ws + OFF_WOUT);
    constexpr int T_IN = (D / 64) * (PW / 64), T_OUT = (MIXW / 64) * (D / 64);
    for (int it = opaque_bid(); it < T_IN + T_OUT; it += gridDim.x) {
        if (it < T_IN) transpose_tile(win, D, PW, WinT, tile, it);
        else transpose_tile(wout, MIXW, D, WoutT, tile, it - T_IN);
    }
}
__device__ __forceinline__ void prenorm_rows(const float* __restrict__ x, const float* __restrict__ g, bf16_t* __restrict__ U) {
    const int tid_ = opaque_tid(); const int lane = tid_ & 63, gw = opaque_bid() * 8 + (tid_ >> 6), ngw = gridDim.x * 8;
    for (int row = gw; row < M; row += ngw) {
        const float4* xr = (const float4*)(x + (size_t)row * D) + lane;
        float4 v[8]; float ss = 0.f;
#pragma unroll
        for (int j = 0; j < 8; ++j) { v[j] = xr[64 * j]; ss += v[j].x * v[j].x + v[j].y * v[j].y + v[j].z * v[j].z + v[j].w * v[j].w; }
        const float rstd = rsqrtf(wave_sum(ss) * (1.f / D) + 1e-6f);
        u32x2* o = (u32x2*)(U + (size_t)row * D) + lane;
#pragma unroll
        for (int j = 0; j < 8; ++j) { const float4 gg = ((const float4*)g)[64 * j + lane];
            u32x2 w; w.x = pk2(v[j].x * rstd * gg.x, v[j].y * rstd * gg.y); w.y = pk2(v[j].z * rstd * gg.z, v[j].w * rstd * gg.w); o[64 * j] = w; }
    }
}
__device__ __forceinline__ void postnorm_rows(const float* __restrict__ y, const float* xin, float* xout, const float* __restrict__ gpost, const float* __restrict__ gpre, bf16_t* __restrict__ U) {
    const int tid_ = opaque_tid(); const int lane = tid_ & 63, gw = opaque_bid() * 8 + (tid_ >> 6), ngw = gridDim.x * 8;
    for (int row = gw; row < M; row += ngw) {
        const float4* yr = (const float4*)(y + (size_t)row * D) + lane;
        const float4* xr = (const float4*)(xin + (size_t)row * D) + lane;
        float4* xo = (float4*)(xout + (size_t)row * D) + lane;
        float4 v[8]; float ss = 0.f;
#pragma unroll
        for (int j = 0; j < 8; ++j) { v[j] = yr[64 * j]; ss += v[j].x * v[j].x + v[j].y * v[j].y + v[j].z * v[j].z + v[j].w * v[j].w; }
        const float rstd = rsqrtf(wave_sum(ss) * (1.f / D) + 1e-6f);
        float s2 = 0.f;
#pragma unroll
        for (int j = 0; j < 8; ++j) { const float4 gg = ((const float4*)gpost)[64 * j + lane]; const float4 xv = xr[64 * j];
            v[j].x = xv.x + v[j].x * rstd * gg.x; v[j].y = xv.y + v[j].y * rstd * gg.y; v[j].z = xv.z + v[j].z * rstd * gg.z; v[j].w = xv.w + v[j].w * rstd * gg.w;
            xo[64 * j] = v[j]; s2 += v[j].x * v[j].x + v[j].y * v[j].y + v[j].z * v[j].z + v[j].w * v[j].w; }
        if (gpre) {
            const float r2 = rsqrtf(wave_sum(s2) * (1.f / D) + 1e-6f);
            u32x2* o = (u32x2*)(U + (size_t)row * D) + lane;
#pragma unroll
            for (int j = 0; j < 8; ++j) { const float4 gg = ((const float4*)gpre)[64 * j + lane];
                u32x2 w; w.x = pk2(v[j].x * r2 * gg.x, v[j].y * r2 * gg.y); w.y = pk2(v[j].z * r2 * gg.z, v[j].w * r2 * gg.w); o[64 * j] = w; }
        }
    }
}

#define RWKV_LOAD_RAW(cc) do { const int n0_ = (cc) * TCH + pw * TPW; const int T0_ = d ? (S - 1 - n0_) : n0_; const int dstep_ = d ? -1 : 1; \
    _Pragma("unroll") for (int j = 0; j < TPW + 2; ++j) { const int tj = T0_ + (j - 1) * dstep_; const bool ok = (tj >= 0) && (tj < S); \
        const bf16_t* row = proj + ((size_t)b * S + (ok ? tj : T0_)) * PW + C_B; \
        raw[j][0] = row[cr]; raw[j][1] = row[ck]; raw[j][2] = row[cv]; raw[j][3] = row[cw]; raw[j][4] = row[ca]; \
        if (!ok) { raw[j][0] = 0; raw[j][1] = 0; raw[j][2] = 0; raw[j][3] = 0; raw[j][4] = 0; } } } while (0)
__device__ __forceinline__ void rwkv_phase(const Params& P, int layer, unsigned char* smem) {
    constexpr int TCH = 16, TPW = 4, NCH = S / TCH;
    float* VEC = (float*)smem;
    bf16_t* UPT = (bf16_t*)(smem + 49152);
    unsigned char* pbase = smem + 49152 + 18432;
    unsigned char* obase = smem + 49152 + 18432 + 12800;
    unsigned char* nbase = obase + 2 * 18176;
    const int tid = opaque_tid(), wid = __builtin_amdgcn_readfirstlane(tid >> 6), lane = tid & 63, r16 = lane & 15, quad = lane >> 4;
    const bf16_t* proj = (const bf16_t*)(P.ws + OFF_PROJ);
    bf16_t* YB = (bf16_t*)(P.ws + OFF_U);
    float* BON = (float*)(P.ws + OFF_BON);
    const float* mu = P.in[11] + (size_t)layer * 2 * 3328;
    for (int chain = opaque_bid(); chain < 256; chain += gridDim.x) {
        const int d = chain >> 7, b = (chain >> 4) & 7, h = chain & 15;
        __syncthreads();
        { const float* wup = P.in[13] + ((size_t)(layer * 2 + d) * 64) * 1024 + h * 64; const float* aup = P.in[15] + ((size_t)(layer * 2 + d) * 64) * 1024 + h * 64;
#pragma unroll
          for (int it = 0; it < 16; ++it) { const int e = tid + 512 * it; const int mat = e >> 12, lora = (e >> 6) & 63, ch = e & 63;
              const float v = (mat ? aup : wup)[(size_t)lora * 1024 + ch]; UPT[mat * 4608 + ch * 72 + lora] = f2bf(v); } }
        __syncthreads();
        if (wid < 4) {
            const int cw = wid;
            float* Nm = (float*)(nbase + cw * 1024);
            const int jl = lane & 15, tg = lane >> 4, jcol = cw * 16 + jl;
            const float rkc = P.in[18][(size_t)layer * 1024 + h * 64 + jcol];
            const f32x4 z4 = {0.f, 0.f, 0.f, 0.f};
            f32x4 ST[4];
#pragma unroll
            for (int mt = 0; mt < 4; ++mt) ST[mt] = z4;
            asm volatile("s_waitcnt lgkmcnt(0)" ::: "memory"); __builtin_amdgcn_s_barrier(); asm volatile("" ::: "memory");
            asm volatile("s_waitcnt lgkmcnt(0)" ::: "memory"); __builtin_amdgcn_s_barrier(); asm volatile("" ::: "memory");
            for (int c = 0; c < NCH; ++c) {
                const float* vb = VEC + (c & 1) * (TCH * 384);
                unsigned char* ob = obase + (c & 1) * 18176;
                bf16_t* Pm = (bf16_t*)ob; bf16_t* Rm = (bf16_t*)(ob + 2304); bf16_t* Qm = (bf16_t*)(ob + 4608); bf16_t* Mm = (bf16_t*)(ob + 6912);
                bf16_t* QT = (bf16_t*)(ob + 9216); bf16_t* MT = (bf16_t*)(ob + 12288); float* GT = (float*)(ob + 15360); bf16_t* Bm = (bf16_t*)(ob + 15872);
                {
                    float nk[4], ww[4], ka[4], km[4], rr[4];
#pragma unroll
                    for (int u = 0; u < 4; ++u) { const float* vt = vb + (4 * tg + u) * 384 + jcol; nk[u] = vt[0]; ww[u] = vt[64]; ka[u] = vt[128]; km[u] = vt[192]; rr[u] = vt[256]; }
                    float gl[4];
                    gl[0] = ww[0]; gl[1] = gl[0] * ww[1]; gl[2] = gl[1] * ww[2]; gl[3] = gl[2] * ww[3];
                    const float G0 = __shfl(gl[3], jl), G1 = __shfl(gl[3], jl + 16), G2 = __shfl(gl[3], jl + 32);
                    const float pre = (tg == 0) ? 1.f : (tg == 1) ? G0 : (tg == 2) ? G0 * G1 : (G0 * G1) * G2;
                    float pv[4], rv[4], qv[4], mv[4];
#pragma unroll
                    for (int u = 0; u < 4; ++u) {
                        const float gprev = (u == 0) ? pre : pre * gl[u - 1], gcur = pre * gl[u];
                        const float ig = __builtin_amdgcn_rcpf(gcur);
                        pv[u] = gprev * nk[u]; qv[u] = ka[u] * ig; mv[u] = km[u] * ig; rv[u] = gcur * rr[u];
                    }
                    const unsigned wp0 = pk2(pv[0], pv[1]), wp1 = pk2(pv[2], pv[3]), wr0 = pk2(rv[0], rv[1]), wr1 = pk2(rv[2], rv[3]);
                    const unsigned wq0 = pk2(qv[0], qv[1]), wq1 = pk2(qv[2], qv[3]), wm0 = pk2(mv[0], mv[1]), wm1 = pk2(mv[2], mv[3]);
                    const int t0 = 4 * tg;
                    Pm[(t0) * 72 + jcol] = (bf16_t)(wp0 & 0xFFFFu); Pm[(t0 + 1) * 72 + jcol] = (bf16_t)(wp0 >> 16); Pm[(t0 + 2) * 72 + jcol] = (bf16_t)(wp1 & 0xFFFFu); Pm[(t0 + 3) * 72 + jcol] = (bf16_t)(wp1 >> 16);
                    Rm[(t0) * 72 + jcol] = (bf16_t)(wr0 & 0xFFFFu); Rm[(t0 + 1) * 72 + jcol] = (bf16_t)(wr0 >> 16); Rm[(t0 + 2) * 72 + jcol] = (bf16_t)(wr1 & 0xFFFFu); Rm[(t0 + 3) * 72 + jcol] = (bf16_t)(wr1 >> 16);
                    Qm[(t0) * 72 + jcol] = (bf16_t)(wq0 & 0xFFFFu); Qm[(t0 + 1) * 72 + jcol] = (bf16_t)(wq0 >> 16); Qm[(t0 + 2) * 72 + jcol] = (bf16_t)(wq1 & 0xFFFFu); Qm[(t0 + 3) * 72 + jcol] = (bf16_t)(wq1 >> 16);
                    Mm[(t0) * 72 + jcol] = (bf16_t)(wm0 & 0xFFFFu); Mm[(t0 + 1) * 72 + jcol] = (bf16_t)(wm0 >> 16); Mm[(t0 + 2) * 72 + jcol] = (bf16_t)(wm1 & 0xFFFFu); Mm[(t0 + 3) * 72 + jcol] = (bf16_t)(wm1 >> 16);
                    u32x2 tq; tq.x = wq0; tq.y = wq1; *(u32x2*)(QT + jcol * 24 + t0) = tq;
                    u32x2 tm; tm.x = wm0; tm.y = wm1; *(u32x2*)(MT + jcol * 24 + t0) = tm;
                    { const unsigned wb0 = pk2(rv[0] * rkc, rv[1] * rkc), wb1 = pk2(rv[2] * rkc, rv[3] * rkc);
                      Bm[(t0) * 72 + jcol] = (bf16_t)(wb0 & 0xFFFFu); Bm[(t0 + 1) * 72 + jcol] = (bf16_t)(wb0 >> 16); Bm[(t0 + 2) * 72 + jcol] = (bf16_t)(wb1 & 0xFFFFu); Bm[(t0 + 3) * 72 + jcol] = (bf16_t)(wb1 >> 16); }
                    if (tg == 3) GT[jcol] = pre * gl[3];
                }
                asm volatile("s_waitcnt lgkmcnt(0)" ::: "memory"); __builtin_amdgcn_s_barrier(); asm volatile("" ::: "memory");
                f32x4 Gqp = z4, Gmp = z4, Gqr = z4, Gmr = z4;
#pragma unroll
                for (int ks = 0; ks < 2; ++ks) {
                    const bf16x8 aQ = *(const bf16x8*)(Qm + r16 * 72 + ks * 32 + quad * 8), aM = *(const bf16x8*)(Mm + r16 * 72 + ks * 32 + quad * 8);
                    const bf16x8 bP = *(const bf16x8*)(Pm + r16 * 72 + ks * 32 + quad * 8), bR = *(const bf16x8*)(Rm + r16 * 72 + ks * 32 + quad * 8);
                    Gqp = MFMA16(aQ, bP, Gqp); Gmp = MFMA16(aM, bP, Gmp); Gqr = MFMA16(aQ, bR, Gqr); Gmr = MFMA16(aM, bR, Gmr);
                }
                if (cw == 0) {
                    f32x4 Gmb = z4;
#pragma unroll
                    for (int ks = 0; ks < 2; ++ks) Gmb = MFMA16(*(const bf16x8*)(Mm + r16 * 72 + ks * 32 + quad * 8), *(const bf16x8*)(Bm + r16 * 72 + ks * 32 + quad * 8), Gmb);
                    if (quad == (r16 >> 2)) {
                        const int rsel = r16 & 3;
                        const float bon = (rsel == 0) ? Gmb[0] : (rsel == 1) ? Gmb[1] : (rsel == 2) ? Gmb[2] : Gmb[3];
                        const int n = c * TCH + r16; const int t = d ? (S - 1 - n) : n;
                        BON[(((size_t)d * NB + b) * 16 + h) * S + t] = bon;
                    }
                }
#pragma unroll
                for (int rg = 0; rg < 4; ++rg) { const int sI = quad * 4 + rg;
                    if (sI >= r16) { Gqp[rg] = 0.f; Gmp[rg] = 0.f; }
                    if (sI > r16) { Gqr[rg] = 0.f; Gmr[rg] = 0.f; } }
                *(f32x4*)(Nm + r16 * 16 + quad * 4) = Gqp;
                f32x4 SA0 = z4, Y0 = z4;
#pragma unroll
                for (int ks = 0; ks < 2; ++ks) {
                    const bf16x8 sb = pack8(ST[2 * ks], ST[2 * ks + 1]);
                    const bf16_t* pp = Pm + r16 * 72 + ks * 32 + quad * 4; const bf16_t* rp = Rm + r16 * 72 + ks * 32 + quad * 4;
                    const bf16x8 pa = join8(*(const s16x4*)pp, *(const s16x4*)(pp + 16)), ra = join8(*(const s16x4*)rp, *(const s16x4*)(rp + 16));
                    SA0 = MFMA16(pa, sb, SA0); Y0 = MFMA16(ra, sb, Y0);
                }
                f32x4 Vv;
#pragma unroll
                for (int jj = 0; jj < 4; ++jj) Vv[jj] = vb[(quad * 4 + jj) * 384 + 320 + cw * 16 + r16];
                const f32x4 Cc = MFMA16(pack8(Gmp, z4), pack8(Vv, z4), SA0);
                float x[16];
#pragma unroll
                for (int c2 = 0; c2 < 16; ++c2) x[c2] = (c2 == r16) ? 1.f : 0.f;
#pragma unroll
                for (int sI = 15; sI >= 1; --sI) {
#pragma unroll
                    for (int c2 = 0; c2 < sI; ++c2) x[c2] += x[sI] * Nm[sI * 16 + c2];
                }
                f32x4 xs;
#pragma unroll
                for (int jj = 0; jj < 4; ++jj) xs[jj] = (quad == 0) ? x[jj] : (quad == 1) ? x[4 + jj] : (quad == 2) ? x[8 + jj] : x[12 + jj];
                const f32x4 SAc = MFMA16(pack8(xs, z4), pack8(Cc, z4), z4);
                const bf16x8 Bsv = pack8(SAc, Vv);
                const f32x4 Yc = MFMA16(pack8(Gqr, Gmr), Bsv, Y0);
#pragma unroll
                for (int rg = 0; rg < 4; ++rg) { const int n = c * TCH + quad * 4 + rg; const int t = d ? (S - 1 - n) : n;
                    YB[((size_t)d * M + (size_t)b * S + t) * 1024 + h * 64 + cw * 16 + r16] = f2bf(Yc[rg]); }
#pragma unroll
                for (int mt = 0; mt < 4; ++mt) {
                    const bf16_t* qp = QT + (mt * 16 + r16) * 24 + quad * 4; const bf16_t* mp = MT + (mt * 16 + r16) * 24 + quad * 4;
                    const f32x4 acc = MFMA16(join8(*(const s16x4*)qp, *(const s16x4*)mp), Bsv, ST[mt]);
                    const f32x4 gt = *(const f32x4*)(GT + mt * 16 + quad * 4);
                    ST[mt] = acc * gt;
                }
                asm volatile("s_waitcnt lgkmcnt(0)" ::: "memory"); __builtin_amdgcn_s_barrier(); asm volatile("" ::: "memory");
            }
        } else {
            const int pw = wid - 4;
            bf16_t* Aw = (bf16_t*)(pbase + pw * 3200); bf16_t* Aa = Aw + TPW * 72; float* X = (float*)(pbase + pw * 3200 + 1152);
            const int cr = h * 64 + lane, ck = 1024 + h * 64 + lane, cv = 2048 + h * 64 + lane, cw = 3072 + d * 64 + lane, ca = 3200 + d * 64 + lane;
            const int mo0 = d ? 3328 : 0, mo1 = d ? 0 : 3328;
            const float mr0 = mu[mo0 + cr], mr1 = mu[mo1 + cr], mk0 = mu[mo0 + ck], mk1 = mu[mo1 + ck], mv0 = mu[mo0 + cv], mv1 = mu[mo1 + cv];
            const float mw0 = mu[mo0 + cw], mw1 = mu[mo1 + cw], ma0 = mu[mo0 + ca], ma1 = mu[mo1 + ca];
            const int chn = h * 64 + lane;
            const float w0v = P.in[12][(size_t)(layer * 2 + d) * 1024 + chn], a0v = P.in[14][(size_t)(layer * 2 + d) * 1024 + chn];
            const float kkw = P.in[16][(size_t)layer * 1024 + chn], kaw = P.in[17][(size_t)layer * 1024 + chn], rkw = P.in[18][(size_t)layer * 1024 + chn];
            unsigned short raw[TPW + 2][5];
            RWKV_LOAD_RAW(0);
            for (int c = 0; c < NCH + 1; ++c) {
                if (c < NCH) {
                    float* vb = VEC + (c & 1) * (TCH * 384);
                    float rr[TPW], kv[TPW], vv[TPW], kk[TPW];
                    {
                        float fr[TPW + 2][5];
#pragma unroll
                        for (int j = 0; j < TPW + 2; ++j)
#pragma unroll
                            for (int st = 0; st < 5; ++st) fr[j][st] = bf2f(raw[j][st]);
                        if (c + 1 < NCH) { RWKV_LOAD_RAW(c + 1); }
#pragma unroll
                        for (int i = 0; i < TPW; ++i) {
                            float p0, pa, pb;
                            p0 = fr[i + 1][0]; pa = fr[i][0]; pb = fr[i + 2][0]; rr[i] = p0 + mr0 * (pa - p0) + mr1 * (pb - p0);
                            p0 = fr[i + 1][1]; pa = fr[i][1]; pb = fr[i + 2][1]; kv[i] = p0 + mk0 * (pa - p0) + mk1 * (pb - p0);
                            p0 = fr[i + 1][2]; pa = fr[i][2]; pb = fr[i + 2][2]; vv[i] = p0 + mv0 * (pa - p0) + mv1 * (pb - p0);
                            p0 = fr[i + 1][3]; pa = fr[i][3]; pb = fr[i + 2][3]; const float wd = p0 + mw0 * (pa - p0) + mw1 * (pb - p0);
                            p0 = fr[i + 1][4]; pa = fr[i][4]; pb = fr[i + 2][4]; const float ad = p0 + ma0 * (pa - p0) + ma1 * (pb - p0);
                            Aw[i * 72 + lane] = f2bf(fast_tanh(wd)); Aa[i * 72 + lane] = f2bf(ad);
                            const float k2 = kv[i] * kkw; const float n2 = wave_sum_fast(k2 * k2);
                            kk[i] = k2 * __builtin_amdgcn_rsqf(fmaxf(n2, 1e-24f));
                        }
                    }
                    asm volatile("s_waitcnt lgkmcnt(0)" ::: "memory"); __builtin_amdgcn_s_barrier(); asm volatile("" ::: "memory");
#pragma unroll
                    for (int mat = 0; mat < 2; ++mat) {
                        const bf16_t* A = mat ? Aa : Aw;
                        const bf16x8 a0f = *(const bf16x8*)(A + (r16 & (TPW - 1)) * 72 + quad * 8), a1f = *(const bf16x8*)(A + (r16 & (TPW - 1)) * 72 + 32 + quad * 8);
#pragma unroll
                        for (int nt = 0; nt < 4; ++nt) {
                            const bf16_t* B = UPT + mat * 4608 + (nt * 16 + r16) * 72 + quad * 8;
                            f32x4 acc = {0.f, 0.f, 0.f, 0.f};
                            acc = MFMA16(a0f, *(const bf16x8*)B, acc); acc = MFMA16(a1f, *(const bf16x8*)(B + 32), acc);
                            if (quad == 0) {
#pragma unroll
                                for (int rg = 0; rg < 4; ++rg) X[mat * 256 + rg * 64 + nt * 16 + r16] = acc[rg];
                            }
                        }
                    }
                    asm volatile("s_waitcnt lgkmcnt(0)" ::: "memory");
#pragma unroll
                    for (int i = 0; i < TPW; ++i) {
                        const int s = pw * TPW + i; const int n = c * TCH + s; const int t = d ? (S - 1 - n) : n;
                        const float xw = X[i * 64 + lane] + w0v, xa = X[256 + i * 64 + lane] + a0v;
                        const float dec = __expf(-0.6065306597126334f * fast_sigmoid(xw)); const float av = fast_sigmoid(xa);
                        const float kmod = kv[i] * (1.f + (av - 1.f) * kaw); const float kka = kk[i] * av;
                        float* o = vb + s * 384 + lane;
                        o[0] = -kk[i]; o[64] = dec; o[128] = kka; o[192] = kmod; o[256] = rr[i]; o[320] = vv[i];
                    }
                }
                if (c == NCH) { asm volatile("s_waitcnt lgkmcnt(0)" ::: "memory"); __builtin_amdgcn_s_barrier(); asm volatile("" ::: "memory"); }
                asm volatile("s_waitcnt lgkmcnt(0)" ::: "memory"); __builtin_amdgcn_s_barrier(); asm volatile("" ::: "memory");
            }
        }
    }
}

__device__ __forceinline__ int swz40(int row, int s) { return row * 40 + ((((s >> 3) ^ (row >> 3)) & 3) << 3) + (s & 7); }
__device__ __forceinline__ void hgrn_phase(const Params& P, int layer, unsigned char* smem) {
    bf16_t* QE = (bf16_t*)smem; bf16_t* KE = (bf16_t*)(smem + 8704); bf16_t* KLT = (bf16_t*)(smem + 17408); bf16_t* VT = (bf16_t*)(smem + 27648);
    float* LF = (float*)(smem + 37888); float* EL = (float*)(smem + 54272);
    const int tid = opaque_tid(), wid = __builtin_amdgcn_readfirstlane(tid >> 6), lane = tid & 63, r16 = lane & 15, quad = lane >> 4;
    const bf16_t* proj = (const bf16_t*)(P.ws + OFF_PROJ);
    bf16_t* OC = (bf16_t*)(P.ws + OFF_OC);
    const int es = tid >> 4, ekc = (tid & 15) * 8;
    for (int chain = opaque_bid(); chain < 128; chain += gridDim.x) {
        const int d = chain >> 6, b = (chain >> 3) & 7, h = chain & 7;
        float lb[8];
#pragma unroll
        for (int j = 0; j < 8; ++j) lb[j] = 0.f;
        if (layer > 0) {
#pragma unroll
            for (int j = 0; j < 8; ++j) { const float l0 = P.in[21][(size_t)(d * 2 + 0) * 1024 + h * 128 + ekc + j], l1 = P.in[21][(size_t)(d * 2 + 1) * 1024 + h * 128 + ekc + j]; lb[j] = 1.f / (1.f + __expf(l0 - l1)); }
        }
        f32x4 Sacc[8];
#pragma unroll
        for (int mt = 0; mt < 8; ++mt) Sacc[mt] = (f32x4){0.f, 0.f, 0.f, 0.f};
        u32x4 zraw, qraw, vraw;
        { const int t = d ? (S - 1 - es) : es; const bf16_t* row = proj + ((size_t)b * S + t) * PW + h * 128 + ekc;
          zraw = *(const u32x4*)(row + C_CF + d * 1024); qraw = *(const u32x4*)(row + C_CQ); vraw = *(const u32x4*)(row + C_CI); }
        for (int c = 0; c < 64; ++c) {
            __syncthreads();
            { const int n = c * 32 + es; const int t = d ? (S - 1 - n) : n; const bf16_t* row = proj + ((size_t)b * S + t) * PW + h * 128 + ekc;
              zraw = *(const u32x4*)(row + C_CF + d * 1024); qraw = *(const u32x4*)(row + C_CQ); vraw = *(const u32x4*)(row + C_CI); }
            float kval[8];
            {
                float lf[8];
#pragma unroll
                for (int j = 0; j < 8; ++j) {
                    const unsigned wv = zraw[j >> 1]; const float z = (j & 1) ? __uint_as_float(wv & 0xFFFF0000u) : __uint_as_float(wv << 16);
                    const float e = __expf(-fabsf(z));
                    const float ls = fminf(z, 0.f) - __logf(1.f + e);
                    const float sg = (z >= 0.f ? 1.f : e) * __builtin_amdgcn_rcpf(1.f + e);
                    lf[j] = (lb[j] > 0.f) ? __logf(lb[j] + (1.f - lb[j]) * sg) : ls;
                    kval[j] = (1.f - lb[j]) * (1.f - sg);
                }
                *(f32x4*)(LF + es * 128 + ekc) = (f32x4){lf[0], lf[1], lf[2], lf[3]}; *(f32x4*)(LF + es * 128 + ekc + 4) = (f32x4){lf[4], lf[5], lf[6], lf[7]};
#pragma unroll
                for (int j = 0; j < 8; ++j) { const unsigned wv = vraw[j >> 1]; VT[swz40(ekc + j, es)] = (bf16_t)((j & 1) ? (wv >> 16) : (wv & 0xFFFFu)); }
            }
            __syncthreads();
            if (tid < 128) {
                float cum = 0.f;
#pragma unroll
                for (int s = 0; s < 32; ++s) { cum += LF[s * 128 + tid]; LF[s * 128 + tid] = cum; }
                EL[tid] = __expf(cum);
            }
            __syncthreads();
            {
                const f32x4 c0 = *(const f32x4*)(LF + es * 128 + ekc), c1v = *(const f32x4*)(LF + es * 128 + ekc + 4);
                const f32x4 l0 = *(const f32x4*)(LF + 31 * 128 + ekc), l1 = *(const f32x4*)(LF + 31 * 128 + ekc + 4);
                float qe[8], ke[8];
#pragma unroll
                for (int j = 0; j < 8; ++j) {
                    const unsigned wv = qraw[j >> 1]; const float qv = (j & 1) ? __uint_as_float(wv & 0xFFFF0000u) : __uint_as_float(wv << 16);
                    const float cum = (j < 4) ? c0[j & 3] : c1v[j & 3], last = (j < 4) ? l0[j & 3] : l1[j & 3];
                    qe[j] = qv * __expf(cum); ke[j] = kval[j] * __expf(-cum);
                    KLT[swz40(ekc + j, es)] = f2bf(kval[j] * __expf(last - cum));
                }
                u32x4 w; w.x = pk2(qe[0], qe[1]); w.y = pk2(qe[2], qe[3]); w.z = pk2(qe[4], qe[5]); w.w = pk2(qe[6], qe[7]); *(u32x4*)(QE + es * 136 + ekc) = w;
                w.x = pk2(ke[0], ke[1]); w.y = pk2(ke[2], ke[3]); w.z = pk2(ke[4], ke[5]); w.w = pk2(ke[6], ke[7]); *(u32x4*)(KE + es * 136 + ekc) = w;
            }
            if (false) { const int n = (c + 1) * 32 + es; const int t = d ? (S - 1 - n) : n; const bf16_t* row = proj + ((size_t)b * S + t) * PW + h * 128 + ekc;
                zraw = *(const u32x4*)(row + C_CF + d * 1024); qraw = *(const u32x4*)(row + C_CQ); vraw = *(const u32x4*)(row + C_CI); }
            __syncthreads();
            f32x4 sc00 = {0.f, 0.f, 0.f, 0.f}, sc01 = sc00, sc11 = sc00;
#pragma unroll
            for (int ks = 0; ks < 4; ++ks) {
                const bf16x8 ke0 = *(const bf16x8*)(KE + r16 * 136 + ks * 32 + quad * 8), ke1 = *(const bf16x8*)(KE + (16 + r16) * 136 + ks * 32 + quad * 8);
                const bf16x8 qe0 = *(const bf16x8*)(QE + r16 * 136 + ks * 32 + quad * 8), qe1 = *(const bf16x8*)(QE + (16 + r16) * 136 + ks * 32 + quad * 8);
                sc00 = MFMA16(ke0, qe0, sc00); sc01 = MFMA16(ke0, qe1, sc01); sc11 = MFMA16(ke1, qe1, sc11);
            }
#pragma unroll
            for (int rg = 0; rg < 4; ++rg) { if (quad * 4 + rg > r16) { sc00[rg] = 0.f; sc11[rg] = 0.f; } }
            const f32x4 zero4 = {0.f, 0.f, 0.f, 0.f};
            const bf16x8 p0 = pack8(sc00, zero4), p1 = pack8(sc01, sc11);
            const int vrow_i = wid * 16 + r16;
            const bf16x8 vperm = join8(*(const s16x4*)(VT + swz40(vrow_i, quad * 4)), *(const s16x4*)(VT + swz40(vrow_i, 16 + quad * 4)));
            f32x4 o0 = MFMA16(p0, vperm, zero4), o1 = MFMA16(p1, vperm, zero4);
#pragma unroll
            for (int ks = 0; ks < 4; ++ks) {
                const bf16x8 sb = pack8(Sacc[2 * ks], Sacc[2 * ks + 1]);
                const bf16_t* q0p = QE + r16 * 136 + ks * 32 + quad * 4; const bf16_t* q1p = QE + (16 + r16) * 136 + ks * 32 + quad * 4;
                const bf16x8 qa0 = join8(*(const s16x4*)q0p, *(const s16x4*)(q0p + 16)), qa1 = join8(*(const s16x4*)q1p, *(const s16x4*)(q1p + 16));
                o0 = MFMA16(qa0, sb, o0); o1 = MFMA16(qa1, sb, o1);
            }
#pragma unroll
            for (int rg = 0; rg < 4; ++rg) {
                { const int n = c * 32 + quad * 4 + rg; const int t = d ? (S - 1 - n) : n; OC[((size_t)d * M + (size_t)b * S + t) * 1024 + h * 128 + wid * 16 + r16] = f2bf(o0[rg]); }
                { const int n = c * 32 + 16 + quad * 4 + rg; const int t = d ? (S - 1 - n) : n; OC[((size_t)d * M + (size_t)b * S + t) * 1024 + h * 128 + wid * 16 + r16] = f2bf(o1[rg]); }
            }
            const bf16x8 vnat = *(const bf16x8*)(VT + swz40(vrow_i, quad * 8));
#pragma unroll
            for (int mt = 0; mt < 8; ++mt) {
                const f32x4 el = *(const f32x4*)(EL + mt * 16 + quad * 4);
                f32x4 sa = Sacc[mt] * el;
                const bf16x8 kl = *(const bf16x8*)(KLT + swz40(mt * 16 + r16, quad * 8));
                Sacc[mt] = MFMA16(kl, vnat, sa);
            }
        }
    }
}

__device__ __forceinline__ void attn_phase(const Params& P, int layer, unsigned char* smem, unsigned* counter) {
    float* TAB = (float*)smem; bf16_t* KT = (bf16_t*)(smem + 16384); bf16_t* VTt = (bf16_t*)(smem + 16384 + 9216); int* sh_unit = (int*)(smem + 16384 + 9216 + 18432);
    const int tid = opaque_tid(), wid = __builtin_amdgcn_readfirstlane(tid >> 6), lane = tid & 63, r16 = lane & 15, quad = lane >> 4;
    const bf16_t* proj = (const bf16_t*)(P.ws + OFF_PROJ);
    bf16_t* AO = (bf16_t*)(P.ws + OFF_AO);
    const float* rel_bias = P.in[1];
    const float c1 = 0.125f * LOG2E;
    for (;;) {
        __syncthreads();
        if (tid == 0) *sh_unit = (int)atomicAdd(counter, 1u);
        __syncthreads();
        const int u = *sh_unit;
        if (u >= 1024) break;
        const int qb = u & 7, m = (u >> 3) & 1, h = (u >> 4) & 7, b = u >> 7;
        for (int e = tid; e < 4095; e += 512) { const int rel = e - 2047; const int n = rel < 0 ? -rel : rel; int bk;
            if (n < 8) bk = n; else { const int lg = 31 - __clz(n * n); bk = 2 + lg; if (bk > 15) bk = 15; }
            if (rel > 0) bk += 16; TAB[e] = rel_bias[bk * 8 + h] * LOG2E; }
        const int qrow0 = qb * 256 + wid * 32;
        bf16x8 Qf[2][2];
#pragma unroll
        for (int nq = 0; nq < 2; ++nq)
#pragma unroll
            for (int ks = 0; ks < 2; ++ks) Qf[nq][ks] = *(const bf16x8*)(proj + ((size_t)b * S + qrow0 + nq * 16 + r16) * PW + C_AQ + h * 128 + m * 64 + ks * 32 + quad * 8);
        f32x4 O[2][8];
#pragma unroll
        for (int nq = 0; nq < 2; ++nq)
#pragma unroll
            for (int dt = 0; dt < 8; ++dt) O[nq][dt] = (f32x4){0.f, 0.f, 0.f, 0.f};
        float mrun[2] = {-1e30f, -1e30f}, lrun[2] = {0.f, 0.f};
        const int kkey = tid >> 3, kchunk = tid & 7;
        const int vkp = tid & 31, vchunk = tid >> 5;
        const bf16_t* kbase = proj + ((size_t)b * S + kkey) * PW + C_AK + h * 128 + m * 64 + kchunk * 8;
        const bf16_t* vbase = proj + ((size_t)b * S + 2 * vkp) * PW + C_AV + h * 128 + vchunk * 8;
        u32x4 kreg = *(const u32x4*)kbase, vreg0 = *(const u32x4*)vbase, vreg1 = *(const u32x4*)(vbase + PW);
        for (int kt = 0; kt < 32; ++kt) {
            __syncthreads();
            *(u32x4*)(KT + kkey * 72 + kchunk * 8) = kreg;
            { unsigned* vd = (unsigned*)(VTt + (vchunk * 8) * 72 + 2 * vkp);
#pragma unroll
              for (int i2 = 0; i2 < 4; ++i2) { const unsigned a = vreg0[i2], bq = vreg1[i2];
                  vd[(2 * i2) * 36] = (a & 0xFFFFu) | (bq << 16); vd[(2 * i2 + 1) * 36] = (a >> 16) | (bq & 0xFFFF0000u); } }
            __syncthreads();
            if (kt + 1 < 32) { const size_t adv = (size_t)(kt + 1) * 64 * PW; kreg = *(const u32x4*)(kbase + adv); vreg0 = *(const u32x4*)(vbase + adv); vreg1 = *(const u32x4*)(vbase + adv + PW); }
            const int k0 = kt * 64;
            f32x4 st[2][4];
#pragma unroll
            for (int mt = 0; mt < 4; ++mt) {
                const bf16x8 ka = *(const bf16x8*)(KT + (mt * 16 + r16) * 72 + quad * 8), kb2 = *(const bf16x8*)(KT + (mt * 16 + r16) * 72 + 32 + quad * 8);
#pragma unroll
                for (int nq = 0; nq < 2; ++nq) { f32x4 a = {0.f, 0.f, 0.f, 0.f}; a = MFMA16(ka, Qf[nq][0], a); a = MFMA16(kb2, Qf[nq][1], a); st[nq][mt] = a; }
            }
            const bool posfar = (k0 - (qrow0 + 31)) >= 96, negfar = (qrow0 - (k0 + 63)) >= 96;
            if (posfar || negfar) {
                const float cb = posfar ? TAB[2047 + 128] : TAB[2047 - 128];
#pragma unroll
                for (int nq = 0; nq < 2; ++nq)
#pragma unroll
                    for (int mt = 0; mt < 4; ++mt) st[nq][mt] = st[nq][mt] * c1 + cb;
            } else {
#pragma unroll
                for (int nq = 0; nq < 2; ++nq)
#pragma unroll
                    for (int mt = 0; mt < 4; ++mt) { const float* tp = TAB + (k0 + mt * 16 + quad * 4) - (qrow0 + nq * 16 + r16) + 2047;
#pragma unroll
                        for (int rg = 0; rg < 4; ++rg) st[nq][mt][rg] = st[nq][mt][rg] * c1 + tp[rg]; }
            }
            bf16x8 pf[2][2];
#pragma unroll
            for (int nq = 0; nq < 2; ++nq) {
                float mx = st[nq][0][0];
#pragma unroll
                for (int mt = 0; mt < 4; ++mt)
#pragma unroll
                    for (int rg = 0; rg < 4; ++rg) mx = fmaxf(mx, st[nq][mt][rg]);
                mx = fmaxf(mx, __shfl_xor(mx, 16)); mx = fmaxf(mx, __shfl_xor(mx, 32));
                const float mnew = fmaxf(mrun[nq], mx); const float alpha = __builtin_amdgcn_exp2f(mrun[nq] - mnew); mrun[nq] = mnew;
                float ps = 0.f;
#pragma unroll
                for (int mt = 0; mt < 4; ++mt)
#pragma unroll
                    for (int rg = 0; rg < 4; ++rg) { const float pv = __builtin_amdgcn_exp2f(st[nq][mt][rg] - mnew); st[nq][mt][rg] = pv; ps += pv; }
                lrun[nq] = lrun[nq] * alpha + ps;
#pragma unroll
                for (int dt = 0; dt < 8; ++dt) O[nq][dt] = O[nq][dt] * alpha;
                pf[nq][0] = pack8(st[nq][0], st[nq][1]); pf[nq][1] = pack8(st[nq][2], st[nq][3]);
            }
#pragma unroll
            for (int dt = 0; dt < 8; ++dt) {
                const bf16_t* vr = VTt + (dt * 16 + r16) * 72 + quad * 4;
                const bf16x8 va0 = join8(*(const s16x4*)vr, *(const s16x4*)(vr + 16)), va1 = join8(*(const s16x4*)(vr + 32), *(const s16x4*)(vr + 48));
#pragma unroll
                for (int nq = 0; nq < 2; ++nq) { O[nq][dt] = MFMA16(va0, pf[nq][0], O[nq][dt]); O[nq][dt] = MFMA16(va1, pf[nq][1], O[nq][dt]); }
            }
        }
#pragma unroll
        for (int nq = 0; nq < 2; ++nq) {
            float l = lrun[nq]; l += __shfl_xor(l, 16); l += __shfl_xor(l, 32);
            const float inv = 1.f / l;
            bf16_t* orow = AO + ((size_t)m * M + (size_t)b * S + qrow0 + nq * 16 + r16) * 1024 + h * 128 + quad * 4;
#pragma unroll
            for (int dt = 0; dt < 8; ++dt) { u32x2 w; w.x = pk2(O[nq][dt][0] * inv, O[nq][dt][1] * inv); w.y = pk2(O[nq][dt][2] * inv, O[nq][dt][3] * inv); *(u32x2*)(orow + dt * 16) = w; }
        }
    }
}

__device__ __forceinline__ void load16(const bf16_t* p, float* o) {
    const u32x4 a = *(const u32x4*)p, b = *(const u32x4*)(p + 8);
#pragma unroll
    for (int i = 0; i < 4; ++i) { o[2 * i] = __uint_as_float(a[i] << 16); o[2 * i + 1] = __uint_as_float(a[i] & 0xFFFF0000u); o[8 + 2 * i] = __uint_as_float(b[i] << 16); o[8 + 2 * i + 1] = __uint_as_float(b[i] & 0xFFFF0000u); }
}
__device__ __forceinline__ void store16(bf16_t* p, const float* v) {
    u32x4 a, b; a.x = pk2(v[0], v[1]); a.y = pk2(v[2], v[3]); a.z = pk2(v[4], v[5]); a.w = pk2(v[6], v[7]); b.x = pk2(v[8], v[9]); b.y = pk2(v[10], v[11]); b.z = pk2(v[12], v[13]); b.w = pk2(v[14], v[15]);
    *(u32x4*)p = a; *(u32x4*)(p + 8) = b;
}
__device__ __forceinline__ void loadf16(const float* p, float* o) {
#pragma unroll
    for (int i = 0; i < 4; ++i) { const float4 v = ((const float4*)p)[i]; o[4 * i] = v.x; o[4 * i + 1] = v.y; o[4 * i + 2] = v.z; o[4 * i + 3] = v.w; }
}
__device__ __forceinline__ void finish_phase(const Params& P, int layer) {
    const int tid_ = opaque_tid(); const int lane = tid_ & 63, gw = opaque_bid() * 8 + (tid_ >> 6), ngw = gridDim.x * 8;
    const bf16_t* proj = (const bf16_t*)(P.ws + OFF_PROJ);
    const bf16_t* AO = (const bf16_t*)(P.ws + OFF_AO); const bf16_t* YB = (const bf16_t*)(P.ws + OFF_U); const bf16_t* OC = (const bf16_t*)(P.ws + OFF_OC);
    const float* BON = (const float*)(P.ws + OFF_BON);
    bf16_t* MIX = (bf16_t*)(P.ws + OFF_MIXED);
    const float lam_init = 0.8f - 0.6f * expf(-0.3f * (float)layer);
    const float s1 = wave_sum(P.in[6][layer * 64 + lane] * P.in[7][layer * 64 + lane]), s2 = wave_sum(P.in[8][layer * 64 + lane] * P.in[9][layer * 64 + lane]);
    const float lam = expf(s1) - expf(s2) + lam_init;
    const int c0 = lane * 16;
    const float* mu0p = P.in[11] + (size_t)layer * 2 * 3328 + 2048 + c0; const float* mu1p = mu0p + 3328;
    for (int tok = gw; tok < M; tok += ngw) {
        const bf16_t* prow = proj + (size_t)tok * PW;
        bf16_t* mrow = MIX + (size_t)tok * MIXW;
        float a[16], bb[16], g[16], pr[16];
        load16(AO + (size_t)tok * 1024 + c0, a); load16(AO + ((size_t)M + tok) * 1024 + c0, bb); load16(prow + C_AG + c0, g);
        { float ss = 0.f;
#pragma unroll
          for (int i = 0; i < 16; ++i) { a[i] = a[i] - lam * bb[i]; ss += a[i] * a[i]; }
          ss += __shfl_xor(ss, 1); ss += __shfl_xor(ss, 2); ss += __shfl_xor(ss, 4);
          const float rstd = rsqrtf(ss * (1.f / 128.f) + 1e-5f) * (1.f - lam_init);
          loadf16(P.in[10] + layer * 128 + (c0 & 127), pr);
#pragma unroll
          for (int i = 0; i < 16; ++i) a[i] = a[i] * rstd * pr[i] * siluf_(g[i]);
          store16(mrow + c0, a); }
        load16(YB + (size_t)tok * 1024 + c0, a); load16(YB + ((size_t)M + tok) * 1024 + c0, bb); load16(prow + C_BG + c0, g);
        { float sm = 0.f;
#pragma unroll
          for (int i = 0; i < 16; ++i) { a[i] += bb[i]; sm += a[i]; }
          sm += __shfl_xor(sm, 1); sm += __shfl_xor(sm, 2);
          const float mean = sm * (1.f / 64.f); float vs = 0.f;
#pragma unroll
          for (int i = 0; i < 16; ++i) { a[i] -= mean; vs += a[i] * a[i]; }
          vs += __shfl_xor(vs, 1); vs += __shfl_xor(vs, 2);
          const float rstd = rsqrtf(vs * (1.f / 64.f) + 64e-5f);
          const int head = lane >> 2;
          const float bon = BON[(((size_t)(tok >> 11)) * 16 + head) * S + (tok & (S - 1))] + BON[(((size_t)NB + (tok >> 11)) * 16 + head) * S + (tok & (S - 1))];
          const int sp = tok & (S - 1);
          loadf16(P.in[19] + layer * 1024 + c0, pr);
#pragma unroll
          for (int i = 0; i < 16; ++i) a[i] = a[i] * rstd * pr[i];
          loadf16(P.in[20] + layer * 1024 + c0, pr);
#pragma unroll
          for (int i = 0; i < 16; ++i) a[i] += pr[i];
          load16(prow + C_B + 2048 + c0, bb);
          float vsft[16];
          { float nb[16];
            if (sp > 0) load16(prow - PW + C_B + 2048 + c0, nb); else {
#pragma unroll
                for (int i = 0; i < 16; ++i) nb[i] = 0.f; }
            loadf16(mu0p, pr);
#pragma unroll
            for (int i = 0; i < 16; ++i) vsft[i] = bb[i] + pr[i] * (nb[i] - bb[i]);
            if (sp < S - 1) load16(prow + PW + C_B + 2048 + c0, nb); else {
#pragma unroll
                for (int i = 0; i < 16; ++i) nb[i] = 0.f; }
            loadf16(mu1p, pr);
#pragma unroll
            for (int i = 0; i < 16; ++i) vsft[i] += pr[i] * (nb[i] - bb[i]); }
#pragma unroll
          for (int i = 0; i < 16; ++i) a[i] = (a[i] + bon * vsft[i]) * siluf_(g[i]);
          store16(mrow + 1024 + c0, a); }
        load16(OC + (size_t)tok * 1024 + c0, a); load16(OC + ((size_t)M + tok) * 1024 + c0, bb); load16(prow + C_CG + c0, g);
        { float ss = 0.f;
#pragma unroll
          for (int i = 0; i < 16; ++i) { a[i] += bb[i]; ss += a[i] * a[i]; }
          ss += __shfl_xor(ss, 1); ss += __shfl_xor(ss, 2); ss += __shfl_xor(ss, 4);
          const float rstd = rsqrtf(ss * (1.f / 128.f) + 1e-6f);
          loadf16(P.in[22] + layer * 128 + (c0 & 127), pr);
#pragma unroll
          for (int i = 0; i < 16; ++i) a[i] = a[i] * rstd * pr[i] * siluf_(g[i]);
          store16(mrow + 2048 + c0, a); }
    }
}

__global__ void __launch_bounds__(NTHR, 2) fwd_megakernel(Params P) {
    extern __shared__ __attribute__((aligned(16))) unsigned char smem[];
    cg::grid_group grid = cg::this_grid();
    unsigned* ctl = (unsigned*)(P.ws + OFF_CTL);
    bf16_t* U = (bf16_t*)(P.ws + OFF_U);
    float* Y = (float*)(P.ws + OFF_PROJ);
#ifndef REP_P0
#define REP_P0 1
#endif
#pragma unroll 1
    for (int rep = 0; rep < REP_P0; ++rep) { convert_weights(P, 0, smem);
    prenorm_rows(P.in[0], P.in[2], U); }
    grid.sync();
#pragma unroll 1
    for (int layer = 0; layer < DEPTH; ++layer) {
#ifndef REP_G1
#define REP_G1 1
#endif
#pragma unroll 1
        for (int rep = 0; rep < REP_G1; ++rep) { pg8::Gemm g; g.A = U; g.Bt = (const bf16_t*)(P.ws + OFF_WIN); g.M = opaque_s(M); g.N = opaque_s(PW); g.K = opaque_s(D);
          pg8::StaticOrder So; So.init(g.M, g.N, (int)gridDim.x, opaque_bid());
          pg8::EpiBf16<0> E; E.O = (bf16_t*)(P.ws + OFF_PROJ); E.ldc = g.N; E.bias = nullptr; E.split_cols = 0; E.split_stride = 0;
          pg8::gemm_phase<pg8::EpiBf16<0>, pg8::StaticOrder, false>((PG8_LAS unsigned char*)smem, g, So, E, nullptr); }
        grid.sync();
#ifndef REP_RWKV
#define REP_RWKV 1
#endif
#ifndef REP_HGRN
#define REP_HGRN 1
#endif
#ifndef REP_ATTN
#define REP_ATTN 1
#endif
#pragma unroll 1
        for (int rep = 0; rep < REP_RWKV; ++rep) rwkv_phase(P, layer, smem);
#pragma unroll 1
        for (int rep = 0; rep < REP_HGRN; ++rep) hgrn_phase(P, layer, smem);
#pragma unroll 1
        for (int rep = 0; rep < REP_ATTN; ++rep) attn_phase(P, layer, smem, ctl + 64 * layer + 128 * rep);
        grid.sync();
#ifndef REP_FIN
#define REP_FIN 1
#endif
#pragma unroll 1
        for (int rep = 0; rep < REP_FIN; ++rep) finish_phase(P, layer);
        grid.sync();
#ifndef REP_G2
#define REP_G2 1
#endif
#pragma unroll 1
        for (int rep = 0; rep < REP_G2; ++rep) { pg8::Gemm g; g.A = (const bf16_t*)(P.ws + OFF_MIXED); g.Bt = (const bf16_t*)(P.ws + OFF_WOUT); g.M = opaque_s(M); g.N = opaque_s(D); g.K = opaque_s(MIXW);
          pg8::StaticOrder So; So.init(g.M, g.N, (int)gridDim.x, opaque_bid());
          pg8::EpiF32 E; E.C = Y; E.ldc = g.N; E.bias = nullptr;
          pg8::gemm_phase<pg8::EpiF32, pg8::StaticOrder, false>((PG8_LAS unsigned char*)smem, g, So, E, nullptr); }
        grid.sync();
        if (layer + 1 < DEPTH) {
            postnorm_rows(Y, layer == 0 ? P.in[0] : P.out, P.out, P.in[3] + layer * D, P.in[2] + (layer + 1) * D, U);
            convert_weights(P, layer + 1, smem);
            grid.sync();
        } else {
            postnorm_rows(Y, layer == 0 ? P.in[0] : P.out, P.out, P.in[3] + layer * D, nullptr, U);
        }
    }
}
}

extern "C" void kernel_launch(void* const* d_in, const int* in_sizes, int n_in, void* d_out, int out_size, void* d_ws, size_t ws_size, hipStream_t stream) {
    static int grid_blocks = 0;
    if (grid_blocks == 0) {
        int dev = 0, cus = 0, per_cu = 0;
        hipGetDevice(&dev);
        hipDeviceGetAttribute(&cus, hipDeviceAttributeMultiprocessorCount, dev);
        if (hipFuncSetAttribute((const void*)mk::fwd_megakernel, hipFuncAttributeMaxDynamicSharedMemorySize, mk::LDS_BYTES) != hipSuccess) fprintf(stderr, "hipFuncSetAttribute failed\n");
        if (hipOccupancyMaxActiveBlocksPerMultiprocessor(&per_cu, (const void*)mk::fwd_megakernel, mk::NTHR, mk::LDS_BYTES) != hipSuccess || per_cu < 1) { fprintf(stderr, "occupancy query: %d\n", per_cu); per_cu = 1; }
        (void)hipGetLastError();
        grid_blocks = cus * 1;
        if (ws_size < mk::WS_END) fprintf(stderr, "workspace too small: %zu < %zu\n", ws_size, (size_t)mk::WS_END);
    }
    hipMemsetAsync((unsigned char*)d_ws + mk::OFF_CTL, 0, 4096, stream);
    mk::Params p{};
    for (int i = 0; i < 23; ++i) p.in[i] = (const float*)d_in[i];
    p.out = (float*)d_out; p.ws = (unsigned char*)d_ws;
    void* args[] = {&p};
    hipError_t e = hipLaunchCooperativeKernel((const void*)mk::fwd_megakernel, dim3(grid_blocks), dim3(mk::NTHR), args, mk::LDS_BYTES, stream);
    if (e != hipSuccess) fprintf(stderr, "cooperative launch failed: %s (grid %d)\n", hipGetErrorString(e), grid_blocks);
}
```

```cpp
#include <hip/hip_runtime.h>
#include <hip/hip_cooperative_groups.h>
#include <cstdio>
#include <cstdint>
namespace cg = cooperative_groups;
namespace pg8 {
#define PG8_LAS __attribute__((address_space(3)))
typedef unsigned short bf16_t;
typedef short bf16x8 __attribute__((ext_vector_type(8)));
typedef float f32x4 __attribute__((ext_vector_type(4)));
typedef unsigned u32x4 __attribute__((ext_vector_type(4)));
constexpr int BM = 256, BK = 64, HALF = 128, HTB = HALF * BK * 2  , STAGE_BYTES = 8 * HTB, NXCD = 8, WGM = 8;

__host__ __device__ __forceinline__ int lds_byte(int r, int c) { const int st = (r >> 4) * 2 + (c >> 5), rr = r & 15, cc = c & 31, ob = rr * 64 + cc * 2; return st * 1024 + (ob ^ (((ob >> 9) & 1) << 5)); }
__host__ __device__ __forceinline__ void stage_rc(int b, int& R, int& C) { const int st = b / 1024, sb = b % 1024, swz = sb ^ (((sb >> 9) & 1) << 5); R = (st >> 1) * 16 + swz / 64; C = (st & 1) * 32 + (swz % 64) / 2; }
__host__ __device__ __forceinline__ int perm32(int rho) { const int n = rho >> 4, i = rho & 15; return 8 * (i >> 2) + 4 * n + (i & 3); }

struct Unit { int pm, pn; };
struct Gemm { const bf16_t* A; const bf16_t* Bt; int M, N, K; };

struct StaticOrder {
    int nM, nN, nwg, G, c;
    __host__ __device__ void init(int M, int N, int G_, int c_) { nM = M / BM; nN = N / BM; nwg = nM * nN; G = G_; c = c_; }
    __host__ __device__ bool next(int i, Unit& u) const {
        const long L = (long)i * G + c; if (L >= nwg) return false;
        int wgid = (int)L; { const int q = nwg / NXCD, r = nwg % NXCD, xcd = wgid % NXCD, off = wgid / NXCD; wgid = (xcd < r ? xcd * (q + 1) : r * (q + 1) + (xcd - r) * q) + off; }
        const int nig = WGM * nN, gid = wgid / nig, fm = gid * WGM, gsz = (nM - fm) < WGM ? (nM - fm) : WGM;
        u.pm = fm + ((wgid % nig) % gsz); u.pn = (wgid % nig) / gsz; return true;
    }
    __device__ __forceinline__ void a_ready(const Unit&) const {}
    __device__ __forceinline__ void done(const Unit&) const {}
};
struct CountedOrder : StaticOrder {
    const unsigned* ready; unsigned need; unsigned* tmo;
    __device__ __forceinline__ void a_ready(const Unit& u) const {
        if (threadIdx.x < 64) {
            const unsigned long long t0 = __builtin_amdgcn_s_memrealtime(); unsigned polls = 0;
            while ((unsigned)__builtin_amdgcn_readfirstlane(__hip_atomic_load(ready + 64 * u.pm, __ATOMIC_RELAXED, __HIP_MEMORY_SCOPE_AGENT)) < need) {
                if ((++polls & 255u) == 0u && __builtin_amdgcn_readfirstlane(__hip_atomic_load(tmo, __ATOMIC_RELAXED, __HIP_MEMORY_SCOPE_AGENT)) != 0u) break;
                if (__builtin_amdgcn_s_memrealtime() - t0 > 2000000ull) {
                    if (threadIdx.x == 0) { unsigned expect = 0u; __hip_atomic_compare_exchange_strong(tmo + 1, &expect, 0x600u | (unsigned)(u.pm & 0xff), __ATOMIC_RELAXED, __ATOMIC_RELAXED, __HIP_MEMORY_SCOPE_AGENT); __hip_atomic_store(tmo, 1u, __ATOMIC_RELAXED, __HIP_MEMORY_SCOPE_AGENT); }
                    break; }
                __builtin_amdgcn_s_sleep(2); }
            __builtin_amdgcn_fence(__ATOMIC_ACQUIRE, "agent");
            asm volatile("s_waitcnt vmcnt(0)" ::: "memory");
        }
#if !defined(BROKEN_HOOK_NO_BARRIER)
        asm volatile("" ::: "memory"); __builtin_amdgcn_s_barrier(); asm volatile("" ::: "memory");
#endif
    }
};

typedef __bf16 bf16x2_t __attribute__((ext_vector_type(2)));
typedef float f32x2c __attribute__((ext_vector_type(2)));
__device__ __forceinline__ unsigned cvt_pk_bf16(float lo, float hi) { f32x2c v = {lo, hi}; bf16x2_t b = __builtin_convertvector(v, bf16x2_t); return __builtin_bit_cast(unsigned, b); }
typedef float f32x2 __attribute__((ext_vector_type(2)));
__device__ __forceinline__ f32x2 gelu_pk(f32x2 v) {
    const f32x2 av = __builtin_elementwise_abs(v), d = av * 0.2316418882f + 1.0f;
    f32x2 t; t.x = __builtin_amdgcn_rcpf(d.x); t.y = __builtin_amdgcn_rcpf(d.y);
    f32x2 q = t * 0.5307027145f + (-0.7265760135f); q = q * t + 0.7107068705f; q = q * t + (-0.142248368f); q = q * t + 0.127414796f; q = q * t;
    const f32x2 s = (v * v) * (-0.72134752044f);
    f32x2 e; e.x = __builtin_amdgcn_exp2f(s.x); e.y = __builtin_amdgcn_exp2f(s.y);
    const f32x2 m = v * (q * e), r = v - m;
    f32x2 o; o.x = v.x < 0.f ? m.x : r.x; o.y = v.y < 0.f ? m.y : r.y; return o;
}

struct EpiF32 {
    static constexpr bool PERM = false, AFTER_DRAIN = false;
    float* C; int ldc; const float* bias;
    __device__ __forceinline__ void operator()(const f32x4 (&acc)[2][2][4][2], const Unit& u, int wr, int wc, int fr, int fq) const {
        const int row0 = u.pm * BM + wr * 64 + fr, col0 = u.pn * BM + wc * 32 + 4 * fq;
        f32x4 bv[2][2];
#pragma unroll
        for (int bj = 0; bj < 2; ++bj)
#pragma unroll
            for (int n = 0; n < 2; ++n) bv[bj][n] = bias ? *(const f32x4*)(bias + col0 + bj * HALF + n * 16) : (f32x4){0.f, 0.f, 0.f, 0.f};
#pragma unroll
        for (int ai = 0; ai < 2; ++ai)
#pragma unroll
            for (int m = 0; m < 4; ++m) { float* rowp = C + (size_t)(row0 + ai * HALF + m * 16) * ldc + col0;
#pragma unroll
                for (int bj = 0; bj < 2; ++bj)
#pragma unroll
                    for (int n = 0; n < 2; ++n) *(f32x4*)(rowp + bj * HALF + n * 16) = acc[ai][bj][m][n] + bv[bj][n]; }
    }
};
template <int ACT  > struct EpiBf16 {
    static constexpr bool PERM = true, AFTER_DRAIN = false;
    bf16_t* O; int ldc; const float* bias; int split_cols; size_t split_stride;
    __device__ __forceinline__ void operator()(const f32x4 (&acc)[2][2][4][2], const Unit& u, int wr, int wc, int fr, int fq) const {
        const int row0 = u.pm * BM + wr * 64 + fr; int colt = u.pn * BM; bf16_t* base = O;
        if (split_cols) { const int t = colt / split_cols; base += (size_t)t * split_stride; colt -= t * split_cols; }
        const int col0 = colt + wc * 32 + 8 * fq, bcol0 = u.pn * BM + wc * 32 + 8 * fq;
        f32x4 bv[2][2];
#pragma unroll
        for (int bj = 0; bj < 2; ++bj)
#pragma unroll
            for (int n = 0; n < 2; ++n) bv[bj][n] = bias ? *(const f32x4*)(bias + bcol0 + bj * HALF + 4 * n) : (f32x4){0.f, 0.f, 0.f, 0.f};
#pragma unroll
        for (int ai = 0; ai < 2; ++ai)
#pragma unroll
            for (int m = 0; m < 4; ++m) { bf16_t* rowp = base + (size_t)(row0 + ai * HALF + m * 16) * ldc + col0;
#pragma unroll
                for (int bj = 0; bj < 2; ++bj) { f32x4 v0 = acc[ai][bj][m][0] + bv[bj][0], v1 = acc[ai][bj][m][1] + bv[bj][1];
                    if (ACT == 1) { f32x2 a = gelu_pk((f32x2){v0[0], v0[1]}), b = gelu_pk((f32x2){v0[2], v0[3]}), c = gelu_pk((f32x2){v1[0], v1[1]}), d = gelu_pk((f32x2){v1[2], v1[3]});
                        v0 = (f32x4){a.x, a.y, b.x, b.y}; v1 = (f32x4){c.x, c.y, d.x, d.y}; }
                    if (ACT == 2) {
#pragma unroll
                        for (int j = 0; j < 4; ++j) { v0[j] = 0.5f * v0[j] * (1.0f + erff(v0[j] * 0.70710678f)); v1[j] = 0.5f * v1[j] * (1.0f + erff(v1[j] * 0.70710678f)); } }
                    u32x4 w; w.x = cvt_pk_bf16(v0[0], v0[1]); w.y = cvt_pk_bf16(v0[2], v0[3]); w.z = cvt_pk_bf16(v1[0], v1[1]); w.w = cvt_pk_bf16(v1[2], v1[3]);
                    *(u32x4*)(rowp + bj * HALF) = w; } }
    }
};


template <class Epi, class Sched, bool STAMP = false>
__device__ __forceinline__ void gemm_phase(PG8_LAS unsigned char* lds, const Gemm g, const Sched& S, const Epi& E, unsigned long long* stamps) {
    int tid_o = threadIdx.x; asm volatile("" : "+v"(tid_o));
    const int tid = tid_o, wid = __builtin_amdgcn_readfirstlane(tid >> 6), lane = tid & 63, wr = wid >> 2, wc = wid & 3, fr = lane & 15, fq = lane >> 4;
    const int K = g.K, nt = K / BK;
    int ts_lo = 0, ts_hi = 0, nts = 0; const unsigned long long rt_entry = STAMP ? (unsigned long long)wall_clock64() : 0ull;
#define PG8_STAMP() do { if (STAMP && wid == 0 && nts < 64) { const unsigned long long _c = (unsigned long long)clock64(); \
        ts_lo = (lane == nts) ? (int)(unsigned)_c : ts_lo; ts_hi = (lane == nts) ? (int)(unsigned)(_c >> 32) : ts_hi; ++nts; } } while (0)
    PG8_STAMP();
    unsigned voffA[2], voffB[2];
#pragma unroll
    for (int i = 0; i < 2; ++i) { int R, C; stage_rc(tid * 16 + i * 8192, R, C); const int Rb = Epi::PERM ? ((R & ~31) + perm32(R & 31)) : R;
        voffA[i] = (unsigned)(R * K + C) * 2u; voffB[i] = (unsigned)(Rb * K + C) * 2u; }
    const size_t kstep = (size_t)(BK * 2);
    const size_t hstep = (size_t)HALF * K * 2;
    const size_t tstep = 2 * hstep;
    const unsigned ldsw = (unsigned)wid * 1024u;
    const int aoff = lds_byte(wr * 64 + fr, fq * 8), boff = lds_byte(wc * 32 + fr, fq * 8);
#define PG8_SA(b, h) (((b) * 2 + (h)) * HTB)
#define PG8_SB(b, h) ((4 + (b) * 2 + (h)) * HTB)
#define PG8_STAGE(bufoff, gbase, voff) do { _Pragma("unroll") for (int _i = 0; _i < 2; ++_i) \
        __builtin_amdgcn_global_load_lds((const unsigned*)((const char*)(gbase) + (voff)[_i]), (PG8_LAS unsigned*)(lds + (bufoff) + ldsw + _i * 8192), 16, 0, 0); } while (0)
#define PG8_LDA(dst, b, h) do { _Pragma("unroll") for (int m = 0; m < 4; ++m) _Pragma("unroll") for (int k = 0; k < 2; ++k) dst[m][k] = *(const PG8_LAS bf16x8*)(lds + PG8_SA(b, h) + aoff + m * 2048 + k * 1024); } while (0)
#define PG8_LDB(dst, b, h) do { _Pragma("unroll") for (int n = 0; n < 2; ++n) _Pragma("unroll") for (int k = 0; k < 2; ++k) dst[n][k] = *(const PG8_LAS bf16x8*)(lds + PG8_SB(b, h) + boff + n * 2048 + k * 1024); } while (0)
#define PG8_MMA(ai, bj, At, Bt) do { __builtin_amdgcn_s_setprio(1); _Pragma("unroll") for (int m = 0; m < 4; ++m) _Pragma("unroll") for (int n = 0; n < 2; ++n) _Pragma("unroll") for (int k = 0; k < 2; ++k) \
        acc[ai][bj][m][n] = __builtin_amdgcn_mfma_f32_16x16x32_bf16(Bt[n][k], At[m][k], acc[ai][bj][m][n], 0, 0, 0); __builtin_amdgcn_s_setprio(0); } while (0)
#define PG8_WAIT_V(n) asm volatile("s_waitcnt vmcnt(" #n ")" ::: "memory")
#define PG8_WAIT_L(n) asm volatile("s_waitcnt lgkmcnt(" #n ")" ::: "memory")
#define PG8_BAR __builtin_amdgcn_s_barrier()
#define PG8_SCHED __builtin_amdgcn_sched_barrier(0)
    Unit cur, nxt; int ui = 0;
    if (!S.next(0, cur)) return;
    f32x4 acc[2][2][4][2];
#pragma unroll
    for (int a = 0; a < 2; ++a)
#pragma unroll
        for (int b = 0; b < 2; ++b)
#pragma unroll
            for (int m = 0; m < 4; ++m)
#pragma unroll
                for (int n = 0; n < 2; ++n) acc[a][b][m][n] = (f32x4){0.f, 0.f, 0.f, 0.f};
    bf16x8 At[4][2], B0[2][2], B1[2][2];
    const char* cA = (const char*)g.A + (size_t)cur.pm * tstep; const char* cB = (const char*)g.Bt + (size_t)cur.pn * tstep;
    S.a_ready(cur);
    PG8_STAGE(PG8_SB(0, 0), cB, voffB); PG8_STAGE(PG8_SA(0, 0), cA, voffA); PG8_STAGE(PG8_SB(0, 1), cB + hstep, voffB); PG8_STAGE(PG8_SA(0, 1), cA + hstep, voffA);
    if (wr == 1) PG8_BAR;
    PG8_WAIT_V(4); PG8_BAR;
    PG8_STAGE(PG8_SB(1, 0), cB + kstep, voffB); PG8_STAGE(PG8_SA(1, 0), cA + kstep, voffA); PG8_STAGE(PG8_SB(1, 1), cB + hstep + kstep, voffB);
    PG8_WAIT_V(6); PG8_BAR;
    PG8_STAMP();
    for (;;) {
        const bool has_next = S.next(ui + 1, nxt);
        const char* nA = has_next ? (const char*)g.A + (size_t)nxt.pm * tstep : cA; const char* nB = has_next ? (const char*)g.Bt + (size_t)nxt.pn * tstep : cB;
        for (int t = 0; t < nt; t += 2) {
            const bool last = (t == nt - 2);
            const char* a1 = cA + (size_t)(t + 1) * kstep;
            const char* a2 = last ? nA : cA + (size_t)(t + 2) * kstep; const char* b2 = last ? nB : cB + (size_t)(t + 2) * kstep;
            const char* a3 = a2 + kstep; const char* b3 = b2 + kstep;
            if (last && has_next) S.a_ready(nxt);
            PG8_LDB(B0, 0, 0); PG8_SCHED; PG8_LDA(At, 0, 0); PG8_STAGE(PG8_SA(1, 1), a1 + hstep, voffA);
            PG8_WAIT_L(8); PG8_BAR; PG8_WAIT_L(0); PG8_MMA(0, 0, At, B0); PG8_BAR; PG8_SCHED;
            PG8_LDB(B1, 0, 1); PG8_STAGE(PG8_SB(0, 0), b2, voffB);
            PG8_BAR; PG8_WAIT_L(0); PG8_MMA(0, 1, At, B1); PG8_BAR;
            PG8_LDA(At, 0, 1); PG8_STAGE(PG8_SA(0, 0), a2, voffA);
            PG8_BAR; PG8_WAIT_L(0); PG8_MMA(1, 0, At, B0); PG8_BAR; PG8_SCHED;
            PG8_STAGE(PG8_SB(0, 1), b2 + hstep, voffB);
            PG8_WAIT_V(6); PG8_BAR; PG8_MMA(1, 1, At, B1); PG8_BAR;
            PG8_LDB(B0, 1, 0); PG8_SCHED; PG8_LDA(At, 1, 0); PG8_STAGE(PG8_SA(0, 1), a2 + hstep, voffA);
            PG8_WAIT_L(8); PG8_BAR; PG8_WAIT_L(0); PG8_MMA(0, 0, At, B0); PG8_BAR; PG8_SCHED;
            PG8_LDB(B1, 1, 1); PG8_STAGE(PG8_SB(1, 0), b3, voffB);
            PG8_BAR; PG8_WAIT_L(0); PG8_MMA(0, 1, At, B1); PG8_BAR;
            PG8_LDA(At, 1, 1); PG8_STAGE(PG8_SA(1, 0), a3, voffA);
            PG8_BAR; PG8_WAIT_L(0); PG8_MMA(1, 0, At, B0); PG8_BAR; PG8_SCHED;
            PG8_STAGE(PG8_SB(1, 1), b3 + hstep, voffB);
            PG8_WAIT_V(6); PG8_BAR; PG8_MMA(1, 1, At, B1); PG8_BAR;
        }
        PG8_STAMP();
        if constexpr (!Epi::AFTER_DRAIN) { E(acc, cur, wr, wc, fr, fq); S.done(cur); }
        PG8_STAMP();
        if (!has_next) break;
#pragma unroll
        for (int a = 0; a < 2; ++a)
#pragma unroll
            for (int b = 0; b < 2; ++b)
#pragma unroll
                for (int m = 0; m < 4; ++m)
#pragma unroll
                    for (int n = 0; n < 2; ++n) acc[a][b][m][n] = (f32x4){0.f, 0.f, 0.f, 0.f};
        cur = nxt; cA = nA; cB = nB; ++ui;
    }
    PG8_WAIT_V(0);
    if (wr == 0) PG8_BAR;
    PG8_BAR;
    if constexpr (Epi::AFTER_DRAIN) { E.fused(acc, cur, wr, wc, fr, fq, lds, wid, lane); S.done(cur); }
    PG8_STAMP();
    if (STAMP && wid == 0) { stamps[lane] = lane < nts ? (((unsigned long long)(unsigned)ts_hi << 32) | (unsigned)ts_lo) : 0ull;
        if (lane == 62) stamps[62] = rt_entry; if (lane == 63) stamps[63] = (unsigned long long)wall_clock64(); }
#undef PG8_STAMP
#undef PG8_SA
#undef PG8_SB
#undef PG8_STAGE
#undef PG8_LDA
#undef PG8_LDB
#undef PG8_MMA
#undef PG8_WAIT_V
#undef PG8_WAIT_L
#undef PG8_BAR
#undef PG8_SCHED
}
}

namespace mk {
using pg8::bf16_t; using pg8::bf16x8; using pg8::f32x4; using pg8::u32x4;
typedef short s16x4 __attribute__((ext_vector_type(4)));
typedef unsigned u32x2 __attribute__((ext_vector_type(2)));

constexpr int D = 2048, NB = 8, S = 2048, M = NB * S, BW = 1024, MIXW = 3072, PW = 13568, DEPTH = 2;
constexpr int C_AQ = 0, C_AK = 1024, C_AV = 2048, C_AG = 3072, C_B = 4096, C_BG = 7424, C_CQ = 8448, C_CI = 9472, C_CF = 10496, C_CG = 12544;
constexpr int NTHR = 512;
constexpr int LDS_BYTES = 147456;
constexpr float LOG2E = 1.4426950408889634f;

constexpr size_t OFF_CTL = 0;
constexpr size_t OFF_WIN = 4096;
constexpr size_t OFF_WOUT = OFF_WIN + (size_t)PW * D * 2;
constexpr size_t OFF_U = OFF_WOUT + (size_t)D * MIXW * 2;
constexpr size_t OFF_PROJ = OFF_U + (size_t)M * D * 2;
constexpr size_t OFF_MIXED = OFF_PROJ + (size_t)M * PW * 2;
constexpr size_t OFF_OC = OFF_MIXED + (size_t)M * MIXW * 2;
constexpr size_t OFF_AO = OFF_OC + (size_t)2 * M * BW * 2;
constexpr size_t OFF_BON = OFF_AO + (size_t)2 * M * BW * 2;
constexpr size_t WS_END = OFF_BON + (size_t)2 * M * 16 * 4;

struct Params { const float* in[23]; float* out; unsigned char* ws; };
__device__ __forceinline__ int opaque_tid() { int t = threadIdx.x; asm volatile("" : "+v"(t)); return t; }
__device__ __forceinline__ int opaque_s(int t) { asm volatile("" : "+s"(t)); return t; }
__device__ __forceinline__ int opaque_bid() { int t = blockIdx.x; asm volatile("" : "+s"(t)); return t; }


__device__ __forceinline__ float bf2f(bf16_t v) { return __uint_as_float(((unsigned)v) << 16); }
__device__ __forceinline__ bf16_t f2bf(float f) { unsigned u = __float_as_uint(f); u += 0x7FFFu + ((u >> 16) & 1u); return (bf16_t)(u >> 16); }
typedef __bf16 bf16x2_t __attribute__((ext_vector_type(2)));
typedef float f32x2c __attribute__((ext_vector_type(2)));
__device__ __forceinline__ unsigned pk2(float lo, float hi) { f32x2c v = {lo, hi}; bf16x2_t b = __builtin_convertvector(v, bf16x2_t); return __builtin_bit_cast(unsigned, b); }
__device__ __forceinline__ float wave_sum(float v) {
#pragma unroll
    for (int o = 1; o < 64; o <<= 1) v += __shfl_xor(v, o);
    return v;
}
__device__ __forceinline__ float sigmoidf_(float x) { return 1.f / (1.f + __expf(-x)); }
__device__ __forceinline__ float siluf_(float x) { return x / (1.f + __expf(-x)); }
__device__ __forceinline__ float dpp_xor1(float v) { return __int_as_float(__builtin_amdgcn_mov_dpp(__float_as_int(v), 0xB1, 0xF, 0xF, true)); }
__device__ __forceinline__ float dpp_xor2(float v) { return __int_as_float(__builtin_amdgcn_mov_dpp(__float_as_int(v), 0x4E, 0xF, 0xF, true)); }
__device__ __forceinline__ float dpp_hmir(float v) { return __int_as_float(__builtin_amdgcn_mov_dpp(__float_as_int(v), 0x141, 0xF, 0xF, true)); }
__device__ __forceinline__ float dpp_mir(float v) { return __int_as_float(__builtin_amdgcn_mov_dpp(__float_as_int(v), 0x140, 0xF, 0xF, true)); }
__device__ __forceinline__ float wave_sum_fast(float v) {
    v += dpp_xor1(v); v += dpp_xor2(v); v += dpp_hmir(v); v += dpp_mir(v);
    v += __shfl_xor(v, 16); v += __shfl_xor(v, 32);
    return v;
}
__device__ __forceinline__ float fast_tanh(float x) { return 1.f - 2.f * __builtin_amdgcn_rcpf(1.f + __expf(2.f * x)); }
__device__ __forceinline__ float fast_sigmoid(float x) { return __builtin_amdgcn_rcpf(1.f + __expf(-x)); }
typedef float f32x2 __attribute__((ext_vector_type(2)));
#define MFMA16(a, b, c) __builtin_amdgcn_mfma_f32_16x16x32_bf16((a), (b), (c), 0, 0, 0)
__device__ __forceinline__ bf16x8 join8(s16x4 lo, s16x4 hi) { return __builtin_shufflevector(lo, hi, 0, 1, 2, 3, 4, 5, 6, 7); }
__device__ __forceinline__ bf16x8 pack8(f32x4 a, f32x4 b) {
    u32x4 w; w.x = pk2(a[0], a[1]); w.y = pk2(a[2], a[3]); w.z = pk2(b[0], b[1]); w.w = pk2(b[2], b[3]);
    return __builtin_bit_cast(bf16x8, w);
}

__device__ __forceinline__ void transpose_tile(const float* __restrict__ W, int K, int N, bf16_t* __restrict__ WT, float* tile, int it) {
    const int tid = opaque_tid();
    const int ntn = N >> 6; const int kb = it / ntn, nbk = it - kb * ntn; const int k0 = kb * 64, n0 = nbk * 64;
#pragma unroll
    for (int rr = 0; rr < 2; ++rr) { const int idx = tid + rr * 512; const int kk = idx >> 4, n4 = (idx & 15) * 4;
        const float4 v = *(const float4*)(W + (size_t)(k0 + kk) * N + n0 + n4);
        float* tp = tile + kk * 65 + n4; tp[0] = v.x; tp[1] = v.y; tp[2] = v.z; tp[3] = v.w; }
    __syncthreads();
    { const int n = tid >> 3, kc = (tid & 7) * 8; const float* tp = tile + kc * 65 + n;
      u32x4 o; o.x = pk2(tp[0], tp[65]); o.y = pk2(tp[2 * 65], tp[3 * 65]); o.z = pk2(tp[4 * 65], tp[5 * 65]); o.w = pk2(tp[6 * 65], tp[7 * 65]);
      *(u32x4*)(WT + (size_t)(n0 + n) * K + k0 + kc) = o; }
    __syncthreads();
}
__device__ __forceinline__ void convert_weights(const Params& P, int layer, unsigned char* smem) {
    float* tile = (float*)smem;
    const float* win = P.in[4] + (size_t)layer * D * PW; const float* wout = P.in[5] + (size_t)layer * MIXW * D;
    bf16_t* WinT = (bf16_t*)(P.ws + OFF_WIN); bf16_t* WoutT = (bf16_t*)(P.ws + OFF_WOUT);
    constexpr int T_IN = (D / 64) * (PW / 64), T_OUT = (MIXW / 64) * (D / 64);
    for (int it = opaque_bid(); it < T_IN + T_OUT; it += gridDim.x) {
        if (it < T_IN) transpose_tile(win, D, PW, WinT, tile, it);
        else transpose_tile(wout, MIXW, D, WoutT, tile, it - T_IN);
    }
}
__device__ __forceinline__ void prenorm_rows(const float* __restrict__ x, const float* __restrict__ g, bf16_t* __restrict__ U) {
    const int tid_ = opaque_tid(); const int lane = tid_ & 63, gw = opaque_bid() * 8 + (tid_ >> 6), ngw = gridDim.x * 8;
    for (int row = gw; row < M; row += ngw) {
        const float4* xr = (const float4*)(x + (size_t)row * D) + lane;
        float4 v[8]; float ss = 0.f;
#pragma unroll
        for (int j = 0; j < 8; ++j) { v[j] = xr[64 * j]; ss += v[j].x * v[j].x + v[j].y * v[j].y + v[j].z * v[j].z + v[j].w * v[j].w; }
        const float rstd = rsqrtf(wave_sum(ss) * (1.f / D) + 1e-6f);
        u32x2* o = (u32x2*)(U + (size_t)row * D) + lane;
#pragma unroll
        for (int j = 0; j < 8; ++j) { const float4 gg = ((const float4*)g)[64 * j + lane];
            u32x2 w; w.x = pk2(v[j].x * rstd * gg.x, v[j].y * rstd * gg.y); w.y = pk2(v[j].z * rstd * gg.z, v[j].w * rstd * gg.w); o[64 * j] = w; }
    }
}
__device__ __forceinline__ void postnorm_rows(const float* __restrict__ y, const float* xin, float* xout, const float* __restrict__ gpost, const float* __restrict__ gpre, bf16_t* __restrict__ U) {
    const int tid_ = opaque_tid(); const int lane = tid_ & 63, gw = opaque_bid() * 8 + (tid_ >> 6), ngw = gridDim.x * 8;
    for (int row = gw; row < M; row += ngw) {
        const float4* yr = (const float4*)(y + (size_t)row * D) + lane;
        const float4* xr = (const float4*)(xin + (size_t)row * D) + lane;
        float4* xo = (float4*)(xout + (size_t)row * D) + lane;
        float4 v[8]; float ss = 0.f;
#pragma unroll
        for (int j = 0; j < 8; ++j) { v[j] = yr[64 * j]; ss += v[j].x * v[j].x + v[j].y * v[j].y + v[j].z * v[j].z + v[j].w * v[j].w; }
        const float rstd = rsqrtf(wave_sum(ss) * (1.f / D) + 1e-6f);
        float s2 = 0.f;
#pragma unroll
        for (int j = 0; j < 8; ++j) { const float4 gg = ((const float4*)gpost)[64 * j + lane]; const float4 xv = xr[64 * j];
            v[j].x = xv.x + v[j].x * rstd * gg.x; v[j].y = xv.y + v[j].y * rstd * gg.y; v[j].z = xv.z + v[j].z * rstd * gg.z; v[j].w = xv.w + v[j].w * rstd * gg.w;
            xo[64 * j] = v[j]; s2 += v[j].x * v[j].x + v[j].y * v[j].y + v[j].z * v[j].z + v[j].w * v[j].w; }
        if (gpre) {
            const float r2 = rsqrtf(wave_sum(s2) * (1.f / D) + 1e-6f);
            u32x2* o = (u32x2*)(U + (size_t)row * D) + lane;
#pragma unroll
            for (int j = 0; j < 8; ++j) { const float4 gg = ((const float4*)gpre)[64 * j + lane];
                u32x2 w; w.x = pk2(v[j].x * r2 * gg.x, v[j].y * r2 * gg.y); w.y = pk2(v[j].z * r2 * gg.z, v[j].w * r2 * gg.w); o[64 * j] = w; }
        }
    }
}

#define RWKV_LOAD_RAW(cc) do { const int n0_ = (cc) * TCH + pw * TPW; const int T0_ = d ? (S - 1 - n0_) : n0_; const int dstep_ = d ? -1 : 1; \
    _Pragma("unroll") for (int j = 0; j < TPW + 2; ++j) { const int tj = T0_ + (j - 1) * dstep_; const bool ok = (tj >= 0) && (tj < S); \
        const bf16_t* row = proj + ((size_t)b * S + (ok ? tj : T0_)) * PW + C_B; \
        raw[j][0] = row[cr]; raw[j][1] = row[ck]; raw[j][2] = row[cv]; raw[j][3] = row[cw]; raw[j][4] = row[ca]; \
        if (!ok) { raw[j][0] = 0; raw[j][1] = 0; raw[j][2] = 0; raw[j][3] = 0; raw[j][4] = 0; } } } while (0)
__device__ __forceinline__ void rwkv_phase(const Params& P, int layer, unsigned char* smem) {
    constexpr int TCH = 16, TPW = 4, NCH = S / TCH;
    float* VEC = (float*)smem;
    bf16_t* UPT = (bf16_t*)(smem + 49152);
    unsigned char* pbase = smem + 49152 + 18432;
    unsigned char* obase = smem + 49152 + 18432 + 12800;
    unsigned char* nbase = obase + 2 * 18176;
    const int tid = opaque_tid(), wid = __builtin_amdgcn_readfirstlane(tid >> 6), lane = tid & 63, r16 = lane & 15, quad = lane >> 4;
    const bf16_t* proj = (const bf16_t*)(P.ws + OFF_PROJ);
    bf16_t* YB = (bf16_t*)(P.ws + OFF_U);
    float* BON = (float*)(P.ws + OFF_BON);
    const float* mu = P.in[11] + (size_t)layer * 2 * 3328;
    for (int chain = opaque_bid(); chain < 256; chain += gridDim.x) {
        const int d = chain >> 7, b = (chain >> 4) & 7, h = chain & 15;
        __syncthreads();
        { const float* wup = P.in[13] + ((size_t)(layer * 2 + d) * 64) * 1024 + h * 64; const float* aup = P.in[15] + ((size_t)(layer * 2 + d) * 64) * 1024 + h * 64;
#pragma unroll
          for (int it = 0; it < 16; ++it) { const int e = tid + 512 * it; const int mat = e >> 12, lora = (e >> 6) & 63, ch = e & 63;
              const float v = (mat ? aup : wup)[(size_t)lora * 1024 + ch]; UPT[mat * 4608 + ch * 72 + lora] = f2bf(v); } }
        __syncthreads();
        if (wid < 4) {
            const int cw = wid;
            float* Nm = (float*)(nbase + cw * 1024);
            const int jl = lane & 15, tg = lane >> 4, jcol = cw * 16 + jl;
            const float rkc = P.in[18][(size_t)layer * 1024 + h * 64 + jcol];
            const f32x4 z4 = {0.f, 0.f, 0.f, 0.f};
            f32x4 ST[4];
#pragma unroll
            for (int mt = 0; mt < 4; ++mt) ST[mt] = z4;
            asm volatile("s_waitcnt lgkmcnt(0)" ::: "memory"); __builtin_amdgcn_s_barrier(); asm volatile("" ::: "memory");
            asm volatile("s_waitcnt lgkmcnt(0)" ::: "memory"); __builtin_amdgcn_s_barrier(); asm volatile("" ::: "memory");
            for (int c = 0; c < NCH; ++c) {
                const float* vb = VEC + (c & 1) * (TCH * 384);
                unsigned char* ob = obase + (c & 1) * 18176;
                bf16_t* Pm = (bf16_t*)ob; bf16_t* Rm = (bf16_t*)(ob + 2304); bf16_t* Qm = (bf16_t*)(ob + 4608); bf16_t* Mm = (bf16_t*)(ob + 6912);
                bf16_t* QT = (bf16_t*)(ob + 9216); bf16_t* MT = (bf16_t*)(ob + 12288); float* GT = (float*)(ob + 15360); bf16_t* Bm = (bf16_t*)(ob + 15872);
                {
                    float nk[4], ww[4], ka[4], km[4], rr[4];
#pragma unroll
                    for (int u = 0; u < 4; ++u) { const float* vt = vb + (4 * tg + u) * 384 + jcol; nk[u] = vt[0]; ww[u] = vt[64]; ka[u] = vt[128]; km[u] = vt[192]; rr[u] = vt[256]; }
                    float gl[4];
                    gl[0] = ww[0]; gl[1] = gl[0] * ww[1]; gl[2] = gl[1] * ww[2]; gl[3] = gl[2] * ww[3];
                    const float G0 = __shfl(gl[3], jl), G1 = __shfl(gl[3], jl + 16), G2 = __shfl(gl[3], jl + 32);
                    const float pre = (tg == 0) ? 1.f : (tg == 1) ? G0 : (tg == 2) ? G0 * G1 : (G0 * G1) * G2;
                    float pv[4], rv[4], qv[4], mv[4];
#pragma unroll
                    for (int u = 0; u < 4; ++u) {
                        const float gprev = (u == 0) ? pre : pre * gl[u - 1], gcur = pre * gl[u];
                        const float ig = __builtin_amdgcn_rcpf(gcur);
                        pv[u] = gprev * nk[u]; qv[u] = ka[u] * ig; mv[u] = km[u] * ig; rv[u] = gcur * rr[u];
                    }
                    const unsigned wp0 = pk2(pv[0], pv[1]), wp1 = pk2(pv[2], pv[3]), wr0 = pk2(rv[0], rv[1]), wr1 = pk2(rv[2], rv[3]);
                    const unsigned wq0 = pk2(qv[0], qv[1]), wq1 = pk2(qv[2], qv[3]), wm0 = pk2(mv[0], mv[1]), wm1 = pk2(mv[2], mv[3]);
                    const int t0 = 4 * tg;
                    Pm[(t0) * 72 + jcol] = (bf16_t)(wp0 & 0xFFFFu); Pm[(t0 + 1) * 72 + jcol] = (bf16_t)(wp0 >> 16); Pm[(t0 + 2) * 72 + jcol] = (bf16_t)(wp1 & 0xFFFFu); Pm[(t0 + 3) * 72 + jcol] = (bf16_t)(wp1 >> 16);
                    Rm[(t0) * 72 + jcol] = (bf16_t)(wr0 & 0xFFFFu); Rm[(t0 + 1) * 72 + jcol] = (bf16_t)(wr0 >> 16); Rm[(t0 + 2) * 72 + jcol] = (bf16_t)(wr1 & 0xFFFFu); Rm[(t0 + 3) * 72 + jcol] = (bf16_t)(wr1 >> 16);
                    Qm[(t0) * 72 + jcol] = (bf16_t)(wq0 & 0xFFFFu); Qm[(t0 + 1) * 72 + jcol] = (bf16_t)(wq0 >> 16); Qm[(t0 + 2) * 72 + jcol] = (bf16_t)(wq1 & 0xFFFFu); Qm[(t0 + 3) * 72 + jcol] = (bf16_t)(wq1 >> 16);
                    Mm[(t0) * 72 + jcol] = (bf16_t)(wm0 & 0xFFFFu); Mm[(t0 + 1) * 72 + jcol] = (bf16_t)(wm0 >> 16); Mm[(t0 + 2) * 72 + jcol] = (bf16_t)(wm1 & 0xFFFFu); Mm[(t0 + 3) * 72 + jcol] = (bf16_t)(wm1 >> 16);
                    u32x2 tq; tq.x = wq0; tq.y = wq1; *(u32x2*)(QT + jcol * 24 + t0) = tq;
                    u32x2 tm; tm.x = wm0; tm.y = wm1; *(u32x2*)(MT + jcol * 24 + t0) = tm;
                    { const unsigned wb0 = pk2(rv[0] * rkc, rv[1] * rkc), wb1 = pk2(rv[2] * rkc, rv[3] * rkc);
                      Bm[(t0) * 72 + jcol] = (bf16_t)(wb0 & 0xFFFFu); Bm[(t0 + 1) * 72 + jcol] = (bf16_t)(wb0 >> 16); Bm[(t0 + 2) * 72 + jcol] = (bf16_t)(wb1 & 0xFFFFu); Bm[(t0 + 3) * 72 + jcol] = (bf16_t)(wb1 >> 16); }
                    if (tg == 3) GT[jcol] = pre * gl[3];
                }
                asm volatile("s_waitcnt lgkmcnt(0)" ::: "memory"); __builtin_amdgcn_s_barrier(); asm volatile("" ::: "memory");
                f32x4 Gqp = z4, Gmp = z4, Gqr = z4, Gmr = z4, Npq = z4;
#pragma unroll
                for (int ks = 0; ks < 2; ++ks) {
                    const bf16x8 aQ = *(const bf16x8*)(Qm + r16 * 72 + ks * 32 + quad * 8), aM = *(const bf16x8*)(Mm + r16 * 72 + ks * 32 + quad * 8);
                    const bf16x8 bP = *(const bf16x8*)(Pm + r16 * 72 + ks * 32 + quad * 8), bR = *(const bf16x8*)(Rm + r16 * 72 + ks * 32 + quad * 8);
                    Gqp = MFMA16(aQ, bP, Gqp); Gmp = MFMA16(aM, bP, Gmp); Gqr = MFMA16(aQ, bR, Gqr); Gmr = MFMA16(aM, bR, Gmr); Npq = MFMA16(bP, aQ, Npq);
                }
                if (cw == 0) {
                    f32x4 Gmb = z4;
#pragma unroll
                    for (int ks = 0; ks < 2; ++ks) Gmb = MFMA16(*(const bf16x8*)(Mm + r16 * 72 + ks * 32 + quad * 8), *(const bf16x8*)(Bm + r16 * 72 + ks * 32 + quad * 8), Gmb);
                    if (quad == (r16 >> 2)) {
                        const int rsel = r16 & 3;
                        const float bon = (rsel == 0) ? Gmb[0] : (rsel == 1) ? Gmb[1] : (rsel == 2) ? Gmb[2] : Gmb[3];
                        const int n = c * TCH + r16; const int t = d ? (S - 1 - n) : n;
                        BON[(((size_t)d * NB + b) * 16 + h) * S + t] = bon;
                    }
                }
#pragma unroll
                for (int rg = 0; rg < 4; ++rg) { const int sI = quad * 4 + rg;
                    if (sI >= r16) { Gqp[rg] = 0.f; Gmp[rg] = 0.f; }
                    if (sI > r16) { Gqr[rg] = 0.f; Gmr[rg] = 0.f; }
                    if (sI <= r16) Npq[rg] = 0.f; }
                f32x4 SA0 = z4, Y0 = z4;
#pragma unroll
                for (int ks = 0; ks < 2; ++ks) {
                    const bf16x8 sb = pack8(ST[2 * ks], ST[2 * ks + 1]);
                    const bf16_t* pp = Pm + r16 * 72 + ks * 32 + quad * 4; const bf16_t* rp = Rm + r16 * 72 + ks * 32 + quad * 4;
                    const bf16x8 pa = join8(*(const s16x4*)pp, *(const s16x4*)(pp + 16)), ra = join8(*(const s16x4*)rp, *(const s16x4*)(rp + 16));
                    SA0 = MFMA16(pa, sb, SA0); Y0 = MFMA16(ra, sb, Y0);
                }
                f32x4 Vv;
#pragma unroll
                for (int jj = 0; jj < 4; ++jj) Vv[jj] = vb[(quad * 4 + jj) * 384 + 320 + cw * 16 + r16];
                const f32x4 Cc = MFMA16(pack8(Gmp, z4), pack8(Vv, z4), SA0);
                const bf16x8 m1 = pack8(Gqp, z4), n1 = pack8(Npq, z4);
                const f32x4 Mc2 = MFMA16(n1, m1, z4), Nc2 = MFMA16(m1, n1, z4);
                const bf16x8 m2 = pack8(Mc2, z4), n2 = pack8(Nc2, z4);
                const f32x4 Mc4 = MFMA16(n2, m2, z4), Nc4 = MFMA16(m2, n2, z4);
                const bf16x8 m4 = pack8(Mc4, z4), n4 = pack8(Nc4, z4);
                const f32x4 Mc8 = MFMA16(n4, m4, z4);
                f32x4 SAc = MFMA16(pack8(Mc8, z4), pack8(Cc, z4), Cc);
                SAc = MFMA16(m4, pack8(SAc, z4), SAc);
                SAc = MFMA16(m2, pack8(SAc, z4), SAc);
                SAc = MFMA16(m1, pack8(SAc, z4), SAc);
                const bf16x8 Bsv = pack8(SAc, Vv);
                const f32x4 Yc = MFMA16(pack8(Gqr, Gmr), Bsv, Y0);
#pragma unroll
                for (int rg = 0; rg < 4; ++rg) { const int n = c * TCH + quad * 4 + rg; const int t = d ? (S - 1 - n) : n;
                    YB[((size_t)d * M + (size_t)b * S + t) * 1024 + h * 64 + cw * 16 + r16] = f2bf(Yc[rg]); }
#pragma unroll
                for (int mt = 0; mt < 4; ++mt) {
                    const bf16_t* qp = QT + (mt * 16 + r16) * 24 + quad * 4; const bf16_t* mp = MT + (mt * 16 + r16) * 24 + quad * 4;
                    const f32x4 acc = MFMA16(join8(*(const s16x4*)qp, *(const s16x4*)mp), Bsv, ST[mt]);
                    const f32x4 gt = *(const f32x4*)(GT + mt * 16 + quad * 4);
                    ST[mt] = acc * gt;
                }
                asm volatile("s_waitcnt lgkmcnt(0)" ::: "memory"); __builtin_amdgcn_s_barrier(); asm volatile("" ::: "memory");
            }
        } else {
            const int pw = wid - 4;
            bf16_t* Aw = (bf16_t*)(pbase + pw * 3200); bf16_t* Aa = Aw + TPW * 72; float* X = (float*)(pbase + pw * 3200 + 1152);
            const int cr = h * 64 + lane, ck = 1024 + h * 64 + lane, cv = 2048 + h * 64 + lane, cw = 3072 + d * 64 + lane, ca = 3200 + d * 64 + lane;
            const int mo0 = d ? 3328 : 0, mo1 = d ? 0 : 3328;
            const float mr0 = mu[mo0 + cr], mr1 = mu[mo1 + cr], mk0 = mu[mo0 + ck], mk1 = mu[mo1 + ck], mv0 = mu[mo0 + cv], mv1 = mu[mo1 + cv];
            const float mw0 = mu[mo0 + cw], mw1 = mu[mo1 + cw], ma0 = mu[mo0 + ca], ma1 = mu[mo1 + ca];
            const int chn = h * 64 + lane;
            const float w0v = P.in[12][(size_t)(layer * 2 + d) * 1024 + chn], a0v = P.in[14][(size_t)(layer * 2 + d) * 1024 + chn];
            const float kkw = P.in[16][(size_t)layer * 1024 + chn], kaw = P.in[17][(size_t)layer * 1024 + chn], rkw = P.in[18][(size_t)layer * 1024 + chn];
            unsigned short raw[TPW + 2][5];
            RWKV_LOAD_RAW(0);
            for (int c = 0; c < NCH + 1; ++c) {
                if (c < NCH) {
                    float* vb = VEC + (c & 1) * (TCH * 384);
                    float rr[TPW], kv[TPW], vv[TPW], kk[TPW];
                    {
                        float fr[TPW + 2][5];
#pragma unroll
                        for (int j = 0; j < TPW + 2; ++j)
#pragma unroll
                            for (int st = 0; st < 5; ++st) fr[j][st] = bf2f(raw[j][st]);
                        if (c + 1 < NCH) { RWKV_LOAD_RAW(c + 1); }
#pragma unroll
                        for (int i = 0; i < TPW; ++i) {
                            float p0, pa, pb;
                            p0 = fr[i + 1][0]; pa = fr[i][0]; pb = fr[i + 2][0]; rr[i] = p0 + mr0 * (pa - p0) + mr1 * (pb - p0);
                            p0 = fr[i + 1][1]; pa = fr[i][1]; pb = fr[i + 2][1]; kv[i] = p0 + mk0 * (pa - p0) + mk1 * (pb - p0);
                            p0 = fr[i + 1][2]; pa = fr[i][2]; pb = fr[i + 2][2]; vv[i] = p0 + mv0 * (pa - p0) + mv1 * (pb - p0);
                            p0 = fr[i + 1][3]; pa = fr[i][3]; pb = fr[i + 2][3]; const float wd = p0 + mw0 * (pa - p0) + mw1 * (pb - p0);
                            p0 = fr[i + 1][4]; pa = fr[i][4]; pb = fr[i + 2][4]; const float ad = p0 + ma0 * (pa - p0) + ma1 * (pb - p0);
                            Aw[i * 72 + lane] = f2bf(fast_tanh(wd)); Aa[i * 72 + lane] = f2bf(ad);
                            const float k2 = kv[i] * kkw; const float n2 = wave_sum_fast(k2 * k2);
                            kk[i] = k2 * __builtin_amdgcn_rsqf(fmaxf(n2, 1e-24f));
                        }
                    }
                    asm volatile("s_waitcnt lgkmcnt(0)" ::: "memory"); __builtin_amdgcn_s_barrier(); asm volatile("" ::: "memory");
#pragma unroll
                    for (int mat = 0; mat < 2; ++mat) {
                        const bf16_t* A = mat ? Aa : Aw;
                        const bf16x8 a0f = *(const bf16x8*)(A + (r16 & (TPW - 1)) * 72 + quad * 8), a1f = *(const bf16x8*)(A + (r16 & (TPW - 1)) * 72 + 32 + quad * 8);
#pragma unroll
                        for (int nt = 0; nt < 4; ++nt) {
                            const bf16_t* B = UPT + mat * 4608 + (nt * 16 + r16) * 72 + quad * 8;
                            f32x4 acc = {0.f, 0.f, 0.f, 0.f};
                            acc = MFMA16(a0f, *(const bf16x8*)B, acc); acc = MFMA16(a1f, *(const bf16x8*)(B + 32), acc);
                            if (quad == 0) {
#pragma unroll
                                for (int rg = 0; rg < 4; ++rg) X[mat * 256 + rg * 64 + nt * 16 + r16] = acc[rg];
                            }
                        }
                    }
                    asm volatile("s_waitcnt lgkmcnt(0)" ::: "memory");
#pragma unroll
                    for (int i = 0; i < TPW; ++i) {
                        const int s = pw * TPW + i; const int n = c * TCH + s; const int t = d ? (S - 1 - n) : n;
                        const float xw = X[i * 64 + lane] + w0v, xa = X[256 + i * 64 + lane] + a0v;
                        const float dec = __expf(-0.6065306597126334f * fast_sigmoid(xw)); const float av = fast_sigmoid(xa);
                        const float kmod = kv[i] * (1.f + (av - 1.f) * kaw); const float kka = kk[i] * av;
                        float* o = vb + s * 384 + lane;
                        o[0] = -kk[i]; o[64] = dec; o[128] = kka; o[192] = kmod; o[256] = rr[i]; o[320] = vv[i];
                    }
                }
                if (c == NCH) { asm volatile("s_waitcnt lgkmcnt(0)" ::: "memory"); __builtin_amdgcn_s_barrier(); asm volatile("" ::: "memory"); }
                asm volatile("s_waitcnt lgkmcnt(0)" ::: "memory"); __builtin_amdgcn_s_barrier(); asm volatile("" ::: "memory");
            }
        }
    }
}

__device__ __forceinline__ int swz40(int row, int s) { return row * 40 + ((((s >> 3) ^ (row >> 3)) & 3) << 3) + (s & 7); }
__device__ __forceinline__ void hgrn_phase(const Params& P, int layer, unsigned char* smem) {
    bf16_t* QE = (bf16_t*)smem; bf16_t* KE = (bf16_t*)(smem + 8704); bf16_t* KLT = (bf16_t*)(smem + 17408); bf16_t* VT = (bf16_t*)(smem + 27648);
    float* LF = (float*)(smem + 37888); float* EL = (float*)(smem + 54272);
    const int tid = opaque_tid(), wid = __builtin_amdgcn_readfirstlane(tid >> 6), lane = tid & 63, r16 = lane & 15, quad = lane >> 4;
    const bf16_t* proj = (const bf16_t*)(P.ws + OFF_PROJ);
    bf16_t* OC = (bf16_t*)(P.ws + OFF_OC);
    const int es = tid >> 4, ekc = (tid & 15) * 8;
    for (int chain = opaque_bid(); chain < 128; chain += gridDim.x) {
        const int d = chain >> 6, b = (chain >> 3) & 7, h = chain & 7;
        float lb[8];
#pragma unroll
        for (int j = 0; j < 8; ++j) lb[j] = 0.f;
        if (layer > 0) {
#pragma unroll
            for (int j = 0; j < 8; ++j) { const float l0 = P.in[21][(size_t)(d * 2 + 0) * 1024 + h * 128 + ekc + j], l1 = P.in[21][(size_t)(d * 2 + 1) * 1024 + h * 128 + ekc + j]; lb[j] = 1.f / (1.f + __expf(l0 - l1)); }
        }
        f32x4 Sacc[8];
#pragma unroll
        for (int mt = 0; mt < 8; ++mt) Sacc[mt] = (f32x4){0.f, 0.f, 0.f, 0.f};
        u32x4 zraw, qraw, vraw;
        { const int t = d ? (S - 1 - es) : es; const bf16_t* row = proj + ((size_t)b * S + t) * PW + h * 128 + ekc;
          zraw = *(const u32x4*)(row + C_CF + d * 1024); qraw = *(const u32x4*)(row + C_CQ); vraw = *(const u32x4*)(row + C_CI); }
        for (int c = 0; c < 64; ++c) {
            __syncthreads();
            { const int n = c * 32 + es; const int t = d ? (S - 1 - n) : n; const bf16_t* row = proj + ((size_t)b * S + t) * PW + h * 128 + ekc;
              zraw = *(const u32x4*)(row + C_CF + d * 1024); qraw = *(const u32x4*)(row + C_CQ); vraw = *(const u32x4*)(row + C_CI); }
            float kval[8];
            {
                float lf[8];
#pragma unroll
                for (int j = 0; j < 8; ++j) {
                    const unsigned wv = zraw[j >> 1]; const float z = (j & 1) ? __uint_as_float(wv & 0xFFFF0000u) : __uint_as_float(wv << 16);
                    const float e = __expf(-fabsf(z));
                    const float ls = fminf(z, 0.f) - __logf(1.f + e);
                    const float sg = (z >= 0.f ? 1.f : e) * __builtin_amdgcn_rcpf(1.f + e);
                    lf[j] = (lb[j] > 0.f) ? __logf(lb[j] + (1.f - lb[j]) * sg) : ls;
                    kval[j] = (1.f - lb[j]) * (1.f - sg);
                }
                *(f32x4*)(LF + es * 128 + ekc) = (f32x4){lf[0], lf[1], lf[2], lf[3]}; *(f32x4*)(LF + es * 128 + ekc + 4) = (f32x4){lf[4], lf[5], lf[6], lf[7]};
#pragma unroll
                for (int j = 0; j < 8; ++j) { const unsigned wv = vraw[j >> 1]; VT[swz40(ekc + j, es)] = (bf16_t)((j & 1) ? (wv >> 16) : (wv & 0xFFFFu)); }
            }
            __syncthreads();
            if (tid < 128) {
                float cum = 0.f;
#pragma unroll
                for (int s = 0; s < 32; ++s) { cum += LF[s * 128 + tid]; LF[s * 128 + tid] = cum; }
                EL[tid] = __expf(cum);
            }
            __syncthreads();
            {
                const f32x4 c0 = *(const f32x4*)(LF + es * 128 + ekc), c1v = *(const f32x4*)(LF + es * 128 + ekc + 4);
                const f32x4 l0 = *(const f32x4*)(LF + 31 * 128 + ekc), l1 = *(const f32x4*)(LF + 31 * 128 + ekc + 4);
                float qe[8], ke[8];
#pragma unroll
                for (int j = 0; j < 8; ++j) {
                    const unsigned wv = qraw[j >> 1]; const float qv = (j & 1) ? __uint_as_float(wv & 0xFFFF0000u) : __uint_as_float(wv << 16);
                    const float cum = (j < 4) ? c0[j & 3] : c1v[j & 3], last = (j < 4) ? l0[j & 3] : l1[j & 3];
                    qe[j] = qv * __expf(cum); ke[j] = kval[j] * __expf(-cum);
                    KLT[swz40(ekc + j, es)] = f2bf(kval[j] * __expf(last - cum));
                }
                u32x4 w; w.x = pk2(qe[0], qe[1]); w.y = pk2(qe[2], qe[3]); w.z = pk2(qe[4], qe[5]); w.w = pk2(qe[6], qe[7]); *(u32x4*)(QE + es * 136 + ekc) = w;
                w.x = pk2(ke[0], ke[1]); w.y = pk2(ke[2], ke[3]); w.z = pk2(ke[4], ke[5]); w.w = pk2(ke[6], ke[7]); *(u32x4*)(KE + es * 136 + ekc) = w;
            }
            if (false) { const int n = (c + 1) * 32 + es; const int t = d ? (S - 1 - n) : n; const bf16_t* row = proj + ((size_t)b * S + t) * PW + h * 128 + ekc;
                zraw = *(const u32x4*)(row + C_CF + d * 1024); qraw = *(const u32x4*)(row + C_CQ); vraw = *(const u32x4*)(row + C_CI); }
            __syncthreads();
            f32x4 sc00 = {0.f, 0.f, 0.f, 0.f}, sc01 = sc00, sc11 = sc00;
#pragma unroll
            for (int ks = 0; ks < 4; ++ks) {
                const bf16x8 ke0 = *(const bf16x8*)(KE + r16 * 136 + ks * 32 + quad * 8), ke1 = *(const bf16x8*)(KE + (16 + r16) * 136 + ks * 32 + quad * 8);
                const bf16x8 qe0 = *(const bf16x8*)(QE + r16 * 136 + ks * 32 + quad * 8), qe1 = *(const bf16x8*)(QE + (16 + r16) * 136 + ks * 32 + quad * 8);
                sc00 = MFMA16(ke0, qe0, sc00); sc01 = MFMA16(ke0, qe1, sc01); sc11 = MFMA16(ke1, qe1, sc11);
            }
#pragma unroll
            for (int rg = 0; rg < 4; ++rg) { if (quad * 4 + rg > r16) { sc00[rg] = 0.f; sc11[rg] = 0.f; } }
            const f32x4 zero4 = {0.f, 0.f, 0.f, 0.f};
            const bf16x8 p0 = pack8(sc00, zero4), p1 = pack8(sc01, sc11);
            const int vrow_i = wid * 16 + r16;
            const bf16x8 vperm = join8(*(const s16x4*)(VT + swz40(vrow_i, quad * 4)), *(const s16x4*)(VT + swz40(vrow_i, 16 + quad * 4)));
            f32x4 o0 = MFMA16(p0, vperm, zero4), o1 = MFMA16(p1, vperm, zero4);
#pragma unroll
            for (int ks = 0; ks < 4; ++ks) {
                const bf16x8 sb = pack8(Sacc[2 * ks], Sacc[2 * ks + 1]);
                const bf16_t* q0p = QE + r16 * 136 + ks * 32 + quad * 4; const bf16_t* q1p = QE + (16 + r16) * 136 + ks * 32 + quad * 4;
                const bf16x8 qa0 = join8(*(const s16x4*)q0p, *(const s16x4*)(q0p + 16)), qa1 = join8(*(const s16x4*)q1p, *(const s16x4*)(q1p + 16));
                o0 = MFMA16(qa0, sb, o0); o1 = MFMA16(qa1, sb, o1);
            }
#pragma unroll
            for (int rg = 0; rg < 4; ++rg) {
                { const int n = c * 32 + quad * 4 + rg; const int t = d ? (S - 1 - n) : n; OC[((size_t)d * M + (size_t)b * S + t) * 1024 + h * 128 + wid * 16 + r16] = f2bf(o0[rg]); }
                { const int n = c * 32 + 16 + quad * 4 + rg; const int t = d ? (S - 1 - n) : n; OC[((size_t)d * M + (size_t)b * S + t) * 1024 + h * 128 + wid * 16 + r16] = f2bf(o1[rg]); }
            }
            const bf16x8 vnat = *(const bf16x8*)(VT + swz40(vrow_i, quad * 8));
#pragma unroll
            for (int mt = 0; mt < 8; ++mt) {
                const f32x4 el = *(const f32x4*)(EL + mt * 16 + quad * 4);
                f32x4 sa = Sacc[mt] * el;
                const bf16x8 kl = *(const bf16x8*)(KLT + swz40(mt * 16 + r16, quad * 8));
                Sacc[mt] = MFMA16(kl, vnat, sa);
            }
        }
    }
}

__device__ __forceinline__ void attn_phase(const Params& P, int layer, unsigned char* smem, unsigned* counter) {
    float* TAB = (float*)smem; bf16_t* KT = (bf16_t*)(smem + 16384); bf16_t* VTt = (bf16_t*)(smem + 16384 + 9216); int* sh_unit = (int*)(smem + 16384 + 9216 + 18432);
    const int tid = opaque_tid(), wid = __builtin_amdgcn_readfirstlane(tid >> 6), lane = tid & 63, r16 = lane & 15, quad = lane >> 4;
    const bf16_t* proj = (const bf16_t*)(P.ws + OFF_PROJ);
    bf16_t* AO = (bf16_t*)(P.ws + OFF_AO);
    const float* rel_bias = P.in[1];
    const float c1 = 0.125f * LOG2E;
    for (;;) {
        __syncthreads();
        if (tid == 0) *sh_unit = (int)atomicAdd(counter, 1u);
        __syncthreads();
        const int u = *sh_unit;
        if (u >= 1024) break;
        const int qb = u & 7, m = (u >> 3) & 1, h = (u >> 4) & 7, b = u >> 7;
        for (int e = tid; e < 4095; e += 512) { const int rel = e - 2047; const int n = rel < 0 ? -rel : rel; int bk;
            if (n < 8) bk = n; else { const int lg = 31 - __clz(n * n); bk = 2 + lg; if (bk > 15) bk = 15; }
            if (rel > 0) bk += 16; TAB[e] = rel_bias[bk * 8 + h] * LOG2E; }
        const int qrow0 = qb * 256 + wid * 32;
        bf16x8 Qf[2][2];
#pragma unroll
        for (int nq = 0; nq < 2; ++nq)
#pragma unroll
            for (int ks = 0; ks < 2; ++ks) Qf[nq][ks] = *(const bf16x8*)(proj + ((size_t)b * S + qrow0 + nq * 16 + r16) * PW + C_AQ + h * 128 + m * 64 + ks * 32 + quad * 8);
        f32x4 O[2][8];
#pragma unroll
        for (int nq = 0; nq < 2; ++nq)
#pragma unroll
            for (int dt = 0; dt < 8; ++dt) O[nq][dt] = (f32x4){0.f, 0.f, 0.f, 0.f};
        float mrun[2] = {-1e30f, -1e30f}, lrun[2] = {0.f, 0.f};
        const int kkey = tid >> 3, kchunk = tid & 7;
        const int vkp = tid & 31, vchunk = tid >> 5;
        const bf16_t* kbase = proj + ((size_t)b * S + kkey) * PW + C_AK + h * 128 + m * 64 + kchunk * 8;
        const bf16_t* vbase = proj + ((size_t)b * S + 2 * vkp) * PW + C_AV + h * 128 + vchunk * 8;
        u32x4 kreg = *(const u32x4*)kbase, vreg0 = *(const u32x4*)vbase, vreg1 = *(const u32x4*)(vbase + PW);
        for (int kt = 0; kt < 32; ++kt) {
            __syncthreads();
            *(u32x4*)(KT + kkey * 72 + kchunk * 8) = kreg;
            { unsigned* vd = (unsigned*)(VTt + (vchunk * 8) * 72 + 2 * vkp);
#pragma unroll
              for (int i2 = 0; i2 < 4; ++i2) { const unsigned a = vreg0[i2], bq = vreg1[i2];
                  vd[(2 * i2) * 36] = (a & 0xFFFFu) | (bq << 16); vd[(2 * i2 + 1) * 36] = (a >> 16) | (bq & 0xFFFF0000u); } }
            __syncthreads();
            if (kt + 1 < 32) { const size_t adv = (size_t)(kt + 1) * 64 * PW; kreg = *(const u32x4*)(kbase + adv); vreg0 = *(const u32x4*)(vbase + adv); vreg1 = *(const u32x4*)(vbase + adv + PW); }
            const int k0 = kt * 64;
            f32x4 st[2][4];
#pragma unroll
            for (int mt = 0; mt < 4; ++mt) {
                const bf16x8 ka = *(const bf16x8*)(KT + (mt * 16 + r16) * 72 + quad * 8), kb2 = *(const bf16x8*)(KT + (mt * 16 + r16) * 72 + 32 + quad * 8);
#pragma unroll
                for (int nq = 0; nq < 2; ++nq) { f32x4 a = {0.f, 0.f, 0.f, 0.f}; a = MFMA16(ka, Qf[nq][0], a); a = MFMA16(kb2, Qf[nq][1], a); st[nq][mt] = a; }
            }
            const bool posfar = (k0 - (qrow0 + 31)) >= 96, negfar = (qrow0 - (k0 + 63)) >= 96;
            if (posfar || negfar) {
                const float cb = posfar ? TAB[2047 + 128] : TAB[2047 - 128];
#pragma unroll
                for (int nq = 0; nq < 2; ++nq)
#pragma unroll
                    for (int mt = 0; mt < 4; ++mt) st[nq][mt] = st[nq][mt] * c1 + cb;
            } else {
#pragma unroll
                for (int nq = 0; nq < 2; ++nq)
#pragma unroll
                    for (int mt = 0; mt < 4; ++mt) { const float* tp = TAB + (k0 + mt * 16 + quad * 4) - (qrow0 + nq * 16 + r16) + 2047;
#pragma unroll
                        for (int rg = 0; rg < 4; ++rg) st[nq][mt][rg] = st[nq][mt][rg] * c1 + tp[rg]; }
            }
            bf16x8 pf[2][2];
#pragma unroll
            for (int nq = 0; nq < 2; ++nq) {
                float mx = st[nq][0][0];
#pragma unroll
                for (int mt = 0; mt < 4; ++mt)
#pragma unroll
                    for (int rg = 0; rg < 4; ++rg) mx = fmaxf(mx, st[nq][mt][rg]);
                mx = fmaxf(mx, __shfl_xor(mx, 16)); mx = fmaxf(mx, __shfl_xor(mx, 32));
                const float mnew = fmaxf(mrun[nq], mx); const float alpha = __builtin_amdgcn_exp2f(mrun[nq] - mnew); mrun[nq] = mnew;
                float ps = 0.f;
#pragma unroll
                for (int mt = 0; mt < 4; ++mt)
#pragma unroll
                    for (int rg = 0; rg < 4; ++rg) { const float pv = __builtin_amdgcn_exp2f(st[nq][mt][rg] - mnew); st[nq][mt][rg] = pv; ps += pv; }
                lrun[nq] = lrun[nq] * alpha + ps;
#pragma unroll
                for (int dt = 0; dt < 8; ++dt) O[nq][dt] = O[nq][dt] * alpha;
                pf[nq][0] = pack8(st[nq][0], st[nq][1]); pf[nq][1] = pack8(st[nq][2], st[nq][3]);
            }
#pragma unroll
            for (int dt = 0; dt < 8; ++dt) {
                const bf16_t* vr = VTt + (dt * 16 + r16) * 72 + quad * 4;
                const bf16x8 va0 = join8(*(const s16x4*)vr, *(const s16x4*)(vr + 16)), va1 = join8(*(const s16x4*)(vr + 32), *(const s16x4*)(vr + 48));
#pragma unroll
                for (int nq = 0; nq < 2; ++nq) { O[nq][dt] = MFMA16(va0, pf[nq][0], O[nq][dt]); O[nq][dt] = MFMA16(va1, pf[nq][1], O[nq][dt]); }
            }
        }
#pragma unroll
        for (int nq = 0; nq < 2; ++nq) {
            float l = lrun[nq]; l += __shfl_xor(l, 16); l += __shfl_xor(l, 32);
            const float inv = 1.f / l;
            bf16_t* orow = AO + ((size_t)m * M + (size_t)b * S + qrow0 + nq * 16 + r16) * 1024 + h * 128 + quad * 4;
#pragma unroll
            for (int dt = 0; dt < 8; ++dt) { u32x2 w; w.x = pk2(O[nq][dt][0] * inv, O[nq][dt][1] * inv); w.y = pk2(O[nq][dt][2] * inv, O[nq][dt][3] * inv); *(u32x2*)(orow + dt * 16) = w; }
        }
    }
}

__device__ __forceinline__ void load16(const bf16_t* p, float* o) {
    const u32x4 a = *(const u32x4*)p, b = *(const u32x4*)(p + 8);
#pragma unroll
    for (int i = 0; i < 4; ++i) { o[2 * i] = __uint_as_float(a[i] << 16); o[2 * i + 1] = __uint_as_float(a[i] & 0xFFFF0000u); o[8 + 2 * i] = __uint_as_float(b[i] << 16); o[8 + 2 * i + 1] = __uint_as_float(b[i] & 0xFFFF0000u); }
}
__device__ __forceinline__ void store16(bf16_t* p, const float* v) {
    u32x4 a, b; a.x = pk2(v[0], v[1]); a.y = pk2(v[2], v[3]); a.z = pk2(v[4], v[5]); a.w = pk2(v[6], v[7]); b.x = pk2(v[8], v[9]); b.y = pk2(v[10], v[11]); b.z = pk2(v[12], v[13]); b.w = pk2(v[14], v[15]);
    *(u32x4*)p = a; *(u32x4*)(p + 8) = b;
}
__device__ __forceinline__ void loadf16(const float* p, float* o) {
#pragma unroll
    for (int i = 0; i < 4; ++i) { const float4 v = ((const float4*)p)[i]; o[4 * i] = v.x; o[4 * i + 1] = v.y; o[4 * i + 2] = v.z; o[4 * i + 3] = v.w; }
}
__device__ __forceinline__ void finish_phase(const Params& P, int layer) {
    const int tid_ = opaque_tid(); const int lane = tid_ & 63, gw = opaque_bid() * 8 + (tid_ >> 6), ngw = gridDim.x * 8;
    const bf16_t* proj = (const bf16_t*)(P.ws + OFF_PROJ);
    const bf16_t* AO = (const bf16_t*)(P.ws + OFF_AO); const bf16_t* YB = (const bf16_t*)(P.ws + OFF_U); const bf16_t* OC = (const bf16_t*)(P.ws + OFF_OC);
    const float* BON = (const float*)(P.ws + OFF_BON);
    bf16_t* MIX = (bf16_t*)(P.ws + OFF_MIXED);
    const float lam_init = 0.8f - 0.6f * expf(-0.3f * (float)layer);
    const float s1 = wave_sum(P.in[6][layer * 64 + lane] * P.in[7][layer * 64 + lane]), s2 = wave_sum(P.in[8][layer * 64 + lane] * P.in[9][layer * 64 + lane]);
    const float lam = expf(s1) - expf(s2) + lam_init;
    const int c0 = lane * 16;
    const float* mu0p = P.in[11] + (size_t)layer * 2 * 3328 + 2048 + c0; const float* mu1p = mu0p + 3328;
    for (int tok = gw; tok < M; tok += ngw) {
        const bf16_t* prow = proj + (size_t)tok * PW;
        bf16_t* mrow = MIX + (size_t)tok * MIXW;
        float a[16], bb[16], g[16], pr[16];
        load16(AO + (size_t)tok * 1024 + c0, a); load16(AO + ((size_t)M + tok) * 1024 + c0, bb); load16(prow + C_AG + c0, g);
        { float ss = 0.f;
#pragma unroll
          for (int i = 0; i < 16; ++i) { a[i] = a[i] - lam * bb[i]; ss += a[i] * a[i]; }
          ss += __shfl_xor(ss, 1); ss += __shfl_xor(ss, 2); ss += __shfl_xor(ss, 4);
          const float rstd = rsqrtf(ss * (1.f / 128.f) + 1e-5f) * (1.f - lam_init);
          loadf16(P.in[10] + layer * 128 + (c0 & 127), pr);
#pragma unroll
          for (int i = 0; i < 16; ++i) a[i] = a[i] * rstd * pr[i] * siluf_(g[i]);
          store16(mrow + c0, a); }
        load16(YB + (size_t)tok * 1024 + c0, a); load16(YB + ((size_t)M + tok) * 1024 + c0, bb); load16(prow + C_BG + c0, g);
        { float sm = 0.f;
#pragma unroll
          for (int i = 0; i < 16; ++i) { a[i] += bb[i]; sm += a[i]; }
          sm += __shfl_xor(sm, 1); sm += __shfl_xor(sm, 2);
          const float mean = sm * (1.f / 64.f); float vs = 0.f;
#pragma unroll
          for (int i = 0; i < 16; ++i) { a[i] -= mean; vs += a[i] * a[i]; }
          vs += __shfl_xor(vs, 1); vs += __shfl_xor(vs, 2);
          const float rstd = rsqrtf(vs * (1.f / 64.f) + 64e-5f);
          const int head = lane >> 2;
          const float bon = BON[(((size_t)(tok >> 11)) * 16 + head) * S + (tok & (S - 1))] + BON[(((size_t)NB + (tok >> 11)) * 16 + head) * S + (tok & (S - 1))];
          const int sp = tok & (S - 1);
          loadf16(P.in[19] + layer * 1024 + c0, pr);
#pragma unroll
          for (int i = 0; i < 16; ++i) a[i] = a[i] * rstd * pr[i];
          loadf16(P.in[20] + layer * 1024 + c0, pr);
#pragma unroll
          for (int i = 0; i < 16; ++i) a[i] += pr[i];
          load16(prow + C_B + 2048 + c0, bb);
          float vsft[16];
          { float nb[16];
            if (sp > 0) load16(prow - PW + C_B + 2048 + c0, nb); else {
#pragma unroll
                for (int i = 0; i < 16; ++i) nb[i] = 0.f; }
            loadf16(mu0p, pr);
#pragma unroll
            for (int i = 0; i < 16; ++i) vsft[i] = bb[i] + pr[i] * (nb[i] - bb[i]);
            if (sp < S - 1) load16(prow + PW + C_B + 2048 + c0, nb); else {
#pragma unroll
                for (int i = 0; i < 16; ++i) nb[i] = 0.f; }
            loadf16(mu1p, pr);
#pragma unroll
            for (int i = 0; i < 16; ++i) vsft[i] += pr[i] * (nb[i] - bb[i]); }
#pragma unroll
          for (int i = 0; i < 16; ++i) a[i] = (a[i] + bon * vsft[i]) * siluf_(g[i]);
          store16(mrow + 1024 + c0, a); }
        load16(OC + (size_t)tok * 1024 + c0, a); load16(OC + ((size_t)M + tok) * 1024 + c0, bb); load16(prow + C_CG + c0, g);
        { float ss = 0.f;
#pragma unroll
          for (int i = 0; i < 16; ++i) { a[i] += bb[i]; ss += a[i] * a[i]; }
          ss += __shfl_xor(ss, 1); ss += __shfl_xor(ss, 2); ss += __shfl_xor(ss, 4);
          const float rstd = rsqrtf(ss * (1.f / 128.f) + 1e-6f);
          loadf16(P.in[22] + layer * 128 + (c0 & 127), pr);
#pragma unroll
          for (int i = 0; i < 16; ++i) a[i] = a[i] * rstd * pr[i] * siluf_(g[i]);
          store16(mrow + 2048 + c0, a); }
    }
}

__global__ void __launch_bounds__(NTHR, 2) fwd_megakernel(Params P) {
    extern __shared__ __attribute__((aligned(16))) unsigned char smem[];
    cg::grid_group grid = cg::this_grid();
    unsigned* ctl = (unsigned*)(P.ws + OFF_CTL);
    bf16_t* U = (bf16_t*)(P.ws + OFF_U);
    float* Y = (float*)(P.ws + OFF_PROJ);
#ifndef REP_P0
#define REP_P0 1
#endif
#pragma unroll 1
    for (int rep = 0; rep < REP_P0; ++rep) { convert_weights(P, 0, smem);
    prenorm_rows(P.in[0], P.in[2], U); }
    grid.sync();
#pragma unroll 1
    for (int layer = 0; layer < DEPTH; ++layer) {
#ifndef REP_G1
#define REP_G1 1
#endif
#pragma unroll 1
        for (int rep = 0; rep < REP_G1; ++rep) { pg8::Gemm g; g.A = U; g.Bt = (const bf16_t*)(P.ws + OFF_WIN); g.M = opaque_s(M); g.N = opaque_s(PW); g.K = opaque_s(D);
          pg8::StaticOrder So; So.init(g.M, g.N, (int)gridDim.x, opaque_bid());
          pg8::EpiBf16<0> E; E.O = (bf16_t*)(P.ws + OFF_PROJ); E.ldc = g.N; E.bias = nullptr; E.split_cols = 0; E.split_stride = 0;
          pg8::gemm_phase<pg8::EpiBf16<0>, pg8::StaticOrder, false>((PG8_LAS unsigned char*)smem, g, So, E, nullptr); }
        grid.sync();
#ifndef REP_RWKV
#define REP_RWKV 1
#endif
#ifndef REP_HGRN
#define REP_HGRN 1
#endif
#ifndef REP_ATTN
#define REP_ATTN 1
#endif
#pragma unroll 1
        for (int rep = 0; rep < REP_RWKV; ++rep) rwkv_phase(P, layer, smem);
#pragma unroll 1
        for (int rep = 0; rep < REP_HGRN; ++rep) hgrn_phase(P, layer, smem);
#pragma unroll 1
        for (int rep = 0; rep < REP_ATTN; ++rep) attn_phase(P, layer, smem, ctl + 64 * layer + 128 * rep);
        grid.sync();
#ifndef REP_FIN
#define REP_FIN 1
#endif
#pragma unroll 1
        for (int rep = 0; rep < REP_FIN; ++rep) finish_phase(P, layer);
        grid.sync();
#ifndef REP_G2
#define REP_G2 1
#endif
#pragma unroll 1
        for (int rep = 0; rep < REP_G2; ++rep) { pg8::Gemm g; g.A = (const bf16_t*)(P.ws + OFF_MIXED); g.Bt = (const bf16_t*)(P.ws + OFF_WOUT); g.M = opaque_s(M); g.N = opaque_s(D); g.K = opaque_s(MIXW);
          pg8::StaticOrder So; So.init(g.M, g.N, (int)gridDim.x, opaque_bid());
          pg8::EpiF32 E; E.C = Y; E.ldc = g.N; E.bias = nullptr;
          pg8::gemm_phase<pg8::EpiF32, pg8::StaticOrder, false>((PG8_LAS unsigned char*)smem, g, So, E, nullptr); }
        grid.sync();
        if (layer + 1 < DEPTH) {
            postnorm_rows(Y, layer == 0 ? P.in[0] : P.out, P.out, P.in[3] + layer * D, P.in[2] + (layer + 1) * D, U);
            convert_weights(P, layer + 1, smem);
            grid.sync();
        } else {
            postnorm_rows(Y, layer == 0 ? P.in[0] : P.out, P.out, P.in[3] + layer * D, nullptr, U);
        }
    }
}
}

extern "C" void kernel_launch(void* const* d_in, const int* in_sizes, int n_in, void* d_out, int out_size, void* d_ws, size_t ws_size, hipStream_t stream) {
    static int grid_blocks = 0;
    if (grid_blocks == 0) {
        int dev = 0, cus = 0, per_cu = 0;
        hipGetDevice(&dev);
        hipDeviceGetAttribute(&cus, hipDeviceAttributeMultiprocessorCount, dev);
        if (hipFuncSetAttribute((const void*)mk::fwd_megakernel, hipFuncAttributeMaxDynamicSharedMemorySize, mk::LDS_BYTES) != hipSuccess) fprintf(stderr, "hipFuncSetAttribute failed\n");
        if (hipOccupancyMaxActiveBlocksPerMultiprocessor(&per_cu, (const void*)mk::fwd_megakernel, mk::NTHR, mk::LDS_BYTES) != hipSuccess || per_cu < 1) { fprintf(stderr, "occupancy query: %d\n", per_cu); per_cu = 1; }
        (void)hipGetLastError();
        grid_blocks = cus * 1;
        if (ws_size < mk::WS_END) fprintf(stderr, "workspace too small: %zu < %zu\n", ws_size, (size_t)mk::WS_END);
    }
    hipMemsetAsync((unsigned char*)d_ws + mk::OFF_CTL, 0, 4096, stream);
    mk::Params p{};
    for (int i = 0; i < 23; ++i) p.in[i] = (const float*)d_in[i];
    p.out = (float*)d_out; p.ws = (unsigned char*)d_ws;
    void* args[] = {&p};
    hipError_t e = hipLaunchCooperativeKernel((const void*)mk::fwd_megakernel, dim3(grid_blocks), dim3(mk::NTHR), args, mk::LDS_BYTES, stream);
    if (e != hipSuccess) fprintf(stderr, "cooperative launch failed: %s (grid %d)\n", hipGetErrorString(e), grid_blocks);
}
```

```cpp
#include <hip/hip_runtime.h>
#include <hip/hip_cooperative_groups.h>
#include <cstdio>
#include <cstdint>
namespace cg = cooperative_groups;
namespace pg8 {
#define PG8_LAS __attribute__((address_space(3)))
typedef unsigned short bf16_t;
typedef short bf16x8 __attribute__((ext_vector_type(8)));
typedef float f32x4 __attribute__((ext_vector_type(4)));
typedef unsigned u32x4 __attribute__((ext_vector_type(4)));
constexpr int BM = 256, BK = 64, HALF = 128, HTB = HALF * BK * 2  , STAGE_BYTES = 8 * HTB, NXCD = 8, WGM = 8;

__host__ __device__ __forceinline__ int lds_byte(int r, int c) { const int st = (r >> 4) * 2 + (c >> 5), rr = r & 15, cc = c & 31, ob = rr * 64 + cc * 2; return st * 1024 + (ob ^ (((ob >> 9) & 1) << 5)); }
__host__ __device__ __forceinline__ void stage_rc(int b, int& R, int& C) { const int st = b / 1024, sb = b % 1024, swz = sb ^ (((sb >> 9) & 1) << 5); R = (st >> 1) * 16 + swz / 64; C = (st & 1) * 32 + (swz % 64) / 2; }
__host__ __device__ __forceinline__ int perm32(int rho) { const int n = rho >> 4, i = rho & 15; return 8 * (i >> 2) + 4 * n + (i & 3); }

struct Unit { int pm, pn; };
struct Gemm { const bf16_t* A; const bf16_t* Bt; int M, N, K; };

struct StaticOrder {
    int nM, nN, nwg, G, c;
    __host__ __device__ void init(int M, int N, int G_, int c_) { nM = M / BM; nN = N / BM; nwg = nM * nN; G = G_; c = c_; }
    __host__ __device__ bool next(int i, Unit& u) const {
        const long L = (long)i * G + c; if (L >= nwg) return false;
        int wgid = (int)L; { const int q = nwg / NXCD, r = nwg % NXCD, xcd = wgid % NXCD, off = wgid / NXCD; wgid = (xcd < r ? xcd * (q + 1) : r * (q + 1) + (xcd - r) * q) + off; }
        const int nig = WGM * nN, gid = wgid / nig, fm = gid * WGM, gsz = (nM - fm) < WGM ? (nM - fm) : WGM;
        u.pm = fm + ((wgid % nig) % gsz); u.pn = (wgid % nig) / gsz; return true;
    }
    __device__ __forceinline__ void a_ready(const Unit&) const {}
    __device__ __forceinline__ void done(const Unit&) const {}
};
struct CountedOrder : StaticOrder {
    const unsigned* ready; unsigned need; unsigned* tmo;
    __device__ __forceinline__ void a_ready(const Unit& u) const {
        if (threadIdx.x < 64) {
            const unsigned long long t0 = __builtin_amdgcn_s_memrealtime(); unsigned polls = 0;
            while ((unsigned)__builtin_amdgcn_readfirstlane(__hip_atomic_load(ready + 64 * u.pm, __ATOMIC_RELAXED, __HIP_MEMORY_SCOPE_AGENT)) < need) {
                if ((++polls & 255u) == 0u && __builtin_amdgcn_readfirstlane(__hip_atomic_load(tmo, __ATOMIC_RELAXED, __HIP_MEMORY_SCOPE_AGENT)) != 0u) break;
                if (__builtin_amdgcn_s_memrealtime() - t0 > 2000000ull) {
                    if (threadIdx.x == 0) { unsigned expect = 0u; __hip_atomic_compare_exchange_strong(tmo + 1, &expect, 0x600u | (unsigned)(u.pm & 0xff), __ATOMIC_RELAXED, __ATOMIC_RELAXED, __HIP_MEMORY_SCOPE_AGENT); __hip_atomic_store(tmo, 1u, __ATOMIC_RELAXED, __HIP_MEMORY_SCOPE_AGENT); }
                    break; }
                __builtin_amdgcn_s_sleep(2); }
            __builtin_amdgcn_fence(__ATOMIC_ACQUIRE, "agent");
            asm volatile("s_waitcnt vmcnt(0)" ::: "memory");
        }
#if !defined(BROKEN_HOOK_NO_BARRIER)
        asm volatile("" ::: "memory"); __builtin_amdgcn_s_barrier(); asm volatile("" ::: "memory");
#endif
    }
};

typedef __bf16 bf16x2_t __attribute__((ext_vector_type(2)));
typedef float f32x2c __attribute__((ext_vector_type(2)));
__device__ __forceinline__ unsigned cvt_pk_bf16(float lo, float hi) { f32x2c v = {lo, hi}; bf16x2_t b = __builtin_convertvector(v, bf16x2_t); return __builtin_bit_cast(unsigned, b); }
typedef float f32x2 __attribute__((ext_vector_type(2)));
__device__ __forceinline__ f32x2 gelu_pk(f32x2 v) {
    const f32x2 av = __builtin_elementwise_abs(v), d = av * 0.2316418882f + 1.0f;
    f32x2 t; t.x = __builtin_amdgcn_rcpf(d.x); t.y = __builtin_amdgcn_rcpf(d.y);
    f32x2 q = t * 0.5307027145f + (-0.7265760135f); q = q * t + 0.7107068705f; q = q * t + (-0.142248368f); q = q * t + 0.127414796f; q = q * t;
    const f32x2 s = (v * v) * (-0.72134752044f);
    f32x2 e; e.x = __builtin_amdgcn_exp2f(s.x); e.y = __builtin_amdgcn_exp2f(s.y);
    const f32x2 m = v * (q * e), r = v - m;
    f32x2 o; o.x = v.x < 0.f ? m.x : r.x; o.y = v.y < 0.f ? m.y : r.y; return o;
}

struct EpiF32 {
    static constexpr bool PERM = false, AFTER_DRAIN = false;
    float* C; int ldc; const float* bias;
    __device__ __forceinline__ void operator()(const f32x4 (&acc)[2][2][4][2], const Unit& u, int wr, int wc, int fr, int fq) const {
        const int row0 = u.pm * BM + wr * 64 + fr, col0 = u.pn * BM + wc * 32 + 4 * fq;
        f32x4 bv[2][2];
#pragma unroll
        for (int bj = 0; bj < 2; ++bj)
#pragma unroll
            for (int n = 0; n < 2; ++n) bv[bj][n] = bias ? *(const f32x4*)(bias + col0 + bj * HALF + n * 16) : (f32x4){0.f, 0.f, 0.f, 0.f};
#pragma unroll
        for (int ai = 0; ai < 2; ++ai)
#pragma unroll
            for (int m = 0; m < 4; ++m) { float* rowp = C + (size_t)(row0 + ai * HALF + m * 16) * ldc + col0;
#pragma unroll
                for (int bj = 0; bj < 2; ++bj)
#pragma unroll
                    for (int n = 0; n < 2; ++n) *(f32x4*)(rowp + bj * HALF + n * 16) = acc[ai][bj][m][n] + bv[bj][n]; }
    }
};
template <int ACT  > struct EpiBf16 {
    static constexpr bool PERM = true, AFTER_DRAIN = false;
    bf16_t* O; int ldc; const float* bias; int split_cols; size_t split_stride;
    __device__ __forceinline__ void operator()(const f32x4 (&acc)[2][2][4][2], const Unit& u, int wr, int wc, int fr, int fq) const {
        const int row0 = u.pm * BM + wr * 64 + fr; int colt = u.pn * BM; bf16_t* base = O;
        if (split_cols) { const int t = colt / split_cols; base += (size_t)t * split_stride; colt -= t * split_cols; }
        const int col0 = colt + wc * 32 + 8 * fq, bcol0 = u.pn * BM + wc * 32 + 8 * fq;
        f32x4 bv[2][2];
#pragma unroll
        for (int bj = 0; bj < 2; ++bj)
#pragma unroll
            for (int n = 0; n < 2; ++n) bv[bj][n] = bias ? *(const f32x4*)(bias + bcol0 + bj * HALF + 4 * n) : (f32x4){0.f, 0.f, 0.f, 0.f};
#pragma unroll
        for (int ai = 0; ai < 2; ++ai)
#pragma unroll
            for (int m = 0; m < 4; ++m) { bf16_t* rowp = base + (size_t)(row0 + ai * HALF + m * 16) * ldc + col0;
#pragma unroll
                for (int bj = 0; bj < 2; ++bj) { f32x4 v0 = acc[ai][bj][m][0] + bv[bj][0], v1 = acc[ai][bj][m][1] + bv[bj][1];
                    if (ACT == 1) { f32x2 a = gelu_pk((f32x2){v0[0], v0[1]}), b = gelu_pk((f32x2){v0[2], v0[3]}), c = gelu_pk((f32x2){v1[0], v1[1]}), d = gelu_pk((f32x2){v1[2], v1[3]});
                        v0 = (f32x4){a.x, a.y, b.x, b.y}; v1 = (f32x4){c.x, c.y, d.x, d.y}; }
                    if (ACT == 2) {
#pragma unroll
                        for (int j = 0; j < 4; ++j) { v0[j] = 0.5f * v0[j] * (1.0f + erff(v0[j] * 0.70710678f)); v1[j] = 0.5f * v1[j] * (1.0f + erff(v1[j] * 0.70710678f)); } }
                    u32x4 w; w.x = cvt_pk_bf16(v0[0], v0[1]); w.y = cvt_pk_bf16(v0[2], v0[3]); w.z = cvt_pk_bf16(v1[0], v1[1]); w.w = cvt_pk_bf16(v1[2], v1[3]);
                    *(u32x4*)(rowp + bj * HALF) = w; } }
    }
};


template <class Epi, class Sched, bool STAMP = false>
__device__ __forceinline__ void gemm_phase(PG8_LAS unsigned char* lds, const Gemm g, const Sched& S, const Epi& E, unsigned long long* stamps) {
    int tid_o = threadIdx.x; asm volatile("" : "+v"(tid_o));
    const int tid = tid_o, wid = __builtin_amdgcn_readfirstlane(tid >> 6), lane = tid & 63, wr = wid >> 2, wc = wid & 3, fr = lane & 15, fq = lane >> 4;
    const int K = g.K, nt = K / BK;
    int ts_lo = 0, ts_hi = 0, nts = 0; const unsigned long long rt_entry = STAMP ? (unsigned long long)wall_clock64() : 0ull;
#define PG8_STAMP() do { if (STAMP && wid == 0 && nts < 64) { const unsigned long long _c = (unsigned long long)clock64(); \
        ts_lo = (lane == nts) ? (int)(unsigned)_c : ts_lo; ts_hi = (lane == nts) ? (int)(unsigned)(_c >> 32) : ts_hi; ++nts; } } while (0)
    PG8_STAMP();
    unsigned voffA[2], voffB[2];
#pragma unroll
    for (int i = 0; i < 2; ++i) { int R, C; stage_rc(tid * 16 + i * 8192, R, C); const int Rb = Epi::PERM ? ((R & ~31) + perm32(R & 31)) : R;
        voffA[i] = (unsigned)(R * K + C) * 2u; voffB[i] = (unsigned)(Rb * K + C) * 2u; }
    const size_t kstep = (size_t)(BK * 2);
    const size_t hstep = (size_t)HALF * K * 2;
    const size_t tstep = 2 * hstep;
    const unsigned ldsw = (unsigned)wid * 1024u;
    const int aoff = lds_byte(wr * 64 + fr, fq * 8), boff = lds_byte(wc * 32 + fr, fq * 8);
#define PG8_SA(b, h) (((b) * 2 + (h)) * HTB)
#define PG8_SB(b, h) ((4 + (b) * 2 + (h)) * HTB)
#define PG8_STAGE(bufoff, gbase, voff) do { _Pragma("unroll") for (int _i = 0; _i < 2; ++_i) \
        __builtin_amdgcn_global_load_lds((const unsigned*)((const char*)(gbase) + (voff)[_i]), (PG8_LAS unsigned*)(lds + (bufoff) + ldsw + _i * 8192), 16, 0, 0); } while (0)
#define PG8_LDA(dst, b, h) do { _Pragma("unroll") for (int m = 0; m < 4; ++m) _Pragma("unroll") for (int k = 0; k < 2; ++k) dst[m][k] = *(const PG8_LAS bf16x8*)(lds + PG8_SA(b, h) + aoff + m * 2048 + k * 1024); } while (0)
#define PG8_LDB(dst, b, h) do { _Pragma("unroll") for (int n = 0; n < 2; ++n) _Pragma("unroll") for (int k = 0; k < 2; ++k) dst[n][k] = *(const PG8_LAS bf16x8*)(lds + PG8_SB(b, h) + boff + n * 2048 + k * 1024); } while (0)
#define PG8_MMA(ai, bj, At, Bt) do { __builtin_amdgcn_s_setprio(1); _Pragma("unroll") for (int m = 0; m < 4; ++m) _Pragma("unroll") for (int n = 0; n < 2; ++n) _Pragma("unroll") for (int k = 0; k < 2; ++k) \
        acc[ai][bj][m][n] = __builtin_amdgcn_mfma_f32_16x16x32_bf16(Bt[n][k], At[m][k], acc[ai][bj][m][n], 0, 0, 0); __builtin_amdgcn_s_setprio(0); } while (0)
#define PG8_WAIT_V(n) asm volatile("s_waitcnt vmcnt(" #n ")" ::: "memory")
#define PG8_WAIT_L(n) asm volatile("s_waitcnt lgkmcnt(" #n ")" ::: "memory")
#define PG8_BAR __builtin_amdgcn_s_barrier()
#define PG8_SCHED __builtin_amdgcn_sched_barrier(0)
    Unit cur, nxt; int ui = 0;
    if (!S.next(0, cur)) return;
    f32x4 acc[2][2][4][2];
#pragma unroll
    for (int a = 0; a < 2; ++a)
#pragma unroll
        for (int b = 0; b < 2; ++b)
#pragma unroll
            for (int m = 0; m < 4; ++m)
#pragma unroll
                for (int n = 0; n < 2; ++n) acc[a][b][m][n] = (f32x4){0.f, 0.f, 0.f, 0.f};
    bf16x8 At[4][2], B0[2][2], B1[2][2];
    const char* cA = (const char*)g.A + (size_t)cur.pm * tstep; const char* cB = (const char*)g.Bt + (size_t)cur.pn * tstep;
    S.a_ready(cur);
    PG8_STAGE(PG8_SB(0, 0), cB, voffB); PG8_STAGE(PG8_SA(0, 0), cA, voffA); PG8_STAGE(PG8_SB(0, 1), cB + hstep, voffB); PG8_STAGE(PG8_SA(0, 1), cA + hstep, voffA);
    if (wr == 1) PG8_BAR;
    PG8_WAIT_V(4); PG8_BAR;
    PG8_STAGE(PG8_SB(1, 0), cB + kstep, voffB); PG8_STAGE(PG8_SA(1, 0), cA + kstep, voffA); PG8_STAGE(PG8_SB(1, 1), cB + hstep + kstep, voffB);
    PG8_WAIT_V(6); PG8_BAR;
    PG8_STAMP();
    for (;;) {
        const bool has_next = S.next(ui + 1, nxt);
        const char* nA = has_next ? (const char*)g.A + (size_t)nxt.pm * tstep : cA; const char* nB = has_next ? (const char*)g.Bt + (size_t)nxt.pn * tstep : cB;
        for (int t = 0; t < nt; t += 2) {
            const bool last = (t == nt - 2);
            const char* a1 = cA + (size_t)(t + 1) * kstep;
            const char* a2 = last ? nA : cA + (size_t)(t + 2) * kstep; const char* b2 = last ? nB : cB + (size_t)(t + 2) * kstep;
            const char* a3 = a2 + kstep; const char* b3 = b2 + kstep;
            if (last && has_next) S.a_ready(nxt);
            PG8_LDB(B0, 0, 0); PG8_SCHED; PG8_LDA(At, 0, 0); PG8_STAGE(PG8_SA(1, 1), a1 + hstep, voffA);
            PG8_WAIT_L(8); PG8_BAR; PG8_WAIT_L(0); PG8_MMA(0, 0, At, B0); PG8_BAR; PG8_SCHED;
            PG8_LDB(B1, 0, 1); PG8_STAGE(PG8_SB(0, 0), b2, voffB);
            PG8_BAR; PG8_WAIT_L(0); PG8_MMA(0, 1, At, B1); PG8_BAR;
            PG8_LDA(At, 0, 1); PG8_STAGE(PG8_SA(0, 0), a2, voffA);
            PG8_BAR; PG8_WAIT_L(0); PG8_MMA(1, 0, At, B0); PG8_BAR; PG8_SCHED;
            PG8_STAGE(PG8_SB(0, 1), b2 + hstep, voffB);
            PG8_WAIT_V(6); PG8_BAR; PG8_MMA(1, 1, At, B1); PG8_BAR;
            PG8_LDB(B0, 1, 0); PG8_SCHED; PG8_LDA(At, 1, 0); PG8_STAGE(PG8_SA(0, 1), a2 + hstep, voffA);
            PG8_WAIT_L(8); PG8_BAR; PG8_WAIT_L(0); PG8_MMA(0, 0, At, B0); PG8_BAR; PG8_SCHED;
            PG8_LDB(B1, 1, 1); PG8_STAGE(PG8_SB(1, 0), b3, voffB);
            PG8_BAR; PG8_WAIT_L(0); PG8_MMA(0, 1, At, B1); PG8_BAR;
            PG8_LDA(At, 1, 1); PG8_STAGE(PG8_SA(1, 0), a3, voffA);
            PG8_BAR; PG8_WAIT_L(0); PG8_MMA(1, 0, At, B0); PG8_BAR; PG8_SCHED;
            PG8_STAGE(PG8_SB(1, 1), b3 + hstep, voffB);
            PG8_WAIT_V(6); PG8_BAR; PG8_MMA(1, 1, At, B1); PG8_BAR;
        }
        PG8_STAMP();
        if constexpr (!Epi::AFTER_DRAIN) { E(acc, cur, wr, wc, fr, fq); S.done(cur); }
        PG8_STAMP();
        if (!has_next) break;
#pragma unroll
        for (int a = 0; a < 2; ++a)
#pragma unroll
            for (int b = 0; b < 2; ++b)
#pragma unroll
                for (int m = 0; m < 4; ++m)
#pragma unroll
                    for (int n = 0; n < 2; ++n) acc[a][b][m][n] = (f32x4){0.f, 0.f, 0.f, 0.f};
        cur = nxt; cA = nA; cB = nB; ++ui;
    }
    PG8_WAIT_V(0);
    if (wr == 0) PG8_BAR;
    PG8_BAR;
    if constexpr (Epi::AFTER_DRAIN) { E.fused(acc, cur, wr, wc, fr, fq, lds, wid, lane); S.done(cur); }
    PG8_STAMP();
    if (STAMP && wid == 0) { stamps[lane] = lane < nts ? (((unsigned long long)(unsigned)ts_hi << 32) | (unsigned)ts_lo) : 0ull;
        if (lane == 62) stamps[62] = rt_entry; if (lane == 63) stamps[63] = (unsigned long long)wall_clock64(); }
#undef PG8_STAMP
#undef PG8_SA
#undef PG8_SB
#undef PG8_STAGE
#undef PG8_LDA
#undef PG8_LDB
#undef PG8_MMA
#undef PG8_WAIT_V
#undef PG8_WAIT_L
#undef PG8_BAR
#undef PG8_SCHED
}
}

namespace mk {
using pg8::bf16_t; using pg8::bf16x8; using pg8::f32x4; using pg8::u32x4;
typedef short s16x4 __attribute__((ext_vector_type(4)));
typedef unsigned u32x2 __attribute__((ext_vector_type(2)));

constexpr int D = 2048, NB = 8, S = 2048, M = NB * S, BW = 1024, MIXW = 3072, PW = 13568, DEPTH = 2;
constexpr int C_AQ = 0, C_AK = 1024, C_AV = 2048, C_AG = 3072, C_B = 4096, C_BG = 7424, C_CQ = 8448, C_CI = 9472, C_CF = 10496, C_CG = 12544;
constexpr int NTHR = 512;
constexpr int LDS_BYTES = 147456;
constexpr float LOG2E = 1.4426950408889634f;

constexpr size_t OFF_CTL = 0;
constexpr size_t OFF_WIN = 4096;
constexpr size_t OFF_WOUT = OFF_WIN + (size_t)PW * D * 2;
constexpr size_t OFF_U = OFF_WOUT + (size_t)D * MIXW * 2;
constexpr size_t OFF_PROJ = OFF_U + (size_t)M * D * 2;
constexpr size_t OFF_MIXED = OFF_PROJ + (size_t)M * PW * 2;
constexpr size_t OFF_OC = OFF_MIXED + (size_t)M * MIXW * 2;
constexpr size_t OFF_AO = OFF_OC + (size_t)2 * M * BW * 2;
constexpr size_t OFF_BON = OFF_AO + (size_t)2 * M * BW * 2;
constexpr size_t OFF_YB = OFF_BON + (size_t)2 * M * 16 * 4;
constexpr size_t WS_END = OFF_YB + (size_t)2 * M * BW * 2;

struct Params { const float* in[23]; float* out; unsigned char* ws; };
__device__ __forceinline__ int opaque_tid() { int t = threadIdx.x; asm volatile("" : "+v"(t)); return t; }
__device__ __forceinline__ int opaque_s(int t) { asm volatile("" : "+s"(t)); return t; }
__device__ __forceinline__ int opaque_bid() { int t = blockIdx.x; asm volatile("" : "+s"(t)); return t; }


__device__ __forceinline__ float bf2f(bf16_t v) { return __uint_as_float(((unsigned)v) << 16); }
__device__ __forceinline__ bf16_t f2bf(float f) { unsigned u = __float_as_uint(f); u += 0x7FFFu + ((u >> 16) & 1u); return (bf16_t)(u >> 16); }
typedef __bf16 bf16x2_t __attribute__((ext_vector_type(2)));
typedef float f32x2c __attribute__((ext_vector_type(2)));
__device__ __forceinline__ unsigned pk2(float lo, float hi) { f32x2c v = {lo, hi}; bf16x2_t b = __builtin_convertvector(v, bf16x2_t); return __builtin_bit_cast(unsigned, b); }
__device__ __forceinline__ float wave_sum(float v) {
#pragma unroll
    for (int o = 1; o < 64; o <<= 1) v += __shfl_xor(v, o);
    return v;
}
__device__ __forceinline__ float sigmoidf_(float x) { return 1.f / (1.f + __expf(-x)); }
__device__ __forceinline__ float siluf_(float x) { return x / (1.f + __expf(-x)); }
__device__ __forceinline__ float dpp_xor1(float v) { return __int_as_float(__builtin_amdgcn_mov_dpp(__float_as_int(v), 0xB1, 0xF, 0xF, true)); }
__device__ __forceinline__ float dpp_xor2(float v) { return __int_as_float(__builtin_amdgcn_mov_dpp(__float_as_int(v), 0x4E, 0xF, 0xF, true)); }
__device__ __forceinline__ float dpp_hmir(float v) { return __int_as_float(__builtin_amdgcn_mov_dpp(__float_as_int(v), 0x141, 0xF, 0xF, true)); }
__device__ __forceinline__ float dpp_mir(float v) { return __int_as_float(__builtin_amdgcn_mov_dpp(__float_as_int(v), 0x140, 0xF, 0xF, true)); }
__device__ __forceinline__ float wave_sum_fast(float v) {
    v += dpp_xor1(v); v += dpp_xor2(v); v += dpp_hmir(v); v += dpp_mir(v);
    v += __shfl_xor(v, 16); v += __shfl_xor(v, 32);
    return v;
}
__device__ __forceinline__ float fast_tanh(float x) { return 1.f - 2.f * __builtin_amdgcn_rcpf(1.f + __expf(2.f * x)); }
__device__ __forceinline__ float fast_sigmoid(float x) { return __builtin_amdgcn_rcpf(1.f + __expf(-x)); }
typedef float f32x2 __attribute__((ext_vector_type(2)));
#define MFMA16(a, b, c) __builtin_amdgcn_mfma_f32_16x16x32_bf16((a), (b), (c), 0, 0, 0)
__device__ __forceinline__ bf16x8 join8(s16x4 lo, s16x4 hi) { return __builtin_shufflevector(lo, hi, 0, 1, 2, 3, 4, 5, 6, 7); }
__device__ __forceinline__ bf16x8 pack8(f32x4 a, f32x4 b) {
    u32x4 w; w.x = pk2(a[0], a[1]); w.y = pk2(a[2], a[3]); w.z = pk2(b[0], b[1]); w.w = pk2(b[2], b[3]);
    return __builtin_bit_cast(bf16x8, w);
}

__device__ __forceinline__ void transpose_tile(const float* __restrict__ W, int K, int N, bf16_t* __restrict__ WT, float* tile, int it) {
    const int tid = opaque_tid();
    const int ntn = N >> 6; const int kb = it / ntn, nbk = it - kb * ntn; const int k0 = kb * 64, n0 = nbk * 64;
#pragma unroll
    for (int rr = 0; rr < 2; ++rr) { const int idx = tid + rr * 512; const int kk = idx >> 4, n4 = (idx & 15) * 4;
        const float4 v = *(const float4*)(W + (size_t)(k0 + kk) * N + n0 + n4);
        float* tp = tile + kk * 65 + n4; tp[0] = v.x; tp[1] = v.y; tp[2] = v.z; tp[3] = v.w; }
    __syncthreads();
    { const int n = tid >> 3, kc = (tid & 7) * 8; const float* tp = tile + kc * 65 + n;
      u32x4 o; o.x = pk2(tp[0], tp[65]); o.y = pk2(tp[2 * 65], tp[3 * 65]); o.z = pk2(tp[4 * 65], tp[5 * 65]); o.w = pk2(tp[6 * 65], tp[7 * 65]);
      *(u32x4*)(WT + (size_t)(n0 + n) * K + k0 + kc) = o; }
    __syncthreads();
}
__device__ __forceinline__ void convert_weights(const Params& P, int layer, unsigned char* smem) {
    float* tile = (float*)smem;
    const float* win = P.in[4] + (size_t)layer * D * PW; const float* wout = P.in[5] + (size_t)layer * MIXW * D;
    bf16_t* WinT = (bf16_t*)(P.ws + OFF_WIN); bf16_t* WoutT = (bf16_t*)(P.ws + OFF_WOUT);
    constexpr int T_IN = (D / 64) * (PW / 64), T_OUT = (MIXW / 64) * (D / 64);
    for (int it = opaque_bid(); it < T_IN + T_OUT; it += gridDim.x) {
        if (it < T_IN) transpose_tile(win, D, PW, WinT, tile, it);
        else transpose_tile(wout, MIXW, D, WoutT, tile, it - T_IN);
    }
}
__device__ __forceinline__ void prenorm_rows(const float* __restrict__ x, const float* __restrict__ g, bf16_t* __restrict__ U) {
    const int tid_ = opaque_tid(); const int lane = tid_ & 63, gw = opaque_bid() * 8 + (tid_ >> 6), ngw = gridDim.x * 8;
    for (int row = gw; row < M; row += ngw) {
        const float4* xr = (const float4*)(x + (size_t)row * D) + lane;
        float4 v[8]; float ss = 0.f;
#pragma unroll
        for (int j = 0; j < 8; ++j) { v[j] = xr[64 * j]; ss += v[j].x * v[j].x + v[j].y * v[j].y + v[j].z * v[j].z + v[j].w * v[j].w; }
        const float rstd = rsqrtf(wave_sum(ss) * (1.f / D) + 1e-6f);
        u32x2* o = (u32x2*)(U + (size_t)row * D) + lane;
#pragma unroll
        for (int j = 0; j < 8; ++j) { const float4 gg = ((const float4*)g)[64 * j + lane];
            u32x2 w; w.x = pk2(v[j].x * rstd * gg.x, v[j].y * rstd * gg.y); w.y = pk2(v[j].z * rstd * gg.z, v[j].w * rstd * gg.w); o[64 * j] = w; }
    }
}
__device__ __forceinline__ void postnorm_rows(const float* __restrict__ y, const float* xin, float* xout, const float* __restrict__ gpost, const float* __restrict__ gpre, bf16_t* __restrict__ U) {
    const int tid_ = opaque_tid(); const int lane = tid_ & 63, gw = opaque_bid() * 8 + (tid_ >> 6), ngw = gridDim.x * 8;
    for (int row = gw; row < M; row += ngw) {
        const float4* yr = (const float4*)(y + (size_t)row * D) + lane;
        const float4* xr = (const float4*)(xin + (size_t)row * D) + lane;
        float4* xo = (float4*)(xout + (size_t)row * D) + lane;
        float4 v[8]; float ss = 0.f;
#pragma unroll
        for (int j = 0; j < 8; ++j) { v[j] = yr[64 * j]; ss += v[j].x * v[j].x + v[j].y * v[j].y + v[j].z * v[j].z + v[j].w * v[j].w; }
        const float rstd = rsqrtf(wave_sum(ss) * (1.f / D) + 1e-6f);
        float s2 = 0.f;
#pragma unroll
        for (int j = 0; j < 8; ++j) { const float4 gg = ((const float4*)gpost)[64 * j + lane]; const float4 xv = xr[64 * j];
            v[j].x = xv.x + v[j].x * rstd * gg.x; v[j].y = xv.y + v[j].y * rstd * gg.y; v[j].z = xv.z + v[j].z * rstd * gg.z; v[j].w = xv.w + v[j].w * rstd * gg.w;
            xo[64 * j] = v[j]; s2 += v[j].x * v[j].x + v[j].y * v[j].y + v[j].z * v[j].z + v[j].w * v[j].w; }
        if (gpre) {
            const float r2 = rsqrtf(wave_sum(s2) * (1.f / D) + 1e-6f);
            u32x2* o = (u32x2*)(U + (size_t)row * D) + lane;
#pragma unroll
            for (int j = 0; j < 8; ++j) { const float4 gg = ((const float4*)gpre)[64 * j + lane];
                u32x2 w; w.x = pk2(v[j].x * r2 * gg.x, v[j].y * r2 * gg.y); w.y = pk2(v[j].z * r2 * gg.z, v[j].w * r2 * gg.w); o[64 * j] = w; }
        }
    }
}

#define RWKV_LOAD_RAW(cc) do { const int n0_ = (cc) * TCH + pw * TPW; const int T0_ = d ? (S - 1 - n0_) : n0_; const int dstep_ = d ? -1 : 1; \
    _Pragma("unroll") for (int j = 0; j < TPW + 2; ++j) { const int tj = T0_ + (j - 1) * dstep_; const bool ok = (tj >= 0) && (tj < S); \
        const bf16_t* row = proj + ((size_t)b * S + (ok ? tj : T0_)) * PW + C_B; \
        raw[j][0] = row[cr]; raw[j][1] = row[ck]; raw[j][2] = row[cv]; raw[j][3] = row[cw]; raw[j][4] = row[ca]; \
        if (!ok) { raw[j][0] = 0; raw[j][1] = 0; raw[j][2] = 0; raw[j][3] = 0; raw[j][4] = 0; } } } while (0)
__device__ __forceinline__ void rwkv_phase(const Params& P, int layer, unsigned char* smem) {
    constexpr int TCH = 16, TPW = 4, NCH = S / TCH;
    float* VEC = (float*)smem;
    bf16_t* UPT = (bf16_t*)(smem + 49152);
    unsigned char* pbase = smem + 49152 + 18432;
    unsigned char* obase = smem + 49152 + 18432 + 12800;
    unsigned char* nbase = obase + 2 * 18176;
    const int tid = opaque_tid(), wid = __builtin_amdgcn_readfirstlane(tid >> 6), lane = tid & 63, r16 = lane & 15, quad = lane >> 4;
    const bf16_t* proj = (const bf16_t*)(P.ws + OFF_PROJ);
    bf16_t* YB = (bf16_t*)(P.ws + OFF_YB);
    float* BON = (float*)(P.ws + OFF_BON);
    const float* mu = P.in[11] + (size_t)layer * 2 * 3328;
    for (int chain = opaque_bid(); chain < 256; chain += gridDim.x) {
        const int d = chain >> 7, b = (chain >> 4) & 7, h = chain & 15;
        __syncthreads();
        { const float* wup = P.in[13] + ((size_t)(layer * 2 + d) * 64) * 1024 + h * 64; const float* aup = P.in[15] + ((size_t)(layer * 2 + d) * 64) * 1024 + h * 64;
#pragma unroll
          for (int it = 0; it < 16; ++it) { const int e = tid + 512 * it; const int mat = e >> 12, lora = (e >> 6) & 63, ch = e & 63;
              const float v = (mat ? aup : wup)[(size_t)lora * 1024 + ch]; UPT[mat * 4608 + ch * 72 + lora] = f2bf(v); } }
        __syncthreads();
        if (wid < 4) {
            const int cw = wid;
            float* Nm = (float*)(nbase + cw * 1024);
            const int jl = lane & 15, tg = lane >> 4, jcol = cw * 16 + jl;
            const float rkc = P.in[18][(size_t)layer * 1024 + h * 64 + jcol];
            const f32x4 z4 = {0.f, 0.f, 0.f, 0.f};
            f32x4 ST[4];
#pragma unroll
            for (int mt = 0; mt < 4; ++mt) ST[mt] = z4;
            asm volatile("s_waitcnt lgkmcnt(0)" ::: "memory"); __builtin_amdgcn_s_barrier(); asm volatile("" ::: "memory");
            asm volatile("s_waitcnt lgkmcnt(0)" ::: "memory"); __builtin_amdgcn_s_barrier(); asm volatile("" ::: "memory");
            for (int c = 0; c < NCH; ++c) {
                const float* vb = VEC + (c & 1) * (TCH * 384);
                unsigned char* ob = obase + (c & 1) * 18176;
                bf16_t* Pm = (bf16_t*)ob; bf16_t* Rm = (bf16_t*)(ob + 2304); bf16_t* Qm = (bf16_t*)(ob + 4608); bf16_t* Mm = (bf16_t*)(ob + 6912);
                bf16_t* QT = (bf16_t*)(ob + 9216); bf16_t* MT = (bf16_t*)(ob + 12288); float* GT = (float*)(ob + 15360); bf16_t* Bm = (bf16_t*)(ob + 15872);
                {
                    float nk[4], ww[4], ka[4], km[4], rr[4];
#pragma unroll
                    for (int u = 0; u < 4; ++u) { const float* vt = vb + (4 * tg + u) * 384 + jcol; nk[u] = vt[0]; ww[u] = vt[64]; ka[u] = vt[128]; km[u] = vt[192]; rr[u] = vt[256]; }
                    float gl[4];
                    gl[0] = ww[0]; gl[1] = gl[0] * ww[1]; gl[2] = gl[1] * ww[2]; gl[3] = gl[2] * ww[3];
                    const float G0 = __shfl(gl[3], jl), G1 = __shfl(gl[3], jl + 16), G2 = __shfl(gl[3], jl + 32);
                    const float pre = (tg == 0) ? 1.f : (tg == 1) ? G0 : (tg == 2) ? G0 * G1 : (G0 * G1) * G2;
                    float pv[4], rv[4], qv[4], mv[4];
#pragma unroll
                    for (int u = 0; u < 4; ++u) {
                        const float gprev = (u == 0) ? pre : pre * gl[u - 1], gcur = pre * gl[u];
                        const float ig = __builtin_amdgcn_rcpf(gcur);
                        pv[u] = gprev * nk[u]; qv[u] = ka[u] * ig; mv[u] = km[u] * ig; rv[u] = gcur * rr[u];
                    }
                    const unsigned wp0 = pk2(pv[0], pv[1]), wp1 = pk2(pv[2], pv[3]), wr0 = pk2(rv[0], rv[1]), wr1 = pk2(rv[2], rv[3]);
                    const unsigned wq0 = pk2(qv[0], qv[1]), wq1 = pk2(qv[2], qv[3]), wm0 = pk2(mv[0], mv[1]), wm1 = pk2(mv[2], mv[3]);
                    const int t0 = 4 * tg;
                    Pm[(t0) * 72 + jcol] = (bf16_t)(wp0 & 0xFFFFu); Pm[(t0 + 1) * 72 + jcol] = (bf16_t)(wp0 >> 16); Pm[(t0 + 2) * 72 + jcol] = (bf16_t)(wp1 & 0xFFFFu); Pm[(t0 + 3) * 72 + jcol] = (bf16_t)(wp1 >> 16);
                    Rm[(t0) * 72 + jcol] = (bf16_t)(wr0 & 0xFFFFu); Rm[(t0 + 1) * 72 + jcol] = (bf16_t)(wr0 >> 16); Rm[(t0 + 2) * 72 + jcol] = (bf16_t)(wr1 & 0xFFFFu); Rm[(t0 + 3) * 72 + jcol] = (bf16_t)(wr1 >> 16);
                    Qm[(t0) * 72 + jcol] = (bf16_t)(wq0 & 0xFFFFu); Qm[(t0 + 1) * 72 + jcol] = (bf16_t)(wq0 >> 16); Qm[(t0 + 2) * 72 + jcol] = (bf16_t)(wq1 & 0xFFFFu); Qm[(t0 + 3) * 72 + jcol] = (bf16_t)(wq1 >> 16);
                    Mm[(t0) * 72 + jcol] = (bf16_t)(wm0 & 0xFFFFu); Mm[(t0 + 1) * 72 + jcol] = (bf16_t)(wm0 >> 16); Mm[(t0 + 2) * 72 + jcol] = (bf16_t)(wm1 & 0xFFFFu); Mm[(t0 + 3) * 72 + jcol] = (bf16_t)(wm1 >> 16);
                    u32x2 tq; tq.x = wq0; tq.y = wq1; *(u32x2*)(QT + jcol * 24 + t0) = tq;
                    u32x2 tm; tm.x = wm0; tm.y = wm1; *(u32x2*)(MT + jcol * 24 + t0) = tm;
                    { const unsigned wb0 = pk2(rv[0] * rkc, rv[1] * rkc), wb1 = pk2(rv[2] * rkc, rv[3] * rkc);
                      Bm[(t0) * 72 + jcol] = (bf16_t)(wb0 & 0xFFFFu); Bm[(t0 + 1) * 72 + jcol] = (bf16_t)(wb0 >> 16); Bm[(t0 + 2) * 72 + jcol] = (bf16_t)(wb1 & 0xFFFFu); Bm[(t0 + 3) * 72 + jcol] = (bf16_t)(wb1 >> 16); }
                    if (tg == 3) GT[jcol] = pre * gl[3];
                }
                asm volatile("s_waitcnt lgkmcnt(0)" ::: "memory"); __builtin_amdgcn_s_barrier(); asm volatile("" ::: "memory");
                f32x4 Gqp = z4, Gmp = z4, Gqr = z4, Gmr = z4, Npq = z4;
#pragma unroll
                for (int ks = 0; ks < 2; ++ks) {
                    const bf16x8 aQ = *(const bf16x8*)(Qm + r16 * 72 + ks * 32 + quad * 8), aM = *(const bf16x8*)(Mm + r16 * 72 + ks * 32 + quad * 8);
                    const bf16x8 bP = *(const bf16x8*)(Pm + r16 * 72 + ks * 32 + quad * 8), bR = *(const bf16x8*)(Rm + r16 * 72 + ks * 32 + quad * 8);
                    Gqp = MFMA16(aQ, bP, Gqp); Gmp = MFMA16(aM, bP, Gmp); Gqr = MFMA16(aQ, bR, Gqr); Gmr = MFMA16(aM, bR, Gmr); Npq = MFMA16(bP, aQ, Npq);
                }
                if (cw == 0) {
                    f32x4 Gmb = z4;
#pragma unroll
                    for (int ks = 0; ks < 2; ++ks) Gmb = MFMA16(*(const bf16x8*)(Mm + r16 * 72 + ks * 32 + quad * 8), *(const bf16x8*)(Bm + r16 * 72 + ks * 32 + quad * 8), Gmb);
                    if (quad == (r16 >> 2)) {
                        const int rsel = r16 & 3;
                        const float bon = (rsel == 0) ? Gmb[0] : (rsel == 1) ? Gmb[1] : (rsel == 2) ? Gmb[2] : Gmb[3];
                        const int n = c * TCH + r16; const int t = d ? (S - 1 - n) : n;
                        BON[(((size_t)d * NB + b) * 16 + h) * S + t] = bon;
                    }
                }
#pragma unroll
                for (int rg = 0; rg < 4; ++rg) { const int sI = quad * 4 + rg;
                    if (sI >= r16) { Gqp[rg] = 0.f; Gmp[rg] = 0.f; }
                    if (sI > r16) { Gqr[rg] = 0.f; Gmr[rg] = 0.f; }
                    if (sI <= r16) Npq[rg] = 0.f; }
                f32x4 SA0 = z4, Y0 = z4;
#pragma unroll
                for (int ks = 0; ks < 2; ++ks) {
                    const bf16x8 sb = pack8(ST[2 * ks], ST[2 * ks + 1]);
                    const bf16_t* pp = Pm + r16 * 72 + ks * 32 + quad * 4; const bf16_t* rp = Rm + r16 * 72 + ks * 32 + quad * 4;
                    const bf16x8 pa = join8(*(const s16x4*)pp, *(const s16x4*)(pp + 16)), ra = join8(*(const s16x4*)rp, *(const s16x4*)(rp + 16));
                    SA0 = MFMA16(pa, sb, SA0); Y0 = MFMA16(ra, sb, Y0);
                }
                f32x4 Vv;
#pragma unroll
                for (int jj = 0; jj < 4; ++jj) Vv[jj] = vb[(quad * 4 + jj) * 384 + 320 + cw * 16 + r16];
                const f32x4 Cc = MFMA16(pack8(Gmp, z4), pack8(Vv, z4), SA0);
                const bf16x8 m1 = pack8(Gqp, z4), n1 = pack8(Npq, z4);
                const f32x4 Mc2 = MFMA16(n1, m1, z4), Nc2 = MFMA16(m1, n1, z4);
                const bf16x8 m2 = pack8(Mc2, z4), n2 = pack8(Nc2, z4);
                const f32x4 Mc4 = MFMA16(n2, m2, z4), Nc4 = MFMA16(m2, n2, z4);
                const bf16x8 m4 = pack8(Mc4, z4), n4 = pack8(Nc4, z4);
                const f32x4 Mc8 = MFMA16(n4, m4, z4);
                f32x4 SAc = MFMA16(pack8(Mc8, z4), pack8(Cc, z4), Cc);
                SAc = MFMA16(m4, pack8(SAc, z4), SAc);
                SAc = MFMA16(m2, pack8(SAc, z4), SAc);
                SAc = MFMA16(m1, pack8(SAc, z4), SAc);
                const bf16x8 Bsv = pack8(SAc, Vv);
                const f32x4 Yc = MFMA16(pack8(Gqr, Gmr), Bsv, Y0);
#pragma unroll
                for (int rg = 0; rg < 4; ++rg) { const int n = c * TCH + quad * 4 + rg; const int t = d ? (S - 1 - n) : n;
                    YB[((size_t)d * M + (size_t)b * S + t) * 1024 + h * 64 + cw * 16 + r16] = f2bf(Yc[rg]); }
#pragma unroll
                for (int mt = 0; mt < 4; ++mt) {
                    const bf16_t* qp = QT + (mt * 16 + r16) * 24 + quad * 4; const bf16_t* mp = MT + (mt * 16 + r16) * 24 + quad * 4;
                    const f32x4 acc = MFMA16(join8(*(const s16x4*)qp, *(const s16x4*)mp), Bsv, ST[mt]);
                    const f32x4 gt = *(const f32x4*)(GT + mt * 16 + quad * 4);
                    ST[mt] = acc * gt;
                }
                asm volatile("s_waitcnt lgkmcnt(0)" ::: "memory"); __builtin_amdgcn_s_barrier(); asm volatile("" ::: "memory");
            }
        } else {
            const int pw = wid - 4;
            bf16_t* Aw = (bf16_t*)(pbase + pw * 3200); bf16_t* Aa = Aw + TPW * 72; float* X = (float*)(pbase + pw * 3200 + 1152);
            const int cr = h * 64 + lane, ck = 1024 + h * 64 + lane, cv = 2048 + h * 64 + lane, cw = 3072 + d * 64 + lane, ca = 3200 + d * 64 + lane;
            const int mo0 = d ? 3328 : 0, mo1 = d ? 0 : 3328;
            const float mr0 = mu[mo0 + cr], mr1 = mu[mo1 + cr], mk0 = mu[mo0 + ck], mk1 = mu[mo1 + ck], mv0 = mu[mo0 + cv], mv1 = mu[mo1 + cv];
            const float mw0 = mu[mo0 + cw], mw1 = mu[mo1 + cw], ma0 = mu[mo0 + ca], ma1 = mu[mo1 + ca];
            const int chn = h * 64 + lane;
            const float w0v = P.in[12][(size_t)(layer * 2 + d) * 1024 + chn], a0v = P.in[14][(size_t)(layer * 2 + d) * 1024 + chn];
            const float kkw = P.in[16][(size_t)layer * 1024 + chn], kaw = P.in[17][(size_t)layer * 1024 + chn], rkw = P.in[18][(size_t)layer * 1024 + chn];
            unsigned short raw[TPW + 2][5];
            RWKV_LOAD_RAW(0);
            for (int c = 0; c < NCH + 1; ++c) {
                if (c < NCH) {
                    float* vb = VEC + (c & 1) * (TCH * 384);
                    float rr[TPW], kv[TPW], vv[TPW], kk[TPW];
                    {
                        float fr[TPW + 2][5];
#pragma unroll
                        for (int j = 0; j < TPW + 2; ++j)
#pragma unroll
                            for (int st = 0; st < 5; ++st) fr[j][st] = bf2f(raw[j][st]);
                        if (c + 1 < NCH) { RWKV_LOAD_RAW(c + 1); }
#pragma unroll
                        for (int i = 0; i < TPW; ++i) {
                            float p0, pa, pb;
                            p0 = fr[i + 1][0]; pa = fr[i][0]; pb = fr[i + 2][0]; rr[i] = p0 + mr0 * (pa - p0) + mr1 * (pb - p0);
                            p0 = fr[i + 1][1]; pa = fr[i][1]; pb = fr[i + 2][1]; kv[i] = p0 + mk0 * (pa - p0) + mk1 * (pb - p0);
                            p0 = fr[i + 1][2]; pa = fr[i][2]; pb = fr[i + 2][2]; vv[i] = p0 + mv0 * (pa - p0) + mv1 * (pb - p0);
                            p0 = fr[i + 1][3]; pa = fr[i][3]; pb = fr[i + 2][3]; const float wd = p0 + mw0 * (pa - p0) + mw1 * (pb - p0);
                            p0 = fr[i + 1][4]; pa = fr[i][4]; pb = fr[i + 2][4]; const float ad = p0 + ma0 * (pa - p0) + ma1 * (pb - p0);
                            Aw[i * 72 + lane] = f2bf(fast_tanh(wd)); Aa[i * 72 + lane] = f2bf(ad);
                            const float k2 = kv[i] * kkw; const float n2 = wave_sum_fast(k2 * k2);
                            kk[i] = k2 * __builtin_amdgcn_rsqf(fmaxf(n2, 1e-24f));
                        }
                    }
                    asm volatile("s_waitcnt lgkmcnt(0)" ::: "memory"); __builtin_amdgcn_s_barrier(); asm volatile("" ::: "memory");
#pragma unroll
                    for (int mat = 0; mat < 2; ++mat) {
                        const bf16_t* A = mat ? Aa : Aw;
                        const bf16x8 a0f = *(const bf16x8*)(A + (r16 & (TPW - 1)) * 72 + quad * 8), a1f = *(const bf16x8*)(A + (r16 & (TPW - 1)) * 72 + 32 + quad * 8);
#pragma unroll
                        for (int nt = 0; nt < 4; ++nt) {
                            const bf16_t* B = UPT + mat * 4608 + (nt * 16 + r16) * 72 + quad * 8;
                            f32x4 acc = {0.f, 0.f, 0.f, 0.f};
                            acc = MFMA16(a0f, *(const bf16x8*)B, acc); acc = MFMA16(a1f, *(const bf16x8*)(B + 32), acc);
                            if (quad == 0) {
#pragma unroll
                                for (int rg = 0; rg < 4; ++rg) X[mat * 256 + rg * 64 + nt * 16 + r16] = acc[rg];
                            }
                        }
                    }
                    asm volatile("s_waitcnt lgkmcnt(0)" ::: "memory");
#pragma unroll
                    for (int i = 0; i < TPW; ++i) {
                        const int s = pw * TPW + i; const int n = c * TCH + s; const int t = d ? (S - 1 - n) : n;
                        const float xw = X[i * 64 + lane] + w0v, xa = X[256 + i * 64 + lane] + a0v;
                        const float dec = __expf(-0.6065306597126334f * fast_sigmoid(xw)); const float av = fast_sigmoid(xa);
                        const float kmod = kv[i] * (1.f + (av - 1.f) * kaw); const float kka = kk[i] * av;
                        float* o = vb + s * 384 + lane;
                        o[0] = -kk[i]; o[64] = dec; o[128] = kka; o[192] = kmod; o[256] = rr[i]; o[320] = vv[i];
                    }
                }
                if (c == NCH) { asm volatile("s_waitcnt lgkmcnt(0)" ::: "memory"); __builtin_amdgcn_s_barrier(); asm volatile("" ::: "memory"); }
                asm volatile("s_waitcnt lgkmcnt(0)" ::: "memory"); __builtin_amdgcn_s_barrier(); asm volatile("" ::: "memory");
            }
        }
    }
}

__device__ __forceinline__ int swz40(int row, int s) { return row * 40 + ((((s >> 3) ^ (row >> 3)) & 3) << 3) + (s & 7); }
__device__ __forceinline__ void hgrn_phase(const Params& P, int layer, unsigned char* smem) {
    bf16_t* QE = (bf16_t*)smem; bf16_t* KE = (bf16_t*)(smem + 8704); bf16_t* KLT = (bf16_t*)(smem + 17408); bf16_t* VT = (bf16_t*)(smem + 27648);
    float* LF = (float*)(smem + 37888); float* EL = (float*)(smem + 54272);
    const int tid = opaque_tid(), wid = __builtin_amdgcn_readfirstlane(tid >> 6), lane = tid & 63, r16 = lane & 15, quad = lane >> 4;
    const bf16_t* proj = (const bf16_t*)(P.ws + OFF_PROJ);
    bf16_t* OC = (bf16_t*)(P.ws + OFF_OC);
    const int es = tid >> 4, ekc = (tid & 15) * 8;
    for (int chain = opaque_bid(); chain < 128; chain += gridDim.x) {
        const int d = chain >> 6, b = (chain >> 3) & 7, h = chain & 7;
        float lb[8];
#pragma unroll
        for (int j = 0; j < 8; ++j) lb[j] = 0.f;
        if (layer > 0) {
#pragma unroll
            for (int j = 0; j < 8; ++j) { const float l0 = P.in[21][(size_t)(d * 2 + 0) * 1024 + h * 128 + ekc + j], l1 = P.in[21][(size_t)(d * 2 + 1) * 1024 + h * 128 + ekc + j]; lb[j] = 1.f / (1.f + __expf(l0 - l1)); }
        }
        f32x4 Sacc[8];
#pragma unroll
        for (int mt = 0; mt < 8; ++mt) Sacc[mt] = (f32x4){0.f, 0.f, 0.f, 0.f};
        u32x4 zraw, qraw, vraw;
        { const int t = d ? (S - 1 - es) : es; const bf16_t* row = proj + ((size_t)b * S + t) * PW + h * 128 + ekc;
          zraw = *(const u32x4*)(row + C_CF + d * 1024); qraw = *(const u32x4*)(row + C_CQ); vraw = *(const u32x4*)(row + C_CI); }
        for (int c = 0; c < 64; ++c) {
            __syncthreads();
            { const int n = c * 32 + es; const int t = d ? (S - 1 - n) : n; const bf16_t* row = proj + ((size_t)b * S + t) * PW + h * 128 + ekc;
              zraw = *(const u32x4*)(row + C_CF + d * 1024); qraw = *(const u32x4*)(row + C_CQ); vraw = *(const u32x4*)(row + C_CI); }
            float kval[8];
            {
                float lf[8];
#pragma unroll
                for (int j = 0; j < 8; ++j) {
                    const unsigned wv = zraw[j >> 1]; const float z = (j & 1) ? __uint_as_float(wv & 0xFFFF0000u) : __uint_as_float(wv << 16);
                    const float e = __expf(-fabsf(z));
                    const float ls = fminf(z, 0.f) - __logf(1.f + e);
                    const float sg = (z >= 0.f ? 1.f : e) * __builtin_amdgcn_rcpf(1.f + e);
                    lf[j] = (lb[j] > 0.f) ? __logf(lb[j] + (1.f - lb[j]) * sg) : ls;
                    kval[j] = (1.f - lb[j]) * (1.f - sg);
                }
                *(f32x4*)(LF + es * 128 + ekc) = (f32x4){lf[0], lf[1], lf[2], lf[3]}; *(f32x4*)(LF + es * 128 + ekc + 4) = (f32x4){lf[4], lf[5], lf[6], lf[7]};
#pragma unroll
                for (int j = 0; j < 8; ++j) { const unsigned wv = vraw[j >> 1]; VT[swz40(ekc + j, es)] = (bf16_t)((j & 1) ? (wv >> 16) : (wv & 0xFFFFu)); }
            }
            __syncthreads();
            if (tid < 128) {
                float cum = 0.f;
#pragma unroll
                for (int s = 0; s < 32; ++s) { cum += LF[s * 128 + tid]; LF[s * 128 + tid] = cum; }
                EL[tid] = __expf(cum);
            }
            __syncthreads();
            {
                const f32x4 c0 = *(const f32x4*)(LF + es * 128 + ekc), c1v = *(const f32x4*)(LF + es * 128 + ekc + 4);
                const f32x4 l0 = *(const f32x4*)(LF + 31 * 128 + ekc), l1 = *(const f32x4*)(LF + 31 * 128 + ekc + 4);
                float qe[8], ke[8];
#pragma unroll
                for (int j = 0; j < 8; ++j) {
                    const unsigned wv = qraw[j >> 1]; const float qv = (j & 1) ? __uint_as_float(wv & 0xFFFF0000u) : __uint_as_float(wv << 16);
                    const float cum = (j < 4) ? c0[j & 3] : c1v[j & 3], last = (j < 4) ? l0[j & 3] : l1[j & 3];
                    qe[j] = qv * __expf(cum); ke[j] = kval[j] * __expf(-cum);
                    KLT[swz40(ekc + j, es)] = f2bf(kval[j] * __expf(last - cum));
                }
                u32x4 w; w.x = pk2(qe[0], qe[1]); w.y = pk2(qe[2], qe[3]); w.z = pk2(qe[4], qe[5]); w.w = pk2(qe[6], qe[7]); *(u32x4*)(QE + es * 136 + ekc) = w;
                w.x = pk2(ke[0], ke[1]); w.y = pk2(ke[2], ke[3]); w.z = pk2(ke[4], ke[5]); w.w = pk2(ke[6], ke[7]); *(u32x4*)(KE + es * 136 + ekc) = w;
            }
            if (false) { const int n = (c + 1) * 32 + es; const int t = d ? (S - 1 - n) : n; const bf16_t* row = proj + ((size_t)b * S + t) * PW + h * 128 + ekc;
                zraw = *(const u32x4*)(row + C_CF + d * 1024); qraw = *(const u32x4*)(row + C_CQ); vraw = *(const u32x4*)(row + C_CI); }
            __syncthreads();
            f32x4 sc00 = {0.f, 0.f, 0.f, 0.f}, sc01 = sc00, sc11 = sc00;
#pragma unroll
            for (int ks = 0; ks < 4; ++ks) {
                const bf16x8 ke0 = *(const bf16x8*)(KE + r16 * 136 + ks * 32 + quad * 8), ke1 = *(const bf16x8*)(KE + (16 + r16) * 136 + ks * 32 + quad * 8);
                const bf16x8 qe0 = *(const bf16x8*)(QE + r16 * 136 + ks * 32 + quad * 8), qe1 = *(const bf16x8*)(QE + (16 + r16) * 136 + ks * 32 + quad * 8);
                sc00 = MFMA16(ke0, qe0, sc00); sc01 = MFMA16(ke0, qe1, sc01); sc11 = MFMA16(ke1, qe1, sc11);
            }
#pragma unroll
            for (int rg = 0; rg < 4; ++rg) { if (quad * 4 + rg > r16) { sc00[rg] = 0.f; sc11[rg] = 0.f; } }
            const f32x4 zero4 = {0.f, 0.f, 0.f, 0.f};
            const bf16x8 p0 = pack8(sc00, zero4), p1 = pack8(sc01, sc11);
            const int vrow_i = wid * 16 + r16;
            const bf16x8 vperm = join8(*(const s16x4*)(VT + swz40(vrow_i, quad * 4)), *(const s16x4*)(VT + swz40(vrow_i, 16 + quad * 4)));
            f32x4 o0 = MFMA16(p0, vperm, zero4), o1 = MFMA16(p1, vperm, zero4);
#pragma unroll
            for (int ks = 0; ks < 4; ++ks) {
                const bf16x8 sb = pack8(Sacc[2 * ks], Sacc[2 * ks + 1]);
                const bf16_t* q0p = QE + r16 * 136 + ks * 32 + quad * 4; const bf16_t* q1p = QE + (16 + r16) * 136 + ks * 32 + quad * 4;
                const bf16x8 qa0 = join8(*(const s16x4*)q0p, *(const s16x4*)(q0p + 16)), qa1 = join8(*(const s16x4*)q1p, *(const s16x4*)(q1p + 16));
                o0 = MFMA16(qa0, sb, o0); o1 = MFMA16(qa1, sb, o1);
            }
#pragma unroll
            for (int rg = 0; rg < 4; ++rg) {
                { const int n = c * 32 + quad * 4 + rg; const int t = d ? (S - 1 - n) : n; OC[((size_t)d * M + (size_t)b * S + t) * 1024 + h * 128 + wid * 16 + r16] = f2bf(o0[rg]); }
                { const int n = c * 32 + 16 + quad * 4 + rg; const int t = d ? (S - 1 - n) : n; OC[((size_t)d * M + (size_t)b * S + t) * 1024 + h * 128 + wid * 16 + r16] = f2bf(o1[rg]); }
            }
            const bf16x8 vnat = *(const bf16x8*)(VT + swz40(vrow_i, quad * 8));
#pragma unroll
            for (int mt = 0; mt < 8; ++mt) {
                const f32x4 el = *(const f32x4*)(EL + mt * 16 + quad * 4);
                f32x4 sa = Sacc[mt] * el;
                const bf16x8 kl = *(const bf16x8*)(KLT + swz40(mt * 16 + r16, quad * 8));
                Sacc[mt] = MFMA16(kl, vnat, sa);
            }
        }
    }
}

__device__ __forceinline__ void attn_phase(const Params& P, int layer, unsigned char* smem, unsigned* counter) {
    float* TAB = (float*)smem; bf16_t* KT = (bf16_t*)(smem + 16384); bf16_t* VTt = (bf16_t*)(smem + 16384 + 9216); int* sh_unit = (int*)(smem + 16384 + 9216 + 18432);
    const int tid = opaque_tid(), wid = __builtin_amdgcn_readfirstlane(tid >> 6), lane = tid & 63, r16 = lane & 15, quad = lane >> 4;
    const bf16_t* proj = (const bf16_t*)(P.ws + OFF_PROJ);
    bf16_t* AO = (bf16_t*)(P.ws + OFF_AO);
    const float* rel_bias = P.in[1];
    const float c1 = 0.125f * LOG2E;
    for (;;) {
        __syncthreads();
        if (tid == 0) *sh_unit = (int)atomicAdd(counter, 1u);
        __syncthreads();
        const int u = *sh_unit;
        if (u >= 1024) break;
        const int qb = u & 7, m = (u >> 3) & 1, h = (u >> 4) & 7, b = u >> 7;
        for (int e = tid; e < 4095; e += 512) { const int rel = e - 2047; const int n = rel < 0 ? -rel : rel; int bk;
            if (n < 8) bk = n; else { const int lg = 31 - __clz(n * n); bk = 2 + lg; if (bk > 15) bk = 15; }
            if (rel > 0) bk += 16; TAB[e] = rel_bias[bk * 8 + h] * LOG2E; }
        const int qrow0 = qb * 256 + wid * 32;
        bf16x8 Qf[2][2];
#pragma unroll
        for (int nq = 0; nq < 2; ++nq)
#pragma unroll
            for (int ks = 0; ks < 2; ++ks) Qf[nq][ks] = *(const bf16x8*)(proj + ((size_t)b * S + qrow0 + nq * 16 + r16) * PW + C_AQ + h * 128 + m * 64 + ks * 32 + quad * 8);
        f32x4 O[2][8];
#pragma unroll
        for (int nq = 0; nq < 2; ++nq)
#pragma unroll
            for (int dt = 0; dt < 8; ++dt) O[nq][dt] = (f32x4){0.f, 0.f, 0.f, 0.f};
        float mrun[2] = {-1e30f, -1e30f}, lrun[2] = {0.f, 0.f};
        const int kkey = tid >> 3, kchunk = tid & 7;
        const int vkp = tid & 31, vchunk = tid >> 5;
        const bf16_t* kbase = proj + ((size_t)b * S + kkey) * PW + C_AK + h * 128 + m * 64 + kchunk * 8;
        const bf16_t* vbase = proj + ((size_t)b * S + 2 * vkp) * PW + C_AV + h * 128 + vchunk * 8;
        u32x4 kreg = *(const u32x4*)kbase, vreg0 = *(const u32x4*)vbase, vreg1 = *(const u32x4*)(vbase + PW);
        for (int kt = 0; kt < 32; ++kt) {
            __syncthreads();
            *(u32x4*)(KT + kkey * 72 + kchunk * 8) = kreg;
            { unsigned* vd = (unsigned*)(VTt + (vchunk * 8) * 72 + 2 * vkp);
#pragma unroll
              for (int i2 = 0; i2 < 4; ++i2) { const unsigned a = vreg0[i2], bq = vreg1[i2];
                  vd[(2 * i2) * 36] = (a & 0xFFFFu) | (bq << 16); vd[(2 * i2 + 1) * 36] = (a >> 16) | (bq & 0xFFFF0000u); } }
            __syncthreads();
            if (kt + 1 < 32) { const size_t adv = (size_t)(kt + 1) * 64 * PW; kreg = *(const u32x4*)(kbase + adv); vreg0 = *(const u32x4*)(vbase + adv); vreg1 = *(const u32x4*)(vbase + adv + PW); }
            const int k0 = kt * 64;
            f32x4 st[2][4];
#pragma unroll
            for (int mt = 0; mt < 4; ++mt) {
                const bf16x8 ka = *(const bf16x8*)(KT + (mt * 16 + r16) * 72 + quad * 8), kb2 = *(const bf16x8*)(KT + (mt * 16 + r16) * 72 + 32 + quad * 8);
#pragma unroll
                for (int nq = 0; nq < 2; ++nq) { f32x4 a = {0.f, 0.f, 0.f, 0.f}; a = MFMA16(ka, Qf[nq][0], a); a = MFMA16(kb2, Qf[nq][1], a); st[nq][mt] = a; }
            }
            const bool posfar = (k0 - (qrow0 + 31)) >= 96, negfar = (qrow0 - (k0 + 63)) >= 96;
            if (posfar || negfar) {
                const float cb = posfar ? TAB[2047 + 128] : TAB[2047 - 128];
#pragma unroll
                for (int nq = 0; nq < 2; ++nq)
#pragma unroll
                    for (int mt = 0; mt < 4; ++mt) st[nq][mt] = st[nq][mt] * c1 + cb;
            } else {
#pragma unroll
                for (int nq = 0; nq < 2; ++nq)
#pragma unroll
                    for (int mt = 0; mt < 4; ++mt) { const float* tp = TAB + (k0 + mt * 16 + quad * 4) - (qrow0 + nq * 16 + r16) + 2047;
#pragma unroll
                        for (int rg = 0; rg < 4; ++rg) st[nq][mt][rg] = st[nq][mt][rg] * c1 + tp[rg]; }
            }
            bf16x8 pf[2][2];
#pragma unroll
            for (int nq = 0; nq < 2; ++nq) {
                float mx = st[nq][0][0];
#pragma unroll
                for (int mt = 0; mt < 4; ++mt)
#pragma unroll
                    for (int rg = 0; rg < 4; ++rg) mx = fmaxf(mx, st[nq][mt][rg]);
                mx = fmaxf(mx, __shfl_xor(mx, 16)); mx = fmaxf(mx, __shfl_xor(mx, 32));
                const float mnew = fmaxf(mrun[nq], mx); const float alpha = __builtin_amdgcn_exp2f(mrun[nq] - mnew); mrun[nq] = mnew;
                float ps = 0.f;
#pragma unroll
                for (int mt = 0; mt < 4; ++mt)
#pragma unroll
                    for (int rg = 0; rg < 4; ++rg) { const float pv = __builtin_amdgcn_exp2f(st[nq][mt][rg] - mnew); st[nq][mt][rg] = pv; ps += pv; }
                lrun[nq] = lrun[nq] * alpha + ps;
#pragma unroll
                for (int dt = 0; dt < 8; ++dt) O[nq][dt] = O[nq][dt] * alpha;
                pf[nq][0] = pack8(st[nq][0], st[nq][1]); pf[nq][1] = pack8(st[nq][2], st[nq][3]);
            }
#pragma unroll
            for (int dt = 0; dt < 8; ++dt) {
                const bf16_t* vr = VTt + (dt * 16 + r16) * 72 + quad * 4;
                const bf16x8 va0 = join8(*(const s16x4*)vr, *(const s16x4*)(vr + 16)), va1 = join8(*(const s16x4*)(vr + 32), *(const s16x4*)(vr + 48));
#pragma unroll
                for (int nq = 0; nq < 2; ++nq) { O[nq][dt] = MFMA16(va0, pf[nq][0], O[nq][dt]); O[nq][dt] = MFMA16(va1, pf[nq][1], O[nq][dt]); }
            }
        }
#pragma unroll
        for (int nq = 0; nq < 2; ++nq) {
            float l = lrun[nq]; l += __shfl_xor(l, 16); l += __shfl_xor(l, 32);
            const float inv = 1.f / l;
            bf16_t* orow = AO + ((size_t)m * M + (size_t)b * S + qrow0 + nq * 16 + r16) * 1024 + h * 128 + quad * 4;
#pragma unroll
            for (int dt = 0; dt < 8; ++dt) { u32x2 w; w.x = pk2(O[nq][dt][0] * inv, O[nq][dt][1] * inv); w.y = pk2(O[nq][dt][2] * inv, O[nq][dt][3] * inv); *(u32x2*)(orow + dt * 16) = w; }
        }
    }
}

__device__ __forceinline__ void load16(const bf16_t* p, float* o) {
    const u32x4 a = *(const u32x4*)p, b = *(const u32x4*)(p + 8);
#pragma unroll
    for (int i = 0; i < 4; ++i) { o[2 * i] = __uint_as_float(a[i] << 16); o[2 * i + 1] = __uint_as_float(a[i] & 0xFFFF0000u); o[8 + 2 * i] = __uint_as_float(b[i] << 16); o[8 + 2 * i + 1] = __uint_as_float(b[i] & 0xFFFF0000u); }
}
__device__ __forceinline__ void store16(bf16_t* p, const float* v) {
    u32x4 a, b; a.x = pk2(v[0], v[1]); a.y = pk2(v[2], v[3]); a.z = pk2(v[4], v[5]); a.w = pk2(v[6], v[7]); b.x = pk2(v[8], v[9]); b.y = pk2(v[10], v[11]); b.z = pk2(v[12], v[13]); b.w = pk2(v[14], v[15]);
    *(u32x4*)p = a; *(u32x4*)(p + 8) = b;
}
__device__ __forceinline__ void loadf16(const float* p, float* o) {
#pragma unroll
    for (int i = 0; i < 4; ++i) { const float4 v = ((const float4*)p)[i]; o[4 * i] = v.x; o[4 * i + 1] = v.y; o[4 * i + 2] = v.z; o[4 * i + 3] = v.w; }
}
__device__ __forceinline__ void finish_phase(const Params& P, int layer) {
    const int tid_ = opaque_tid(); const int lane = tid_ & 63, gw = opaque_bid() * 8 + (tid_ >> 6), ngw = gridDim.x * 8;
    const bf16_t* proj = (const bf16_t*)(P.ws + OFF_PROJ);
    const bf16_t* AO = (const bf16_t*)(P.ws + OFF_AO); const bf16_t* YB = (const bf16_t*)(P.ws + OFF_YB); const bf16_t* OC = (const bf16_t*)(P.ws + OFF_OC);
    const float* BON = (const float*)(P.ws + OFF_BON);
    bf16_t* MIX = (bf16_t*)(P.ws + OFF_MIXED);
    const float lam_init = 0.8f - 0.6f * expf(-0.3f * (float)layer);
    const float s1 = wave_sum(P.in[6][layer * 64 + lane] * P.in[7][layer * 64 + lane]), s2 = wave_sum(P.in[8][layer * 64 + lane] * P.in[9][layer * 64 + lane]);
    const float lam = expf(s1) - expf(s2) + lam_init;
    const int c0 = lane * 16;
    const float* mu0p = P.in[11] + (size_t)layer * 2 * 3328 + 2048 + c0; const float* mu1p = mu0p + 3328;
    for (int tok = gw; tok < M; tok += ngw) {
        const bf16_t* prow = proj + (size_t)tok * PW;
        bf16_t* mrow = MIX + (size_t)tok * MIXW;
        float a[16], bb[16], g[16], pr[16];
        load16(AO + (size_t)tok * 1024 + c0, a); load16(AO + ((size_t)M + tok) * 1024 + c0, bb); load16(prow + C_AG + c0, g);
        { float ss = 0.f;
#pragma unroll
          for (int i = 0; i < 16; ++i) { a[i] = a[i] - lam * bb[i]; ss += a[i] * a[i]; }
          ss += __shfl_xor(ss, 1); ss += __shfl_xor(ss, 2); ss += __shfl_xor(ss, 4);
          const float rstd = rsqrtf(ss * (1.f / 128.f) + 1e-5f) * (1.f - lam_init);
          loadf16(P.in[10] + layer * 128 + (c0 & 127), pr);
#pragma unroll
          for (int i = 0; i < 16; ++i) a[i] = a[i] * rstd * pr[i] * siluf_(g[i]);
          store16(mrow + c0, a); }
        load16(YB + (size_t)tok * 1024 + c0, a); load16(YB + ((size_t)M + tok) * 1024 + c0, bb); load16(prow + C_BG + c0, g);
        { float sm = 0.f;
#pragma unroll
          for (int i = 0; i < 16; ++i) { a[i] += bb[i]; sm += a[i]; }
          sm += __shfl_xor(sm, 1); sm += __shfl_xor(sm, 2);
          const float mean = sm * (1.f / 64.f); float vs = 0.f;
#pragma unroll
          for (int i = 0; i < 16; ++i) { a[i] -= mean; vs += a[i] * a[i]; }
          vs += __shfl_xor(vs, 1); vs += __shfl_xor(vs, 2);
          const float rstd = rsqrtf(vs * (1.f / 64.f) + 64e-5f);
          const int head = lane >> 2;
          const float bon = BON[(((size_t)(tok >> 11)) * 16 + head) * S + (tok & (S - 1))] + BON[(((size_t)NB + (tok >> 11)) * 16 + head) * S + (tok & (S - 1))];
          const int sp = tok & (S - 1);
          loadf16(P.in[19] + layer * 1024 + c0, pr);
#pragma unroll
          for (int i = 0; i < 16; ++i) a[i] = a[i] * rstd * pr[i];
          loadf16(P.in[20] + layer * 1024 + c0, pr);
#pragma unroll
          for (int i = 0; i < 16; ++i) a[i] += pr[i];
          load16(prow + C_B + 2048 + c0, bb);
          float vsft[16];
          { float nb[16];
            if (sp > 0) load16(prow - PW + C_B + 2048 + c0, nb); else {
#pragma unroll
                for (int i = 0; i < 16; ++i) nb[i] = 0.f; }
            loadf16(mu0p, pr);
#pragma unroll
            for (int i = 0; i < 16; ++i) vsft[i] = bb[i] + pr[i] * (nb[i] - bb[i]);
            if (sp < S - 1) load16(prow + PW + C_B + 2048 + c0, nb); else {
#pragma unroll
                for (int i = 0; i < 16; ++i) nb[i] = 0.f; }
            loadf16(mu1p, pr);
#pragma unroll
            for (int i = 0; i < 16; ++i) vsft[i] += pr[i] * (nb[i] - bb[i]); }
#pragma unroll
          for (int i = 0; i < 16; ++i) a[i] = (a[i] + bon * vsft[i]) * siluf_(g[i]);
          store16(mrow + 1024 + c0, a); }
        load16(OC + (size_t)tok * 1024 + c0, a); load16(OC + ((size_t)M + tok) * 1024 + c0, bb); load16(prow + C_CG + c0, g);
        { float ss = 0.f;
#pragma unroll
          for (int i = 0; i < 16; ++i) { a[i] += bb[i]; ss += a[i] * a[i]; }
          ss += __shfl_xor(ss, 1); ss += __shfl_xor(ss, 2); ss += __shfl_xor(ss, 4);
          const float rstd = rsqrtf(ss * (1.f / 128.f) + 1e-6f);
          loadf16(P.in[22] + layer * 128 + (c0 & 127), pr);
#pragma unroll
          for (int i = 0; i < 16; ++i) a[i] = a[i] * rstd * pr[i] * siluf_(g[i]);
          store16(mrow + 2048 + c0, a); }
    }
}

__global__ void __launch_bounds__(NTHR, 2) fwd_megakernel(Params P) {
    extern __shared__ __attribute__((aligned(16))) unsigned char smem[];
    cg::grid_group grid = cg::this_grid();
    unsigned* ctl = (unsigned*)(P.ws + OFF_CTL);
    bf16_t* U = (bf16_t*)(P.ws + OFF_U);
    float* Y = (float*)(P.ws + OFF_PROJ);
#ifndef REP_P0
#define REP_P0 1
#endif
#pragma unroll 1
    for (int rep = 0; rep < REP_P0; ++rep) { convert_weights(P, 0, smem);
    prenorm_rows(P.in[0], P.in[2], U); }
    grid.sync();
#pragma unroll 1
    for (int layer = 0; layer < DEPTH; ++layer) {
#ifndef REP_G1
#define REP_G1 1
#endif
#pragma unroll 1
        for (int rep = 0; rep < REP_G1; ++rep) { pg8::Gemm g; g.A = U; g.Bt = (const bf16_t*)(P.ws + OFF_WIN); g.M = opaque_s(M); g.N = opaque_s(PW - 256); g.K = opaque_s(D);
          pg8::StaticOrder So; So.init(g.M, g.N, (int)gridDim.x, opaque_bid());
          pg8::EpiBf16<0> E; E.O = (bf16_t*)(P.ws + OFF_PROJ); E.ldc = opaque_s(PW); E.bias = nullptr; E.split_cols = 0; E.split_stride = 0;
          pg8::gemm_phase<pg8::EpiBf16<0>, pg8::StaticOrder, false>((PG8_LAS unsigned char*)smem, g, So, E, nullptr); }
        grid.sync();
#ifndef REP_RWKV
#define REP_RWKV 1
#endif
#ifndef REP_HGRN
#define REP_HGRN 1
#endif
#ifndef REP_ATTN
#define REP_ATTN 1
#endif
#pragma unroll 1
        for (int rep = 0; rep < REP_RWKV; ++rep) rwkv_phase(P, layer, smem);
#pragma unroll 1
        for (int rep = 0; rep < REP_HGRN; ++rep) hgrn_phase(P, layer, smem);
        { const int tb = opaque_bid();
          if (tb >= 128 && tb < 192) {
              pg8::Gemm g; g.A = U; g.Bt = (const bf16_t*)(P.ws + OFF_WIN) + (size_t)(PW - 256) * D; g.M = opaque_s(M); g.N = opaque_s(256); g.K = opaque_s(D);
              pg8::StaticOrder So; So.init(g.M, g.N, (int)gridDim.x, tb - 128);
              pg8::EpiBf16<0> E; E.O = (bf16_t*)(P.ws + OFF_PROJ) + (PW - 256); E.ldc = opaque_s(PW); E.bias = nullptr; E.split_cols = 0; E.split_stride = 0;
              pg8::gemm_phase<pg8::EpiBf16<0>, pg8::StaticOrder, false>((PG8_LAS unsigned char*)smem, g, So, E, nullptr);
          } }

#pragma unroll 1
        for (int rep = 0; rep < REP_ATTN; ++rep) attn_phase(P, layer, smem, ctl + 64 * layer + 128 * rep);
        grid.sync();
#ifndef REP_FIN
#define REP_FIN 1
#endif
#pragma unroll 1
        for (int rep = 0; rep < REP_FIN; ++rep) finish_phase(P, layer);
        grid.sync();
#ifndef REP_G2
#define REP_G2 1
#endif
#pragma unroll 1
        for (int rep = 0; rep < REP_G2; ++rep) { pg8::Gemm g; g.A = (const bf16_t*)(P.ws + OFF_MIXED); g.Bt = (const bf16_t*)(P.ws + OFF_WOUT); g.M = opaque_s(M); g.N = opaque_s(D); g.K = opaque_s(MIXW);
          pg8::StaticOrder So; So.init(g.M, g.N, (int)gridDim.x, opaque_bid());
          pg8::EpiF32 E; E.C = Y; E.ldc = g.N; E.bias = nullptr;
          pg8::gemm_phase<pg8::EpiF32, pg8::StaticOrder, false>((PG8_LAS unsigned char*)smem, g, So, E, nullptr); }
        grid.sync();
        if (layer + 1 < DEPTH) {
            postnorm_rows(Y, layer == 0 ? P.in[0] : P.out, P.out, P.in[3] + layer * D, P.in[2] + (layer + 1) * D, U);
            convert_weights(P, layer + 1, smem);
            grid.sync();
        } else {
            postnorm_rows(Y, layer == 0 ? P.in[0] : P.out, P.out, P.in[3] + layer * D, nullptr, U);
        }
    }
}
}

extern "C" void kernel_launch(void* const* d_in, const int* in_sizes, int n_in, void* d_out, int out_size, void* d_ws, size_t ws_size, hipStream_t stream) {
    static int grid_blocks = 0;
    if (grid_blocks == 0) {
        int dev = 0, cus = 0, per_cu = 0;
        hipGetDevice(&dev);
        hipDeviceGetAttribute(&cus, hipDeviceAttributeMultiprocessorCount, dev);
        if (hipFuncSetAttribute((const void*)mk::fwd_megakernel, hipFuncAttributeMaxDynamicSharedMemorySize, mk::LDS_BYTES) != hipSuccess) fprintf(stderr, "hipFuncSetAttribute failed\n");
        if (hipOccupancyMaxActiveBlocksPerMultiprocessor(&per_cu, (const void*)mk::fwd_megakernel, mk::NTHR, mk::LDS_BYTES) != hipSuccess || per_cu < 1) { fprintf(stderr, "occupancy query: %d\n", per_cu); per_cu = 1; }
        (void)hipGetLastError();
        grid_blocks = cus * 1;
        if (ws_size < mk::WS_END) fprintf(stderr, "workspace too small: %zu < %zu\n", ws_size, (size_t)mk::WS_END);
    }
    hipMemsetAsync((unsigned char*)d_ws + mk::OFF_CTL, 0, 4096, stream);
    mk::Params p{};
    for (int i = 0; i < 23; ++i) p.in[i] = (const float*)d_in[i];
    p.out = (float*)d_out; p.ws = (unsigned char*)d_ws;
    void* args[] = {&p};
    hipError_t e = hipLaunchCooperativeKernel((const void*)mk::fwd_megakernel, dim3(grid_blocks), dim3(mk::NTHR), args, mk::LDS_BYTES, stream);
    if (e != hipSuccess) fprintf(stderr, "cooperative launch failed: %s (grid %d)\n", hipGetErrorString(e), grid_blocks);
}
```

```cpp
#include <hip/hip_runtime.h>
#include <hip/hip_cooperative_groups.h>
#include <cstdio>
#include <cstdint>
namespace cg = cooperative_groups;
namespace pg8 {
#define PG8_LAS __attribute__((address_space(3)))
typedef unsigned short bf16_t;
typedef short bf16x8 __attribute__((ext_vector_type(8)));
typedef float f32x4 __attribute__((ext_vector_type(4)));
typedef unsigned u32x4 __attribute__((ext_vector_type(4)));
constexpr int BM = 256, BK = 64, HALF = 128, HTB = HALF * BK * 2  , STAGE_BYTES = 8 * HTB, NXCD = 8, WGM = 8;

__host__ __device__ __forceinline__ int lds_byte(int r, int c) { const int st = (r >> 4) * 2 + (c >> 5), rr = r & 15, cc = c & 31, ob = rr * 64 + cc * 2; return st * 1024 + (ob ^ (((ob >> 9) & 1) << 5)); }
__host__ __device__ __forceinline__ void stage_rc(int b, int& R, int& C) { const int st = b / 1024, sb = b % 1024, swz = sb ^ (((sb >> 9) & 1) << 5); R = (st >> 1) * 16 + swz / 64; C = (st & 1) * 32 + (swz % 64) / 2; }
__host__ __device__ __forceinline__ int perm32(int rho) { const int n = rho >> 4, i = rho & 15; return 8 * (i >> 2) + 4 * n + (i & 3); }

struct Unit { int pm, pn; };
struct Gemm { const bf16_t* A; const bf16_t* Bt; int M, N, K; };

struct StaticOrder {
    int nM, nN, nwg, G, c;
    __host__ __device__ void init(int M, int N, int G_, int c_) { nM = M / BM; nN = N / BM; nwg = nM * nN; G = G_; c = c_; }
    __host__ __device__ bool next(int i, Unit& u) const {
        const long L = (long)i * G + c; if (L >= nwg) return false;
        int wgid = (int)L; { const int q = nwg / NXCD, r = nwg % NXCD, xcd = wgid % NXCD, off = wgid / NXCD; wgid = (xcd < r ? xcd * (q + 1) : r * (q + 1) + (xcd - r) * q) + off; }
        const int nig = WGM * nN, gid = wgid / nig, fm = gid * WGM, gsz = (nM - fm) < WGM ? (nM - fm) : WGM;
        u.pm = fm + ((wgid % nig) % gsz); u.pn = (wgid % nig) / gsz; return true;
    }
    __device__ __forceinline__ void a_ready(const Unit&) const {}
    __device__ __forceinline__ void done(const Unit&) const {}
};
struct CountedOrder : StaticOrder {
    const unsigned* ready; unsigned need; unsigned* tmo;
    __device__ __forceinline__ void a_ready(const Unit& u) const {
        if (threadIdx.x < 64) {
            const unsigned long long t0 = __builtin_amdgcn_s_memrealtime(); unsigned polls = 0;
            while ((unsigned)__builtin_amdgcn_readfirstlane(__hip_atomic_load(ready + 64 * u.pm, __ATOMIC_RELAXED, __HIP_MEMORY_SCOPE_AGENT)) < need) {
                if ((++polls & 255u) == 0u && __builtin_amdgcn_readfirstlane(__hip_atomic_load(tmo, __ATOMIC_RELAXED, __HIP_MEMORY_SCOPE_AGENT)) != 0u) break;
                if (__builtin_amdgcn_s_memrealtime() - t0 > 2000000ull) {
                    if (threadIdx.x == 0) { unsigned expect = 0u; __hip_atomic_compare_exchange_strong(tmo + 1, &expect, 0x600u | (unsigned)(u.pm & 0xff), __ATOMIC_RELAXED, __ATOMIC_RELAXED, __HIP_MEMORY_SCOPE_AGENT); __hip_atomic_store(tmo, 1u, __ATOMIC_RELAXED, __HIP_MEMORY_SCOPE_AGENT); }
                    break; }
                __builtin_amdgcn_s_sleep(2); }
            __builtin_amdgcn_fence(__ATOMIC_ACQUIRE, "agent");
            asm volatile("s_waitcnt vmcnt(0)" ::: "memory");
        }
#if !defined(BROKEN_HOOK_NO_BARRIER)
        asm volatile("" ::: "memory"); __builtin_amdgcn_s_barrier(); asm volatile("" ::: "memory");
#endif
    }
};

typedef __bf16 bf16x2_t __attribute__((ext_vector_type(2)));
typedef float f32x2c __attribute__((ext_vector_type(2)));
__device__ __forceinline__ unsigned cvt_pk_bf16(float lo, float hi) { f32x2c v = {lo, hi}; bf16x2_t b = __builtin_convertvector(v, bf16x2_t); return __builtin_bit_cast(unsigned, b); }
typedef float f32x2 __attribute__((ext_vector_type(2)));
__device__ __forceinline__ f32x2 gelu_pk(f32x2 v) {
    const f32x2 av = __builtin_elementwise_abs(v), d = av * 0.2316418882f + 1.0f;
    f32x2 t; t.x = __builtin_amdgcn_rcpf(d.x); t.y = __builtin_amdgcn_rcpf(d.y);
    f32x2 q = t * 0.5307027145f + (-0.7265760135f); q = q * t + 0.7107068705f; q = q * t + (-0.142248368f); q = q * t + 0.127414796f; q = q * t;
    const f32x2 s = (v * v) * (-0.72134752044f);
    f32x2 e; e.x = __builtin_amdgcn_exp2f(s.x); e.y = __builtin_amdgcn_exp2f(s.y);
    const f32x2 m = v * (q * e), r = v - m;
    f32x2 o; o.x = v.x < 0.f ? m.x : r.x; o.y = v.y < 0.f ? m.y : r.y; return o;
}

struct EpiF32 {
    static constexpr bool PERM = false, AFTER_DRAIN = false;
    float* C; int ldc; const float* bias;
    __device__ __forceinline__ void operator()(const f32x4 (&acc)[2][2][4][2], const Unit& u, int wr, int wc, int fr, int fq) const {
        const int row0 = u.pm * BM + wr * 64 + fr, col0 = u.pn * BM + wc * 32 + 4 * fq;
        f32x4 bv[2][2];
#pragma unroll
        for (int bj = 0; bj < 2; ++bj)
#pragma unroll
            for (int n = 0; n < 2; ++n) bv[bj][n] = bias ? *(const f32x4*)(bias + col0 + bj * HALF + n * 16) : (f32x4){0.f, 0.f, 0.f, 0.f};
#pragma unroll
        for (int ai = 0; ai < 2; ++ai)
#pragma unroll
            for (int m = 0; m < 4; ++m) { float* rowp = C + (size_t)(row0 + ai * HALF + m * 16) * ldc + col0;
#pragma unroll
                for (int bj = 0; bj < 2; ++bj)
#pragma unroll
                    for (int n = 0; n < 2; ++n) *(f32x4*)(rowp + bj * HALF + n * 16) = acc[ai][bj][m][n] + bv[bj][n]; }
    }
};
template <int ACT  > struct EpiBf16 {
    static constexpr bool PERM = true, AFTER_DRAIN = false;
    bf16_t* O; int ldc; const float* bias; int split_cols; size_t split_stride;
    __device__ __forceinline__ void operator()(const f32x4 (&acc)[2][2][4][2], const Unit& u, int wr, int wc, int fr, int fq) const {
        const int row0 = u.pm * BM + wr * 64 + fr; int colt = u.pn * BM; bf16_t* base = O;
        if (split_cols) { const int t = colt / split_cols; base += (size_t)t * split_stride; colt -= t * split_cols; }
        const int col0 = colt + wc * 32 + 8 * fq, bcol0 = u.pn * BM + wc * 32 + 8 * fq;
        f32x4 bv[2][2];
#pragma unroll
        for (int bj = 0; bj < 2; ++bj)
#pragma unroll
            for (int n = 0; n < 2; ++n) bv[bj][n] = bias ? *(const f32x4*)(bias + bcol0 + bj * HALF + 4 * n) : (f32x4){0.f, 0.f, 0.f, 0.f};
#pragma unroll
        for (int ai = 0; ai < 2; ++ai)
#pragma unroll
            for (int m = 0; m < 4; ++m) { bf16_t* rowp = base + (size_t)(row0 + ai * HALF + m * 16) * ldc + col0;
#pragma unroll
                for (int bj = 0; bj < 2; ++bj) { f32x4 v0 = acc[ai][bj][m][0] + bv[bj][0], v1 = acc[ai][bj][m][1] + bv[bj][1];
                    if (ACT == 1) { f32x2 a = gelu_pk((f32x2){v0[0], v0[1]}), b = gelu_pk((f32x2){v0[2], v0[3]}), c = gelu_pk((f32x2){v1[0], v1[1]}), d = gelu_pk((f32x2){v1[2], v1[3]});
                        v0 = (f32x4){a.x, a.y, b.x, b.y}; v1 = (f32x4){c.x, c.y, d.x, d.y}; }
                    if (ACT == 2) {
#pragma unroll
                        for (int j = 0; j < 4; ++j) { v0[j] = 0.5f * v0[j] * (1.0f + erff(v0[j] * 0.70710678f)); v1[j] = 0.5f * v1[j] * (1.0f + erff(v1[j] * 0.70710678f)); } }
                    u32x4 w; w.x = cvt_pk_bf16(v0[0], v0[1]); w.y = cvt_pk_bf16(v0[2], v0[3]); w.z = cvt_pk_bf16(v1[0], v1[1]); w.w = cvt_pk_bf16(v1[2], v1[3]);
                    *(u32x4*)(rowp + bj * HALF) = w; } }
    }
};


template <class Epi, class Sched, bool STAMP = false>
__device__ __forceinline__ void gemm_phase(PG8_LAS unsigned char* lds, const Gemm g, const Sched& S, const Epi& E, unsigned long long* stamps) {
    int tid_o = threadIdx.x; asm volatile("" : "+v"(tid_o));
    const int tid = tid_o, wid = __builtin_amdgcn_readfirstlane(tid >> 6), lane = tid & 63, wr = wid >> 2, wc = wid & 3, fr = lane & 15, fq = lane >> 4;
    const int K = g.K, nt = K / BK;
    int ts_lo = 0, ts_hi = 0, nts = 0; const unsigned long long rt_entry = STAMP ? (unsigned long long)wall_clock64() : 0ull;
#define PG8_STAMP() do { if (STAMP && wid == 0 && nts < 64) { const unsigned long long _c = (unsigned long long)clock64(); \
        ts_lo = (lane == nts) ? (int)(unsigned)_c : ts_lo; ts_hi = (lane == nts) ? (int)(unsigned)(_c >> 32) : ts_hi; ++nts; } } while (0)
    PG8_STAMP();
    unsigned voffA[2], voffB[2];
#pragma unroll
    for (int i = 0; i < 2; ++i) { int R, C; stage_rc(tid * 16 + i * 8192, R, C); const int Rb = Epi::PERM ? ((R & ~31) + perm32(R & 31)) : R;
        voffA[i] = (unsigned)(R * K + C) * 2u; voffB[i] = (unsigned)(Rb * K + C) * 2u; }
    const size_t kstep = (size_t)(BK * 2);
    const size_t hstep = (size_t)HALF * K * 2;
    const size_t tstep = 2 * hstep;
    const unsigned ldsw = (unsigned)wid * 1024u;
    const int aoff = lds_byte(wr * 64 + fr, fq * 8), boff = lds_byte(wc * 32 + fr, fq * 8);
#define PG8_SA(b, h) (((b) * 2 + (h)) * HTB)
#define PG8_SB(b, h) ((4 + (b) * 2 + (h)) * HTB)
#define PG8_STAGE(bufoff, gbase, voff) do { _Pragma("unroll") for (int _i = 0; _i < 2; ++_i) \
        __builtin_amdgcn_global_load_lds((const unsigned*)((const char*)(gbase) + (voff)[_i]), (PG8_LAS unsigned*)(lds + (bufoff) + ldsw + _i * 8192), 16, 0, 0); } while (0)
#define PG8_LDA(dst, b, h) do { _Pragma("unroll") for (int m = 0; m < 4; ++m) _Pragma("unroll") for (int k = 0; k < 2; ++k) dst[m][k] = *(const PG8_LAS bf16x8*)(lds + PG8_SA(b, h) + aoff + m * 2048 + k * 1024); } while (0)
#define PG8_LDB(dst, b, h) do { _Pragma("unroll") for (int n = 0; n < 2; ++n) _Pragma("unroll") for (int k = 0; k < 2; ++k) dst[n][k] = *(const PG8_LAS bf16x8*)(lds + PG8_SB(b, h) + boff + n * 2048 + k * 1024); } while (0)
#define PG8_MMA(ai, bj, At, Bt) do { __builtin_amdgcn_s_setprio(1); _Pragma("unroll") for (int m = 0; m < 4; ++m) _Pragma("unroll") for (int n = 0; n < 2; ++n) _Pragma("unroll") for (int k = 0; k < 2; ++k) \
        acc[ai][bj][m][n] = __builtin_amdgcn_mfma_f32_16x16x32_bf16(Bt[n][k], At[m][k], acc[ai][bj][m][n], 0, 0, 0); __builtin_amdgcn_s_setprio(0); } while (0)
#define PG8_WAIT_V(n) asm volatile("s_waitcnt vmcnt(" #n ")" ::: "memory")
#define PG8_WAIT_L(n) asm volatile("s_waitcnt lgkmcnt(" #n ")" ::: "memory")
#define PG8_BAR __builtin_amdgcn_s_barrier()
#define PG8_SCHED __builtin_amdgcn_sched_barrier(0)
    Unit cur, nxt; int ui = 0;
    if (!S.next(0, cur)) return;
    f32x4 acc[2][2][4][2];
#pragma unroll
    for (int a = 0; a < 2; ++a)
#pragma unroll
        for (int b = 0; b < 2; ++b)
#pragma unroll
            for (int m = 0; m < 4; ++m)
#pragma unroll
                for (int n = 0; n < 2; ++n) acc[a][b][m][n] = (f32x4){0.f, 0.f, 0.f, 0.f};
    bf16x8 At[4][2], B0[2][2], B1[2][2];
    const char* cA = (const char*)g.A + (size_t)cur.pm * tstep; const char* cB = (const char*)g.Bt + (size_t)cur.pn * tstep;
    S.a_ready(cur);
    PG8_STAGE(PG8_SB(0, 0), cB, voffB); PG8_STAGE(PG8_SA(0, 0), cA, voffA); PG8_STAGE(PG8_SB(0, 1), cB + hstep, voffB); PG8_STAGE(PG8_SA(0, 1), cA + hstep, voffA);
    if (wr == 1) PG8_BAR;
    PG8_WAIT_V(4); PG8_BAR;
    PG8_STAGE(PG8_SB(1, 0), cB + kstep, voffB); PG8_STAGE(PG8_SA(1, 0), cA + kstep, voffA); PG8_STAGE(PG8_SB(1, 1), cB + hstep + kstep, voffB);
    PG8_WAIT_V(6); PG8_BAR;
    PG8_STAMP();
    for (;;) {
        const bool has_next = S.next(ui + 1, nxt);
        const char* nA = has_next ? (const char*)g.A + (size_t)nxt.pm * tstep : cA; const char* nB = has_next ? (const char*)g.Bt + (size_t)nxt.pn * tstep : cB;
        for (int t = 0; t < nt; t += 2) {
            const bool last = (t == nt - 2);
            const char* a1 = cA + (size_t)(t + 1) * kstep;
            const char* a2 = last ? nA : cA + (size_t)(t + 2) * kstep; const char* b2 = last ? nB : cB + (size_t)(t + 2) * kstep;
            const char* a3 = a2 + kstep; const char* b3 = b2 + kstep;
            if (last && has_next) S.a_ready(nxt);
            PG8_LDB(B0, 0, 0); PG8_SCHED; PG8_LDA(At, 0, 0); PG8_STAGE(PG8_SA(1, 1), a1 + hstep, voffA);
            PG8_WAIT_L(8); PG8_BAR; PG8_WAIT_L(0); PG8_MMA(0, 0, At, B0); PG8_BAR; PG8_SCHED;
            PG8_LDB(B1, 0, 1); PG8_STAGE(PG8_SB(0, 0), b2, voffB);
            PG8_BAR; PG8_WAIT_L(0); PG8_MMA(0, 1, At, B1); PG8_BAR;
            PG8_LDA(At, 0, 1); PG8_STAGE(PG8_SA(0, 0), a2, voffA);
            PG8_BAR; PG8_WAIT_L(0); PG8_MMA(1, 0, At, B0); PG8_BAR; PG8_SCHED;
            PG8_STAGE(PG8_SB(0, 1), b2 + hstep, voffB);
            PG8_WAIT_V(6); PG8_BAR; PG8_MMA(1, 1, At, B1); PG8_BAR;
            PG8_LDB(B0, 1, 0); PG8_SCHED; PG8_LDA(At, 1, 0); PG8_STAGE(PG8_SA(0, 1), a2 + hstep, voffA);
            PG8_WAIT_L(8); PG8_BAR; PG8_WAIT_L(0); PG8_MMA(0, 0, At, B0); PG8_BAR; PG8_SCHED;
            PG8_LDB(B1, 1, 1); PG8_STAGE(PG8_SB(1, 0), b3, voffB);
            PG8_BAR; PG8_WAIT_L(0); PG8_MMA(0, 1, At, B1); PG8_BAR;
            PG8_LDA(At, 1, 1); PG8_STAGE(PG8_SA(1, 0), a3, voffA);
            PG8_BAR; PG8_WAIT_L(0); PG8_MMA(1, 0, At, B0); PG8_BAR; PG8_SCHED;
            PG8_STAGE(PG8_SB(1, 1), b3 + hstep, voffB);
            PG8_WAIT_V(6); PG8_BAR; PG8_MMA(1, 1, At, B1); PG8_BAR;
        }
        PG8_STAMP();
        if constexpr (!Epi::AFTER_DRAIN) { E(acc, cur, wr, wc, fr, fq); S.done(cur); }
        PG8_STAMP();
        if (!has_next) break;
#pragma unroll
        for (int a = 0; a < 2; ++a)
#pragma unroll
            for (int b = 0; b < 2; ++b)
#pragma unroll
                for (int m = 0; m < 4; ++m)
#pragma unroll
                    for (int n = 0; n < 2; ++n) acc[a][b][m][n] = (f32x4){0.f, 0.f, 0.f, 0.f};
        cur = nxt; cA = nA; cB = nB; ++ui;
    }
    PG8_WAIT_V(0);
    if (wr == 0) PG8_BAR;
    PG8_BAR;
    if constexpr (Epi::AFTER_DRAIN) { E.fused(acc, cur, wr, wc, fr, fq, lds, wid, lane); S.done(cur); }
    PG8_STAMP();
    if (STAMP && wid == 0) { stamps[lane] = lane < nts ? (((unsigned long long)(unsigned)ts_hi << 32) | (unsigned)ts_lo) : 0ull;
        if (lane == 62) stamps[62] = rt_entry; if (lane == 63) stamps[63] = (unsigned long long)wall_clock64(); }
#undef PG8_STAMP
#undef PG8_SA
#undef PG8_SB
#undef PG8_STAGE
#undef PG8_LDA
#undef PG8_LDB
#undef PG8_MMA
#undef PG8_WAIT_V
#undef PG8_WAIT_L
#undef PG8_BAR
#undef PG8_SCHED
}
}

namespace mk {
using pg8::bf16_t; using pg8::bf16x8; using pg8::f32x4; using pg8::u32x4;
typedef short s16x4 __attribute__((ext_vector_type(4)));
typedef unsigned u32x2 __attribute__((ext_vector_type(2)));

constexpr int D = 2048, NB = 8, S = 2048, M = NB * S, BW = 1024, MIXW = 3072, PW = 13568, DEPTH = 2;
constexpr int C_AQ = 0, C_AK = 1024, C_AV = 2048, C_AG = 3072, C_B = 4096, C_BG = 7424, C_CQ = 8448, C_CI = 9472, C_CF = 10496, C_CG = 12544;
constexpr int NTHR = 512;
constexpr int LDS_BYTES = 147456;
constexpr float LOG2E = 1.4426950408889634f;

constexpr size_t OFF_CTL = 0;
constexpr size_t OFF_WIN = 4096;
constexpr size_t OFF_WOUT = OFF_WIN + (size_t)PW * D * 2;
constexpr size_t OFF_U = OFF_WOUT + (size_t)D * MIXW * 2;
constexpr size_t OFF_PROJ = OFF_U + (size_t)M * D * 2;
constexpr size_t OFF_MIXED = OFF_PROJ + (size_t)M * PW * 2;
constexpr size_t OFF_OC = OFF_MIXED + (size_t)M * MIXW * 2;
constexpr size_t OFF_AO = OFF_OC + (size_t)2 * M * BW * 2;
constexpr size_t OFF_BON = OFF_AO + (size_t)2 * M * BW * 2;
constexpr size_t OFF_YB = OFF_BON + (size_t)2 * M * 16 * 4;
constexpr size_t WS_END = OFF_YB + (size_t)2 * M * BW * 2;

struct Params { const float* in[23]; float* out; unsigned char* ws; };
__device__ __forceinline__ int opaque_tid() { int t = threadIdx.x; asm volatile("" : "+v"(t)); return t; }
__device__ __forceinline__ int opaque_s(int t) { asm volatile("" : "+s"(t)); return t; }
__device__ __forceinline__ int opaque_bid() { int t = blockIdx.x; asm volatile("" : "+s"(t)); return t; }


__device__ __forceinline__ float bf2f(bf16_t v) { return __uint_as_float(((unsigned)v) << 16); }
__device__ __forceinline__ bf16_t f2bf(float f) { unsigned u = __float_as_uint(f); u += 0x7FFFu + ((u >> 16) & 1u); return (bf16_t)(u >> 16); }
typedef __bf16 bf16x2_t __attribute__((ext_vector_type(2)));
typedef float f32x2c __attribute__((ext_vector_type(2)));
__device__ __forceinline__ unsigned pk2(float lo, float hi) { f32x2c v = {lo, hi}; bf16x2_t b = __builtin_convertvector(v, bf16x2_t); return __builtin_bit_cast(unsigned, b); }
__device__ __forceinline__ float wave_sum(float v) {
#pragma unroll
    for (int o = 1; o < 64; o <<= 1) v += __shfl_xor(v, o);
    return v;
}
__device__ __forceinline__ float sigmoidf_(float x) { return 1.f / (1.f + __expf(-x)); }
__device__ __forceinline__ float siluf_(float x) { return x / (1.f + __expf(-x)); }
__device__ __forceinline__ float dpp_xor1(float v) { return __int_as_float(__builtin_amdgcn_mov_dpp(__float_as_int(v), 0xB1, 0xF, 0xF, true)); }
__device__ __forceinline__ float dpp_xor2(float v) { return __int_as_float(__builtin_amdgcn_mov_dpp(__float_as_int(v), 0x4E, 0xF, 0xF, true)); }
__device__ __forceinline__ float dpp_hmir(float v) { return __int_as_float(__builtin_amdgcn_mov_dpp(__float_as_int(v), 0x141, 0xF, 0xF, true)); }
__device__ __forceinline__ float dpp_mir(float v) { return __int_as_float(__builtin_amdgcn_mov_dpp(__float_as_int(v), 0x140, 0xF, 0xF, true)); }
__device__ __forceinline__ float wave_sum_fast(float v) {
    v += dpp_xor1(v); v += dpp_xor2(v); v += dpp_hmir(v); v += dpp_mir(v);
    v += __shfl_xor(v, 16); v += __shfl_xor(v, 32);
    return v;
}
__device__ __forceinline__ float fast_tanh(float x) { return 1.f - 2.f * __builtin_amdgcn_rcpf(1.f + __expf(2.f * x)); }
__device__ __forceinline__ float fast_sigmoid(float x) { return __builtin_amdgcn_rcpf(1.f + __expf(-x)); }
typedef float f32x2 __attribute__((ext_vector_type(2)));
#define MFMA16(a, b, c) __builtin_amdgcn_mfma_f32_16x16x32_bf16((a), (b), (c), 0, 0, 0)
__device__ __forceinline__ bf16x8 join8(s16x4 lo, s16x4 hi) { return __builtin_shufflevector(lo, hi, 0, 1, 2, 3, 4, 5, 6, 7); }
__device__ __forceinline__ bf16x8 pack8(f32x4 a, f32x4 b) {
    u32x4 w; w.x = pk2(a[0], a[1]); w.y = pk2(a[2], a[3]); w.z = pk2(b[0], b[1]); w.w = pk2(b[2], b[3]);
    return __builtin_bit_cast(bf16x8, w);
}

__device__ __forceinline__ void transpose_tile(const float* __restrict__ W, int K, int N, bf16_t* __restrict__ WT, float* tile, int it) {
    const int tid = opaque_tid();
    const int ntn = N >> 6; const int kb = it / ntn, nbk = it - kb * ntn; const int k0 = kb * 64, n0 = nbk * 64;
#pragma unroll
    for (int rr = 0; rr < 2; ++rr) { const int idx = tid + rr * 512; const int kk = idx >> 4, n4 = (idx & 15) * 4;
        const float4 v = *(const float4*)(W + (size_t)(k0 + kk) * N + n0 + n4);
        float* tp = tile + kk * 65 + n4; tp[0] = v.x; tp[1] = v.y; tp[2] = v.z; tp[3] = v.w; }
    __syncthreads();
    { const int n = tid >> 3, kc = (tid & 7) * 8; const float* tp = tile + kc * 65 + n;
      u32x4 o; o.x = pk2(tp[0], tp[65]); o.y = pk2(tp[2 * 65], tp[3 * 65]); o.z = pk2(tp[4 * 65], tp[5 * 65]); o.w = pk2(tp[6 * 65], tp[7 * 65]);
      *(u32x4*)(WT + (size_t)(n0 + n) * K + k0 + kc) = o; }
    __syncthreads();
}
__device__ __forceinline__ void convert_weights(const Params& P, int layer, unsigned char* smem) {
    float* tile = (float*)smem;
    const float* win = P.in[4] + (size_t)layer * D * PW; const float* wout = P.in[5] + (size_t)layer * MIXW * D;
    bf16_t* WinT = (bf16_t*)(P.ws + OFF_WIN); bf16_t* WoutT = (bf16_t*)(P.ws + OFF_WOUT);
    constexpr int T_IN = (D / 64) * (PW / 64), T_OUT = (MIXW / 64) * (D / 64);
    for (int it = opaque_bid(); it < T_IN + T_OUT; it += gridDim.x) {
        if (it < T_IN) transpose_tile(win, D, PW, WinT, tile, it);
        else transpose_tile(wout, MIXW, D, WoutT, tile, it - T_IN);
    }
}
__device__ __forceinline__ void prenorm_rows(const float* __restrict__ x, const float* __restrict__ g, bf16_t* __restrict__ U) {
    const int tid_ = opaque_tid(); const int lane = tid_ & 63, gw = opaque_bid() * 8 + (tid_ >> 6), ngw = gridDim.x * 8;
    for (int row = gw; row < M; row += ngw) {
        const float4* xr = (const float4*)(x + (size_t)row * D) + lane;
        float4 v[8]; float ss = 0.f;
#pragma unroll
        for (int j = 0; j < 8; ++j) { v[j] = xr[64 * j]; ss += v[j].x * v[j].x + v[j].y * v[j].y + v[j].z * v[j].z + v[j].w * v[j].w; }
        const float rstd = rsqrtf(wave_sum(ss) * (1.f / D) + 1e-6f);
        u32x2* o = (u32x2*)(U + (size_t)row * D) + lane;
#pragma unroll
        for (int j = 0; j < 8; ++j) { const float4 gg = ((const float4*)g)[64 * j + lane];
            u32x2 w; w.x = pk2(v[j].x * rstd * gg.x, v[j].y * rstd * gg.y); w.y = pk2(v[j].z * rstd * gg.z, v[j].w * rstd * gg.w); o[64 * j] = w; }
    }
}
__device__ __forceinline__ void postnorm_rows(const bf16_t* __restrict__ y, const float* xin, float* xout, const float* __restrict__ gpost, const float* __restrict__ gpre, bf16_t* __restrict__ U) {
    const int tid_ = opaque_tid(); const int lane = tid_ & 63, gw = opaque_bid() * 8 + (tid_ >> 6), ngw = gridDim.x * 8;
    for (int row = gw; row < M; row += ngw) {
        const u32x2* yr = (const u32x2*)(y + (size_t)row * D) + lane;
        const float4* xr = (const float4*)(xin + (size_t)row * D) + lane;
        float4* xo = (float4*)(xout + (size_t)row * D) + lane;
        float4 v[8]; float ss = 0.f;
#pragma unroll
        for (int j = 0; j < 8; ++j) { const u32x2 w = yr[64 * j]; v[j].x = __uint_as_float(w.x << 16); v[j].y = __uint_as_float(w.x & 0xFFFF0000u); v[j].z = __uint_as_float(w.y << 16); v[j].w = __uint_as_float(w.y & 0xFFFF0000u);
            ss += v[j].x * v[j].x + v[j].y * v[j].y + v[j].z * v[j].z + v[j].w * v[j].w; }
        const float rstd = rsqrtf(wave_sum(ss) * (1.f / D) + 1e-6f);
        float s2 = 0.f;
#pragma unroll
        for (int j = 0; j < 8; ++j) { const float4 gg = ((const float4*)gpost)[64 * j + lane]; const float4 xv = xr[64 * j];
            v[j].x = xv.x + v[j].x * rstd * gg.x; v[j].y = xv.y + v[j].y * rstd * gg.y; v[j].z = xv.z + v[j].z * rstd * gg.z; v[j].w = xv.w + v[j].w * rstd * gg.w;
            xo[64 * j] = v[j]; s2 += v[j].x * v[j].x + v[j].y * v[j].y + v[j].z * v[j].z + v[j].w * v[j].w; }
        if (gpre) {
            const float r2 = rsqrtf(wave_sum(s2) * (1.f / D) + 1e-6f);
            u32x2* o = (u32x2*)(U + (size_t)row * D) + lane;
#pragma unroll
            for (int j = 0; j < 8; ++j) { const float4 gg = ((const float4*)gpre)[64 * j + lane];
                u32x2 w; w.x = pk2(v[j].x * r2 * gg.x, v[j].y * r2 * gg.y); w.y = pk2(v[j].z * r2 * gg.z, v[j].w * r2 * gg.w); o[64 * j] = w; }
        }
    }
}

#define RWKV_LOAD_RAW(cc) do { const int n0_ = (cc) * TCH + pw * TPW; const int T0_ = d ? (S - 1 - n0_) : n0_; const int dstep_ = d ? -1 : 1; \
    _Pragma("unroll") for (int j = 0; j < TPW + 2; ++j) { const int tj = T0_ + (j - 1) * dstep_; const bool ok = (tj >= 0) && (tj < S); \
        const bf16_t* row = proj + ((size_t)b * S + (ok ? tj : T0_)) * PW + C_B; \
        raw[j][0] = row[cr]; raw[j][1] = row[ck]; raw[j][2] = row[cv]; raw[j][3] = row[cw]; raw[j][4] = row[ca]; \
        if (!ok) { raw[j][0] = 0; raw[j][1] = 0; raw[j][2] = 0; raw[j][3] = 0; raw[j][4] = 0; } } } while (0)
__device__ __forceinline__ void rwkv_phase(const Params& P, int layer, unsigned char* smem) {
    constexpr int TCH = 16, TPW = 4, NCH = S / TCH;
    float* VEC = (float*)smem;
    bf16_t* UPT = (bf16_t*)(smem + 49152);
    unsigned char* pbase = smem + 49152 + 18432;
    unsigned char* obase = smem + 49152 + 18432 + 12800;
    unsigned char* nbase = obase + 2 * 18176;
    const int tid = opaque_tid(), wid = __builtin_amdgcn_readfirstlane(tid >> 6), lane = tid & 63, r16 = lane & 15, quad = lane >> 4;
    const bf16_t* proj = (const bf16_t*)(P.ws + OFF_PROJ);
    bf16_t* YB = (bf16_t*)(P.ws + OFF_YB);
    float* BON = (float*)(P.ws + OFF_BON);
    const float* mu = P.in[11] + (size_t)layer * 2 * 3328;
    for (int chain = opaque_bid(); chain < 256; chain += gridDim.x) {
        const int d = chain >> 7, b = (chain >> 4) & 7, h = chain & 15;
        __syncthreads();
        { const float* wup = P.in[13] + ((size_t)(layer * 2 + d) * 64) * 1024 + h * 64; const float* aup = P.in[15] + ((size_t)(layer * 2 + d) * 64) * 1024 + h * 64;
#pragma unroll
          for (int it = 0; it < 16; ++it) { const int e = tid + 512 * it; const int mat = e >> 12, lora = (e >> 6) & 63, ch = e & 63;
              const float v = (mat ? aup : wup)[(size_t)lora * 1024 + ch]; UPT[mat * 4608 + ch * 72 + lora] = f2bf(v); } }
        __syncthreads();
        if (wid < 4) {
            const int cw = wid;
            float* Nm = (float*)(nbase + cw * 1024);
            const int jl = lane & 15, tg = lane >> 4, jcol = cw * 16 + jl;
            const float rkc = P.in[18][(size_t)layer * 1024 + h * 64 + jcol];
            const f32x4 z4 = {0.f, 0.f, 0.f, 0.f};
            f32x4 ST[4];
#pragma unroll
            for (int mt = 0; mt < 4; ++mt) ST[mt] = z4;
            asm volatile("s_waitcnt lgkmcnt(0)" ::: "memory"); __builtin_amdgcn_s_barrier(); asm volatile("" ::: "memory");
            asm volatile("s_waitcnt lgkmcnt(0)" ::: "memory"); __builtin_amdgcn_s_barrier(); asm volatile("" ::: "memory");
            for (int c = 0; c < NCH; ++c) {
                const float* vb = VEC + (c & 1) * (TCH * 384);
                unsigned char* ob = obase + (c & 1) * 18176;
                bf16_t* Pm = (bf16_t*)ob; bf16_t* Rm = (bf16_t*)(ob + 2304); bf16_t* Qm = (bf16_t*)(ob + 4608); bf16_t* Mm = (bf16_t*)(ob + 6912);
                bf16_t* QT = (bf16_t*)(ob + 9216); bf16_t* MT = (bf16_t*)(ob + 12288); float* GT = (float*)(ob + 15360); bf16_t* Bm = (bf16_t*)(ob + 15872);
                {
                    float nk[4], ww[4], ka[4], km[4], rr[4];
#pragma unroll
                    for (int u = 0; u < 4; ++u) { const float* vt = vb + (4 * tg + u) * 384 + jcol; nk[u] = vt[0]; ww[u] = vt[64]; ka[u] = vt[128]; km[u] = vt[192]; rr[u] = vt[256]; }
                    float gl[4];
                    gl[0] = ww[0]; gl[1] = gl[0] * ww[1]; gl[2] = gl[1] * ww[2]; gl[3] = gl[2] * ww[3];
                    const float G0 = __shfl(gl[3], jl), G1 = __shfl(gl[3], jl + 16), G2 = __shfl(gl[3], jl + 32);
                    const float pre = (tg == 0) ? 1.f : (tg == 1) ? G0 : (tg == 2) ? G0 * G1 : (G0 * G1) * G2;
                    float pv[4], rv[4], qv[4], mv[4];
#pragma unroll
                    for (int u = 0; u < 4; ++u) {
                        const float gprev = (u == 0) ? pre : pre * gl[u - 1], gcur = pre * gl[u];
                        const float ig = __builtin_amdgcn_rcpf(gcur);
                        pv[u] = gprev * nk[u]; qv[u] = ka[u] * ig; mv[u] = km[u] * ig; rv[u] = gcur * rr[u];
                    }
                    const unsigned wp0 = pk2(pv[0], pv[1]), wp1 = pk2(pv[2], pv[3]), wr0 = pk2(rv[0], rv[1]), wr1 = pk2(rv[2], rv[3]);
                    const unsigned wq0 = pk2(qv[0], qv[1]), wq1 = pk2(qv[2], qv[3]), wm0 = pk2(mv[0], mv[1]), wm1 = pk2(mv[2], mv[3]);
                    const int t0 = 4 * tg;
                    Pm[(t0) * 72 + jcol] = (bf16_t)(wp0 & 0xFFFFu); Pm[(t0 + 1) * 72 + jcol] = (bf16_t)(wp0 >> 16); Pm[(t0 + 2) * 72 + jcol] = (bf16_t)(wp1 & 0xFFFFu); Pm[(t0 + 3) * 72 + jcol] = (bf16_t)(wp1 >> 16);
                    Rm[(t0) * 72 + jcol] = (bf16_t)(wr0 & 0xFFFFu); Rm[(t0 + 1) * 72 + jcol] = (bf16_t)(wr0 >> 16); Rm[(t0 + 2) * 72 + jcol] = (bf16_t)(wr1 & 0xFFFFu); Rm[(t0 + 3) * 72 + jcol] = (bf16_t)(wr1 >> 16);
                    Qm[(t0) * 72 + jcol] = (bf16_t)(wq0 & 0xFFFFu); Qm[(t0 + 1) * 72 + jcol] = (bf16_t)(wq0 >> 16); Qm[(t0 + 2) * 72 + jcol] = (bf16_t)(wq1 & 0xFFFFu); Qm[(t0 + 3) * 72 + jcol] = (bf16_t)(wq1 >> 16);
                    Mm[(t0) * 72 + jcol] = (bf16_t)(wm0 & 0xFFFFu); Mm[(t0 + 1) * 72 + jcol] = (bf16_t)(wm0 >> 16); Mm[(t0 + 2) * 72 + jcol] = (bf16_t)(wm1 & 0xFFFFu); Mm[(t0 + 3) * 72 + jcol] = (bf16_t)(wm1 >> 16);
                    u32x2 tq; tq.x = wq0; tq.y = wq1; *(u32x2*)(QT + jcol * 24 + t0) = tq;
                    u32x2 tm; tm.x = wm0; tm.y = wm1; *(u32x2*)(MT + jcol * 24 + t0) = tm;
                    { const unsigned wb0 = pk2(rv[0] * rkc, rv[1] * rkc), wb1 = pk2(rv[2] * rkc, rv[3] * rkc);
                      Bm[(t0) * 72 + jcol] = (bf16_t)(wb0 & 0xFFFFu); Bm[(t0 + 1) * 72 + jcol] = (bf16_t)(wb0 >> 16); Bm[(t0 + 2) * 72 + jcol] = (bf16_t)(wb1 & 0xFFFFu); Bm[(t0 + 3) * 72 + jcol] = (bf16_t)(wb1 >> 16); }
                    if (tg == 3) GT[jcol] = pre * gl[3];
                }
                asm volatile("s_waitcnt lgkmcnt(0)" ::: "memory"); __builtin_amdgcn_s_barrier(); asm volatile("" ::: "memory");
                f32x4 Gqp = z4, Gmp = z4, Gqr = z4, Gmr = z4, Npq = z4;
#pragma unroll
                for (int ks = 0; ks < 2; ++ks) {
                    const bf16x8 aQ = *(const bf16x8*)(Qm + r16 * 72 + ks * 32 + quad * 8), aM = *(const bf16x8*)(Mm + r16 * 72 + ks * 32 + quad * 8);
                    const bf16x8 bP = *(const bf16x8*)(Pm + r16 * 72 + ks * 32 + quad * 8), bR = *(const bf16x8*)(Rm + r16 * 72 + ks * 32 + quad * 8);
                    Gqp = MFMA16(aQ, bP, Gqp); Gmp = MFMA16(aM, bP, Gmp); Gqr = MFMA16(aQ, bR, Gqr); Gmr = MFMA16(aM, bR, Gmr); Npq = MFMA16(bP, aQ, Npq);
                }
                if (cw == 0) {
                    f32x4 Gmb = z4;
#pragma unroll
                    for (int ks = 0; ks < 2; ++ks) Gmb = MFMA16(*(const bf16x8*)(Mm + r16 * 72 + ks * 32 + quad * 8), *(const bf16x8*)(Bm + r16 * 72 + ks * 32 + quad * 8), Gmb);
                    if (quad == (r16 >> 2)) {
                        const int rsel = r16 & 3;
                        const float bon = (rsel == 0) ? Gmb[0] : (rsel == 1) ? Gmb[1] : (rsel == 2) ? Gmb[2] : Gmb[3];
                        const int n = c * TCH + r16; const int t = d ? (S - 1 - n) : n;
                        BON[(((size_t)d * NB + b) * 16 + h) * S + t] = bon;
                    }
                }
#pragma unroll
                for (int rg = 0; rg < 4; ++rg) { const int sI = quad * 4 + rg;
                    if (sI >= r16) { Gqp[rg] = 0.f; Gmp[rg] = 0.f; }
                    if (sI > r16) { Gqr[rg] = 0.f; Gmr[rg] = 0.f; }
                    if (sI <= r16) Npq[rg] = 0.f; }
                f32x4 SA0 = z4, Y0 = z4;
#pragma unroll
                for (int ks = 0; ks < 2; ++ks) {
                    const bf16x8 sb = pack8(ST[2 * ks], ST[2 * ks + 1]);
                    const bf16_t* pp = Pm + r16 * 72 + ks * 32 + quad * 4; const bf16_t* rp = Rm + r16 * 72 + ks * 32 + quad * 4;
                    const bf16x8 pa = join8(*(const s16x4*)pp, *(const s16x4*)(pp + 16)), ra = join8(*(const s16x4*)rp, *(const s16x4*)(rp + 16));
                    SA0 = MFMA16(pa, sb, SA0); Y0 = MFMA16(ra, sb, Y0);
                }
                f32x4 Vv;
#pragma unroll
                for (int jj = 0; jj < 4; ++jj) Vv[jj] = vb[(quad * 4 + jj) * 384 + 320 + cw * 16 + r16];
                const f32x4 Cc = MFMA16(pack8(Gmp, z4), pack8(Vv, z4), SA0);
                const bf16x8 m1 = pack8(Gqp, z4), n1 = pack8(Npq, z4);
                const f32x4 Mc2 = MFMA16(n1, m1, z4), Nc2 = MFMA16(m1, n1, z4);
                const bf16x8 m2 = pack8(Mc2, z4), n2 = pack8(Nc2, z4);
                const f32x4 Mc4 = MFMA16(n2, m2, z4), Nc4 = MFMA16(m2, n2, z4);
                const bf16x8 m4 = pack8(Mc4, z4), n4 = pack8(Nc4, z4);
                const f32x4 Mc8 = MFMA16(n4, m4, z4);
                f32x4 SAc = MFMA16(pack8(Mc8, z4), pack8(Cc, z4), Cc);
                SAc = MFMA16(m4, pack8(SAc, z4), SAc);
                SAc = MFMA16(m2, pack8(SAc, z4), SAc);
                SAc = MFMA16(m1, pack8(SAc, z4), SAc);
                const bf16x8 Bsv = pack8(SAc, Vv);
                const f32x4 Yc = MFMA16(pack8(Gqr, Gmr), Bsv, Y0);
#pragma unroll
                for (int rg = 0; rg < 4; ++rg) { const int n = c * TCH + quad * 4 + rg; const int t = d ? (S - 1 - n) : n;
                    YB[((size_t)d * M + (size_t)b * S + t) * 1024 + h * 64 + cw * 16 + r16] = f2bf(Yc[rg]); }
#pragma unroll
                for (int mt = 0; mt < 4; ++mt) {
                    const bf16_t* qp = QT + (mt * 16 + r16) * 24 + quad * 4; const bf16_t* mp = MT + (mt * 16 + r16) * 24 + quad * 4;
                    const f32x4 acc = MFMA16(join8(*(const s16x4*)qp, *(const s16x4*)mp), Bsv, ST[mt]);
                    const f32x4 gt = *(const f32x4*)(GT + mt * 16 + quad * 4);
                    ST[mt] = acc * gt;
                }
                asm volatile("s_waitcnt lgkmcnt(0)" ::: "memory"); __builtin_amdgcn_s_barrier(); asm volatile("" ::: "memory");
            }
        } else {
            const int pw = wid - 4;
            bf16_t* Aw = (bf16_t*)(pbase + pw * 3200); bf16_t* Aa = Aw + TPW * 72; float* X = (float*)(pbase + pw * 3200 + 1152);
            const int cr = h * 64 + lane, ck = 1024 + h * 64 + lane, cv = 2048 + h * 64 + lane, cw = 3072 + d * 64 + lane, ca = 3200 + d * 64 + lane;
            const int mo0 = d ? 3328 : 0, mo1 = d ? 0 : 3328;
            const float mr0 = mu[mo0 + cr], mr1 = mu[mo1 + cr], mk0 = mu[mo0 + ck], mk1 = mu[mo1 + ck], mv0 = mu[mo0 + cv], mv1 = mu[mo1 + cv];
            const float mw0 = mu[mo0 + cw], mw1 = mu[mo1 + cw], ma0 = mu[mo0 + ca], ma1 = mu[mo1 + ca];
            const int chn = h * 64 + lane;
            const float w0v = P.in[12][(size_t)(layer * 2 + d) * 1024 + chn], a0v = P.in[14][(size_t)(layer * 2 + d) * 1024 + chn];
            const float kkw = P.in[16][(size_t)layer * 1024 + chn], kaw = P.in[17][(size_t)layer * 1024 + chn], rkw = P.in[18][(size_t)layer * 1024 + chn];
            unsigned short raw[TPW + 2][5];
            RWKV_LOAD_RAW(0);
            for (int c = 0; c < NCH + 1; ++c) {
                if (c < NCH) {
                    float* vb = VEC + (c & 1) * (TCH * 384);
                    float rr[TPW], kv[TPW], vv[TPW], kk[TPW];
                    {
                        float fr[TPW + 2][5];
#pragma unroll
                        for (int j = 0; j < TPW + 2; ++j)
#pragma unroll
                            for (int st = 0; st < 5; ++st) fr[j][st] = bf2f(raw[j][st]);
                        if (c + 1 < NCH) { RWKV_LOAD_RAW(c + 1); }
#pragma unroll
                        for (int i = 0; i < TPW; ++i) {
                            float p0, pa, pb;
                            p0 = fr[i + 1][0]; pa = fr[i][0]; pb = fr[i + 2][0]; rr[i] = p0 + mr0 * (pa - p0) + mr1 * (pb - p0);
                            p0 = fr[i + 1][1]; pa = fr[i][1]; pb = fr[i + 2][1]; kv[i] = p0 + mk0 * (pa - p0) + mk1 * (pb - p0);
                            p0 = fr[i + 1][2]; pa = fr[i][2]; pb = fr[i + 2][2]; vv[i] = p0 + mv0 * (pa - p0) + mv1 * (pb - p0);
                            p0 = fr[i + 1][3]; pa = fr[i][3]; pb = fr[i + 2][3]; const float wd = p0 + mw0 * (pa - p0) + mw1 * (pb - p0);
                            p0 = fr[i + 1][4]; pa = fr[i][4]; pb = fr[i + 2][4]; const float ad = p0 + ma0 * (pa - p0) + ma1 * (pb - p0);
                            Aw[i * 72 + lane] = f2bf(fast_tanh(wd)); Aa[i * 72 + lane] = f2bf(ad);
                            const float k2 = kv[i] * kkw; const float n2 = wave_sum_fast(k2 * k2);
                            kk[i] = k2 * __builtin_amdgcn_rsqf(fmaxf(n2, 1e-24f));
                        }
                    }
                    asm volatile("s_waitcnt lgkmcnt(0)" ::: "memory"); __builtin_amdgcn_s_barrier(); asm volatile("" ::: "memory");
#pragma unroll
                    for (int mat = 0; mat < 2; ++mat) {
                        const bf16_t* A = mat ? Aa : Aw;
                        const bf16x8 a0f = *(const bf16x8*)(A + (r16 & (TPW - 1)) * 72 + quad * 8), a1f = *(const bf16x8*)(A + (r16 & (TPW - 1)) * 72 + 32 + quad * 8);
#pragma unroll
                        for (int nt = 0; nt < 4; ++nt) {
                            const bf16_t* B = UPT + mat * 4608 + (nt * 16 + r16) * 72 + quad * 8;
                            f32x4 acc = {0.f, 0.f, 0.f, 0.f};
                            acc = MFMA16(a0f, *(const bf16x8*)B, acc); acc = MFMA16(a1f, *(const bf16x8*)(B + 32), acc);
                            if (quad == 0) {
#pragma unroll
                                for (int rg = 0; rg < 4; ++rg) X[mat * 256 + rg * 64 + nt * 16 + r16] = acc[rg];
                            }
                        }
                    }
                    asm volatile("s_waitcnt lgkmcnt(0)" ::: "memory");
#pragma unroll
                    for (int i = 0; i < TPW; ++i) {
                        const int s = pw * TPW + i; const int n = c * TCH + s; const int t = d ? (S - 1 - n) : n;
                        const float xw = X[i * 64 + lane] + w0v, xa = X[256 + i * 64 + lane] + a0v;
                        const float dec = __expf(-0.6065306597126334f * fast_sigmoid(xw)); const float av = fast_sigmoid(xa);
                        const float kmod = kv[i] * (1.f + (av - 1.f) * kaw); const float kka = kk[i] * av;
                        float* o = vb + s * 384 + lane;
                        o[0] = -kk[i]; o[64] = dec; o[128] = kka; o[192] = kmod; o[256] = rr[i]; o[320] = vv[i];
                    }
                }
                if (c == NCH) { asm volatile("s_waitcnt lgkmcnt(0)" ::: "memory"); __builtin_amdgcn_s_barrier(); asm volatile("" ::: "memory"); }
                asm volatile("s_waitcnt lgkmcnt(0)" ::: "memory"); __builtin_amdgcn_s_barrier(); asm volatile("" ::: "memory");
            }
        }
    }
}

__device__ __forceinline__ int swz40(int row, int s) { return row * 40 + ((((s >> 3) ^ (row >> 3)) & 3) << 3) + (s & 7); }
__device__ __forceinline__ void hgrn_phase(const Params& P, int layer, unsigned char* smem) {
    bf16_t* QE = (bf16_t*)smem; bf16_t* KE = (bf16_t*)(smem + 8704); bf16_t* KLT = (bf16_t*)(smem + 17408); bf16_t* VT = (bf16_t*)(smem + 27648);
    float* LF = (float*)(smem + 37888); float* EL = (float*)(smem + 54272);
    const int tid = opaque_tid(), wid = __builtin_amdgcn_readfirstlane(tid >> 6), lane = tid & 63, r16 = lane & 15, quad = lane >> 4;
    const bf16_t* proj = (const bf16_t*)(P.ws + OFF_PROJ);
    bf16_t* OC = (bf16_t*)(P.ws + OFF_OC);
    const int es = tid >> 4, ekc = (tid & 15) * 8;
    for (int chain = opaque_bid(); chain < 128; chain += gridDim.x) {
        const int d = chain >> 6, b = (chain >> 3) & 7, h = chain & 7;
        float lb[8];
#pragma unroll
        for (int j = 0; j < 8; ++j) lb[j] = 0.f;
        if (layer > 0) {
#pragma unroll
            for (int j = 0; j < 8; ++j) { const float l0 = P.in[21][(size_t)(d * 2 + 0) * 1024 + h * 128 + ekc + j], l1 = P.in[21][(size_t)(d * 2 + 1) * 1024 + h * 128 + ekc + j]; lb[j] = 1.f / (1.f + __expf(l0 - l1)); }
        }
        f32x4 Sacc[8];
#pragma unroll
        for (int mt = 0; mt < 8; ++mt) Sacc[mt] = (f32x4){0.f, 0.f, 0.f, 0.f};
        u32x4 zraw, qraw, vraw;
        { const int t = d ? (S - 1 - es) : es; const bf16_t* row = proj + ((size_t)b * S + t) * PW + h * 128 + ekc;
          zraw = *(const u32x4*)(row + C_CF + d * 1024); qraw = *(const u32x4*)(row + C_CQ); vraw = *(const u32x4*)(row + C_CI); }
        for (int c = 0; c < 64; ++c) {
            __syncthreads();
            { const int n = c * 32 + es; const int t = d ? (S - 1 - n) : n; const bf16_t* row = proj + ((size_t)b * S + t) * PW + h * 128 + ekc;
              zraw = *(const u32x4*)(row + C_CF + d * 1024); qraw = *(const u32x4*)(row + C_CQ); vraw = *(const u32x4*)(row + C_CI); }
            float kval[8];
            {
                float lf[8];
#pragma unroll
                for (int j = 0; j < 8; ++j) {
                    const unsigned wv = zraw[j >> 1]; const float z = (j & 1) ? __uint_as_float(wv & 0xFFFF0000u) : __uint_as_float(wv << 16);
                    const float e = __expf(-fabsf(z));
                    const float ls = fminf(z, 0.f) - __logf(1.f + e);
                    const float sg = (z >= 0.f ? 1.f : e) * __builtin_amdgcn_rcpf(1.f + e);
                    lf[j] = (lb[j] > 0.f) ? __logf(lb[j] + (1.f - lb[j]) * sg) : ls;
                    kval[j] = (1.f - lb[j]) * (1.f - sg);
                }
                *(f32x4*)(LF + es * 128 + ekc) = (f32x4){lf[0], lf[1], lf[2], lf[3]}; *(f32x4*)(LF + es * 128 + ekc + 4) = (f32x4){lf[4], lf[5], lf[6], lf[7]};
#pragma unroll
                for (int j = 0; j < 8; ++j) { const unsigned wv = vraw[j >> 1]; VT[swz40(ekc + j, es)] = (bf16_t)((j & 1) ? (wv >> 16) : (wv & 0xFFFFu)); }
            }
            __syncthreads();
            if (tid < 128) {
                float cum = 0.f;
#pragma unroll
                for (int s = 0; s < 32; ++s) { cum += LF[s * 128 + tid]; LF[s * 128 + tid] = cum; }
                EL[tid] = __expf(cum);
            }
            __syncthreads();
            {
                const f32x4 c0 = *(const f32x4*)(LF + es * 128 + ekc), c1v = *(const f32x4*)(LF + es * 128 + ekc + 4);
                const f32x4 l0 = *(const f32x4*)(LF + 31 * 128 + ekc), l1 = *(const f32x4*)(LF + 31 * 128 + ekc + 4);
                float qe[8], ke[8];
#pragma unroll
                for (int j = 0; j < 8; ++j) {
                    const unsigned wv = qraw[j >> 1]; const float qv = (j & 1) ? __uint_as_float(wv & 0xFFFF0000u) : __uint_as_float(wv << 16);
                    const float cum = (j < 4) ? c0[j & 3] : c1v[j & 3], last = (j < 4) ? l0[j & 3] : l1[j & 3];
                    qe[j] = qv * __expf(cum); ke[j] = kval[j] * __expf(-cum);
                    KLT[swz40(ekc + j, es)] = f2bf(kval[j] * __expf(last - cum));
                }
                u32x4 w; w.x = pk2(qe[0], qe[1]); w.y = pk2(qe[2], qe[3]); w.z = pk2(qe[4], qe[5]); w.w = pk2(qe[6], qe[7]); *(u32x4*)(QE + es * 136 + ekc) = w;
                w.x = pk2(ke[0], ke[1]); w.y = pk2(ke[2], ke[3]); w.z = pk2(ke[4], ke[5]); w.w = pk2(ke[6], ke[7]); *(u32x4*)(KE + es * 136 + ekc) = w;
            }
            if (false) { const int n = (c + 1) * 32 + es; const int t = d ? (S - 1 - n) : n; const bf16_t* row = proj + ((size_t)b * S + t) * PW + h * 128 + ekc;
                zraw = *(const u32x4*)(row + C_CF + d * 1024); qraw = *(const u32x4*)(row + C_CQ); vraw = *(const u32x4*)(row + C_CI); }
            __syncthreads();
            f32x4 sc00 = {0.f, 0.f, 0.f, 0.f}, sc01 = sc00, sc11 = sc00;
#pragma unroll
            for (int ks = 0; ks < 4; ++ks) {
                const bf16x8 ke0 = *(const bf16x8*)(KE + r16 * 136 + ks * 32 + quad * 8), ke1 = *(const bf16x8*)(KE + (16 + r16) * 136 + ks * 32 + quad * 8);
                const bf16x8 qe0 = *(const bf16x8*)(QE + r16 * 136 + ks * 32 + quad * 8), qe1 = *(const bf16x8*)(QE + (16 + r16) * 136 + ks * 32 + quad * 8);
                sc00 = MFMA16(ke0, qe0, sc00); sc01 = MFMA16(ke0, qe1, sc01); sc11 = MFMA16(ke1, qe1, sc11);
            }
#pragma unroll
            for (int rg = 0; rg < 4; ++rg) { if (quad * 4 + rg > r16) { sc00[rg] = 0.f; sc11[rg] = 0.f; } }
            const f32x4 zero4 = {0.f, 0.f, 0.f, 0.f};
            const bf16x8 p0 = pack8(sc00, zero4), p1 = pack8(sc01, sc11);
            const int vrow_i = wid * 16 + r16;
            const bf16x8 vperm = join8(*(const s16x4*)(VT + swz40(vrow_i, quad * 4)), *(const s16x4*)(VT + swz40(vrow_i, 16 + quad * 4)));
            f32x4 o0 = MFMA16(p0, vperm, zero4), o1 = MFMA16(p1, vperm, zero4);
#pragma unroll
            for (int ks = 0; ks < 4; ++ks) {
                const bf16x8 sb = pack8(Sacc[2 * ks], Sacc[2 * ks + 1]);
                const bf16_t* q0p = QE + r16 * 136 + ks * 32 + quad * 4; const bf16_t* q1p = QE + (16 + r16) * 136 + ks * 32 + quad * 4;
                const bf16x8 qa0 = join8(*(const s16x4*)q0p, *(const s16x4*)(q0p + 16)), qa1 = join8(*(const s16x4*)q1p, *(const s16x4*)(q1p + 16));
                o0 = MFMA16(qa0, sb, o0); o1 = MFMA16(qa1, sb, o1);
            }
#pragma unroll
            for (int rg = 0; rg < 4; ++rg) {
                { const int n = c * 32 + quad * 4 + rg; const int t = d ? (S - 1 - n) : n; OC[((size_t)d * M + (size_t)b * S + t) * 1024 + h * 128 + wid * 16 + r16] = f2bf(o0[rg]); }
                { const int n = c * 32 + 16 + quad * 4 + rg; const int t = d ? (S - 1 - n) : n; OC[((size_t)d * M + (size_t)b * S + t) * 1024 + h * 128 + wid * 16 + r16] = f2bf(o1[rg]); }
            }
            const bf16x8 vnat = *(const bf16x8*)(VT + swz40(vrow_i, quad * 8));
#pragma unroll
            for (int mt = 0; mt < 8; ++mt) {
                const f32x4 el = *(const f32x4*)(EL + mt * 16 + quad * 4);
                f32x4 sa = Sacc[mt] * el;
                const bf16x8 kl = *(const bf16x8*)(KLT + swz40(mt * 16 + r16, quad * 8));
                Sacc[mt] = MFMA16(kl, vnat, sa);
            }
        }
    }
}

__device__ __forceinline__ void attn_phase(const Params& P, int layer, unsigned char* smem, unsigned* counter) {
    float* TAB = (float*)smem; bf16_t* KT = (bf16_t*)(smem + 16384); bf16_t* VTt = (bf16_t*)(smem + 16384 + 9216); int* sh_unit = (int*)(smem + 16384 + 9216 + 18432);
    const int tid = opaque_tid(), wid = __builtin_amdgcn_readfirstlane(tid >> 6), lane = tid & 63, r16 = lane & 15, quad = lane >> 4;
    const bf16_t* proj = (const bf16_t*)(P.ws + OFF_PROJ);
    bf16_t* AO = (bf16_t*)(P.ws + OFF_AO);
    const float* rel_bias = P.in[1];
    const float c1 = 0.125f * LOG2E;
    for (;;) {
        __syncthreads();
        if (tid == 0) *sh_unit = (int)atomicAdd(counter, 1u);
        __syncthreads();
        const int u = *sh_unit;
        if (u >= 1024) break;
        const int qb = u & 7, m = (u >> 3) & 1, h = (u >> 4) & 7, b = u >> 7;
        for (int e = tid; e < 4095; e += 512) { const int rel = e - 2047; const int n = rel < 0 ? -rel : rel; int bk;
            if (n < 8) bk = n; else { const int lg = 31 - __clz(n * n); bk = 2 + lg; if (bk > 15) bk = 15; }
            if (rel > 0) bk += 16; TAB[e] = rel_bias[bk * 8 + h] * LOG2E; }
        const int qrow0 = qb * 256 + wid * 32;
        bf16x8 Qf[2][2];
#pragma unroll
        for (int nq = 0; nq < 2; ++nq)
#pragma unroll
            for (int ks = 0; ks < 2; ++ks) Qf[nq][ks] = *(const bf16x8*)(proj + ((size_t)b * S + qrow0 + nq * 16 + r16) * PW + C_AQ + h * 128 + m * 64 + ks * 32 + quad * 8);
        f32x4 O[2][8];
#pragma unroll
        for (int nq = 0; nq < 2; ++nq)
#pragma unroll
            for (int dt = 0; dt < 8; ++dt) O[nq][dt] = (f32x4){0.f, 0.f, 0.f, 0.f};
        float mrun[2] = {-1e30f, -1e30f}, lrun[2] = {0.f, 0.f};
        const int kkey = tid >> 3, kchunk = tid & 7;
        const int vkp = tid & 31, vchunk = tid >> 5;
        const bf16_t* kbase = proj + ((size_t)b * S + kkey) * PW + C_AK + h * 128 + m * 64 + kchunk * 8;
        const bf16_t* vbase = proj + ((size_t)b * S + 2 * vkp) * PW + C_AV + h * 128 + vchunk * 8;
        u32x4 kreg = *(const u32x4*)kbase, vreg0 = *(const u32x4*)vbase, vreg1 = *(const u32x4*)(vbase + PW);
        for (int kt = 0; kt < 32; ++kt) {
            __syncthreads();
            *(u32x4*)(KT + kkey * 72 + kchunk * 8) = kreg;
            { unsigned* vd = (unsigned*)(VTt + (vchunk * 8) * 72 + 2 * vkp);
#pragma unroll
              for (int i2 = 0; i2 < 4; ++i2) { const unsigned a = vreg0[i2], bq = vreg1[i2];
                  vd[(2 * i2) * 36] = (a & 0xFFFFu) | (bq << 16); vd[(2 * i2 + 1) * 36] = (a >> 16) | (bq & 0xFFFF0000u); } }
            __syncthreads();
            if (kt + 1 < 32) { const size_t adv = (size_t)(kt + 1) * 64 * PW; kreg = *(const u32x4*)(kbase + adv); vreg0 = *(const u32x4*)(vbase + adv); vreg1 = *(const u32x4*)(vbase + adv + PW); }
            const int k0 = kt * 64;
            f32x4 st[2][4];
#pragma unroll
            for (int mt = 0; mt < 4; ++mt) {
                const bf16x8 ka = *(const bf16x8*)(KT + (mt * 16 + r16) * 72 + quad * 8), kb2 = *(const bf16x8*)(KT + (mt * 16 + r16) * 72 + 32 + quad * 8);
#pragma unroll
                for (int nq = 0; nq < 2; ++nq) { f32x4 a = {0.f, 0.f, 0.f, 0.f}; a = MFMA16(ka, Qf[nq][0], a); a = MFMA16(kb2, Qf[nq][1], a); st[nq][mt] = a; }
            }
            const bool posfar = (k0 - (qrow0 + 31)) >= 96, negfar = (qrow0 - (k0 + 63)) >= 96;
            if (posfar || negfar) {
                const float cb = posfar ? TAB[2047 + 128] : TAB[2047 - 128];
#pragma unroll
                for (int nq = 0; nq < 2; ++nq)
#pragma unroll
                    for (int mt = 0; mt < 4; ++mt) st[nq][mt] = st[nq][mt] * c1 + cb;
            } else {
#pragma unroll
                for (int nq = 0; nq < 2; ++nq)
#pragma unroll
                    for (int mt = 0; mt < 4; ++mt) { const float* tp = TAB + (k0 + mt * 16 + quad * 4) - (qrow0 + nq * 16 + r16) + 2047;
#pragma unroll
                        for (int rg = 0; rg < 4; ++rg) st[nq][mt][rg] = st[nq][mt][rg] * c1 + tp[rg]; }
            }
            bf16x8 pf[2][2];
#pragma unroll
            for (int nq = 0; nq < 2; ++nq) {
                float mx = st[nq][0][0];
#pragma unroll
                for (int mt = 0; mt < 4; ++mt)
#pragma unroll
                    for (int rg = 0; rg < 4; ++rg) mx = fmaxf(mx, st[nq][mt][rg]);
                mx = fmaxf(mx, __shfl_xor(mx, 16)); mx = fmaxf(mx, __shfl_xor(mx, 32));
                const float mnew = fmaxf(mrun[nq], mx); const float alpha = __builtin_amdgcn_exp2f(mrun[nq] - mnew); mrun[nq] = mnew;
                float ps = 0.f;
#pragma unroll
                for (int mt = 0; mt < 4; ++mt)
#pragma unroll
                    for (int rg = 0; rg < 4; ++rg) { const float pv = __builtin_amdgcn_exp2f(st[nq][mt][rg] - mnew); st[nq][mt][rg] = pv; ps += pv; }
                lrun[nq] = lrun[nq] * alpha + ps;
#pragma unroll
                for (int dt = 0; dt < 8; ++dt) O[nq][dt] = O[nq][dt] * alpha;
                pf[nq][0] = pack8(st[nq][0], st[nq][1]); pf[nq][1] = pack8(st[nq][2], st[nq][3]);
            }
#pragma unroll
            for (int dt = 0; dt < 8; ++dt) {
                const bf16_t* vr = VTt + (dt * 16 + r16) * 72 + quad * 4;
                const bf16x8 va0 = join8(*(const s16x4*)vr, *(const s16x4*)(vr + 16)), va1 = join8(*(const s16x4*)(vr + 32), *(const s16x4*)(vr + 48));
#pragma unroll
                for (int nq = 0; nq < 2; ++nq) { O[nq][dt] = MFMA16(va0, pf[nq][0], O[nq][dt]); O[nq][dt] = MFMA16(va1, pf[nq][1], O[nq][dt]); }
            }
        }
#pragma unroll
        for (int nq = 0; nq < 2; ++nq) {
            float l = lrun[nq]; l += __shfl_xor(l, 16); l += __shfl_xor(l, 32);
            const float inv = 1.f / l;
            bf16_t* orow = AO + ((size_t)m * M + (size_t)b * S + qrow0 + nq * 16 + r16) * 1024 + h * 128 + quad * 4;
#pragma unroll
            for (int dt = 0; dt < 8; ++dt) { u32x2 w; w.x = pk2(O[nq][dt][0] * inv, O[nq][dt][1] * inv); w.y = pk2(O[nq][dt][2] * inv, O[nq][dt][3] * inv); *(u32x2*)(orow + dt * 16) = w; }
        }
    }
}

__device__ __forceinline__ void load16(const bf16_t* p, float* o) {
    const u32x4 a = *(const u32x4*)p, b = *(const u32x4*)(p + 8);
#pragma unroll
    for (int i = 0; i < 4; ++i) { o[2 * i] = __uint_as_float(a[i] << 16); o[2 * i + 1] = __uint_as_float(a[i] & 0xFFFF0000u); o[8 + 2 * i] = __uint_as_float(b[i] << 16); o[8 + 2 * i + 1] = __uint_as_float(b[i] & 0xFFFF0000u); }
}
__device__ __forceinline__ void store16(bf16_t* p, const float* v) {
    u32x4 a, b; a.x = pk2(v[0], v[1]); a.y = pk2(v[2], v[3]); a.z = pk2(v[4], v[5]); a.w = pk2(v[6], v[7]); b.x = pk2(v[8], v[9]); b.y = pk2(v[10], v[11]); b.z = pk2(v[12], v[13]); b.w = pk2(v[14], v[15]);
    *(u32x4*)p = a; *(u32x4*)(p + 8) = b;
}
__device__ __forceinline__ void loadf16(const float* p, float* o) {
#pragma unroll
    for (int i = 0; i < 4; ++i) { const float4 v = ((const float4*)p)[i]; o[4 * i] = v.x; o[4 * i + 1] = v.y; o[4 * i + 2] = v.z; o[4 * i + 3] = v.w; }
}
__device__ __forceinline__ void finish_phase(const Params& P, int layer) {
    const int tid_ = opaque_tid(); const int lane = tid_ & 63, gw = opaque_bid() * 8 + (tid_ >> 6), ngw = gridDim.x * 8;
    const bf16_t* proj = (const bf16_t*)(P.ws + OFF_PROJ);
    const bf16_t* AO = (const bf16_t*)(P.ws + OFF_AO); const bf16_t* YB = (const bf16_t*)(P.ws + OFF_YB); const bf16_t* OC = (const bf16_t*)(P.ws + OFF_OC);
    const float* BON = (const float*)(P.ws + OFF_BON);
    bf16_t* MIX = (bf16_t*)(P.ws + OFF_MIXED);
    const float lam_init = 0.8f - 0.6f * expf(-0.3f * (float)layer);
    const float s1 = wave_sum(P.in[6][layer * 64 + lane] * P.in[7][layer * 64 + lane]), s2 = wave_sum(P.in[8][layer * 64 + lane] * P.in[9][layer * 64 + lane]);
    const float lam = expf(s1) - expf(s2) + lam_init;
    const int c0 = lane * 16;
    const float* mu0p = P.in[11] + (size_t)layer * 2 * 3328 + 2048 + c0; const float* mu1p = mu0p + 3328;
    for (int tok = gw; tok < M; tok += ngw) {
        const bf16_t* prow = proj + (size_t)tok * PW;
        bf16_t* mrow = MIX + (size_t)tok * MIXW;
        float a[16], bb[16], g[16], pr[16];
        load16(AO + (size_t)tok * 1024 + c0, a); load16(AO + ((size_t)M + tok) * 1024 + c0, bb); load16(prow + C_AG + c0, g);
        { float ss = 0.f;
#pragma unroll
          for (int i = 0; i < 16; ++i) { a[i] = a[i] - lam * bb[i]; ss += a[i] * a[i]; }
          ss += __shfl_xor(ss, 1); ss += __shfl_xor(ss, 2); ss += __shfl_xor(ss, 4);
          const float rstd = rsqrtf(ss * (1.f / 128.f) + 1e-5f) * (1.f - lam_init);
          loadf16(P.in[10] + layer * 128 + (c0 & 127), pr);
#pragma unroll
          for (int i = 0; i < 16; ++i) a[i] = a[i] * rstd * pr[i] * siluf_(g[i]);
          store16(mrow + c0, a); }
        load16(YB + (size_t)tok * 1024 + c0, a); load16(YB + ((size_t)M + tok) * 1024 + c0, bb); load16(prow + C_BG + c0, g);
        { float sm = 0.f;
#pragma unroll
          for (int i = 0; i < 16; ++i) { a[i] += bb[i]; sm += a[i]; }
          sm += __shfl_xor(sm, 1); sm += __shfl_xor(sm, 2);
          const float mean = sm * (1.f / 64.f); float vs = 0.f;
#pragma unroll
          for (int i = 0; i < 16; ++i) { a[i] -= mean; vs += a[i] * a[i]; }
          vs += __shfl_xor(vs, 1); vs += __shfl_xor(vs, 2);
          const float rstd = rsqrtf(vs * (1.f / 64.f) + 64e-5f);
          const int head = lane >> 2;
          const float bon = BON[(((size_t)(tok >> 11)) * 16 + head) * S + (tok & (S - 1))] + BON[(((size_t)NB + (tok >> 11)) * 16 + head) * S + (tok & (S - 1))];
          const int sp = tok & (S - 1);
          loadf16(P.in[19] + layer * 1024 + c0, pr);
#pragma unroll
          for (int i = 0; i < 16; ++i) a[i] = a[i] * rstd * pr[i];
          loadf16(P.in[20] + layer * 1024 + c0, pr);
#pragma unroll
          for (int i = 0; i < 16; ++i) a[i] += pr[i];
          load16(prow + C_B + 2048 + c0, bb);
          float vsft[16];
          { float nb[16];
            if (sp > 0) load16(prow - PW + C_B + 2048 + c0, nb); else {
#pragma unroll
                for (int i = 0; i < 16; ++i) nb[i] = 0.f; }
            loadf16(mu0p, pr);
#pragma unroll
            for (int i = 0; i < 16; ++i) vsft[i] = bb[i] + pr[i] * (nb[i] - bb[i]);
            if (sp < S - 1) load16(prow + PW + C_B + 2048 + c0, nb); else {
#pragma unroll
                for (int i = 0; i < 16; ++i) nb[i] = 0.f; }
            loadf16(mu1p, pr);
#pragma unroll
            for (int i = 0; i < 16; ++i) vsft[i] += pr[i] * (nb[i] - bb[i]); }
#pragma unroll
          for (int i = 0; i < 16; ++i) a[i] = (a[i] + bon * vsft[i]) * siluf_(g[i]);
          store16(mrow + 1024 + c0, a); }
        load16(OC + (size_t)tok * 1024 + c0, a); load16(OC + ((size_t)M + tok) * 1024 + c0, bb); load16(prow + C_CG + c0, g);
        { float ss = 0.f;
#pragma unroll
          for (int i = 0; i < 16; ++i) { a[i] += bb[i]; ss += a[i] * a[i]; }
          ss += __shfl_xor(ss, 1); ss += __shfl_xor(ss, 2); ss += __shfl_xor(ss, 4);
          const float rstd = rsqrtf(ss * (1.f / 128.f) + 1e-6f);
          loadf16(P.in[22] + layer * 128 + (c0 & 127), pr);
#pragma unroll
          for (int i = 0; i < 16; ++i) a[i] = a[i] * rstd * pr[i] * siluf_(g[i]);
          store16(mrow + 2048 + c0, a); }
    }
}

__global__ void __launch_bounds__(NTHR, 2) fwd_megakernel(Params P) {
    extern __shared__ __attribute__((aligned(16))) unsigned char smem[];
    cg::grid_group grid = cg::this_grid();
    unsigned* ctl = (unsigned*)(P.ws + OFF_CTL);
    bf16_t* U = (bf16_t*)(P.ws + OFF_U);
    bf16_t* Y = (bf16_t*)(P.ws + OFF_PROJ);
#ifndef REP_P0
#define REP_P0 1
#endif
#pragma unroll 1
    for (int rep = 0; rep < REP_P0; ++rep) { convert_weights(P, 0, smem);
    prenorm_rows(P.in[0], P.in[2], U); }
    grid.sync();
#pragma unroll 1
    for (int layer = 0; layer < DEPTH; ++layer) {
#ifndef REP_G1
#define REP_G1 1
#endif
#pragma unroll 1
        for (int rep = 0; rep < REP_G1; ++rep) { pg8::Gemm g; g.A = U; g.Bt = (const bf16_t*)(P.ws + OFF_WIN); g.M = opaque_s(M); g.N = opaque_s(PW - 256); g.K = opaque_s(D);
          pg8::StaticOrder So; So.init(g.M, g.N, (int)gridDim.x, opaque_bid());
          pg8::EpiBf16<0> E; E.O = (bf16_t*)(P.ws + OFF_PROJ); E.ldc = opaque_s(PW); E.bias = nullptr; E.split_cols = 0; E.split_stride = 0;
          pg8::gemm_phase<pg8::EpiBf16<0>, pg8::StaticOrder, false>((PG8_LAS unsigned char*)smem, g, So, E, nullptr); }
        grid.sync();
#ifndef REP_RWKV
#define REP_RWKV 1
#endif
#ifndef REP_HGRN
#define REP_HGRN 1
#endif
#ifndef REP_ATTN
#define REP_ATTN 1
#endif
#pragma unroll 1
        for (int rep = 0; rep < REP_RWKV; ++rep) rwkv_phase(P, layer, smem);
#pragma unroll 1
        for (int rep = 0; rep < REP_HGRN; ++rep) hgrn_phase(P, layer, smem);
        { const int tb = opaque_bid();
          if (tb >= 128 && tb < 192) {
              pg8::Gemm g; g.A = U; g.Bt = (const bf16_t*)(P.ws + OFF_WIN) + (size_t)(PW - 256) * D; g.M = opaque_s(M); g.N = opaque_s(256); g.K = opaque_s(D);
              pg8::StaticOrder So; So.init(g.M, g.N, (int)gridDim.x, tb - 128);
              pg8::EpiBf16<0> E; E.O = (bf16_t*)(P.ws + OFF_PROJ) + (PW - 256); E.ldc = opaque_s(PW); E.bias = nullptr; E.split_cols = 0; E.split_stride = 0;
              pg8::gemm_phase<pg8::EpiBf16<0>, pg8::StaticOrder, false>((PG8_LAS unsigned char*)smem, g, So, E, nullptr);
          } }

#pragma unroll 1
        for (int rep = 0; rep < REP_ATTN; ++rep) attn_phase(P, layer, smem, ctl + 64 * layer + 128 * rep);
        grid.sync();
#ifndef REP_FIN
#define REP_FIN 1
#endif
#pragma unroll 1
        for (int rep = 0; rep < REP_FIN; ++rep) finish_phase(P, layer);
        grid.sync();
#ifndef REP_G2
#define REP_G2 1
#endif
#pragma unroll 1
        for (int rep = 0; rep < REP_G2; ++rep) { pg8::Gemm g; g.A = (const bf16_t*)(P.ws + OFF_MIXED); g.Bt = (const bf16_t*)(P.ws + OFF_WOUT); g.M = opaque_s(M); g.N = opaque_s(D); g.K = opaque_s(MIXW);
          pg8::StaticOrder So; So.init(g.M, g.N, (int)gridDim.x, opaque_bid());
          pg8::EpiBf16<0> E; E.O = Y; E.ldc = g.N; E.bias = nullptr; E.split_cols = 0; E.split_stride = 0;
          pg8::gemm_phase<pg8::EpiBf16<0>, pg8::StaticOrder, false>((PG8_LAS unsigned char*)smem, g, So, E, nullptr); }
        grid.sync();
        if (layer + 1 < DEPTH) {
            postnorm_rows(Y, layer == 0 ? P.in[0] : P.out, P.out, P.in[3] + layer * D, P.in[2] + (layer + 1) * D, U);
            convert_weights(P, layer + 1, smem);
            grid.sync();
        } else {
            postnorm_rows(Y, layer == 0 ? P.in[0] : P.out, P.out, P.in[3] + layer * D, nullptr, U);
        }
    }
}
}

extern "C" void kernel_launch(void* const* d_in, const int* in_sizes, int n_in, void* d_out, int out_size, void* d_ws, size_t ws_size, hipStream_t stream) {
    static int grid_blocks = 0;
    if (grid_blocks == 0) {
        int dev = 0, cus = 0, per_cu = 0;
        hipGetDevice(&dev);
        hipDeviceGetAttribute(&cus, hipDeviceAttributeMultiprocessorCount, dev);
        if (hipFuncSetAttribute((const void*)mk::fwd_megakernel, hipFuncAttributeMaxDynamicSharedMemorySize, mk::LDS_BYTES) != hipSuccess) fprintf(stderr, "hipFuncSetAttribute failed\n");
        if (hipOccupancyMaxActiveBlocksPerMultiprocessor(&per_cu, (const void*)mk::fwd_megakernel, mk::NTHR, mk::LDS_BYTES) != hipSuccess || per_cu < 1) { fprintf(stderr, "occupancy query: %d\n", per_cu); per_cu = 1; }
        (void)hipGetLastError();
        grid_blocks = cus * 1;
        if (ws_size < mk::WS_END) fprintf(stderr, "workspace too small: %zu < %zu\n", ws_size, (size_t)mk::WS_END);
    }
    hipMemsetAsync((unsigned char*)d_ws + mk::OFF_CTL, 0, 4096, stream);
    mk::Params p{};
    for (int i = 0; i < 23; ++i) p.in[i] = (const float*)d_in[i];
    p.out = (float*)d_out; p.ws = (unsigned char*)d_ws;
    void* args[] = {&p};
    hipError_t e = hipLaunchCooperativeKernel((const void*)mk::fwd_megakernel, dim3(grid_blocks), dim3(mk::NTHR), args, mk::LDS_BYTES, stream);
    if (e != hipSuccess) fprintf(stderr, "cooperative launch failed: %s (grid %d)\n", hipGetErrorString(e), grid_blocks);
}
```

```cpp
#include <hip/hip_runtime.h>
#include <hip/hip_cooperative_groups.h>
#include <cstdio>
#include <cstdint>
namespace cg = cooperative_groups;
namespace pg8 {
#define PG8_LAS __attribute__((address_space(3)))
typedef unsigned short bf16_t;
typedef short bf16x8 __attribute__((ext_vector_type(8)));
typedef float f32x4 __attribute__((ext_vector_type(4)));
typedef unsigned u32x4 __attribute__((ext_vector_type(4)));
constexpr int BM = 256, BK = 64, HALF = 128, HTB = HALF * BK * 2  , STAGE_BYTES = 8 * HTB, NXCD = 8, WGM = 8;

__host__ __device__ __forceinline__ int lds_byte(int r, int c) { const int st = (r >> 4) * 2 + (c >> 5), rr = r & 15, cc = c & 31, ob = rr * 64 + cc * 2; return st * 1024 + (ob ^ (((ob >> 9) & 1) << 5)); }
__host__ __device__ __forceinline__ void stage_rc(int b, int& R, int& C) { const int st = b / 1024, sb = b % 1024, swz = sb ^ (((sb >> 9) & 1) << 5); R = (st >> 1) * 16 + swz / 64; C = (st & 1) * 32 + (swz % 64) / 2; }
__host__ __device__ __forceinline__ int perm32(int rho) { const int n = rho >> 4, i = rho & 15; return 8 * (i >> 2) + 4 * n + (i & 3); }

struct Unit { int pm, pn; };
struct Gemm { const bf16_t* A; const bf16_t* Bt; int M, N, K; };

struct StaticOrder {
    int nM, nN, nwg, G, c;
    __host__ __device__ void init(int M, int N, int G_, int c_) { nM = M / BM; nN = N / BM; nwg = nM * nN; G = G_; c = c_; }
    __host__ __device__ bool next(int i, Unit& u) const {
        const long L = (long)i * G + c; if (L >= nwg) return false;
        int wgid = (int)L; { const int q = nwg / NXCD, r = nwg % NXCD, xcd = wgid % NXCD, off = wgid / NXCD; wgid = (xcd < r ? xcd * (q + 1) : r * (q + 1) + (xcd - r) * q) + off; }
        const int nig = WGM * nN, gid = wgid / nig, fm = gid * WGM, gsz = (nM - fm) < WGM ? (nM - fm) : WGM;
        u.pm = fm + ((wgid % nig) % gsz); u.pn = (wgid % nig) / gsz; return true;
    }
    __device__ __forceinline__ void a_ready(const Unit&) const {}
    __device__ __forceinline__ void done(const Unit&) const {}
};
struct CountedOrder : StaticOrder {
    const unsigned* ready; unsigned need; unsigned* tmo;
    __device__ __forceinline__ void a_ready(const Unit& u) const {
        if (threadIdx.x < 64) {
            const unsigned long long t0 = __builtin_amdgcn_s_memrealtime(); unsigned polls = 0;
            while ((unsigned)__builtin_amdgcn_readfirstlane(__hip_atomic_load(ready + 64 * u.pm, __ATOMIC_RELAXED, __HIP_MEMORY_SCOPE_AGENT)) < need) {
                if ((++polls & 255u) == 0u && __builtin_amdgcn_readfirstlane(__hip_atomic_load(tmo, __ATOMIC_RELAXED, __HIP_MEMORY_SCOPE_AGENT)) != 0u) break;
                if (__builtin_amdgcn_s_memrealtime() - t0 > 2000000ull) {
                    if (threadIdx.x == 0) { unsigned expect = 0u; __hip_atomic_compare_exchange_strong(tmo + 1, &expect, 0x600u | (unsigned)(u.pm & 0xff), __ATOMIC_RELAXED, __ATOMIC_RELAXED, __HIP_MEMORY_SCOPE_AGENT); __hip_atomic_store(tmo, 1u, __ATOMIC_RELAXED, __HIP_MEMORY_SCOPE_AGENT); }
                    break; }
                __builtin_amdgcn_s_sleep(2); }
            __builtin_amdgcn_fence(__ATOMIC_ACQUIRE, "agent");
            asm volatile("s_waitcnt vmcnt(0)" ::: "memory");
        }
#if !defined(BROKEN_HOOK_NO_BARRIER)
        asm volatile("" ::: "memory"); __builtin_amdgcn_s_barrier(); asm volatile("" ::: "memory");
#endif
    }
};

typedef __bf16 bf16x2_t __attribute__((ext_vector_type(2)));
typedef float f32x2c __attribute__((ext_vector_type(2)));
__device__ __forceinline__ unsigned cvt_pk_bf16(float lo, float hi) { f32x2c v = {lo, hi}; bf16x2_t b = __builtin_convertvector(v, bf16x2_t); return __builtin_bit_cast(unsigned, b); }
typedef float f32x2 __attribute__((ext_vector_type(2)));
__device__ __forceinline__ f32x2 gelu_pk(f32x2 v) {
    const f32x2 av = __builtin_elementwise_abs(v), d = av * 0.2316418882f + 1.0f;
    f32x2 t; t.x = __builtin_amdgcn_rcpf(d.x); t.y = __builtin_amdgcn_rcpf(d.y);
    f32x2 q = t * 0.5307027145f + (-0.7265760135f); q = q * t + 0.7107068705f; q = q * t + (-0.142248368f); q = q * t + 0.127414796f; q = q * t;
    const f32x2 s = (v * v) * (-0.72134752044f);
    f32x2 e; e.x = __builtin_amdgcn_exp2f(s.x); e.y = __builtin_amdgcn_exp2f(s.y);
    const f32x2 m = v * (q * e), r = v - m;
    f32x2 o; o.x = v.x < 0.f ? m.x : r.x; o.y = v.y < 0.f ? m.y : r.y; return o;
}

struct EpiF32 {
    static constexpr bool PERM = false, AFTER_DRAIN = false;
    float* C; int ldc; const float* bias;
    __device__ __forceinline__ void operator()(const f32x4 (&acc)[2][2][4][2], const Unit& u, int wr, int wc, int fr, int fq) const {
        const int row0 = u.pm * BM + wr * 64 + fr, col0 = u.pn * BM + wc * 32 + 4 * fq;
        f32x4 bv[2][2];
#pragma unroll
        for (int bj = 0; bj < 2; ++bj)
#pragma unroll
            for (int n = 0; n < 2; ++n) bv[bj][n] = bias ? *(const f32x4*)(bias + col0 + bj * HALF + n * 16) : (f32x4){0.f, 0.f, 0.f, 0.f};
#pragma unroll
        for (int ai = 0; ai < 2; ++ai)
#pragma unroll
            for (int m = 0; m < 4; ++m) { float* rowp = C + (size_t)(row0 + ai * HALF + m * 16) * ldc + col0;
#pragma unroll
                for (int bj = 0; bj < 2; ++bj)
#pragma unroll
                    for (int n = 0; n < 2; ++n) *(f32x4*)(rowp + bj * HALF + n * 16) = acc[ai][bj][m][n] + bv[bj][n]; }
    }
};
template <int ACT  > struct EpiBf16 {
    static constexpr bool PERM = true, AFTER_DRAIN = false;
    bf16_t* O; int ldc; const float* bias; int split_cols; size_t split_stride;
    __device__ __forceinline__ void operator()(const f32x4 (&acc)[2][2][4][2], const Unit& u, int wr, int wc, int fr, int fq) const {
        const int row0 = u.pm * BM + wr * 64 + fr; int colt = u.pn * BM; bf16_t* base = O;
        if (split_cols) { const int t = colt / split_cols; base += (size_t)t * split_stride; colt -= t * split_cols; }
        const int col0 = colt + wc * 32 + 8 * fq, bcol0 = u.pn * BM + wc * 32 + 8 * fq;
        f32x4 bv[2][2];
#pragma unroll
        for (int bj = 0; bj < 2; ++bj)
#pragma unroll
            for (int n = 0; n < 2; ++n) bv[bj][n] = bias ? *(const f32x4*)(bias + bcol0 + bj * HALF + 4 * n) : (f32x4){0.f, 0.f, 0.f, 0.f};
#pragma unroll
        for (int ai = 0; ai < 2; ++ai)
#pragma unroll
            for (int m = 0; m < 4; ++m) { bf16_t* rowp = base + (size_t)(row0 + ai * HALF + m * 16) * ldc + col0;
#pragma unroll
                for (int bj = 0; bj < 2; ++bj) { f32x4 v0 = acc[ai][bj][m][0] + bv[bj][0], v1 = acc[ai][bj][m][1] + bv[bj][1];
                    if (ACT == 1) { f32x2 a = gelu_pk((f32x2){v0[0], v0[1]}), b = gelu_pk((f32x2){v0[2], v0[3]}), c = gelu_pk((f32x2){v1[0], v1[1]}), d = gelu_pk((f32x2){v1[2], v1[3]});
                        v0 = (f32x4){a.x, a.y, b.x, b.y}; v1 = (f32x4){c.x, c.y, d.x, d.y}; }
                    if (ACT == 2) {
#pragma unroll
                        for (int j = 0; j < 4; ++j) { v0[j] = 0.5f * v0[j] * (1.0f + erff(v0[j] * 0.70710678f)); v1[j] = 0.5f * v1[j] * (1.0f + erff(v1[j] * 0.70710678f)); } }
                    u32x4 w; w.x = cvt_pk_bf16(v0[0], v0[1]); w.y = cvt_pk_bf16(v0[2], v0[3]); w.z = cvt_pk_bf16(v1[0], v1[1]); w.w = cvt_pk_bf16(v1[2], v1[3]);
                    *(u32x4*)(rowp + bj * HALF) = w; } }
    }
};


template <class Epi, class Sched, bool STAMP = false>
__device__ __forceinline__ void gemm_phase(PG8_LAS unsigned char* lds, const Gemm g, const Sched& S, const Epi& E, unsigned long long* stamps) {
    int tid_o = threadIdx.x; asm volatile("" : "+v"(tid_o));
    const int tid = tid_o, wid = __builtin_amdgcn_readfirstlane(tid >> 6), lane = tid & 63, wr = wid >> 2, wc = wid & 3, fr = lane & 15, fq = lane >> 4;
    const int K = g.K, nt = K / BK;
    int ts_lo = 0, ts_hi = 0, nts = 0; const unsigned long long rt_entry = STAMP ? (unsigned long long)wall_clock64() : 0ull;
#define PG8_STAMP() do { if (STAMP && wid == 0 && nts < 64) { const unsigned long long _c = (unsigned long long)clock64(); \
        ts_lo = (lane == nts) ? (int)(unsigned)_c : ts_lo; ts_hi = (lane == nts) ? (int)(unsigned)(_c >> 32) : ts_hi; ++nts; } } while (0)
    PG8_STAMP();
    unsigned voffA[2], voffB[2];
#pragma unroll
    for (int i = 0; i < 2; ++i) { int R, C; stage_rc(tid * 16 + i * 8192, R, C); const int Rb = Epi::PERM ? ((R & ~31) + perm32(R & 31)) : R;
        voffA[i] = (unsigned)(R * K + C) * 2u; voffB[i] = (unsigned)(Rb * K + C) * 2u; }
    const size_t kstep = (size_t)(BK * 2);
    const size_t hstep = (size_t)HALF * K * 2;
    const size_t tstep = 2 * hstep;
    const unsigned ldsw = (unsigned)wid * 1024u;
    const int aoff = lds_byte(wr * 64 + fr, fq * 8), boff = lds_byte(wc * 32 + fr, fq * 8);
#define PG8_SA(b, h) (((b) * 2 + (h)) * HTB)
#define PG8_SB(b, h) ((4 + (b) * 2 + (h)) * HTB)
#define PG8_STAGE(bufoff, gbase, voff) do { _Pragma("unroll") for (int _i = 0; _i < 2; ++_i) \
        __builtin_amdgcn_global_load_lds((const unsigned*)((const char*)(gbase) + (voff)[_i]), (PG8_LAS unsigned*)(lds + (bufoff) + ldsw + _i * 8192), 16, 0, 0); } while (0)
#define PG8_LDA(dst, b, h) do { _Pragma("unroll") for (int m = 0; m < 4; ++m) _Pragma("unroll") for (int k = 0; k < 2; ++k) dst[m][k] = *(const PG8_LAS bf16x8*)(lds + PG8_SA(b, h) + aoff + m * 2048 + k * 1024); } while (0)
#define PG8_LDB(dst, b, h) do { _Pragma("unroll") for (int n = 0; n < 2; ++n) _Pragma("unroll") for (int k = 0; k < 2; ++k) dst[n][k] = *(const PG8_LAS bf16x8*)(lds + PG8_SB(b, h) + boff + n * 2048 + k * 1024); } while (0)
#define PG8_MMA(ai, bj, At, Bt) do { __builtin_amdgcn_s_setprio(1); _Pragma("unroll") for (int m = 0; m < 4; ++m) _Pragma("unroll") for (int n = 0; n < 2; ++n) _Pragma("unroll") for (int k = 0; k < 2; ++k) \
        acc[ai][bj][m][n] = __builtin_amdgcn_mfma_f32_16x16x32_bf16(Bt[n][k], At[m][k], acc[ai][bj][m][n], 0, 0, 0); __builtin_amdgcn_s_setprio(0); } while (0)
#define PG8_WAIT_V(n) asm volatile("s_waitcnt vmcnt(" #n ")" ::: "memory")
#define PG8_WAIT_L(n) asm volatile("s_waitcnt lgkmcnt(" #n ")" ::: "memory")
#define PG8_BAR __builtin_amdgcn_s_barrier()
#define PG8_SCHED __builtin_amdgcn_sched_barrier(0)
    Unit cur, nxt; int ui = 0;
    if (!S.next(0, cur)) return;
    f32x4 acc[2][2][4][2];
#pragma unroll
    for (int a = 0; a < 2; ++a)
#pragma unroll
        for (int b = 0; b < 2; ++b)
#pragma unroll
            for (int m = 0; m < 4; ++m)
#pragma unroll
                for (int n = 0; n < 2; ++n) acc[a][b][m][n] = (f32x4){0.f, 0.f, 0.f, 0.f};
    bf16x8 At[4][2], B0[2][2], B1[2][2];
    const char* cA = (const char*)g.A + (size_t)cur.pm * tstep; const char* cB = (const char*)g.Bt + (size_t)cur.pn * tstep;
    S.a_ready(cur);
    PG8_STAGE(PG8_SB(0, 0), cB, voffB); PG8_STAGE(PG8_SA(0, 0), cA, voffA); PG8_STAGE(PG8_SB(0, 1), cB + hstep, voffB); PG8_STAGE(PG8_SA(0, 1), cA + hstep, voffA);
    if (wr == 1) PG8_BAR;
    PG8_WAIT_V(4); PG8_BAR;
    PG8_STAGE(PG8_SB(1, 0), cB + kstep, voffB); PG8_STAGE(PG8_SA(1, 0), cA + kstep, voffA); PG8_STAGE(PG8_SB(1, 1), cB + hstep + kstep, voffB);
    PG8_WAIT_V(6); PG8_BAR;
    PG8_STAMP();
    for (;;) {
        const bool has_next = S.next(ui + 1, nxt);
        const char* nA = has_next ? (const char*)g.A + (size_t)nxt.pm * tstep : cA; const char* nB = has_next ? (const char*)g.Bt + (size_t)nxt.pn * tstep : cB;
        for (int t = 0; t < nt; t += 2) {
            const bool last = (t == nt - 2);
            const char* a1 = cA + (size_t)(t + 1) * kstep;
            const char* a2 = last ? nA : cA + (size_t)(t + 2) * kstep; const char* b2 = last ? nB : cB + (size_t)(t + 2) * kstep;
            const char* a3 = a2 + kstep; const char* b3 = b2 + kstep;
            if (last && has_next) S.a_ready(nxt);
            PG8_LDB(B0, 0, 0); PG8_SCHED; PG8_LDA(At, 0, 0); PG8_STAGE(PG8_SA(1, 1), a1 + hstep, voffA);
            PG8_WAIT_L(8); PG8_BAR; PG8_WAIT_L(0); PG8_MMA(0, 0, At, B0); PG8_BAR; PG8_SCHED;
            PG8_LDB(B1, 0, 1); PG8_STAGE(PG8_SB(0, 0), b2, voffB);
            PG8_BAR; PG8_WAIT_L(0); PG8_MMA(0, 1, At, B1); PG8_BAR;
            PG8_LDA(At, 0, 1); PG8_STAGE(PG8_SA(0, 0), a2, voffA);
            PG8_BAR; PG8_WAIT_L(0); PG8_MMA(1, 0, At, B0); PG8_BAR; PG8_SCHED;
            PG8_STAGE(PG8_SB(0, 1), b2 + hstep, voffB);
            PG8_WAIT_V(6); PG8_BAR; PG8_MMA(1, 1, At, B1); PG8_BAR;
            PG8_LDB(B0, 1, 0); PG8_SCHED; PG8_LDA(At, 1, 0); PG8_STAGE(PG8_SA(0, 1), a2 + hstep, voffA);
            PG8_WAIT_L(8); PG8_BAR; PG8_WAIT_L(0); PG8_MMA(0, 0, At, B0); PG8_BAR; PG8_SCHED;
            PG8_LDB(B1, 1, 1); PG8_STAGE(PG8_SB(1, 0), b3, voffB);
            PG8_BAR; PG8_WAIT_L(0); PG8_MMA(0, 1, At, B1); PG8_BAR;
            PG8_LDA(At, 1, 1); PG8_STAGE(PG8_SA(1, 0), a3, voffA);
            PG8_BAR; PG8_WAIT_L(0); PG8_MMA(1, 0, At, B0); PG8_BAR; PG8_SCHED;
            PG8_STAGE(PG8_SB(1, 1), b3 + hstep, voffB);
            PG8_WAIT_V(6); PG8_BAR; PG8_MMA(1, 1, At, B1); PG8_BAR;
        }
        PG8_STAMP();
        if constexpr (!Epi::AFTER_DRAIN) { E(acc, cur, wr, wc, fr, fq); S.done(cur); }
        PG8_STAMP();
        if (!has_next) break;
#pragma unroll
        for (int a = 0; a < 2; ++a)
#pragma unroll
            for (int b = 0; b < 2; ++b)
#pragma unroll
                for (int m = 0; m < 4; ++m)
#pragma unroll
                    for (int n = 0; n < 2; ++n) acc[a][b][m][n] = (f32x4){0.f, 0.f, 0.f, 0.f};
        cur = nxt; cA = nA; cB = nB; ++ui;
    }
    PG8_WAIT_V(0);
    if (wr == 0) PG8_BAR;
    PG8_BAR;
    if constexpr (Epi::AFTER_DRAIN) { E.fused(acc, cur, wr, wc, fr, fq, lds, wid, lane); S.done(cur); }
    PG8_STAMP();
    if (STAMP && wid == 0) { stamps[lane] = lane < nts ? (((unsigned long long)(unsigned)ts_hi << 32) | (unsigned)ts_lo) : 0ull;
        if (lane == 62) stamps[62] = rt_entry; if (lane == 63) stamps[63] = (unsigned long long)wall_clock64(); }
#undef PG8_STAMP
#undef PG8_SA
#undef PG8_SB
#undef PG8_STAGE
#undef PG8_LDA
#undef PG8_LDB
#undef PG8_MMA
#undef PG8_WAIT_V
#undef PG8_WAIT_L
#undef PG8_BAR
#undef PG8_SCHED
}
}

namespace mk {
using pg8::bf16_t; using pg8::bf16x8; using pg8::f32x4; using pg8::u32x4;
typedef short s16x4 __attribute__((ext_vector_type(4)));
typedef unsigned u32x2 __attribute__((ext_vector_type(2)));

constexpr int D = 2048, NB = 8, S = 2048, M = NB * S, BW = 1024, MIXW = 3072, PW = 13568, DEPTH = 2;
constexpr int C_AQ = 0, C_AK = 1024, C_AV = 2048, C_AG = 3072, C_B = 4096, C_BG = 7424, C_CQ = 8448, C_CI = 9472, C_CF = 10496, C_CG = 12544;
constexpr int NTHR = 512;
constexpr int LDS_BYTES = 147456;
constexpr float LOG2E = 1.4426950408889634f;

constexpr size_t OFF_CTL = 0;
constexpr size_t OFF_WIN = 4096;
constexpr size_t OFF_WOUT = OFF_WIN + (size_t)PW * D * 2;
constexpr size_t OFF_U = OFF_WOUT + (size_t)D * MIXW * 2;
constexpr size_t OFF_PROJ = OFF_U + (size_t)M * D * 2;
constexpr size_t OFF_MIXED = OFF_PROJ + (size_t)M * PW * 2;
constexpr size_t OFF_OC = OFF_MIXED + (size_t)M * MIXW * 2;
constexpr size_t OFF_AO = OFF_OC + (size_t)2 * M * BW * 2;
constexpr size_t OFF_BON = OFF_AO + (size_t)2 * M * BW * 2;
constexpr size_t OFF_YB = OFF_BON + (size_t)2 * M * 16 * 4;
constexpr size_t WS_END = OFF_YB + (size_t)2 * M * BW * 2;

struct Params { const float* in[23]; float* out; unsigned char* ws; };
__device__ __forceinline__ int opaque_tid() { int t = threadIdx.x; asm volatile("" : "+v"(t)); return t; }
__device__ __forceinline__ int opaque_s(int t) { asm volatile("" : "+s"(t)); return t; }
__device__ __forceinline__ int opaque_bid() { int t = blockIdx.x; asm volatile("" : "+s"(t)); return t; }


__device__ __forceinline__ float bf2f(bf16_t v) { return __uint_as_float(((unsigned)v) << 16); }
__device__ __forceinline__ bf16_t f2bf(float f) { unsigned u = __float_as_uint(f); u += 0x7FFFu + ((u >> 16) & 1u); return (bf16_t)(u >> 16); }
typedef __bf16 bf16x2_t __attribute__((ext_vector_type(2)));
typedef float f32x2c __attribute__((ext_vector_type(2)));
__device__ __forceinline__ unsigned pk2(float lo, float hi) { f32x2c v = {lo, hi}; bf16x2_t b = __builtin_convertvector(v, bf16x2_t); return __builtin_bit_cast(unsigned, b); }
__device__ __forceinline__ float wave_sum(float v) {
#pragma unroll
    for (int o = 1; o < 64; o <<= 1) v += __shfl_xor(v, o);
    return v;
}
__device__ __forceinline__ float sigmoidf_(float x) { return 1.f / (1.f + __expf(-x)); }
__device__ __forceinline__ float siluf_(float x) { return x / (1.f + __expf(-x)); }
__device__ __forceinline__ float dpp_xor1(float v) { return __int_as_float(__builtin_amdgcn_mov_dpp(__float_as_int(v), 0xB1, 0xF, 0xF, true)); }
__device__ __forceinline__ float dpp_xor2(float v) { return __int_as_float(__builtin_amdgcn_mov_dpp(__float_as_int(v), 0x4E, 0xF, 0xF, true)); }
__device__ __forceinline__ float dpp_hmir(float v) { return __int_as_float(__builtin_amdgcn_mov_dpp(__float_as_int(v), 0x141, 0xF, 0xF, true)); }
__device__ __forceinline__ float dpp_mir(float v) { return __int_as_float(__builtin_amdgcn_mov_dpp(__float_as_int(v), 0x140, 0xF, 0xF, true)); }
__device__ __forceinline__ float wave_sum_fast(float v) {
    v += dpp_xor1(v); v += dpp_xor2(v); v += dpp_hmir(v); v += dpp_mir(v);
    v += __shfl_xor(v, 16); v += __shfl_xor(v, 32);
    return v;
}
__device__ __forceinline__ float fast_tanh(float x) { return 1.f - 2.f * __builtin_amdgcn_rcpf(1.f + __expf(2.f * x)); }
__device__ __forceinline__ float fast_sigmoid(float x) { return __builtin_amdgcn_rcpf(1.f + __expf(-x)); }
typedef float f32x2 __attribute__((ext_vector_type(2)));
#define MFMA16(a, b, c) __builtin_amdgcn_mfma_f32_16x16x32_bf16((a), (b), (c), 0, 0, 0)
__device__ __forceinline__ bf16x8 join8(s16x4 lo, s16x4 hi) { return __builtin_shufflevector(lo, hi, 0, 1, 2, 3, 4, 5, 6, 7); }
__device__ __forceinline__ bf16x8 pack8(f32x4 a, f32x4 b) {
    u32x4 w; w.x = pk2(a[0], a[1]); w.y = pk2(a[2], a[3]); w.z = pk2(b[0], b[1]); w.w = pk2(b[2], b[3]);
    return __builtin_bit_cast(bf16x8, w);
}

__device__ __forceinline__ void transpose_tile(const float* __restrict__ W, int K, int N, bf16_t* __restrict__ WT, float* tile, int it) {
    const int tid = opaque_tid();
    const int ntn = N >> 6; const int kb = it / ntn, nbk = it - kb * ntn; const int k0 = kb * 64, n0 = nbk * 64;
#pragma unroll
    for (int rr = 0; rr < 2; ++rr) { const int idx = tid + rr * 512; const int kk = idx >> 4, n4 = (idx & 15) * 4;
        const float4 v = *(const float4*)(W + (size_t)(k0 + kk) * N + n0 + n4);
        float* tp = tile + kk * 65 + n4; tp[0] = v.x; tp[1] = v.y; tp[2] = v.z; tp[3] = v.w; }
    __syncthreads();
    { const int n = tid >> 3, kc = (tid & 7) * 8; const float* tp = tile + kc * 65 + n;
      u32x4 o; o.x = pk2(tp[0], tp[65]); o.y = pk2(tp[2 * 65], tp[3 * 65]); o.z = pk2(tp[4 * 65], tp[5 * 65]); o.w = pk2(tp[6 * 65], tp[7 * 65]);
      *(u32x4*)(WT + (size_t)(n0 + n) * K + k0 + kc) = o; }
    __syncthreads();
}
__device__ __forceinline__ void convert_weights(const Params& P, int layer, unsigned char* smem) {
    float* tile = (float*)smem;
    const float* win = P.in[4] + (size_t)layer * D * PW; const float* wout = P.in[5] + (size_t)layer * MIXW * D;
    bf16_t* WinT = (bf16_t*)(P.ws + OFF_WIN); bf16_t* WoutT = (bf16_t*)(P.ws + OFF_WOUT);
    constexpr int T_IN = (D / 64) * (PW / 64), T_OUT = (MIXW / 64) * (D / 64);
    for (int it = opaque_bid(); it < T_IN + T_OUT; it += gridDim.x) {
        if (it < T_IN) transpose_tile(win, D, PW, WinT, tile, it);
        else transpose_tile(wout, MIXW, D, WoutT, tile, it - T_IN);
    }
}
__device__ __forceinline__ void prenorm_rows(const float* __restrict__ x, const float* __restrict__ g, bf16_t* __restrict__ U) {
    const int tid_ = opaque_tid(); const int lane = tid_ & 63, gw = opaque_bid() * 8 + (tid_ >> 6), ngw = gridDim.x * 8;
    for (int row = gw; row < M; row += ngw) {
        const float4* xr = (const float4*)(x + (size_t)row * D) + lane;
        float4 v[8]; float ss = 0.f;
#pragma unroll
        for (int j = 0; j < 8; ++j) { v[j] = xr[64 * j]; ss += v[j].x * v[j].x + v[j].y * v[j].y + v[j].z * v[j].z + v[j].w * v[j].w; }
        const float rstd = rsqrtf(wave_sum(ss) * (1.f / D) + 1e-6f);
        u32x2* o = (u32x2*)(U + (size_t)row * D) + lane;
#pragma unroll
        for (int j = 0; j < 8; ++j) { const float4 gg = ((const float4*)g)[64 * j + lane];
            u32x2 w; w.x = pk2(v[j].x * rstd * gg.x, v[j].y * rstd * gg.y); w.y = pk2(v[j].z * rstd * gg.z, v[j].w * rstd * gg.w); o[64 * j] = w; }
    }
}
__device__ __forceinline__ void postnorm_rows(const bf16_t* __restrict__ y, const float* xin, float* xout, const float* __restrict__ gpost, const float* __restrict__ gpre, bf16_t* __restrict__ U) {
    const int tid_ = opaque_tid(); const int lane = tid_ & 63, gw = opaque_bid() * 8 + (tid_ >> 6), ngw = gridDim.x * 8;
    for (int row = gw; row < M; row += ngw) {
        const u32x2* yr = (const u32x2*)(y + (size_t)row * D) + lane;
        const float4* xr = (const float4*)(xin + (size_t)row * D) + lane;
        float4* xo = (float4*)(xout + (size_t)row * D) + lane;
        float4 v[8]; float ss = 0.f;
#pragma unroll
        for (int j = 0; j < 8; ++j) { const u32x2 w = yr[64 * j]; v[j].x = __uint_as_float(w.x << 16); v[j].y = __uint_as_float(w.x & 0xFFFF0000u); v[j].z = __uint_as_float(w.y << 16); v[j].w = __uint_as_float(w.y & 0xFFFF0000u);
            ss += v[j].x * v[j].x + v[j].y * v[j].y + v[j].z * v[j].z + v[j].w * v[j].w; }
        const float rstd = rsqrtf(wave_sum(ss) * (1.f / D) + 1e-6f);
        float s2 = 0.f;
#pragma unroll
        for (int j = 0; j < 8; ++j) { const float4 gg = ((const float4*)gpost)[64 * j + lane]; const float4 xv = xr[64 * j];
            v[j].x = xv.x + v[j].x * rstd * gg.x; v[j].y = xv.y + v[j].y * rstd * gg.y; v[j].z = xv.z + v[j].z * rstd * gg.z; v[j].w = xv.w + v[j].w * rstd * gg.w;
            xo[64 * j] = v[j]; s2 += v[j].x * v[j].x + v[j].y * v[j].y + v[j].z * v[j].z + v[j].w * v[j].w; }
        if (gpre) {
            const float r2 = rsqrtf(wave_sum(s2) * (1.f / D) + 1e-6f);
            u32x2* o = (u32x2*)(U + (size_t)row * D) + lane;
#pragma unroll
            for (int j = 0; j < 8; ++j) { const float4 gg = ((const float4*)gpre)[64 * j + lane];
                u32x2 w; w.x = pk2(v[j].x * r2 * gg.x, v[j].y * r2 * gg.y); w.y = pk2(v[j].z * r2 * gg.z, v[j].w * r2 * gg.w); o[64 * j] = w; }
        }
    }
}

#define RWKV_LOAD_RAW(cc) do { const int n0_ = (cc) * TCH + pw * TPW; const int T0_ = d ? (S - 1 - n0_) : n0_; const int dstep_ = d ? -1 : 1; \
    _Pragma("unroll") for (int j = 0; j < TPW + 2; ++j) { const int tj = T0_ + (j - 1) * dstep_; const bool ok = (tj >= 0) && (tj < S); \
        const bf16_t* row = proj + ((size_t)b * S + (ok ? tj : T0_)) * PW + C_B; \
        raw[j][0] = row[cr]; raw[j][1] = row[ck]; raw[j][2] = row[cv]; raw[j][3] = row[cw]; raw[j][4] = row[ca]; \
        if (!ok) { raw[j][0] = 0; raw[j][1] = 0; raw[j][2] = 0; raw[j][3] = 0; raw[j][4] = 0; } } } while (0)
__device__ __forceinline__ void rwkv_phase(const Params& P, int layer, unsigned char* smem) {
    constexpr int TCH = 16, TPW = 4, NCH = S / TCH;
    float* VEC = (float*)smem;
    bf16_t* UPT = (bf16_t*)(smem + 49152);
    unsigned char* pbase = smem + 49152 + 18432;
    unsigned char* obase = smem + 49152 + 18432 + 12800;
    unsigned char* nbase = obase + 2 * 18176;
    const int tid = opaque_tid(), wid = __builtin_amdgcn_readfirstlane(tid >> 6), lane = tid & 63, r16 = lane & 15, quad = lane >> 4;
    const bf16_t* proj = (const bf16_t*)(P.ws + OFF_PROJ);
    bf16_t* YB = (bf16_t*)(P.ws + OFF_YB);
    float* BON = (float*)(P.ws + OFF_BON);
    const float* mu = P.in[11] + (size_t)layer * 2 * 3328;
    for (int chain = opaque_bid(); chain < 256; chain += gridDim.x) {
        const int d = chain >> 7, b = (chain >> 4) & 7, h = chain & 15;
        __syncthreads();
        { const float* wup = P.in[13] + ((size_t)(layer * 2 + d) * 64) * 1024 + h * 64; const float* aup = P.in[15] + ((size_t)(layer * 2 + d) * 64) * 1024 + h * 64;
#pragma unroll
          for (int it = 0; it < 16; ++it) { const int e = tid + 512 * it; const int mat = e >> 12, lora = (e >> 6) & 63, ch = e & 63;
              const float v = (mat ? aup : wup)[(size_t)lora * 1024 + ch]; UPT[mat * 4608 + ch * 72 + lora] = f2bf(v); } }
        __syncthreads();
        if (wid < 4) {
            const int cw = wid;
            float* Nm = (float*)(nbase + cw * 1024);
            const int jl = lane & 15, tg = lane >> 4, jcol = cw * 16 + jl;
            const float rkc = P.in[18][(size_t)layer * 1024 + h * 64 + jcol];
            const f32x4 z4 = {0.f, 0.f, 0.f, 0.f};
            f32x4 ST[4];
#pragma unroll
            for (int mt = 0; mt < 4; ++mt) ST[mt] = z4;
            asm volatile("s_waitcnt lgkmcnt(0)" ::: "memory"); __builtin_amdgcn_s_barrier(); asm volatile("" ::: "memory");
            asm volatile("s_waitcnt lgkmcnt(0)" ::: "memory"); __builtin_amdgcn_s_barrier(); asm volatile("" ::: "memory");
            for (int c = 0; c < NCH; ++c) {
                const float* vb = VEC + (c & 1) * (TCH * 384);
                unsigned char* ob = obase + (c & 1) * 18176;
                bf16_t* Pm = (bf16_t*)ob; bf16_t* Rm = (bf16_t*)(ob + 2304); bf16_t* Qm = (bf16_t*)(ob + 4608); bf16_t* Mm = (bf16_t*)(ob + 6912);
                bf16_t* QT = (bf16_t*)(ob + 9216); bf16_t* MT = (bf16_t*)(ob + 12288); float* GT = (float*)(ob + 15360); bf16_t* Bm = (bf16_t*)(ob + 15872);
                {
                    float nk[4], ww[4], ka[4], km[4], rr[4];
#pragma unroll
                    for (int u = 0; u < 4; ++u) { const float* vt = vb + (4 * tg + u) * 384 + jcol; nk[u] = vt[0]; ww[u] = vt[64]; ka[u] = vt[128]; km[u] = vt[192]; rr[u] = vt[256]; }
                    float gl[4];
                    gl[0] = ww[0]; gl[1] = gl[0] * ww[1]; gl[2] = gl[1] * ww[2]; gl[3] = gl[2] * ww[3];
                    const float G0 = __shfl(gl[3], jl), G1 = __shfl(gl[3], jl + 16), G2 = __shfl(gl[3], jl + 32);
                    const float pre = (tg == 0) ? 1.f : (tg == 1) ? G0 : (tg == 2) ? G0 * G1 : (G0 * G1) * G2;
                    float pv[4], rv[4], qv[4], mv[4];
#pragma unroll
                    for (int u = 0; u < 4; ++u) {
                        const float gprev = (u == 0) ? pre : pre * gl[u - 1], gcur = pre * gl[u];
                        const float ig = __builtin_amdgcn_rcpf(gcur);
                        pv[u] = gprev * nk[u]; qv[u] = ka[u] * ig; mv[u] = km[u] * ig; rv[u] = gcur * rr[u];
                    }
                    const unsigned wp0 = pk2(pv[0], pv[1]), wp1 = pk2(pv[2], pv[3]), wr0 = pk2(rv[0], rv[1]), wr1 = pk2(rv[2], rv[3]);
                    const unsigned wq0 = pk2(qv[0], qv[1]), wq1 = pk2(qv[2], qv[3]), wm0 = pk2(mv[0], mv[1]), wm1 = pk2(mv[2], mv[3]);
                    const int t0 = 4 * tg;
                    Pm[(t0) * 72 + jcol] = (bf16_t)(wp0 & 0xFFFFu); Pm[(t0 + 1) * 72 + jcol] = (bf16_t)(wp0 >> 16); Pm[(t0 + 2) * 72 + jcol] = (bf16_t)(wp1 & 0xFFFFu); Pm[(t0 + 3) * 72 + jcol] = (bf16_t)(wp1 >> 16);
                    Rm[(t0) * 72 + jcol] = (bf16_t)(wr0 & 0xFFFFu); Rm[(t0 + 1) * 72 + jcol] = (bf16_t)(wr0 >> 16); Rm[(t0 + 2) * 72 + jcol] = (bf16_t)(wr1 & 0xFFFFu); Rm[(t0 + 3) * 72 + jcol] = (bf16_t)(wr1 >> 16);
                    Qm[(t0) * 72 + jcol] = (bf16_t)(wq0 & 0xFFFFu); Qm[(t0 + 1) * 72 + jcol] = (bf16_t)(wq0 >> 16); Qm[(t0 + 2) * 72 + jcol] = (bf16_t)(wq1 & 0xFFFFu); Qm[(t0 + 3) * 72 + jcol] = (bf16_t)(wq1 >> 16);
                    Mm[(t0) * 72 + jcol] = (bf16_t)(wm0 & 0xFFFFu); Mm[(t0 + 1) * 72 + jcol] = (bf16_t)(wm0 >> 16); Mm[(t0 + 2) * 72 + jcol] = (bf16_t)(wm1 & 0xFFFFu); Mm[(t0 + 3) * 72 + jcol] = (bf16_t)(wm1 >> 16);
                    u32x2 tq; tq.x = wq0; tq.y = wq1; *(u32x2*)(QT + jcol * 24 + t0) = tq;
                    u32x2 tm; tm.x = wm0; tm.y = wm1; *(u32x2*)(MT + jcol * 24 + t0) = tm;
                    { const unsigned wb0 = pk2(rv[0] * rkc, rv[1] * rkc), wb1 = pk2(rv[2] * rkc, rv[3] * rkc);
                      Bm[(t0) * 72 + jcol] = (bf16_t)(wb0 & 0xFFFFu); Bm[(t0 + 1) * 72 + jcol] = (bf16_t)(wb0 >> 16); Bm[(t0 + 2) * 72 + jcol] = (bf16_t)(wb1 & 0xFFFFu); Bm[(t0 + 3) * 72 + jcol] = (bf16_t)(wb1 >> 16); }
                    if (tg == 3) GT[jcol] = pre * gl[3];
                }
                asm volatile("s_waitcnt lgkmcnt(0)" ::: "memory"); __builtin_amdgcn_s_barrier(); asm volatile("" ::: "memory");
                f32x4 Gqp = z4, Gmp = z4, Gqr = z4, Gmr = z4, Npq = z4;
#pragma unroll
                for (int ks = 0; ks < 2; ++ks) {
                    const bf16x8 aQ = *(const bf16x8*)(Qm + r16 * 72 + ks * 32 + quad * 8), aM = *(const bf16x8*)(Mm + r16 * 72 + ks * 32 + quad * 8);
                    const bf16x8 bP = *(const bf16x8*)(Pm + r16 * 72 + ks * 32 + quad * 8), bR = *(const bf16x8*)(Rm + r16 * 72 + ks * 32 + quad * 8);
                    Gqp = MFMA16(aQ, bP, Gqp); Gmp = MFMA16(aM, bP, Gmp); Gqr = MFMA16(aQ, bR, Gqr); Gmr = MFMA16(aM, bR, Gmr); Npq = MFMA16(bP, aQ, Npq);
                }
                if (cw == 0) {
                    f32x4 Gmb = z4;
#pragma unroll
                    for (int ks = 0; ks < 2; ++ks) Gmb = MFMA16(*(const bf16x8*)(Mm + r16 * 72 + ks * 32 + quad * 8), *(const bf16x8*)(Bm + r16 * 72 + ks * 32 + quad * 8), Gmb);
                    if (quad == (r16 >> 2)) {
                        const int rsel = r16 & 3;
                        const float bon = (rsel == 0) ? Gmb[0] : (rsel == 1) ? Gmb[1] : (rsel == 2) ? Gmb[2] : Gmb[3];
                        const int n = c * TCH + r16; const int t = d ? (S - 1 - n) : n;
                        BON[(((size_t)d * NB + b) * 16 + h) * S + t] = bon;
                    }
                }
#pragma unroll
                for (int rg = 0; rg < 4; ++rg) { const int sI = quad * 4 + rg;
                    if (sI >= r16) { Gqp[rg] = 0.f; Gmp[rg] = 0.f; }
                    if (sI > r16) { Gqr[rg] = 0.f; Gmr[rg] = 0.f; }
                    if (sI <= r16) Npq[rg] = 0.f; }
                f32x4 SA0 = z4, Y0 = z4;
#pragma unroll
                for (int ks = 0; ks < 2; ++ks) {
                    const bf16x8 sb = pack8(ST[2 * ks], ST[2 * ks + 1]);
                    const bf16_t* pp = Pm + r16 * 72 + ks * 32 + quad * 4; const bf16_t* rp = Rm + r16 * 72 + ks * 32 + quad * 4;
                    const bf16x8 pa = join8(*(const s16x4*)pp, *(const s16x4*)(pp + 16)), ra = join8(*(const s16x4*)rp, *(const s16x4*)(rp + 16));
                    SA0 = MFMA16(pa, sb, SA0); Y0 = MFMA16(ra, sb, Y0);
                }
                f32x4 Vv;
#pragma unroll
                for (int jj = 0; jj < 4; ++jj) Vv[jj] = vb[(quad * 4 + jj) * 384 + 320 + cw * 16 + r16];
                const f32x4 Cc = MFMA16(pack8(Gmp, z4), pack8(Vv, z4), SA0);
                const bf16x8 m1 = pack8(Gqp, z4), n1 = pack8(Npq, z4);
                const f32x4 Mc2 = MFMA16(n1, m1, z4), Nc2 = MFMA16(m1, n1, z4);
                const bf16x8 m2 = pack8(Mc2, z4), n2 = pack8(Nc2, z4);
                const f32x4 Mc4 = MFMA16(n2, m2, z4), Nc4 = MFMA16(m2, n2, z4);
                const bf16x8 m4 = pack8(Mc4, z4), n4 = pack8(Nc4, z4);
                const f32x4 Mc8 = MFMA16(n4, m4, z4);
                f32x4 SAc = MFMA16(pack8(Mc8, z4), pack8(Cc, z4), Cc);
                SAc = MFMA16(m4, pack8(SAc, z4), SAc);
                SAc = MFMA16(m2, pack8(SAc, z4), SAc);
                SAc = MFMA16(m1, pack8(SAc, z4), SAc);
                const bf16x8 Bsv = pack8(SAc, Vv);
                const f32x4 Yc = MFMA16(pack8(Gqr, Gmr), Bsv, Y0);
#pragma unroll
                for (int rg = 0; rg < 4; ++rg) { const int n = c * TCH + quad * 4 + rg; const int t = d ? (S - 1 - n) : n;
                    YB[((size_t)d * M + (size_t)b * S + t) * 1024 + h * 64 + cw * 16 + r16] = f2bf(Yc[rg]); }
#pragma unroll
                for (int mt = 0; mt < 4; ++mt) {
                    const bf16_t* qp = QT + (mt * 16 + r16) * 24 + quad * 4; const bf16_t* mp = MT + (mt * 16 + r16) * 24 + quad * 4;
                    const f32x4 acc = MFMA16(join8(*(const s16x4*)qp, *(const s16x4*)mp), Bsv, ST[mt]);
                    const f32x4 gt = *(const f32x4*)(GT + mt * 16 + quad * 4);
                    ST[mt] = acc * gt;
                }
                asm volatile("s_waitcnt lgkmcnt(0)" ::: "memory"); __builtin_amdgcn_s_barrier(); asm volatile("" ::: "memory");
            }
        } else {
            const int pw = wid - 4;
            bf16_t* Aw = (bf16_t*)(pbase + pw * 3200); bf16_t* Aa = Aw + TPW * 72; float* X = (float*)(pbase + pw * 3200 + 1152);
            const int cr = h * 64 + lane, ck = 1024 + h * 64 + lane, cv = 2048 + h * 64 + lane, cw = 3072 + d * 64 + lane, ca = 3200 + d * 64 + lane;
            const int mo0 = d ? 3328 : 0, mo1 = d ? 0 : 3328;
            const float mr0 = mu[mo0 + cr], mr1 = mu[mo1 + cr], mk0 = mu[mo0 + ck], mk1 = mu[mo1 + ck], mv0 = mu[mo0 + cv], mv1 = mu[mo1 + cv];
            const float mw0 = mu[mo0 + cw], mw1 = mu[mo1 + cw], ma0 = mu[mo0 + ca], ma1 = mu[mo1 + ca];
            const int chn = h * 64 + lane;
            const float w0v = P.in[12][(size_t)(layer * 2 + d) * 1024 + chn], a0v = P.in[14][(size_t)(layer * 2 + d) * 1024 + chn];
            const float kkw = P.in[16][(size_t)layer * 1024 + chn], kaw = P.in[17][(size_t)layer * 1024 + chn], rkw = P.in[18][(size_t)layer * 1024 + chn];
            unsigned short raw[TPW + 2][5];
            RWKV_LOAD_RAW(0);
            for (int c = 0; c < NCH + 1; ++c) {
                if (c < NCH) {
                    float* vb = VEC + (c & 1) * (TCH * 384);
                    float rr[TPW], kv[TPW], vv[TPW], kk[TPW];
                    {
                        float fr[TPW + 2][5];
#pragma unroll
                        for (int j = 0; j < TPW + 2; ++j)
#pragma unroll
                            for (int st = 0; st < 5; ++st) fr[j][st] = bf2f(raw[j][st]);
                        if (c + 1 < NCH) { RWKV_LOAD_RAW(c + 1); }
#pragma unroll
                        for (int i = 0; i < TPW; ++i) {
                            float p0, pa, pb;
                            p0 = fr[i + 1][0]; pa = fr[i][0]; pb = fr[i + 2][0]; rr[i] = p0 + mr0 * (pa - p0) + mr1 * (pb - p0);
                            p0 = fr[i + 1][1]; pa = fr[i][1]; pb = fr[i + 2][1]; kv[i] = p0 + mk0 * (pa - p0) + mk1 * (pb - p0);
                            p0 = fr[i + 1][2]; pa = fr[i][2]; pb = fr[i + 2][2]; vv[i] = p0 + mv0 * (pa - p0) + mv1 * (pb - p0);
                            p0 = fr[i + 1][3]; pa = fr[i][3]; pb = fr[i + 2][3]; const float wd = p0 + mw0 * (pa - p0) + mw1 * (pb - p0);
                            p0 = fr[i + 1][4]; pa = fr[i][4]; pb = fr[i + 2][4]; const float ad = p0 + ma0 * (pa - p0) + ma1 * (pb - p0);
                            Aw[i * 72 + lane] = f2bf(fast_tanh(wd)); Aa[i * 72 + lane] = f2bf(ad);
                            const float k2 = kv[i] * kkw; const float n2 = wave_sum_fast(k2 * k2);
                            kk[i] = k2 * __builtin_amdgcn_rsqf(fmaxf(n2, 1e-24f));
                        }
                    }
                    asm volatile("s_waitcnt lgkmcnt(0)" ::: "memory"); __builtin_amdgcn_s_barrier(); asm volatile("" ::: "memory");
#pragma unroll
                    for (int mat = 0; mat < 2; ++mat) {
                        const bf16_t* A = mat ? Aa : Aw;
                        const bf16x8 a0f = *(const bf16x8*)(A + (r16 & (TPW - 1)) * 72 + quad * 8), a1f = *(const bf16x8*)(A + (r16 & (TPW - 1)) * 72 + 32 + quad * 8);
#pragma unroll
                        for (int nt = 0; nt < 4; ++nt) {
                            const bf16_t* B = UPT + mat * 4608 + (nt * 16 + r16) * 72 + quad * 8;
                            f32x4 acc = {0.f, 0.f, 0.f, 0.f};
                            acc = MFMA16(a0f, *(const bf16x8*)B, acc); acc = MFMA16(a1f, *(const bf16x8*)(B + 32), acc);
                            if (quad == 0) {
#pragma unroll
                                for (int rg = 0; rg < 4; ++rg) X[mat * 256 + rg * 64 + nt * 16 + r16] = acc[rg];
                            }
                        }
                    }
                    asm volatile("s_waitcnt lgkmcnt(0)" ::: "memory");
#pragma unroll
                    for (int i = 0; i < TPW; ++i) {
                        const int s = pw * TPW + i; const int n = c * TCH + s; const int t = d ? (S - 1 - n) : n;
                        const float xw = X[i * 64 + lane] + w0v, xa = X[256 + i * 64 + lane] + a0v;
                        const float dec = __expf(-0.6065306597126334f * fast_sigmoid(xw)); const float av = fast_sigmoid(xa);
                        const float kmod = kv[i] * (1.f + (av - 1.f) * kaw); const float kka = kk[i] * av;
                        float* o = vb + s * 384 + lane;
                        o[0] = -kk[i]; o[64] = dec; o[128] = kka; o[192] = kmod; o[256] = rr[i]; o[320] = vv[i];
                    }
                }
                if (c == NCH) { asm volatile("s_waitcnt lgkmcnt(0)" ::: "memory"); __builtin_amdgcn_s_barrier(); asm volatile("" ::: "memory"); }
                asm volatile("s_waitcnt lgkmcnt(0)" ::: "memory"); __builtin_amdgcn_s_barrier(); asm volatile("" ::: "memory");
            }
        }
    }
}

__device__ __forceinline__ int swz40(int row, int s) { return row * 40 + ((((s >> 3) ^ (row >> 3)) & 3) << 3) + (s & 7); }
__device__ __forceinline__ void hgrn_phase(const Params& P, int layer, unsigned char* smem) {
    bf16_t* QE = (bf16_t*)smem; bf16_t* KE = (bf16_t*)(smem + 8704); bf16_t* KLT = (bf16_t*)(smem + 17408); bf16_t* VT = (bf16_t*)(smem + 27648);
    float* LF = (float*)(smem + 37888); float* EL = (float*)(smem + 54272);
    const int tid = opaque_tid(), wid = __builtin_amdgcn_readfirstlane(tid >> 6), lane = tid & 63, r16 = lane & 15, quad = lane >> 4;
    const bf16_t* proj = (const bf16_t*)(P.ws + OFF_PROJ);
    bf16_t* OC = (bf16_t*)(P.ws + OFF_OC);
    const int es = tid >> 4, ekc = (tid & 15) * 8;
    for (int chain = opaque_bid(); chain < 128; chain += gridDim.x) {
        const int d = chain >> 6, b = (chain >> 3) & 7, h = chain & 7;
        float lb[8];
#pragma unroll
        for (int j = 0; j < 8; ++j) lb[j] = 0.f;
        if (layer > 0) {
#pragma unroll
            for (int j = 0; j < 8; ++j) { const float l0 = P.in[21][(size_t)(d * 2 + 0) * 1024 + h * 128 + ekc + j], l1 = P.in[21][(size_t)(d * 2 + 1) * 1024 + h * 128 + ekc + j]; lb[j] = 1.f / (1.f + __expf(l0 - l1)); }
        }
        f32x4 Sacc[8];
#pragma unroll
        for (int mt = 0; mt < 8; ++mt) Sacc[mt] = (f32x4){0.f, 0.f, 0.f, 0.f};
        u32x4 zraw, qraw, vraw;
        { const int t = d ? (S - 1 - es) : es; const bf16_t* row = proj + ((size_t)b * S + t) * PW + h * 128 + ekc;
          zraw = *(const u32x4*)(row + C_CF + d * 1024); qraw = *(const u32x4*)(row + C_CQ); vraw = *(const u32x4*)(row + C_CI); }
        for (int c = 0; c < 64; ++c) {
            __syncthreads();
            { const int n = c * 32 + es; const int t = d ? (S - 1 - n) : n; const bf16_t* row = proj + ((size_t)b * S + t) * PW + h * 128 + ekc;
              zraw = *(const u32x4*)(row + C_CF + d * 1024); qraw = *(const u32x4*)(row + C_CQ); vraw = *(const u32x4*)(row + C_CI); }
            float kval[8];
            {
                float lf[8];
#pragma unroll
                for (int j = 0; j < 8; ++j) {
                    const unsigned wv = zraw[j >> 1]; const float z = (j & 1) ? __uint_as_float(wv & 0xFFFF0000u) : __uint_as_float(wv << 16);
                    const float e = __expf(-fabsf(z));
                    const float ls = fminf(z, 0.f) - __logf(1.f + e);
                    const float sg = (z >= 0.f ? 1.f : e) * __builtin_amdgcn_rcpf(1.f + e);
                    lf[j] = (lb[j] > 0.f) ? __logf(lb[j] + (1.f - lb[j]) * sg) : ls;
                    kval[j] = (1.f - lb[j]) * (1.f - sg);
                }
                *(f32x4*)(LF + es * 128 + ekc) = (f32x4){lf[0], lf[1], lf[2], lf[3]}; *(f32x4*)(LF + es * 128 + ekc + 4) = (f32x4){lf[4], lf[5], lf[6], lf[7]};
#pragma unroll
                for (int j = 0; j < 8; ++j) { const unsigned wv = vraw[j >> 1]; VT[swz40(ekc + j, es)] = (bf16_t)((j & 1) ? (wv >> 16) : (wv & 0xFFFFu)); }
            }
            __syncthreads();
            if (tid < 128) {
                float cum = 0.f;
#pragma unroll
                for (int s = 0; s < 32; ++s) { cum += LF[s * 128 + tid]; LF[s * 128 + tid] = cum; }
                EL[tid] = __expf(cum);
            }
            __syncthreads();
            {
                const f32x4 c0 = *(const f32x4*)(LF + es * 128 + ekc), c1v = *(const f32x4*)(LF + es * 128 + ekc + 4);
                const f32x4 l0 = *(const f32x4*)(LF + 31 * 128 + ekc), l1 = *(const f32x4*)(LF + 31 * 128 + ekc + 4);
                float qe[8], ke[8];
#pragma unroll
                for (int j = 0; j < 8; ++j) {
                    const unsigned wv = qraw[j >> 1]; const float qv = (j & 1) ? __uint_as_float(wv & 0xFFFF0000u) : __uint_as_float(wv << 16);
                    const float cum = (j < 4) ? c0[j & 3] : c1v[j & 3], last = (j < 4) ? l0[j & 3] : l1[j & 3];
                    qe[j] = qv * __expf(cum); ke[j] = kval[j] * __expf(-cum);
                    KLT[swz40(ekc + j, es)] = f2bf(kval[j] * __expf(last - cum));
                }
                u32x4 w; w.x = pk2(qe[0], qe[1]); w.y = pk2(qe[2], qe[3]); w.z = pk2(qe[4], qe[5]); w.w = pk2(qe[6], qe[7]); *(u32x4*)(QE + es * 136 + ekc) = w;
                w.x = pk2(ke[0], ke[1]); w.y = pk2(ke[2], ke[3]); w.z = pk2(ke[4], ke[5]); w.w = pk2(ke[6], ke[7]); *(u32x4*)(KE + es * 136 + ekc) = w;
            }
            if (false) { const int n = (c + 1) * 32 + es; const int t = d ? (S - 1 - n) : n; const bf16_t* row = proj + ((size_t)b * S + t) * PW + h * 128 + ekc;
                zraw = *(const u32x4*)(row + C_CF + d * 1024); qraw = *(const u32x4*)(row + C_CQ); vraw = *(const u32x4*)(row + C_CI); }
            __syncthreads();
            f32x4 sc00 = {0.f, 0.f, 0.f, 0.f}, sc01 = sc00, sc11 = sc00;
#pragma unroll
            for (int ks = 0; ks < 4; ++ks) {
                const bf16x8 ke0 = *(const bf16x8*)(KE + r16 * 136 + ks * 32 + quad * 8), ke1 = *(const bf16x8*)(KE + (16 + r16) * 136 + ks * 32 + quad * 8);
                const bf16x8 qe0 = *(const bf16x8*)(QE + r16 * 136 + ks * 32 + quad * 8), qe1 = *(const bf16x8*)(QE + (16 + r16) * 136 + ks * 32 + quad * 8);
                sc00 = MFMA16(ke0, qe0, sc00); sc01 = MFMA16(ke0, qe1, sc01); sc11 = MFMA16(ke1, qe1, sc11);
            }
#pragma unroll
            for (int rg = 0; rg < 4; ++rg) { if (quad * 4 + rg > r16) { sc00[rg] = 0.f; sc11[rg] = 0.f; } }
            const f32x4 zero4 = {0.f, 0.f, 0.f, 0.f};
            const bf16x8 p0 = pack8(sc00, zero4), p1 = pack8(sc01, sc11);
            const int vrow_i = wid * 16 + r16;
            const bf16x8 vperm = join8(*(const s16x4*)(VT + swz40(vrow_i, quad * 4)), *(const s16x4*)(VT + swz40(vrow_i, 16 + quad * 4)));
            f32x4 o0 = MFMA16(p0, vperm, zero4), o1 = MFMA16(p1, vperm, zero4);
#pragma unroll
            for (int ks = 0; ks < 4; ++ks) {
                const bf16x8 sb = pack8(Sacc[2 * ks], Sacc[2 * ks + 1]);
                const bf16_t* q0p = QE + r16 * 136 + ks * 32 + quad * 4; const bf16_t* q1p = QE + (16 + r16) * 136 + ks * 32 + quad * 4;
                const bf16x8 qa0 = join8(*(const s16x4*)q0p, *(const s16x4*)(q0p + 16)), qa1 = join8(*(const s16x4*)q1p, *(const s16x4*)(q1p + 16));
                o0 = MFMA16(qa0, sb, o0); o1 = MFMA16(qa1, sb, o1);
            }
#pragma unroll
            for (int rg = 0; rg < 4; ++rg) {
                { const int n = c * 32 + quad * 4 + rg; const int t = d ? (S - 1 - n) : n; OC[((size_t)d * M + (size_t)b * S + t) * 1024 + h * 128 + wid * 16 + r16] = f2bf(o0[rg]); }
                { const int n = c * 32 + 16 + quad * 4 + rg; const int t = d ? (S - 1 - n) : n; OC[((size_t)d * M + (size_t)b * S + t) * 1024 + h * 128 + wid * 16 + r16] = f2bf(o1[rg]); }
            }
            const bf16x8 vnat = *(const bf16x8*)(VT + swz40(vrow_i, quad * 8));
#pragma unroll
            for (int mt = 0; mt < 8; ++mt) {
                const f32x4 el = *(const f32x4*)(EL + mt * 16 + quad * 4);
                f32x4 sa = Sacc[mt] * el;
                const bf16x8 kl = *(const bf16x8*)(KLT + swz40(mt * 16 + r16, quad * 8));
                Sacc[mt] = MFMA16(kl, vnat, sa);
            }
        }
    }
}

__device__ __forceinline__ void attn_phase(const Params& P, int layer, unsigned char* smem, unsigned* counter) {
    float* TAB = (float*)smem; bf16_t* KT = (bf16_t*)(smem + 16384); bf16_t* VTt = (bf16_t*)(smem + 16384 + 9216); int* sh_unit = (int*)(smem + 16384 + 9216 + 18432);
    const int tid = opaque_tid(), wid = __builtin_amdgcn_readfirstlane(tid >> 6), lane = tid & 63, r16 = lane & 15, quad = lane >> 4;
    const bf16_t* proj = (const bf16_t*)(P.ws + OFF_PROJ);
    bf16_t* AO = (bf16_t*)(P.ws + OFF_AO);
    const float* rel_bias = P.in[1];
    const float c1 = 0.125f * LOG2E;
    const int xcd = opaque_bid() & 7;
    for (;;) {
        __syncthreads();
        if (tid == 0) *sh_unit = (int)atomicAdd(counter + xcd, 1u);
        __syncthreads();
        const int li = *sh_unit;
        if (li >= 128) break;
        const int qb = li & 7, grp = (li >> 3) * 8 + xcd;
        const int m = grp & 1, h = (grp >> 1) & 7, b = grp >> 4;
        for (int e = tid; e < 4095; e += 512) { const int rel = e - 2047; const int n = rel < 0 ? -rel : rel; int bk;
            if (n < 8) bk = n; else { const int lg = 31 - __clz(n * n); bk = 2 + lg; if (bk > 15) bk = 15; }
            if (rel > 0) bk += 16; TAB[e] = rel_bias[bk * 8 + h] * LOG2E; }
        const int qrow0 = qb * 256 + wid * 32;
        bf16x8 Qf[2][2];
#pragma unroll
        for (int nq = 0; nq < 2; ++nq)
#pragma unroll
            for (int ks = 0; ks < 2; ++ks) Qf[nq][ks] = *(const bf16x8*)(proj + ((size_t)b * S + qrow0 + nq * 16 + r16) * PW + C_AQ + h * 128 + m * 64 + ks * 32 + quad * 8);
        f32x4 O[2][8];
#pragma unroll
        for (int nq = 0; nq < 2; ++nq)
#pragma unroll
            for (int dt = 0; dt < 8; ++dt) O[nq][dt] = (f32x4){0.f, 0.f, 0.f, 0.f};
        float mrun[2] = {-1e30f, -1e30f}, lrun[2] = {0.f, 0.f};
        const int kkey = tid >> 3, kchunk = tid & 7;
        const int vkp = tid & 31, vchunk = tid >> 5;
        const bf16_t* kbase = proj + ((size_t)b * S + kkey) * PW + C_AK + h * 128 + m * 64 + kchunk * 8;
        const bf16_t* vbase = proj + ((size_t)b * S + 2 * vkp) * PW + C_AV + h * 128 + vchunk * 8;
        u32x4 kreg = *(const u32x4*)kbase, vreg0 = *(const u32x4*)vbase, vreg1 = *(const u32x4*)(vbase + PW);
        for (int kt = 0; kt < 32; ++kt) {
            __syncthreads();
            *(u32x4*)(KT + kkey * 72 + kchunk * 8) = kreg;
            { unsigned* vd = (unsigned*)(VTt + (vchunk * 8) * 72 + 2 * vkp);
#pragma unroll
              for (int i2 = 0; i2 < 4; ++i2) { const unsigned a = vreg0[i2], bq = vreg1[i2];
                  vd[(2 * i2) * 36] = (a & 0xFFFFu) | (bq << 16); vd[(2 * i2 + 1) * 36] = (a >> 16) | (bq & 0xFFFF0000u); } }
            __syncthreads();
            if (kt + 1 < 32) { const size_t adv = (size_t)(kt + 1) * 64 * PW; kreg = *(const u32x4*)(kbase + adv); vreg0 = *(const u32x4*)(vbase + adv); vreg1 = *(const u32x4*)(vbase + adv + PW); }
            const int k0 = kt * 64;
            f32x4 st[2][4];
#pragma unroll
            for (int mt = 0; mt < 4; ++mt) {
                const bf16x8 ka = *(const bf16x8*)(KT + (mt * 16 + r16) * 72 + quad * 8), kb2 = *(const bf16x8*)(KT + (mt * 16 + r16) * 72 + 32 + quad * 8);
#pragma unroll
                for (int nq = 0; nq < 2; ++nq) { f32x4 a = {0.f, 0.f, 0.f, 0.f}; a = MFMA16(ka, Qf[nq][0], a); a = MFMA16(kb2, Qf[nq][1], a); st[nq][mt] = a; }
            }
            const bool posfar = (k0 - (qrow0 + 31)) >= 96, negfar = (qrow0 - (k0 + 63)) >= 96;
            if (posfar || negfar) {
                const float cb = posfar ? TAB[2047 + 128] : TAB[2047 - 128];
#pragma unroll
                for (int nq = 0; nq < 2; ++nq)
#pragma unroll
                    for (int mt = 0; mt < 4; ++mt) st[nq][mt] = st[nq][mt] * c1 + cb;
            } else {
#pragma unroll
                for (int nq = 0; nq < 2; ++nq)
#pragma unroll
                    for (int mt = 0; mt < 4; ++mt) { const float* tp = TAB + (k0 + mt * 16 + quad * 4) - (qrow0 + nq * 16 + r16) + 2047;
#pragma unroll
                        for (int rg = 0; rg < 4; ++rg) st[nq][mt][rg] = st[nq][mt][rg] * c1 + tp[rg]; }
            }
            bf16x8 pf[2][2];
#pragma unroll
            for (int nq = 0; nq < 2; ++nq) {
                float mx = st[nq][0][0];
#pragma unroll
                for (int mt = 0; mt < 4; ++mt)
#pragma unroll
                    for (int rg = 0; rg < 4; ++rg) mx = fmaxf(mx, st[nq][mt][rg]);
                mx = fmaxf(mx, __shfl_xor(mx, 16)); mx = fmaxf(mx, __shfl_xor(mx, 32));
                const float mnew = fmaxf(mrun[nq], mx); const float alpha = __builtin_amdgcn_exp2f(mrun[nq] - mnew); mrun[nq] = mnew;
                float ps = 0.f;
#pragma unroll
                for (int mt = 0; mt < 4; ++mt)
#pragma unroll
                    for (int rg = 0; rg < 4; ++rg) { const float pv = __builtin_amdgcn_exp2f(st[nq][mt][rg] - mnew); st[nq][mt][rg] = pv; ps += pv; }
                lrun[nq] = lrun[nq] * alpha + ps;
#pragma unroll
                for (int dt = 0; dt < 8; ++dt) O[nq][dt] = O[nq][dt] * alpha;
                pf[nq][0] = pack8(st[nq][0], st[nq][1]); pf[nq][1] = pack8(st[nq][2], st[nq][3]);
            }
#pragma unroll
            for (int dt = 0; dt < 8; ++dt) {
                const bf16_t* vr = VTt + (dt * 16 + r16) * 72 + quad * 4;
                const bf16x8 va0 = join8(*(const s16x4*)vr, *(const s16x4*)(vr + 16)), va1 = join8(*(const s16x4*)(vr + 32), *(const s16x4*)(vr + 48));
#pragma unroll
                for (int nq = 0; nq < 2; ++nq) { O[nq][dt] = MFMA16(va0, pf[nq][0], O[nq][dt]); O[nq][dt] = MFMA16(va1, pf[nq][1], O[nq][dt]); }
            }
        }
#pragma unroll
        for (int nq = 0; nq < 2; ++nq) {
            float l = lrun[nq]; l += __shfl_xor(l, 16); l += __shfl_xor(l, 32);
            const float inv = 1.f / l;
            bf16_t* orow = AO + ((size_t)m * M + (size_t)b * S + qrow0 + nq * 16 + r16) * 1024 + h * 128 + quad * 4;
#pragma unroll
            for (int dt = 0; dt < 8; ++dt) { u32x2 w; w.x = pk2(O[nq][dt][0] * inv, O[nq][dt][1] * inv); w.y = pk2(O[nq][dt][2] * inv, O[nq][dt][3] * inv); *(u32x2*)(orow + dt * 16) = w; }
        }
    }
}

__device__ __forceinline__ void load16(const bf16_t* p, float* o) {
    const u32x4 a = *(const u32x4*)p, b = *(const u32x4*)(p + 8);
#pragma unroll
    for (int i = 0; i < 4; ++i) { o[2 * i] = __uint_as_float(a[i] << 16); o[2 * i + 1] = __uint_as_float(a[i] & 0xFFFF0000u); o[8 + 2 * i] = __uint_as_float(b[i] << 16); o[8 + 2 * i + 1] = __uint_as_float(b[i] & 0xFFFF0000u); }
}
__device__ __forceinline__ void store16(bf16_t* p, const float* v) {
    u32x4 a, b; a.x = pk2(v[0], v[1]); a.y = pk2(v[2], v[3]); a.z = pk2(v[4], v[5]); a.w = pk2(v[6], v[7]); b.x = pk2(v[8], v[9]); b.y = pk2(v[10], v[11]); b.z = pk2(v[12], v[13]); b.w = pk2(v[14], v[15]);
    *(u32x4*)p = a; *(u32x4*)(p + 8) = b;
}
__device__ __forceinline__ void loadf16(const float* p, float* o) {
#pragma unroll
    for (int i = 0; i < 4; ++i) { const float4 v = ((const float4*)p)[i]; o[4 * i] = v.x; o[4 * i + 1] = v.y; o[4 * i + 2] = v.z; o[4 * i + 3] = v.w; }
}
__device__ __forceinline__ void finish_phase(const Params& P, int layer) {
    const int tid_ = opaque_tid(); const int lane = tid_ & 63, gw = opaque_bid() * 8 + (tid_ >> 6), ngw = gridDim.x * 8;
    const bf16_t* proj = (const bf16_t*)(P.ws + OFF_PROJ);
    const bf16_t* AO = (const bf16_t*)(P.ws + OFF_AO); const bf16_t* YB = (const bf16_t*)(P.ws + OFF_YB); const bf16_t* OC = (const bf16_t*)(P.ws + OFF_OC);
    const float* BON = (const float*)(P.ws + OFF_BON);
    bf16_t* MIX = (bf16_t*)(P.ws + OFF_MIXED);
    const float lam_init = 0.8f - 0.6f * expf(-0.3f * (float)layer);
    const float s1 = wave_sum(P.in[6][layer * 64 + lane] * P.in[7][layer * 64 + lane]), s2 = wave_sum(P.in[8][layer * 64 + lane] * P.in[9][layer * 64 + lane]);
    const float lam = expf(s1) - expf(s2) + lam_init;
    const int c0 = lane * 16;
    const float* mu0p = P.in[11] + (size_t)layer * 2 * 3328 + 2048 + c0; const float* mu1p = mu0p + 3328;
    for (int tok = gw; tok < M; tok += ngw) {
        const bf16_t* prow = proj + (size_t)tok * PW;
        bf16_t* mrow = MIX + (size_t)tok * MIXW;
        float a[16], bb[16], g[16], pr[16];
        load16(AO + (size_t)tok * 1024 + c0, a); load16(AO + ((size_t)M + tok) * 1024 + c0, bb); load16(prow + C_AG + c0, g);
        { float ss = 0.f;
#pragma unroll
          for (int i = 0; i < 16; ++i) { a[i] = a[i] - lam * bb[i]; ss += a[i] * a[i]; }
          ss += __shfl_xor(ss, 1); ss += __shfl_xor(ss, 2); ss += __shfl_xor(ss, 4);
          const float rstd = rsqrtf(ss * (1.f / 128.f) + 1e-5f) * (1.f - lam_init);
          loadf16(P.in[10] + layer * 128 + (c0 & 127), pr);
#pragma unroll
          for (int i = 0; i < 16; ++i) a[i] = a[i] * rstd * pr[i] * siluf_(g[i]);
          store16(mrow + c0, a); }
        load16(YB + (size_t)tok * 1024 + c0, a); load16(YB + ((size_t)M + tok) * 1024 + c0, bb); load16(prow + C_BG + c0, g);
        { float sm = 0.f;
#pragma unroll
          for (int i = 0; i < 16; ++i) { a[i] += bb[i]; sm += a[i]; }
          sm += __shfl_xor(sm, 1); sm += __shfl_xor(sm, 2);
          const float mean = sm * (1.f / 64.f); float vs = 0.f;
#pragma unroll
          for (int i = 0; i < 16; ++i) { a[i] -= mean; vs += a[i] * a[i]; }
          vs += __shfl_xor(vs, 1); vs += __shfl_xor(vs, 2);
          const float rstd = rsqrtf(vs * (1.f / 64.f) + 64e-5f);
          const int head = lane >> 2;
          const float bon = BON[(((size_t)(tok >> 11)) * 16 + head) * S + (tok & (S - 1))] + BON[(((size_t)NB + (tok >> 11)) * 16 + head) * S + (tok & (S - 1))];
          const int sp = tok & (S - 1);
          loadf16(P.in[19] + layer * 1024 + c0, pr);
#pragma unroll
          for (int i = 0; i < 16; ++i) a[i] = a[i] * rstd * pr[i];
          loadf16(P.in[20] + layer * 1024 + c0, pr);
#pragma unroll
          for (int i = 0; i < 16; ++i) a[i] += pr[i];
          load16(prow + C_B + 2048 + c0, bb);
          float vsft[16];
          { float nb[16];
            if (sp > 0) load16(prow - PW + C_B + 2048 + c0, nb); else {
#pragma unroll
                for (int i = 0; i < 16; ++i) nb[i] = 0.f; }
            loadf16(mu0p, pr);
#pragma unroll
            for (int i = 0; i < 16; ++i) vsft[i] = bb[i] + pr[i] * (nb[i] - bb[i]);
            if (sp < S - 1) load16(prow + PW + C_B + 2048 + c0, nb); else {
#pragma unroll
                for (int i = 0; i < 16; ++i) nb[i] = 0.f; }
            loadf16(mu1p, pr);
#pragma unroll
            for (int i = 0; i < 16; ++i) vsft[i] += pr[i] * (nb[i] - bb[i]); }
#pragma unroll
          for (int i = 0; i < 16; ++i) a[i] = (a[i] + bon * vsft[i]) * siluf_(g[i]);
          store16(mrow + 1024 + c0, a); }
        load16(OC + (size_t)tok * 1024 + c0, a); load16(OC + ((size_t)M + tok) * 1024 + c0, bb); load16(prow + C_CG + c0, g);
        { float ss = 0.f;
#pragma unroll
          for (int i = 0; i < 16; ++i) { a[i] += bb[i]; ss += a[i] * a[i]; }
          ss += __shfl_xor(ss, 1); ss += __shfl_xor(ss, 2); ss += __shfl_xor(ss, 4);
          const float rstd = rsqrtf(ss * (1.f / 128.f) + 1e-6f);
          loadf16(P.in[22] + layer * 128 + (c0 & 127), pr);
#pragma unroll
          for (int i = 0; i < 16; ++i) a[i] = a[i] * rstd * pr[i] * siluf_(g[i]);
          store16(mrow + 2048 + c0, a); }
    }
}

__global__ void __launch_bounds__(NTHR, 2) fwd_megakernel(Params P) {
    extern __shared__ __attribute__((aligned(16))) unsigned char smem[];
    cg::grid_group grid = cg::this_grid();
    unsigned* ctl = (unsigned*)(P.ws + OFF_CTL);
    bf16_t* U = (bf16_t*)(P.ws + OFF_U);
    bf16_t* Y = (bf16_t*)(P.ws + OFF_PROJ);
#ifndef REP_P0
#define REP_P0 1
#endif
#pragma unroll 1
    for (int rep = 0; rep < REP_P0; ++rep) { convert_weights(P, 0, smem);
    prenorm_rows(P.in[0], P.in[2], U); }
    grid.sync();
#pragma unroll 1
    for (int layer = 0; layer < DEPTH; ++layer) {
#ifndef REP_G1
#define REP_G1 1
#endif
#pragma unroll 1
        for (int rep = 0; rep < REP_G1; ++rep) { pg8::Gemm g; g.A = U; g.Bt = (const bf16_t*)(P.ws + OFF_WIN); g.M = opaque_s(M); g.N = opaque_s(PW - 256); g.K = opaque_s(D);
          pg8::StaticOrder So; So.init(g.M, g.N, (int)gridDim.x, opaque_bid());
          pg8::EpiBf16<0> E; E.O = (bf16_t*)(P.ws + OFF_PROJ); E.ldc = opaque_s(PW); E.bias = nullptr; E.split_cols = 0; E.split_stride = 0;
          pg8::gemm_phase<pg8::EpiBf16<0>, pg8::StaticOrder, false>((PG8_LAS unsigned char*)smem, g, So, E, nullptr); }
        grid.sync();
#ifndef REP_RWKV
#define REP_RWKV 1
#endif
#ifndef REP_HGRN
#define REP_HGRN 1
#endif
#ifndef REP_ATTN
#define REP_ATTN 1
#endif
#pragma unroll 1
        for (int rep = 0; rep < REP_RWKV; ++rep) rwkv_phase(P, layer, smem);
#pragma unroll 1
        for (int rep = 0; rep < REP_HGRN; ++rep) hgrn_phase(P, layer, smem);
        { const int tb = opaque_bid();
          if (tb >= 128 && tb < 192) {
              pg8::Gemm g; g.A = U; g.Bt = (const bf16_t*)(P.ws + OFF_WIN) + (size_t)(PW - 256) * D; g.M = opaque_s(M); g.N = opaque_s(256); g.K = opaque_s(D);
              pg8::StaticOrder So; So.init(g.M, g.N, (int)gridDim.x, tb - 128);
              pg8::EpiBf16<0> E; E.O = (bf16_t*)(P.ws + OFF_PROJ) + (PW - 256); E.ldc = opaque_s(PW); E.bias = nullptr; E.split_cols = 0; E.split_stride = 0;
              pg8::gemm_phase<pg8::EpiBf16<0>, pg8::StaticOrder, false>((PG8_LAS unsigned char*)smem, g, So, E, nullptr);
          } }

#pragma unroll 1
        for (int rep = 0; rep < REP_ATTN; ++rep) attn_phase(P, layer, smem, ctl + 64 * layer + 128 * rep);
        grid.sync();
#ifndef REP_FIN
#define REP_FIN 1
#endif
#pragma unroll 1
        for (int rep = 0; rep < REP_FIN; ++rep) finish_phase(P, layer);
        grid.sync();
#ifndef REP_G2
#define REP_G2 1
#endif
#pragma unroll 1
        for (int rep = 0; rep < REP_G2; ++rep) { pg8::Gemm g; g.A = (const bf16_t*)(P.ws + OFF_MIXED); g.Bt = (const bf16_t*)(P.ws + OFF_WOUT); g.M = opaque_s(M); g.N = opaque_s(D); g.K = opaque_s(MIXW);
          pg8::StaticOrder So; So.init(g.M, g.N, (int)gridDim.x, opaque_bid());
          pg8::EpiBf16<0> E; E.O = Y; E.ldc = g.N; E.bias = nullptr; E.split_cols = 0; E.split_stride = 0;
          pg8::gemm_phase<pg8::EpiBf16<0>, pg8::StaticOrder, false>((PG8_LAS unsigned char*)smem, g, So, E, nullptr); }
        grid.sync();
        if (layer + 1 < DEPTH) {
            postnorm_rows(Y, layer == 0 ? P.in[0] : P.out, P.out, P.in[3] + layer * D, P.in[2] + (layer + 1) * D, U);
            convert_weights(P, layer + 1, smem);
            grid.sync();
        } else {
            postnorm_rows(Y, layer == 0 ? P.in[0] : P.out, P.out, P.in[3] + layer * D, nullptr, U);
        }
    }
}
}

extern "C" void kernel_launch(void* const* d_in, const int* in_sizes, int n_in, void* d_out, int out_size, void* d_ws, size_t ws_size, hipStream_t stream) {
    static int grid_blocks = 0;
    if (grid_blocks == 0) {
        int dev = 0, cus = 0, per_cu = 0;
        hipGetDevice(&dev);
        hipDeviceGetAttribute(&cus, hipDeviceAttributeMultiprocessorCount, dev);
        if (hipFuncSetAttribute((const void*)mk::fwd_megakernel, hipFuncAttributeMaxDynamicSharedMemorySize, mk::LDS_BYTES) != hipSuccess) fprintf(stderr, "hipFuncSetAttribute failed\n");
        if (hipOccupancyMaxActiveBlocksPerMultiprocessor(&per_cu, (const void*)mk::fwd_megakernel, mk::NTHR, mk::LDS_BYTES) != hipSuccess || per_cu < 1) { fprintf(stderr, "occupancy query: %d\n", per_cu); per_cu = 1; }
        (void)hipGetLastError();
        grid_blocks = cus * 1;
        if (ws_size < mk::WS_END) fprintf(stderr, "workspace too small: %zu < %zu\n", ws_size, (size_t)mk::WS_END);
    }
    hipMemsetAsync((unsigned char*)d_ws + mk::OFF_CTL, 0, 4096, stream);
    mk::Params p{};
    for (int i = 0; i < 23; ++i) p.in[i] = (const float*)d_in[i];
    p.out = (float*)d_out; p.ws = (unsigned char*)d_ws;
    void* args[] = {&p};
    hipError_t e = hipLaunchCooperativeKernel((const void*)mk::fwd_megakernel, dim3(grid_blocks), dim3(mk::NTHR), args, mk::LDS_BYTES, stream);
    if (e != hipSuccess) fprintf(stderr, "cooperative launch failed: %s (grid %d)\n", hipGetErrorString(e), grid_blocks);
}
```

```cpp
#include <hip/hip_runtime.h>
#include <hip/hip_cooperative_groups.h>
#include <cstdio>
#include <cstdint>
namespace cg = cooperative_groups;
namespace pg8 {
#define PG8_LAS __attribute__((address_space(3)))
typedef unsigned short bf16_t;
typedef short bf16x8 __attribute__((ext_vector_type(8)));
typedef float f32x4 __attribute__((ext_vector_type(4)));
typedef unsigned u32x4 __attribute__((ext_vector_type(4)));
constexpr int BM = 256, BK = 64, HALF = 128, HTB = HALF * BK * 2  , STAGE_BYTES = 8 * HTB, NXCD = 8, WGM = 8;

__host__ __device__ __forceinline__ int lds_byte(int r, int c) { const int st = (r >> 4) * 2 + (c >> 5), rr = r & 15, cc = c & 31, ob = rr * 64 + cc * 2; return st * 1024 + (ob ^ (((ob >> 9) & 1) << 5)); }
__host__ __device__ __forceinline__ void stage_rc(int b, int& R, int& C) { const int st = b / 1024, sb = b % 1024, swz = sb ^ (((sb >> 9) & 1) << 5); R = (st >> 1) * 16 + swz / 64; C = (st & 1) * 32 + (swz % 64) / 2; }
__host__ __device__ __forceinline__ int perm32(int rho) { const int n = rho >> 4, i = rho & 15; return 8 * (i >> 2) + 4 * n + (i & 3); }

struct Unit { int pm, pn; };
struct Gemm { const bf16_t* A; const bf16_t* Bt; int M, N, K; };

struct StaticOrder {
    int nM, nN, nwg, G, c;
    __host__ __device__ void init(int M, int N, int G_, int c_) { nM = M / BM; nN = N / BM; nwg = nM * nN; G = G_; c = c_; }
    __host__ __device__ bool next(int i, Unit& u) const {
        const long L = (long)i * G + c; if (L >= nwg) return false;
        int wgid = (int)L; { const int q = nwg / NXCD, r = nwg % NXCD, xcd = wgid % NXCD, off = wgid / NXCD; wgid = (xcd < r ? xcd * (q + 1) : r * (q + 1) + (xcd - r) * q) + off; }
        const int nig = WGM * nN, gid = wgid / nig, fm = gid * WGM, gsz = (nM - fm) < WGM ? (nM - fm) : WGM;
        u.pm = fm + ((wgid % nig) % gsz); u.pn = (wgid % nig) / gsz; return true;
    }
    __device__ __forceinline__ void a_ready(const Unit&) const {}
    __device__ __forceinline__ void done(const Unit&) const {}
};
struct CountedOrder : StaticOrder {
    const unsigned* ready; unsigned need; unsigned* tmo;
    __device__ __forceinline__ void a_ready(const Unit& u) const {
        if (threadIdx.x < 64) {
            const unsigned long long t0 = __builtin_amdgcn_s_memrealtime(); unsigned polls = 0;
            while ((unsigned)__builtin_amdgcn_readfirstlane(__hip_atomic_load(ready + 64 * u.pm, __ATOMIC_RELAXED, __HIP_MEMORY_SCOPE_AGENT)) < need) {
                if ((++polls & 255u) == 0u && __builtin_amdgcn_readfirstlane(__hip_atomic_load(tmo, __ATOMIC_RELAXED, __HIP_MEMORY_SCOPE_AGENT)) != 0u) break;
                if (__builtin_amdgcn_s_memrealtime() - t0 > 2000000ull) {
                    if (threadIdx.x == 0) { unsigned expect = 0u; __hip_atomic_compare_exchange_strong(tmo + 1, &expect, 0x600u | (unsigned)(u.pm & 0xff), __ATOMIC_RELAXED, __ATOMIC_RELAXED, __HIP_MEMORY_SCOPE_AGENT); __hip_atomic_store(tmo, 1u, __ATOMIC_RELAXED, __HIP_MEMORY_SCOPE_AGENT); }
                    break; }
                __builtin_amdgcn_s_sleep(2); }
            __builtin_amdgcn_fence(__ATOMIC_ACQUIRE, "agent");
            asm volatile("s_waitcnt vmcnt(0)" ::: "memory");
        }
#if !defined(BROKEN_HOOK_NO_BARRIER)
        asm volatile("" ::: "memory"); __builtin_amdgcn_s_barrier(); asm volatile("" ::: "memory");
#endif
    }
};

typedef __bf16 bf16x2_t __attribute__((ext_vector_type(2)));
typedef float f32x2c __attribute__((ext_vector_type(2)));
__device__ __forceinline__ unsigned cvt_pk_bf16(float lo, float hi) { f32x2c v = {lo, hi}; bf16x2_t b = __builtin_convertvector(v, bf16x2_t); return __builtin_bit_cast(unsigned, b); }
typedef float f32x2 __attribute__((ext_vector_type(2)));
__device__ __forceinline__ f32x2 gelu_pk(f32x2 v) {
    const f32x2 av = __builtin_elementwise_abs(v), d = av * 0.2316418882f + 1.0f;
    f32x2 t; t.x = __builtin_amdgcn_rcpf(d.x); t.y = __builtin_amdgcn_rcpf(d.y);
    f32x2 q = t * 0.5307027145f + (-0.7265760135f); q = q * t + 0.7107068705f; q = q * t + (-0.142248368f); q = q * t + 0.127414796f; q = q * t;
    const f32x2 s = (v * v) * (-0.72134752044f);
    f32x2 e; e.x = __builtin_amdgcn_exp2f(s.x); e.y = __builtin_amdgcn_exp2f(s.y);
    const f32x2 m = v * (q * e), r = v - m;
    f32x2 o; o.x = v.x < 0.f ? m.x : r.x; o.y = v.y < 0.f ? m.y : r.y; return o;
}

struct EpiF32 {
    static constexpr bool PERM = false, AFTER_DRAIN = false;
    float* C; int ldc; const float* bias;
    __device__ __forceinline__ void operator()(const f32x4 (&acc)[2][2][4][2], const Unit& u, int wr, int wc, int fr, int fq) const {
        const int row0 = u.pm * BM + wr * 64 + fr, col0 = u.pn * BM + wc * 32 + 4 * fq;
        f32x4 bv[2][2];
#pragma unroll
        for (int bj = 0; bj < 2; ++bj)
#pragma unroll
            for (int n = 0; n < 2; ++n) bv[bj][n] = bias ? *(const f32x4*)(bias + col0 + bj * HALF + n * 16) : (f32x4){0.f, 0.f, 0.f, 0.f};
#pragma unroll
        for (int ai = 0; ai < 2; ++ai)
#pragma unroll
            for (int m = 0; m < 4; ++m) { float* rowp = C + (size_t)(row0 + ai * HALF + m * 16) * ldc + col0;
#pragma unroll
                for (int bj = 0; bj < 2; ++bj)
#pragma unroll
                    for (int n = 0; n < 2; ++n) *(f32x4*)(rowp + bj * HALF + n * 16) = acc[ai][bj][m][n] + bv[bj][n]; }
    }
};
template <int ACT  > struct EpiBf16 {
    static constexpr bool PERM = true, AFTER_DRAIN = false;
    bf16_t* O; int ldc; const float* bias; int split_cols; size_t split_stride;
    __device__ __forceinline__ void operator()(const f32x4 (&acc)[2][2][4][2], const Unit& u, int wr, int wc, int fr, int fq) const {
        const int row0 = u.pm * BM + wr * 64 + fr; int colt = u.pn * BM; bf16_t* base = O;
        if (split_cols) { const int t = colt / split_cols; base += (size_t)t * split_stride; colt -= t * split_cols; }
        const int col0 = colt + wc * 32 + 8 * fq, bcol0 = u.pn * BM + wc * 32 + 8 * fq;
        f32x4 bv[2][2];
#pragma unroll
        for (int bj = 0; bj < 2; ++bj)
#pragma unroll
            for (int n = 0; n < 2; ++n) bv[bj][n] = bias ? *(const f32x4*)(bias + bcol0 + bj * HALF + 4 * n) : (f32x4){0.f, 0.f, 0.f, 0.f};
#pragma unroll
        for (int ai = 0; ai < 2; ++ai)
#pragma unroll
            for (int m = 0; m < 4; ++m) { bf16_t* rowp = base + (size_t)(row0 + ai * HALF + m * 16) * ldc + col0;
#pragma unroll
                for (int bj = 0; bj < 2; ++bj) { f32x4 v0 = acc[ai][bj][m][0] + bv[bj][0], v1 = acc[ai][bj][m][1] + bv[bj][1];
                    if (ACT == 1) { f32x2 a = gelu_pk((f32x2){v0[0], v0[1]}), b = gelu_pk((f32x2){v0[2], v0[3]}), c = gelu_pk((f32x2){v1[0], v1[1]}), d = gelu_pk((f32x2){v1[2], v1[3]});
                        v0 = (f32x4){a.x, a.y, b.x, b.y}; v1 = (f32x4){c.x, c.y, d.x, d.y}; }
                    if (ACT == 2) {
#pragma unroll
                        for (int j = 0; j < 4; ++j) { v0[j] = 0.5f * v0[j] * (1.0f + erff(v0[j] * 0.70710678f)); v1[j] = 0.5f * v1[j] * (1.0f + erff(v1[j] * 0.70710678f)); } }
                    u32x4 w; w.x = cvt_pk_bf16(v0[0], v0[1]); w.y = cvt_pk_bf16(v0[2], v0[3]); w.z = cvt_pk_bf16(v1[0], v1[1]); w.w = cvt_pk_bf16(v1[2], v1[3]);
                    *(u32x4*)(rowp + bj * HALF) = w; } }
    }
};


template <class Epi, class Sched, bool STAMP = false>
__device__ __forceinline__ void gemm_phase(PG8_LAS unsigned char* lds, const Gemm g, const Sched& S, const Epi& E, unsigned long long* stamps) {
    int tid_o = threadIdx.x; asm volatile("" : "+v"(tid_o));
    const int tid = tid_o, wid = __builtin_amdgcn_readfirstlane(tid >> 6), lane = tid & 63, wr = wid >> 2, wc = wid & 3, fr = lane & 15, fq = lane >> 4;
    const int K = g.K, nt = K / BK;
    int ts_lo = 0, ts_hi = 0, nts = 0; const unsigned long long rt_entry = STAMP ? (unsigned long long)wall_clock64() : 0ull;
#define PG8_STAMP() do { if (STAMP && wid == 0 && nts < 64) { const unsigned long long _c = (unsigned long long)clock64(); \
        ts_lo = (lane == nts) ? (int)(unsigned)_c : ts_lo; ts_hi = (lane == nts) ? (int)(unsigned)(_c >> 32) : ts_hi; ++nts; } } while (0)
    PG8_STAMP();
    unsigned voffA[2], voffB[2];
#pragma unroll
    for (int i = 0; i < 2; ++i) { int R, C; stage_rc(tid * 16 + i * 8192, R, C); const int Rb = Epi::PERM ? ((R & ~31) + perm32(R & 31)) : R;
        voffA[i] = (unsigned)(R * K + C) * 2u; voffB[i] = (unsigned)(Rb * K + C) * 2u; }
    const size_t kstep = (size_t)(BK * 2);
    const size_t hstep = (size_t)HALF * K * 2;
    const size_t tstep = 2 * hstep;
    const unsigned ldsw = (unsigned)wid * 1024u;
    const int aoff = lds_byte(wr * 64 + fr, fq * 8), boff = lds_byte(wc * 32 + fr, fq * 8);
#define PG8_SA(b, h) (((b) * 2 + (h)) * HTB)
#define PG8_SB(b, h) ((4 + (b) * 2 + (h)) * HTB)
#define PG8_STAGE(bufoff, gbase, voff) do { _Pragma("unroll") for (int _i = 0; _i < 2; ++_i) \
        __builtin_amdgcn_global_load_lds((const unsigned*)((const char*)(gbase) + (voff)[_i]), (PG8_LAS unsigned*)(lds + (bufoff) + ldsw + _i * 8192), 16, 0, 0); } while (0)
#define PG8_LDA(dst, b, h) do { _Pragma("unroll") for (int m = 0; m < 4; ++m) _Pragma("unroll") for (int k = 0; k < 2; ++k) dst[m][k] = *(const PG8_LAS bf16x8*)(lds + PG8_SA(b, h) + aoff + m * 2048 + k * 1024); } while (0)
#define PG8_LDB(dst, b, h) do { _Pragma("unroll") for (int n = 0; n < 2; ++n) _Pragma("unroll") for (int k = 0; k < 2; ++k) dst[n][k] = *(const PG8_LAS bf16x8*)(lds + PG8_SB(b, h) + boff + n * 2048 + k * 1024); } while (0)
#define PG8_MMA(ai, bj, At, Bt) do { __builtin_amdgcn_s_setprio(1); _Pragma("unroll") for (int m = 0; m < 4; ++m) _Pragma("unroll") for (int n = 0; n < 2; ++n) _Pragma("unroll") for (int k = 0; k < 2; ++k) \
        acc[ai][bj][m][n] = __builtin_amdgcn_mfma_f32_16x16x32_bf16(Bt[n][k], At[m][k], acc[ai][bj][m][n], 0, 0, 0); __builtin_amdgcn_s_setprio(0); } while (0)
#define PG8_WAIT_V(n) asm volatile("s_waitcnt vmcnt(" #n ")" ::: "memory")
#define PG8_WAIT_L(n) asm volatile("s_waitcnt lgkmcnt(" #n ")" ::: "memory")
#define PG8_BAR __builtin_amdgcn_s_barrier()
#define PG8_SCHED __builtin_amdgcn_sched_barrier(0)
    Unit cur, nxt; int ui = 0;
    if (!S.next(0, cur)) return;
    f32x4 acc[2][2][4][2];
#pragma unroll
    for (int a = 0; a < 2; ++a)
#pragma unroll
        for (int b = 0; b < 2; ++b)
#pragma unroll
            for (int m = 0; m < 4; ++m)
#pragma unroll
                for (int n = 0; n < 2; ++n) acc[a][b][m][n] = (f32x4){0.f, 0.f, 0.f, 0.f};
    bf16x8 At[4][2], B0[2][2], B1[2][2];
    const char* cA = (const char*)g.A + (size_t)cur.pm * tstep; const char* cB = (const char*)g.Bt + (size_t)cur.pn * tstep;
    S.a_ready(cur);
    PG8_STAGE(PG8_SB(0, 0), cB, voffB); PG8_STAGE(PG8_SA(0, 0), cA, voffA); PG8_STAGE(PG8_SB(0, 1), cB + hstep, voffB); PG8_STAGE(PG8_SA(0, 1), cA + hstep, voffA);
    if (wr == 1) PG8_BAR;
    PG8_WAIT_V(4); PG8_BAR;
    PG8_STAGE(PG8_SB(1, 0), cB + kstep, voffB); PG8_STAGE(PG8_SA(1, 0), cA + kstep, voffA); PG8_STAGE(PG8_SB(1, 1), cB + hstep + kstep, voffB);
    PG8_WAIT_V(6); PG8_BAR;
    PG8_STAMP();
    for (;;) {
        const bool has_next = S.next(ui + 1, nxt);
        const char* nA = has_next ? (const char*)g.A + (size_t)nxt.pm * tstep : cA; const char* nB = has_next ? (const char*)g.Bt + (size_t)nxt.pn * tstep : cB;
        for (int t = 0; t < nt; t += 2) {
            const bool last = (t == nt - 2);
            const char* a1 = cA + (size_t)(t + 1) * kstep;
            const char* a2 = last ? nA : cA + (size_t)(t + 2) * kstep; const char* b2 = last ? nB : cB + (size_t)(t + 2) * kstep;
            const char* a3 = a2 + kstep; const char* b3 = b2 + kstep;
            if (last && has_next) S.a_ready(nxt);
            PG8_LDB(B0, 0, 0); PG8_SCHED; PG8_LDA(At, 0, 0); PG8_STAGE(PG8_SA(1, 1), a1 + hstep, voffA);
            PG8_WAIT_L(8); PG8_BAR; PG8_WAIT_L(0); PG8_MMA(0, 0, At, B0); PG8_BAR; PG8_SCHED;
            PG8_LDB(B1, 0, 1); PG8_STAGE(PG8_SB(0, 0), b2, voffB);
            PG8_BAR; PG8_WAIT_L(0); PG8_MMA(0, 1, At, B1); PG8_BAR;
            PG8_LDA(At, 0, 1); PG8_STAGE(PG8_SA(0, 0), a2, voffA);
            PG8_BAR; PG8_WAIT_L(0); PG8_MMA(1, 0, At, B0); PG8_BAR; PG8_SCHED;
            PG8_STAGE(PG8_SB(0, 1), b2 + hstep, voffB);
            PG8_WAIT_V(6); PG8_BAR; PG8_MMA(1, 1, At, B1); PG8_BAR;
            PG8_LDB(B0, 1, 0); PG8_SCHED; PG8_LDA(At, 1, 0); PG8_STAGE(PG8_SA(0, 1), a2 + hstep, voffA);
            PG8_WAIT_L(8); PG8_BAR; PG8_WAIT_L(0); PG8_MMA(0, 0, At, B0); PG8_BAR; PG8_SCHED;
            PG8_LDB(B1, 1, 1); PG8_STAGE(PG8_SB(1, 0), b3, voffB);
            PG8_BAR; PG8_WAIT_L(0); PG8_MMA(0, 1, At, B1); PG8_BAR;
            PG8_LDA(At, 1, 1); PG8_STAGE(PG8_SA(1, 0), a3, voffA);
            PG8_BAR; PG8_WAIT_L(0); PG8_MMA(1, 0, At, B0); PG8_BAR; PG8_SCHED;
            PG8_STAGE(PG8_SB(1, 1), b3 + hstep, voffB);
            PG8_WAIT_V(6); PG8_BAR; PG8_MMA(1, 1, At, B1); PG8_BAR;
        }
        PG8_STAMP();
        if constexpr (!Epi::AFTER_DRAIN) { E(acc, cur, wr, wc, fr, fq); S.done(cur); }
        PG8_STAMP();
        if (!has_next) break;
#pragma unroll
        for (int a = 0; a < 2; ++a)
#pragma unroll
            for (int b = 0; b < 2; ++b)
#pragma unroll
                for (int m = 0; m < 4; ++m)
#pragma unroll
                    for (int n = 0; n < 2; ++n) acc[a][b][m][n] = (f32x4){0.f, 0.f, 0.f, 0.f};
        cur = nxt; cA = nA; cB = nB; ++ui;
    }
    PG8_WAIT_V(0);
    if (wr == 0) PG8_BAR;
    PG8_BAR;
    if constexpr (Epi::AFTER_DRAIN) { E.fused(acc, cur, wr, wc, fr, fq, lds, wid, lane); S.done(cur); }
    PG8_STAMP();
    if (STAMP && wid == 0) { stamps[lane] = lane < nts ? (((unsigned long long)(unsigned)ts_hi << 32) | (unsigned)ts_lo) : 0ull;
        if (lane == 62) stamps[62] = rt_entry; if (lane == 63) stamps[63] = (unsigned long long)wall_clock64(); }
#undef PG8_STAMP
#undef PG8_SA
#undef PG8_SB
#undef PG8_STAGE
#undef PG8_LDA
#undef PG8_LDB
#undef PG8_MMA
#undef PG8_WAIT_V
#undef PG8_WAIT_L
#undef PG8_BAR
#undef PG8_SCHED
}
}

namespace mk {
using pg8::bf16_t; using pg8::bf16x8; using pg8::f32x4; using pg8::u32x4;
typedef short s16x4 __attribute__((ext_vector_type(4)));
typedef unsigned u32x2 __attribute__((ext_vector_type(2)));

constexpr int D = 2048, NB = 8, S = 2048, M = NB * S, BW = 1024, MIXW = 3072, PW = 13568, DEPTH = 2;
constexpr int C_AQ = 0, C_AK = 1024, C_AV = 2048, C_AG = 3072, C_B = 4096, C_BG = 7424, C_CQ = 8448, C_CI = 9472, C_CF = 10496, C_CG = 12544;
constexpr int NTHR = 512;
constexpr int LDS_BYTES = 147456;
constexpr float LOG2E = 1.4426950408889634f;

constexpr size_t OFF_CTL = 0;
constexpr size_t OFF_WIN = 4096;
constexpr size_t OFF_WOUT = OFF_WIN + (size_t)PW * D * 2;
constexpr size_t OFF_U = OFF_WOUT + (size_t)D * MIXW * 2;
constexpr size_t OFF_PROJ = OFF_U + (size_t)M * D * 2;
constexpr size_t OFF_MIXED = OFF_PROJ + (size_t)M * PW * 2;
constexpr size_t OFF_OC = OFF_MIXED + (size_t)M * MIXW * 2;
constexpr size_t OFF_AO = OFF_OC + (size_t)2 * M * BW * 2;
constexpr size_t OFF_BON = OFF_AO + (size_t)2 * M * BW * 2;
constexpr size_t OFF_YB = OFF_BON + (size_t)2 * M * 16 * 4;
constexpr size_t WS_END = OFF_YB + (size_t)2 * M * BW * 2;

struct Params { const float* in[23]; float* out; unsigned char* ws; };
__device__ __forceinline__ int opaque_tid() { int t = threadIdx.x; asm volatile("" : "+v"(t)); return t; }
__device__ __forceinline__ int opaque_s(int t) { asm volatile("" : "+s"(t)); return t; }
__device__ __forceinline__ int opaque_bid() { int t = blockIdx.x; asm volatile("" : "+s"(t)); return t; }


__device__ __forceinline__ float bf2f(bf16_t v) { return __uint_as_float(((unsigned)v) << 16); }
__device__ __forceinline__ bf16_t f2bf(float f) { unsigned u = __float_as_uint(f); u += 0x7FFFu + ((u >> 16) & 1u); return (bf16_t)(u >> 16); }
typedef __bf16 bf16x2_t __attribute__((ext_vector_type(2)));
typedef float f32x2c __attribute__((ext_vector_type(2)));
__device__ __forceinline__ unsigned pk2(float lo, float hi) { f32x2c v = {lo, hi}; bf16x2_t b = __builtin_convertvector(v, bf16x2_t); return __builtin_bit_cast(unsigned, b); }
__device__ __forceinline__ float wave_sum(float v) {
#pragma unroll
    for (int o = 1; o < 64; o <<= 1) v += __shfl_xor(v, o);
    return v;
}
__device__ __forceinline__ float sigmoidf_(float x) { return 1.f / (1.f + __expf(-x)); }
__device__ __forceinline__ float siluf_(float x) { return x / (1.f + __expf(-x)); }
__device__ __forceinline__ float dpp_xor1(float v) { return __int_as_float(__builtin_amdgcn_mov_dpp(__float_as_int(v), 0xB1, 0xF, 0xF, true)); }
__device__ __forceinline__ float dpp_xor2(float v) { return __int_as_float(__builtin_amdgcn_mov_dpp(__float_as_int(v), 0x4E, 0xF, 0xF, true)); }
__device__ __forceinline__ float dpp_hmir(float v) { return __int_as_float(__builtin_amdgcn_mov_dpp(__float_as_int(v), 0x141, 0xF, 0xF, true)); }
__device__ __forceinline__ float dpp_mir(float v) { return __int_as_float(__builtin_amdgcn_mov_dpp(__float_as_int(v), 0x140, 0xF, 0xF, true)); }
__device__ __forceinline__ float wave_sum_fast(float v) {
    v += dpp_xor1(v); v += dpp_xor2(v); v += dpp_hmir(v); v += dpp_mir(v);
    v += __shfl_xor(v, 16); v += __shfl_xor(v, 32);
    return v;
}
__device__ __forceinline__ float fast_tanh(float x) { return 1.f - 2.f * __builtin_amdgcn_rcpf(1.f + __expf(2.f * x)); }
__device__ __forceinline__ float fast_sigmoid(float x) { return __builtin_amdgcn_rcpf(1.f + __expf(-x)); }
typedef float f32x2 __attribute__((ext_vector_type(2)));
#define MFMA16(a, b, c) __builtin_amdgcn_mfma_f32_16x16x32_bf16((a), (b), (c), 0, 0, 0)
__device__ __forceinline__ bf16x8 join8(s16x4 lo, s16x4 hi) { return __builtin_shufflevector(lo, hi, 0, 1, 2, 3, 4, 5, 6, 7); }
__device__ __forceinline__ bf16x8 pack8(f32x4 a, f32x4 b) {
    u32x4 w; w.x = pk2(a[0], a[1]); w.y = pk2(a[2], a[3]); w.z = pk2(b[0], b[1]); w.w = pk2(b[2], b[3]);
    return __builtin_bit_cast(bf16x8, w);
}

__device__ __forceinline__ void transpose_tile(const float* __restrict__ W, int K, int N, bf16_t* __restrict__ WT, float* tile, int it) {
    const int tid = opaque_tid();
    const int ntn = N >> 6; const int kb = it / ntn, nbk = it - kb * ntn; const int k0 = kb * 64, n0 = nbk * 64;
#pragma unroll
    for (int rr = 0; rr < 2; ++rr) { const int idx = tid + rr * 512; const int kk = idx >> 4, n4 = (idx & 15) * 4;
        const float4 v = *(const float4*)(W + (size_t)(k0 + kk) * N + n0 + n4);
        float* tp = tile + kk * 65 + n4; tp[0] = v.x; tp[1] = v.y; tp[2] = v.z; tp[3] = v.w; }
    __syncthreads();
    { const int n = tid >> 3, kc = (tid & 7) * 8; const float* tp = tile + kc * 65 + n;
      u32x4 o; o.x = pk2(tp[0], tp[65]); o.y = pk2(tp[2 * 65], tp[3 * 65]); o.z = pk2(tp[4 * 65], tp[5 * 65]); o.w = pk2(tp[6 * 65], tp[7 * 65]);
      *(u32x4*)(WT + (size_t)(n0 + n) * K + k0 + kc) = o; }
    __syncthreads();
}
__device__ __forceinline__ void convert_weights(const Params& P, int layer, unsigned char* smem, bool skip_filled) {
    float* tile = (float*)smem;
    const float* win = P.in[4] + (size_t)layer * D * PW; const float* wout = P.in[5] + (size_t)layer * MIXW * D;
    bf16_t* WinT = (bf16_t*)(P.ws + OFF_WIN); bf16_t* WoutT = (bf16_t*)(P.ws + OFF_WOUT);
    constexpr int T_IN = (D / 64) * (PW / 64), T_OUT = (MIXW / 64) * (D / 64);
    if (!skip_filled) {
        for (int it = opaque_bid(); it < T_IN + T_OUT; it += gridDim.x) {
            if (it < T_IN) transpose_tile(win, D, PW, WinT, tile, it);
            else transpose_tile(wout, MIXW, D, WoutT, tile, it - T_IN);
        }
    } else {
        constexpr int T_REST = (D / 64) * 4;
        for (int it = opaque_bid(); it < T_REST + T_OUT; it += gridDim.x) {
            if (it < T_REST) transpose_tile(win, D, PW, WinT, tile, (it >> 2) * (PW / 64) + 208 + (it & 3));
            else transpose_tile(wout, MIXW, D, WoutT, tile, it - T_REST);
        }
    }
}
__device__ __forceinline__ void convert_fill(const Params& P, int layer_next, unsigned char* smem, unsigned* counter) {
    float* tile = (float*)smem; int* sh = (int*)(smem + 20480);
    const int tid = opaque_tid();
    const float* win = P.in[4] + (size_t)layer_next * D * PW;
    bf16_t* WinT = (bf16_t*)(P.ws + OFF_WIN);
    constexpr int NT = (D / 64) * 208;
    for (;;) {
        __syncthreads();
        if (tid == 0) *sh = (int)atomicAdd(counter, 1u);
        __syncthreads();
        const int it = *sh;
        if (it >= NT) break;
        transpose_tile(win, D, PW, WinT, tile, (it / 208) * (PW / 64) + (it % 208));
    }
}
__device__ __forceinline__ void prenorm_rows(const float* __restrict__ x, const float* __restrict__ g, bf16_t* __restrict__ U) {
    const int tid_ = opaque_tid(); const int lane = tid_ & 63, gw = opaque_bid() * 8 + (tid_ >> 6), ngw = gridDim.x * 8;
    for (int row = gw; row < M; row += ngw) {
        const float4* xr = (const float4*)(x + (size_t)row * D) + lane;
        float4 v[8]; float ss = 0.f;
#pragma unroll
        for (int j = 0; j < 8; ++j) { v[j] = xr[64 * j]; ss += v[j].x * v[j].x + v[j].y * v[j].y + v[j].z * v[j].z + v[j].w * v[j].w; }
        const float rstd = rsqrtf(wave_sum(ss) * (1.f / D) + 1e-6f);
        u32x2* o = (u32x2*)(U + (size_t)row * D) + lane;
#pragma unroll
        for (int j = 0; j < 8; ++j) { const float4 gg = ((const float4*)g)[64 * j + lane];
            u32x2 w; w.x = pk2(v[j].x * rstd * gg.x, v[j].y * rstd * gg.y); w.y = pk2(v[j].z * rstd * gg.z, v[j].w * rstd * gg.w); o[64 * j] = w; }
    }
}
__device__ __forceinline__ void postnorm_rows(const bf16_t* __restrict__ y, const float* xin, float* xout, const float* __restrict__ gpost, const float* __restrict__ gpre, bf16_t* __restrict__ U) {
    const int tid_ = opaque_tid(); const int lane = tid_ & 63, gw = opaque_bid() * 8 + (tid_ >> 6), ngw = gridDim.x * 8;
    for (int row = gw; row < M; row += ngw) {
        const u32x2* yr = (const u32x2*)(y + (size_t)row * D) + lane;
        const float4* xr = (const float4*)(xin + (size_t)row * D) + lane;
        float4* xo = (float4*)(xout + (size_t)row * D) + lane;
        float4 v[8]; float ss = 0.f;
#pragma unroll
        for (int j = 0; j < 8; ++j) { const u32x2 w = yr[64 * j]; v[j].x = __uint_as_float(w.x << 16); v[j].y = __uint_as_float(w.x & 0xFFFF0000u); v[j].z = __uint_as_float(w.y << 16); v[j].w = __uint_as_float(w.y & 0xFFFF0000u);
            ss += v[j].x * v[j].x + v[j].y * v[j].y + v[j].z * v[j].z + v[j].w * v[j].w; }
        const float rstd = rsqrtf(wave_sum(ss) * (1.f / D) + 1e-6f);
        float s2 = 0.f;
#pragma unroll
        for (int j = 0; j < 8; ++j) { const float4 gg = ((const float4*)gpost)[64 * j + lane]; const float4 xv = xr[64 * j];
            v[j].x = xv.x + v[j].x * rstd * gg.x; v[j].y = xv.y + v[j].y * rstd * gg.y; v[j].z = xv.z + v[j].z * rstd * gg.z; v[j].w = xv.w + v[j].w * rstd * gg.w;
            xo[64 * j] = v[j]; s2 += v[j].x * v[j].x + v[j].y * v[j].y + v[j].z * v[j].z + v[j].w * v[j].w; }
        if (gpre) {
            const float r2 = rsqrtf(wave_sum(s2) * (1.f / D) + 1e-6f);
            u32x2* o = (u32x2*)(U + (size_t)row * D) + lane;
#pragma unroll
            for (int j = 0; j < 8; ++j) { const float4 gg = ((const float4*)gpre)[64 * j + lane];
                u32x2 w; w.x = pk2(v[j].x * r2 * gg.x, v[j].y * r2 * gg.y); w.y = pk2(v[j].z * r2 * gg.z, v[j].w * r2 * gg.w); o[64 * j] = w; }
        }
    }
}

#define RWKV_LOAD_RAW(cc) do { const int n0_ = (cc) * TCH + pw * TPW; const int T0_ = d ? (S - 1 - n0_) : n0_; const int dstep_ = d ? -1 : 1; \
    _Pragma("unroll") for (int j = 0; j < TPW + 2; ++j) { const int tj = T0_ + (j - 1) * dstep_; const bool ok = (tj >= 0) && (tj < S); \
        const bf16_t* row = proj + ((size_t)b * S + (ok ? tj : T0_)) * PW + C_B; \
        raw[j][0] = row[cr]; raw[j][1] = row[ck]; raw[j][2] = row[cv]; raw[j][3] = row[cw]; raw[j][4] = row[ca]; \
        if (!ok) { raw[j][0] = 0; raw[j][1] = 0; raw[j][2] = 0; raw[j][3] = 0; raw[j][4] = 0; } } } while (0)
__device__ __forceinline__ void rwkv_phase(const Params& P, int layer, unsigned char* smem) {
    constexpr int TCH = 16, TPW = 4, NCH = S / TCH;
    float* VEC = (float*)smem;
    bf16_t* UPT = (bf16_t*)(smem + 49152);
    unsigned char* pbase = smem + 49152 + 18432;
    unsigned char* obase = smem + 49152 + 18432 + 12800;
    unsigned char* nbase = obase + 2 * 18176;
    const int tid = opaque_tid(), wid = __builtin_amdgcn_readfirstlane(tid >> 6), lane = tid & 63, r16 = lane & 15, quad = lane >> 4;
    const bf16_t* proj = (const bf16_t*)(P.ws + OFF_PROJ);
    bf16_t* YB = (bf16_t*)(P.ws + OFF_YB);
    float* BON = (float*)(P.ws + OFF_BON);
    const float* mu = P.in[11] + (size_t)layer * 2 * 3328;
    for (int chain = opaque_bid(); chain < 256; chain += gridDim.x) {
        const int d = chain >> 7, b = (chain >> 4) & 7, h = chain & 15;
        __syncthreads();
        { const float* wup = P.in[13] + ((size_t)(layer * 2 + d) * 64) * 1024 + h * 64; const float* aup = P.in[15] + ((size_t)(layer * 2 + d) * 64) * 1024 + h * 64;
#pragma unroll
          for (int it = 0; it < 16; ++it) { const int e = tid + 512 * it; const int mat = e >> 12, lora = (e >> 6) & 63, ch = e & 63;
              const float v = (mat ? aup : wup)[(size_t)lora * 1024 + ch]; UPT[mat * 4608 + ch * 72 + lora] = f2bf(v); } }
        __syncthreads();
        if (wid < 4) {
            const int cw = wid;
            float* Nm = (float*)(nbase + cw * 1024);
            const int jl = lane & 15, tg = lane >> 4, jcol = cw * 16 + jl;
            const float rkc = P.in[18][(size_t)layer * 1024 + h * 64 + jcol];
            const f32x4 z4 = {0.f, 0.f, 0.f, 0.f};
            f32x4 ST[4];
#pragma unroll
            for (int mt = 0; mt < 4; ++mt) ST[mt] = z4;
            asm volatile("s_waitcnt lgkmcnt(0)" ::: "memory"); __builtin_amdgcn_s_barrier(); asm volatile("" ::: "memory");
            asm volatile("s_waitcnt lgkmcnt(0)" ::: "memory"); __builtin_amdgcn_s_barrier(); asm volatile("" ::: "memory");
            for (int c = 0; c < NCH; ++c) {
                const float* vb = VEC + (c & 1) * (TCH * 384);
                unsigned char* ob = obase + (c & 1) * 18176;
                bf16_t* Pm = (bf16_t*)ob; bf16_t* Rm = (bf16_t*)(ob + 2304); bf16_t* Qm = (bf16_t*)(ob + 4608); bf16_t* Mm = (bf16_t*)(ob + 6912);
                bf16_t* QT = (bf16_t*)(ob + 9216); bf16_t* MT = (bf16_t*)(ob + 12288); float* GT = (float*)(ob + 15360); bf16_t* Bm = (bf16_t*)(ob + 15872);
                {
                    float nk[4], ww[4], ka[4], km[4], rr[4];
#pragma unroll
                    for (int u = 0; u < 4; ++u) { const float* vt = vb + (4 * tg + u) * 384 + jcol; nk[u] = vt[0]; ww[u] = vt[64]; ka[u] = vt[128]; km[u] = vt[192]; rr[u] = vt[256]; }
                    float gl[4];
                    gl[0] = ww[0]; gl[1] = gl[0] * ww[1]; gl[2] = gl[1] * ww[2]; gl[3] = gl[2] * ww[3];
                    const float G0 = __shfl(gl[3], jl), G1 = __shfl(gl[3], jl + 16), G2 = __shfl(gl[3], jl + 32);
                    const float pre = (tg == 0) ? 1.f : (tg == 1) ? G0 : (tg == 2) ? G0 * G1 : (G0 * G1) * G2;
                    float pv[4], rv[4], qv[4], mv[4];
#pragma unroll
                    for (int u = 0; u < 4; ++u) {
                        const float gprev = (u == 0) ? pre : pre * gl[u - 1], gcur = pre * gl[u];
                        const float ig = __builtin_amdgcn_rcpf(gcur);
                        pv[u] = gprev * nk[u]; qv[u] = ka[u] * ig; mv[u] = km[u] * ig; rv[u] = gcur * rr[u];
                    }
                    const unsigned wp0 = pk2(pv[0], pv[1]), wp1 = pk2(pv[2], pv[3]), wr0 = pk2(rv[0], rv[1]), wr1 = pk2(rv[2], rv[3]);
                    const unsigned wq0 = pk2(qv[0], qv[1]), wq1 = pk2(qv[2], qv[3]), wm0 = pk2(mv[0], mv[1]), wm1 = pk2(mv[2], mv[3]);
                    const int t0 = 4 * tg;
                    Pm[(t0) * 72 + jcol] = (bf16_t)(wp0 & 0xFFFFu); Pm[(t0 + 1) * 72 + jcol] = (bf16_t)(wp0 >> 16); Pm[(t0 + 2) * 72 + jcol] = (bf16_t)(wp1 & 0xFFFFu); Pm[(t0 + 3) * 72 + jcol] = (bf16_t)(wp1 >> 16);
                    Rm[(t0) * 72 + jcol] = (bf16_t)(wr0 & 0xFFFFu); Rm[(t0 + 1) * 72 + jcol] = (bf16_t)(wr0 >> 16); Rm[(t0 + 2) * 72 + jcol] = (bf16_t)(wr1 & 0xFFFFu); Rm[(t0 + 3) * 72 + jcol] = (bf16_t)(wr1 >> 16);
                    Qm[(t0) * 72 + jcol] = (bf16_t)(wq0 & 0xFFFFu); Qm[(t0 + 1) * 72 + jcol] = (bf16_t)(wq0 >> 16); Qm[(t0 + 2) * 72 + jcol] = (bf16_t)(wq1 & 0xFFFFu); Qm[(t0 + 3) * 72 + jcol] = (bf16_t)(wq1 >> 16);
                    Mm[(t0) * 72 + jcol] = (bf16_t)(wm0 & 0xFFFFu); Mm[(t0 + 1) * 72 + jcol] = (bf16_t)(wm0 >> 16); Mm[(t0 + 2) * 72 + jcol] = (bf16_t)(wm1 & 0xFFFFu); Mm[(t0 + 3) * 72 + jcol] = (bf16_t)(wm1 >> 16);
                    u32x2 tq; tq.x = wq0; tq.y = wq1; *(u32x2*)(QT + jcol * 24 + t0) = tq;
                    u32x2 tm; tm.x = wm0; tm.y = wm1; *(u32x2*)(MT + jcol * 24 + t0) = tm;
                    { const unsigned wb0 = pk2(rv[0] * rkc, rv[1] * rkc), wb1 = pk2(rv[2] * rkc, rv[3] * rkc);
                      Bm[(t0) * 72 + jcol] = (bf16_t)(wb0 & 0xFFFFu); Bm[(t0 + 1) * 72 + jcol] = (bf16_t)(wb0 >> 16); Bm[(t0 + 2) * 72 + jcol] = (bf16_t)(wb1 & 0xFFFFu); Bm[(t0 + 3) * 72 + jcol] = (bf16_t)(wb1 >> 16); }
                    if (tg == 3) GT[jcol] = pre * gl[3];
                }
                asm volatile("s_waitcnt lgkmcnt(0)" ::: "memory"); __builtin_amdgcn_s_barrier(); asm volatile("" ::: "memory");
                f32x4 Gqp = z4, Gmp = z4, Gqr = z4, Gmr = z4, Npq = z4;
#pragma unroll
                for (int ks = 0; ks < 2; ++ks) {
                    const bf16x8 aQ = *(const bf16x8*)(Qm + r16 * 72 + ks * 32 + quad * 8), aM = *(const bf16x8*)(Mm + r16 * 72 + ks * 32 + quad * 8);
                    const bf16x8 bP = *(const bf16x8*)(Pm + r16 * 72 + ks * 32 + quad * 8), bR = *(const bf16x8*)(Rm + r16 * 72 + ks * 32 + quad * 8);
                    Gqp = MFMA16(aQ, bP, Gqp); Gmp = MFMA16(aM, bP, Gmp); Gqr = MFMA16(aQ, bR, Gqr); Gmr = MFMA16(aM, bR, Gmr); Npq = MFMA16(bP, aQ, Npq);
                }
                if (cw == 0) {
                    f32x4 Gmb = z4;
#pragma unroll
                    for (int ks = 0; ks < 2; ++ks) Gmb = MFMA16(*(const bf16x8*)(Mm + r16 * 72 + ks * 32 + quad * 8), *(const bf16x8*)(Bm + r16 * 72 + ks * 32 + quad * 8), Gmb);
                    if (quad == (r16 >> 2)) {
                        const int rsel = r16 & 3;
                        const float bon = (rsel == 0) ? Gmb[0] : (rsel == 1) ? Gmb[1] : (rsel == 2) ? Gmb[2] : Gmb[3];
                        const int n = c * TCH + r16; const int t = d ? (S - 1 - n) : n;
                        BON[(((size_t)d * NB + b) * 16 + h) * S + t] = bon;
                    }
                }
#pragma unroll
                for (int rg = 0; rg < 4; ++rg) { const int sI = quad * 4 + rg;
                    if (sI >= r16) { Gqp[rg] = 0.f; Gmp[rg] = 0.f; }
                    if (sI > r16) { Gqr[rg] = 0.f; Gmr[rg] = 0.f; }
                    if (sI <= r16) Npq[rg] = 0.f; }
                f32x4 SA0 = z4, Y0 = z4;
#pragma unroll
                for (int ks = 0; ks < 2; ++ks) {
                    const bf16x8 sb = pack8(ST[2 * ks], ST[2 * ks + 1]);
                    const bf16_t* pp = Pm + r16 * 72 + ks * 32 + quad * 4; const bf16_t* rp = Rm + r16 * 72 + ks * 32 + quad * 4;
                    const bf16x8 pa = join8(*(const s16x4*)pp, *(const s16x4*)(pp + 16)), ra = join8(*(const s16x4*)rp, *(const s16x4*)(rp + 16));
                    SA0 = MFMA16(pa, sb, SA0); Y0 = MFMA16(ra, sb, Y0);
                }
                f32x4 Vv;
#pragma unroll
                for (int jj = 0; jj < 4; ++jj) Vv[jj] = vb[(quad * 4 + jj) * 384 + 320 + cw * 16 + r16];
                const f32x4 Cc = MFMA16(pack8(Gmp, z4), pack8(Vv, z4), SA0);
                const bf16x8 m1 = pack8(Gqp, z4), n1 = pack8(Npq, z4);
                const f32x4 Mc2 = MFMA16(n1, m1, z4), Nc2 = MFMA16(m1, n1, z4);
                const bf16x8 m2 = pack8(Mc2, z4), n2 = pack8(Nc2, z4);
                const f32x4 Mc4 = MFMA16(n2, m2, z4), Nc4 = MFMA16(m2, n2, z4);
                const bf16x8 m4 = pack8(Mc4, z4), n4 = pack8(Nc4, z4);
                const f32x4 Mc8 = MFMA16(n4, m4, z4);
                f32x4 SAc = MFMA16(pack8(Mc8, z4), pack8(Cc, z4), Cc);
                SAc = MFMA16(m4, pack8(SAc, z4), SAc);
                SAc = MFMA16(m2, pack8(SAc, z4), SAc);
                SAc = MFMA16(m1, pack8(SAc, z4), SAc);
                const bf16x8 Bsv = pack8(SAc, Vv);
                const f32x4 Yc = MFMA16(pack8(Gqr, Gmr), Bsv, Y0);
#pragma unroll
                for (int rg = 0; rg < 4; ++rg) { const int n = c * TCH + quad * 4 + rg; const int t = d ? (S - 1 - n) : n;
                    YB[((size_t)d * M + (size_t)b * S + t) * 1024 + h * 64 + cw * 16 + r16] = f2bf(Yc[rg]); }
#pragma unroll
                for (int mt = 0; mt < 4; ++mt) {
                    const bf16_t* qp = QT + (mt * 16 + r16) * 24 + quad * 4; const bf16_t* mp = MT + (mt * 16 + r16) * 24 + quad * 4;
                    const f32x4 acc = MFMA16(join8(*(const s16x4*)qp, *(const s16x4*)mp), Bsv, ST[mt]);
                    const f32x4 gt = *(const f32x4*)(GT + mt * 16 + quad * 4);
                    ST[mt] = acc * gt;
                }
                asm volatile("s_waitcnt lgkmcnt(0)" ::: "memory"); __builtin_amdgcn_s_barrier(); asm volatile("" ::: "memory");
            }
        } else {
            const int pw = wid - 4;
            bf16_t* Aw = (bf16_t*)(pbase + pw * 3200); bf16_t* Aa = Aw + TPW * 72; float* X = (float*)(pbase + pw * 3200 + 1152);
            const int cr = h * 64 + lane, ck = 1024 + h * 64 + lane, cv = 2048 + h * 64 + lane, cw = 3072 + d * 64 + lane, ca = 3200 + d * 64 + lane;
            const int mo0 = d ? 3328 : 0, mo1 = d ? 0 : 3328;
            const float mr0 = mu[mo0 + cr], mr1 = mu[mo1 + cr], mk0 = mu[mo0 + ck], mk1 = mu[mo1 + ck], mv0 = mu[mo0 + cv], mv1 = mu[mo1 + cv];
            const float mw0 = mu[mo0 + cw], mw1 = mu[mo1 + cw], ma0 = mu[mo0 + ca], ma1 = mu[mo1 + ca];
            const int chn = h * 64 + lane;
            const float w0v = P.in[12][(size_t)(layer * 2 + d) * 1024 + chn], a0v = P.in[14][(size_t)(layer * 2 + d) * 1024 + chn];
            const float kkw = P.in[16][(size_t)layer * 1024 + chn], kaw = P.in[17][(size_t)layer * 1024 + chn], rkw = P.in[18][(size_t)layer * 1024 + chn];
            unsigned short raw[TPW + 2][5];
            RWKV_LOAD_RAW(0);
            for (int c = 0; c < NCH + 1; ++c) {
                if (c < NCH) {
                    float* vb = VEC + (c & 1) * (TCH * 384);
                    float rr[TPW], kv[TPW], vv[TPW], kk[TPW];
                    {
                        float fr[TPW + 2][5];
#pragma unroll
                        for (int j = 0; j < TPW + 2; ++j)
#pragma unroll
                            for (int st = 0; st < 5; ++st) fr[j][st] = bf2f(raw[j][st]);
                        if (c + 1 < NCH) { RWKV_LOAD_RAW(c + 1); }
#pragma unroll
                        for (int i = 0; i < TPW; ++i) {
                            float p0, pa, pb;
                            p0 = fr[i + 1][0]; pa = fr[i][0]; pb = fr[i + 2][0]; rr[i] = p0 + mr0 * (pa - p0) + mr1 * (pb - p0);
                            p0 = fr[i + 1][1]; pa = fr[i][1]; pb = fr[i + 2][1]; kv[i] = p0 + mk0 * (pa - p0) + mk1 * (pb - p0);
                            p0 = fr[i + 1][2]; pa = fr[i][2]; pb = fr[i + 2][2]; vv[i] = p0 + mv0 * (pa - p0) + mv1 * (pb - p0);
                            p0 = fr[i + 1][3]; pa = fr[i][3]; pb = fr[i + 2][3]; const float wd = p0 + mw0 * (pa - p0) + mw1 * (pb - p0);
                            p0 = fr[i + 1][4]; pa = fr[i][4]; pb = fr[i + 2][4]; const float ad = p0 + ma0 * (pa - p0) + ma1 * (pb - p0);
                            Aw[i * 72 + lane] = f2bf(fast_tanh(wd)); Aa[i * 72 + lane] = f2bf(ad);
                            const float k2 = kv[i] * kkw; const float n2 = wave_sum_fast(k2 * k2);
                            kk[i] = k2 * __builtin_amdgcn_rsqf(fmaxf(n2, 1e-24f));
                        }
                    }
                    asm volatile("s_waitcnt lgkmcnt(0)" ::: "memory"); __builtin_amdgcn_s_barrier(); asm volatile("" ::: "memory");
#pragma unroll
                    for (int mat = 0; mat < 2; ++mat) {
                        const bf16_t* A = mat ? Aa : Aw;
                        const bf16x8 a0f = *(const bf16x8*)(A + (r16 & (TPW - 1)) * 72 + quad * 8), a1f = *(const bf16x8*)(A + (r16 & (TPW - 1)) * 72 + 32 + quad * 8);
#pragma unroll
                        for (int nt = 0; nt < 4; ++nt) {
                            const bf16_t* B = UPT + mat * 4608 + (nt * 16 + r16) * 72 + quad * 8;
                            f32x4 acc = {0.f, 0.f, 0.f, 0.f};
                            acc = MFMA16(a0f, *(const bf16x8*)B, acc); acc = MFMA16(a1f, *(const bf16x8*)(B + 32), acc);
                            if (quad == 0) {
#pragma unroll
                                for (int rg = 0; rg < 4; ++rg) X[mat * 256 + rg * 64 + nt * 16 + r16] = acc[rg];
                            }
                        }
                    }
                    asm volatile("s_waitcnt lgkmcnt(0)" ::: "memory");
#pragma unroll
                    for (int i = 0; i < TPW; ++i) {
                        const int s = pw * TPW + i; const int n = c * TCH + s; const int t = d ? (S - 1 - n) : n;
                        const float xw = X[i * 64 + lane] + w0v, xa = X[256 + i * 64 + lane] + a0v;
                        const float dec = __expf(-0.6065306597126334f * fast_sigmoid(xw)); const float av = fast_sigmoid(xa);
                        const float kmod = kv[i] * (1.f + (av - 1.f) * kaw); const float kka = kk[i] * av;
                        float* o = vb + s * 384 + lane;
                        o[0] = -kk[i]; o[64] = dec; o[128] = kka; o[192] = kmod; o[256] = rr[i]; o[320] = vv[i];
                    }
                }
                if (c == NCH) { asm volatile("s_waitcnt lgkmcnt(0)" ::: "memory"); __builtin_amdgcn_s_barrier(); asm volatile("" ::: "memory"); }
                asm volatile("s_waitcnt lgkmcnt(0)" ::: "memory"); __builtin_amdgcn_s_barrier(); asm volatile("" ::: "memory");
            }
        }
    }
}

__device__ __forceinline__ int swz40(int row, int s) { return row * 40 + ((((s >> 3) ^ (row >> 3)) & 3) << 3) + (s & 7); }
__device__ __forceinline__ void hgrn_phase(const Params& P, int layer, unsigned char* smem) {
    bf16_t* QE = (bf16_t*)smem; bf16_t* KE = (bf16_t*)(smem + 8704); bf16_t* KLT = (bf16_t*)(smem + 17408); bf16_t* VT = (bf16_t*)(smem + 27648);
    float* LF = (float*)(smem + 37888); float* EL = (float*)(smem + 54272);
    const int tid = opaque_tid(), wid = __builtin_amdgcn_readfirstlane(tid >> 6), lane = tid & 63, r16 = lane & 15, quad = lane >> 4;
    const bf16_t* proj = (const bf16_t*)(P.ws + OFF_PROJ);
    bf16_t* OC = (bf16_t*)(P.ws + OFF_OC);
    const int es = tid >> 4, ekc = (tid & 15) * 8;
    for (int chain = opaque_bid(); chain < 128; chain += gridDim.x) {
        const int d = chain >> 6, b = (chain >> 3) & 7, h = chain & 7;
        float lb[8];
#pragma unroll
        for (int j = 0; j < 8; ++j) lb[j] = 0.f;
        if (layer > 0) {
#pragma unroll
            for (int j = 0; j < 8; ++j) { const float l0 = P.in[21][(size_t)(d * 2 + 0) * 1024 + h * 128 + ekc + j], l1 = P.in[21][(size_t)(d * 2 + 1) * 1024 + h * 128 + ekc + j]; lb[j] = 1.f / (1.f + __expf(l0 - l1)); }
        }
        f32x4 Sacc[8];
#pragma unroll
        for (int mt = 0; mt < 8; ++mt) Sacc[mt] = (f32x4){0.f, 0.f, 0.f, 0.f};
        u32x4 zraw, qraw, vraw;
        { const int t = d ? (S - 1 - es) : es; const bf16_t* row = proj + ((size_t)b * S + t) * PW + h * 128 + ekc;
          zraw = *(const u32x4*)(row + C_CF + d * 1024); qraw = *(const u32x4*)(row + C_CQ); vraw = *(const u32x4*)(row + C_CI); }
        for (int c = 0; c < 64; ++c) {
            __syncthreads();
            { const int n = c * 32 + es; const int t = d ? (S - 1 - n) : n; const bf16_t* row = proj + ((size_t)b * S + t) * PW + h * 128 + ekc;
              zraw = *(const u32x4*)(row + C_CF + d * 1024); qraw = *(const u32x4*)(row + C_CQ); vraw = *(const u32x4*)(row + C_CI); }
            float kval[8];
            {
                float lf[8];
#pragma unroll
                for (int j = 0; j < 8; ++j) {
                    const unsigned wv = zraw[j >> 1]; const float z = (j & 1) ? __uint_as_float(wv & 0xFFFF0000u) : __uint_as_float(wv << 16);
                    const float e = __expf(-fabsf(z));
                    const float ls = fminf(z, 0.f) - __logf(1.f + e);
                    const float sg = (z >= 0.f ? 1.f : e) * __builtin_amdgcn_rcpf(1.f + e);
                    lf[j] = (lb[j] > 0.f) ? __logf(lb[j] + (1.f - lb[j]) * sg) : ls;
                    kval[j] = (1.f - lb[j]) * (1.f - sg);
                }
                *(f32x4*)(LF + es * 128 + ekc) = (f32x4){lf[0], lf[1], lf[2], lf[3]}; *(f32x4*)(LF + es * 128 + ekc + 4) = (f32x4){lf[4], lf[5], lf[6], lf[7]};
#pragma unroll
                for (int j = 0; j < 8; ++j) { const unsigned wv = vraw[j >> 1]; VT[swz40(ekc + j, es)] = (bf16_t)((j & 1) ? (wv >> 16) : (wv & 0xFFFFu)); }
            }
            __syncthreads();
            if (tid < 128) {
                float cum = 0.f;
#pragma unroll
                for (int s = 0; s < 32; ++s) { cum += LF[s * 128 + tid]; LF[s * 128 + tid] = cum; }
                EL[tid] = __expf(cum);
            }
            __syncthreads();
            {
                const f32x4 c0 = *(const f32x4*)(LF + es * 128 + ekc), c1v = *(const f32x4*)(LF + es * 128 + ekc + 4);
                const f32x4 l0 = *(const f32x4*)(LF + 31 * 128 + ekc), l1 = *(const f32x4*)(LF + 31 * 128 + ekc + 4);
                float qe[8], ke[8];
#pragma unroll
                for (int j = 0; j < 8; ++j) {
                    const unsigned wv = qraw[j >> 1]; const float qv = (j & 1) ? __uint_as_float(wv & 0xFFFF0000u) : __uint_as_float(wv << 16);
                    const float cum = (j < 4) ? c0[j & 3] : c1v[j & 3], last = (j < 4) ? l0[j & 3] : l1[j & 3];
                    qe[j] = qv * __expf(cum); ke[j] = kval[j] * __expf(-cum);
                    KLT[swz40(ekc + j, es)] = f2bf(kval[j] * __expf(last - cum));
                }
                u32x4 w; w.x = pk2(qe[0], qe[1]); w.y = pk2(qe[2], qe[3]); w.z = pk2(qe[4], qe[5]); w.w = pk2(qe[6], qe[7]); *(u32x4*)(QE + es * 136 + ekc) = w;
                w.x = pk2(ke[0], ke[1]); w.y = pk2(ke[2], ke[3]); w.z = pk2(ke[4], ke[5]); w.w = pk2(ke[6], ke[7]); *(u32x4*)(KE + es * 136 + ekc) = w;
            }
            if (false) { const int n = (c + 1) * 32 + es; const int t = d ? (S - 1 - n) : n; const bf16_t* row = proj + ((size_t)b * S + t) * PW + h * 128 + ekc;
                zraw = *(const u32x4*)(row + C_CF + d * 1024); qraw = *(const u32x4*)(row + C_CQ); vraw = *(const u32x4*)(row + C_CI); }
            __syncthreads();
            f32x4 sc00 = {0.f, 0.f, 0.f, 0.f}, sc01 = sc00, sc11 = sc00;
#pragma unroll
            for (int ks = 0; ks < 4; ++ks) {
                const bf16x8 ke0 = *(const bf16x8*)(KE + r16 * 136 + ks * 32 + quad * 8), ke1 = *(const bf16x8*)(KE + (16 + r16) * 136 + ks * 32 + quad * 8);
                const bf16x8 qe0 = *(const bf16x8*)(QE + r16 * 136 + ks * 32 + quad * 8), qe1 = *(const bf16x8*)(QE + (16 + r16) * 136 + ks * 32 + quad * 8);
                sc00 = MFMA16(ke0, qe0, sc00); sc01 = MFMA16(ke0, qe1, sc01); sc11 = MFMA16(ke1, qe1, sc11);
            }
#pragma unroll
            for (int rg = 0; rg < 4; ++rg) { if (quad * 4 + rg > r16) { sc00[rg] = 0.f; sc11[rg] = 0.f; } }
            const f32x4 zero4 = {0.f, 0.f, 0.f, 0.f};
            const bf16x8 p0 = pack8(sc00, zero4), p1 = pack8(sc01, sc11);
            const int vrow_i = wid * 16 + r16;
            const bf16x8 vperm = join8(*(const s16x4*)(VT + swz40(vrow_i, quad * 4)), *(const s16x4*)(VT + swz40(vrow_i, 16 + quad * 4)));
            f32x4 o0 = MFMA16(p0, vperm, zero4), o1 = MFMA16(p1, vperm, zero4);
#pragma unroll
            for (int ks = 0; ks < 4; ++ks) {
                const bf16x8 sb = pack8(Sacc[2 * ks], Sacc[2 * ks + 1]);
                const bf16_t* q0p = QE + r16 * 136 + ks * 32 + quad * 4; const bf16_t* q1p = QE + (16 + r16) * 136 + ks * 32 + quad * 4;
                const bf16x8 qa0 = join8(*(const s16x4*)q0p, *(const s16x4*)(q0p + 16)), qa1 = join8(*(const s16x4*)q1p, *(const s16x4*)(q1p + 16));
                o0 = MFMA16(qa0, sb, o0); o1 = MFMA16(qa1, sb, o1);
            }
#pragma unroll
            for (int rg = 0; rg < 4; ++rg) {
                { const int n = c * 32 + quad * 4 + rg; const int t = d ? (S - 1 - n) : n; OC[((size_t)d * M + (size_t)b * S + t) * 1024 + h * 128 + wid * 16 + r16] = f2bf(o0[rg]); }
                { const int n = c * 32 + 16 + quad * 4 + rg; const int t = d ? (S - 1 - n) : n; OC[((size_t)d * M + (size_t)b * S + t) * 1024 + h * 128 + wid * 16 + r16] = f2bf(o1[rg]); }
            }
            const bf16x8 vnat = *(const bf16x8*)(VT + swz40(vrow_i, quad * 8));
#pragma unroll
            for (int mt = 0; mt < 8; ++mt) {
                const f32x4 el = *(const f32x4*)(EL + mt * 16 + quad * 4);
                f32x4 sa = Sacc[mt] * el;
                const bf16x8 kl = *(const bf16x8*)(KLT + swz40(mt * 16 + r16, quad * 8));
                Sacc[mt] = MFMA16(kl, vnat, sa);
            }
        }
    }
}

__device__ __forceinline__ void attn_phase(const Params& P, int layer, unsigned char* smem, unsigned* counter) {
    float* TAB = (float*)smem; bf16_t* KT = (bf16_t*)(smem + 16384); bf16_t* VTt = (bf16_t*)(smem + 16384 + 9216); int* sh_unit = (int*)(smem + 16384 + 9216 + 18432);
    const int tid = opaque_tid(), wid = __builtin_amdgcn_readfirstlane(tid >> 6), lane = tid & 63, r16 = lane & 15, quad = lane >> 4;
    const bf16_t* proj = (const bf16_t*)(P.ws + OFF_PROJ);
    bf16_t* AO = (bf16_t*)(P.ws + OFF_AO);
    const float* rel_bias = P.in[1];
    const float c1 = 0.125f * LOG2E;
    const int xcd = opaque_bid() & 7;
    for (;;) {
        __syncthreads();
        if (tid == 0) *sh_unit = (int)atomicAdd(counter + xcd, 1u);
        __syncthreads();
        const int li = *sh_unit;
        if (li >= 128) break;
        const int qb = li & 7, grp = (li >> 3) * 8 + xcd;
        const int m = grp & 1, h = (grp >> 1) & 7, b = grp >> 4;
        for (int e = tid; e < 4095; e += 512) { const int rel = e - 2047; const int n = rel < 0 ? -rel : rel; int bk;
            if (n < 8) bk = n; else { const int lg = 31 - __clz(n * n); bk = 2 + lg; if (bk > 15) bk = 15; }
            if (rel > 0) bk += 16; TAB[e] = rel_bias[bk * 8 + h] * LOG2E; }
        const int qrow0 = qb * 256 + wid * 32;
        bf16x8 Qf[2][2];
#pragma unroll
        for (int nq = 0; nq < 2; ++nq)
#pragma unroll
            for (int ks = 0; ks < 2; ++ks) Qf[nq][ks] = *(const bf16x8*)(proj + ((size_t)b * S + qrow0 + nq * 16 + r16) * PW + C_AQ + h * 128 + m * 64 + ks * 32 + quad * 8);
        f32x4 O[2][8];
#pragma unroll
        for (int nq = 0; nq < 2; ++nq)
#pragma unroll
            for (int dt = 0; dt < 8; ++dt) O[nq][dt] = (f32x4){0.f, 0.f, 0.f, 0.f};
        float mrun[2] = {-1e30f, -1e30f}, lrun[2] = {0.f, 0.f};
        const int kkey = tid >> 3, kchunk = tid & 7;
        const int vkp = tid & 31, vchunk = tid >> 5;
        const bf16_t* kbase = proj + ((size_t)b * S + kkey) * PW + C_AK + h * 128 + m * 64 + kchunk * 8;
        const bf16_t* vbase = proj + ((size_t)b * S + 2 * vkp) * PW + C_AV + h * 128 + vchunk * 8;
        u32x4 kreg = *(const u32x4*)kbase, vreg0 = *(const u32x4*)vbase, vreg1 = *(const u32x4*)(vbase + PW);
        for (int kt = 0; kt < 32; ++kt) {
            __syncthreads();
            *(u32x4*)(KT + kkey * 72 + kchunk * 8) = kreg;
            { unsigned* vd = (unsigned*)(VTt + (vchunk * 8) * 72 + 2 * vkp);
#pragma unroll
              for (int i2 = 0; i2 < 4; ++i2) { const unsigned a = vreg0[i2], bq = vreg1[i2];
                  vd[(2 * i2) * 36] = (a & 0xFFFFu) | (bq << 16); vd[(2 * i2 + 1) * 36] = (a >> 16) | (bq & 0xFFFF0000u); } }
            __syncthreads();
            if (kt + 1 < 32) { const size_t adv = (size_t)(kt + 1) * 64 * PW; kreg = *(const u32x4*)(kbase + adv); vreg0 = *(const u32x4*)(vbase + adv); vreg1 = *(const u32x4*)(vbase + adv + PW); }
            const int k0 = kt * 64;
            f32x4 st[2][4];
#pragma unroll
            for (int mt = 0; mt < 4; ++mt) {
                const bf16x8 ka = *(const bf16x8*)(KT + (mt * 16 + r16) * 72 + quad * 8), kb2 = *(const bf16x8*)(KT + (mt * 16 + r16) * 72 + 32 + quad * 8);
#pragma unroll
                for (int nq = 0; nq < 2; ++nq) { f32x4 a = {0.f, 0.f, 0.f, 0.f}; a = MFMA16(ka, Qf[nq][0], a); a = MFMA16(kb2, Qf[nq][1], a); st[nq][mt] = a; }
            }
            const bool posfar = (k0 - (qrow0 + 31)) >= 96, negfar = (qrow0 - (k0 + 63)) >= 96;
            if (posfar || negfar) {
                const float cb = posfar ? TAB[2047 + 128] : TAB[2047 - 128];
#pragma unroll
                for (int nq = 0; nq < 2; ++nq)
#pragma unroll
                    for (int mt = 0; mt < 4; ++mt) st[nq][mt] = st[nq][mt] * c1 + cb;
            } else {
#pragma unroll
                for (int nq = 0; nq < 2; ++nq)
#pragma unroll
                    for (int mt = 0; mt < 4; ++mt) { const float* tp = TAB + (k0 + mt * 16 + quad * 4) - (qrow0 + nq * 16 + r16) + 2047;
#pragma unroll
                        for (int rg = 0; rg < 4; ++rg) st[nq][mt][rg] = st[nq][mt][rg] * c1 + tp[rg]; }
            }
            bf16x8 pf[2][2];
#pragma unroll
            for (int nq = 0; nq < 2; ++nq) {
                float mx = st[nq][0][0];
#pragma unroll
                for (int mt = 0; mt < 4; ++mt)
#pragma unroll
                    for (int rg = 0; rg < 4; ++rg) mx = fmaxf(mx, st[nq][mt][rg]);
                mx = fmaxf(mx, __shfl_xor(mx, 16)); mx = fmaxf(mx, __shfl_xor(mx, 32));
                const float mnew = fmaxf(mrun[nq], mx); const float alpha = __builtin_amdgcn_exp2f(mrun[nq] - mnew); mrun[nq] = mnew;
                float ps = 0.f;
#pragma unroll
                for (int mt = 0; mt < 4; ++mt)
#pragma unroll
                    for (int rg = 0; rg < 4; ++rg) { const float pv = __builtin_amdgcn_exp2f(st[nq][mt][rg] - mnew); st[nq][mt][rg] = pv; ps += pv; }
                lrun[nq] = lrun[nq] * alpha + ps;
#pragma unroll
                for (int dt = 0; dt < 8; ++dt) O[nq][dt] = O[nq][dt] * alpha;
                pf[nq][0] = pack8(st[nq][0], st[nq][1]); pf[nq][1] = pack8(st[nq][2], st[nq][3]);
            }
#pragma unroll
            for (int dt = 0; dt < 8; ++dt) {
                const bf16_t* vr = VTt + (dt * 16 + r16) * 72 + quad * 4;
                const bf16x8 va0 = join8(*(const s16x4*)vr, *(const s16x4*)(vr + 16)), va1 = join8(*(const s16x4*)(vr + 32), *(const s16x4*)(vr + 48));
#pragma unroll
                for (int nq = 0; nq < 2; ++nq) { O[nq][dt] = MFMA16(va0, pf[nq][0], O[nq][dt]); O[nq][dt] = MFMA16(va1, pf[nq][1], O[nq][dt]); }
            }
        }
#pragma unroll
        for (int nq = 0; nq < 2; ++nq) {
            float l = lrun[nq]; l += __shfl_xor(l, 16); l += __shfl_xor(l, 32);
            const float inv = 1.f / l;
            bf16_t* orow = AO + ((size_t)m * M + (size_t)b * S + qrow0 + nq * 16 + r16) * 1024 + h * 128 + quad * 4;
#pragma unroll
            for (int dt = 0; dt < 8; ++dt) { u32x2 w; w.x = pk2(O[nq][dt][0] * inv, O[nq][dt][1] * inv); w.y = pk2(O[nq][dt][2] * inv, O[nq][dt][3] * inv); *(u32x2*)(orow + dt * 16) = w; }
        }
    }
}

__device__ __forceinline__ void load16(const bf16_t* p, float* o) {
    const u32x4 a = *(const u32x4*)p, b = *(const u32x4*)(p + 8);
#pragma unroll
    for (int i = 0; i < 4; ++i) { o[2 * i] = __uint_as_float(a[i] << 16); o[2 * i + 1] = __uint_as_float(a[i] & 0xFFFF0000u); o[8 + 2 * i] = __uint_as_float(b[i] << 16); o[8 + 2 * i + 1] = __uint_as_float(b[i] & 0xFFFF0000u); }
}
__device__ __forceinline__ void store16(bf16_t* p, const float* v) {
    u32x4 a, b; a.x = pk2(v[0], v[1]); a.y = pk2(v[2], v[3]); a.z = pk2(v[4], v[5]); a.w = pk2(v[6], v[7]); b.x = pk2(v[8], v[9]); b.y = pk2(v[10], v[11]); b.z = pk2(v[12], v[13]); b.w = pk2(v[14], v[15]);
    *(u32x4*)p = a; *(u32x4*)(p + 8) = b;
}
__device__ __forceinline__ void loadf16(const float* p, float* o) {
#pragma unroll
    for (int i = 0; i < 4; ++i) { const float4 v = ((const float4*)p)[i]; o[4 * i] = v.x; o[4 * i + 1] = v.y; o[4 * i + 2] = v.z; o[4 * i + 3] = v.w; }
}
__device__ __forceinline__ void finish_phase(const Params& P, int layer) {
    const int tid_ = opaque_tid(); const int lane = tid_ & 63, gw = opaque_bid() * 8 + (tid_ >> 6), ngw = gridDim.x * 8;
    const bf16_t* proj = (const bf16_t*)(P.ws + OFF_PROJ);
    const bf16_t* AO = (const bf16_t*)(P.ws + OFF_AO); const bf16_t* YB = (const bf16_t*)(P.ws + OFF_YB); const bf16_t* OC = (const bf16_t*)(P.ws + OFF_OC);
    const float* BON = (const float*)(P.ws + OFF_BON);
    bf16_t* MIX = (bf16_t*)(P.ws + OFF_MIXED);
    const float lam_init = 0.8f - 0.6f * expf(-0.3f * (float)layer);
    const float s1 = wave_sum(P.in[6][layer * 64 + lane] * P.in[7][layer * 64 + lane]), s2 = wave_sum(P.in[8][layer * 64 + lane] * P.in[9][layer * 64 + lane]);
    const float lam = expf(s1) - expf(s2) + lam_init;
    const int c0 = lane * 16;
    const float* mu0p = P.in[11] + (size_t)layer * 2 * 3328 + 2048 + c0; const float* mu1p = mu0p + 3328;
    for (int tok = gw; tok < M; tok += ngw) {
        const bf16_t* prow = proj + (size_t)tok * PW;
        bf16_t* mrow = MIX + (size_t)tok * MIXW;
        float a[16], bb[16], g[16], pr[16];
        load16(AO + (size_t)tok * 1024 + c0, a); load16(AO + ((size_t)M + tok) * 1024 + c0, bb); load16(prow + C_AG + c0, g);
        { float ss = 0.f;
#pragma unroll
          for (int i = 0; i < 16; ++i) { a[i] = a[i] - lam * bb[i]; ss += a[i] * a[i]; }
          ss += __shfl_xor(ss, 1); ss += __shfl_xor(ss, 2); ss += __shfl_xor(ss, 4);
          const float rstd = rsqrtf(ss * (1.f / 128.f) + 1e-5f) * (1.f - lam_init);
          loadf16(P.in[10] + layer * 128 + (c0 & 127), pr);
#pragma unroll
          for (int i = 0; i < 16; ++i) a[i] = a[i] * rstd * pr[i] * siluf_(g[i]);
          store16(mrow + c0, a); }
        load16(YB + (size_t)tok * 1024 + c0, a); load16(YB + ((size_t)M + tok) * 1024 + c0, bb); load16(prow + C_BG + c0, g);
        { float sm = 0.f;
#pragma unroll
          for (int i = 0; i < 16; ++i) { a[i] += bb[i]; sm += a[i]; }
          sm += __shfl_xor(sm, 1); sm += __shfl_xor(sm, 2);
          const float mean = sm * (1.f / 64.f); float vs = 0.f;
#pragma unroll
          for (int i = 0; i < 16; ++i) { a[i] -= mean; vs += a[i] * a[i]; }
          vs += __shfl_xor(vs, 1); vs += __shfl_xor(vs, 2);
          const float rstd = rsqrtf(vs * (1.f / 64.f) + 64e-5f);
          const int head = lane >> 2;
          const float bon = BON[(((size_t)(tok >> 11)) * 16 + head) * S + (tok & (S - 1))] + BON[(((size_t)NB + (tok >> 11)) * 16 + head) * S + (tok & (S - 1))];
          const int sp = tok & (S - 1);
          loadf16(P.in[19] + layer * 1024 + c0, pr);
#pragma unroll
          for (int i = 0; i < 16; ++i) a[i] = a[i] * rstd * pr[i];
          loadf16(P.in[20] + layer * 1024 + c0, pr);
#pragma unroll
          for (int i = 0; i < 16; ++i) a[i] += pr[i];
          load16(prow + C_B + 2048 + c0, bb);
          float vsft[16];
          { float nb[16];
            if (sp > 0) load16(prow - PW + C_B + 2048 + c0, nb); else {
#pragma unroll
                for (int i = 0; i < 16; ++i) nb[i] = 0.f; }
            loadf16(mu0p, pr);
#pragma unroll
            for (int i = 0; i < 16; ++i) vsft[i] = bb[i] + pr[i] * (nb[i] - bb[i]);
            if (sp < S - 1) load16(prow + PW + C_B + 2048 + c0, nb); else {
#pragma unroll
                for (int i = 0; i < 16; ++i) nb[i] = 0.f; }
            loadf16(mu1p, pr);
#pragma unroll
            for (int i = 0; i < 16; ++i) vsft[i] += pr[i] * (nb[i] - bb[i]); }
#pragma unroll
          for (int i = 0; i < 16; ++i) a[i] = (a[i] + bon * vsft[i]) * siluf_(g[i]);
          store16(mrow + 1024 + c0, a); }
        load16(OC + (size_t)tok * 1024 + c0, a); load16(OC + ((size_t)M + tok) * 1024 + c0, bb); load16(prow + C_CG + c0, g);
        { float ss = 0.f;
#pragma unroll
          for (int i = 0; i < 16; ++i) { a[i] += bb[i]; ss += a[i] * a[i]; }
          ss += __shfl_xor(ss, 1); ss += __shfl_xor(ss, 2); ss += __shfl_xor(ss, 4);
          const float rstd = rsqrtf(ss * (1.f / 128.f) + 1e-6f);
          loadf16(P.in[22] + layer * 128 + (c0 & 127), pr);
#pragma unroll
          for (int i = 0; i < 16; ++i) a[i] = a[i] * rstd * pr[i] * siluf_(g[i]);
          store16(mrow + 2048 + c0, a); }
    }
}

__global__ void __launch_bounds__(NTHR, 2) fwd_megakernel(Params P) {
    extern __shared__ __attribute__((aligned(16))) unsigned char smem[];
    cg::grid_group grid = cg::this_grid();
    unsigned* ctl = (unsigned*)(P.ws + OFF_CTL);
    bf16_t* U = (bf16_t*)(P.ws + OFF_U);
    bf16_t* Y = (bf16_t*)(P.ws + OFF_PROJ);
#ifndef REP_P0
#define REP_P0 1
#endif
#pragma unroll 1
    for (int rep = 0; rep < REP_P0; ++rep) { convert_weights(P, 0, smem, false);
    prenorm_rows(P.in[0], P.in[2], U); }
    grid.sync();
#pragma unroll 1
    for (int layer = 0; layer < DEPTH; ++layer) {
#ifndef REP_G1
#define REP_G1 1
#endif
#pragma unroll 1
        for (int rep = 0; rep < REP_G1; ++rep) { pg8::Gemm g; g.A = U; g.Bt = (const bf16_t*)(P.ws + OFF_WIN); g.M = opaque_s(M); g.N = opaque_s(PW - 256); g.K = opaque_s(D);
          pg8::StaticOrder So; So.init(g.M, g.N, (int)gridDim.x, opaque_bid());
          pg8::EpiBf16<0> E; E.O = (bf16_t*)(P.ws + OFF_PROJ); E.ldc = opaque_s(PW); E.bias = nullptr; E.split_cols = 0; E.split_stride = 0;
          pg8::gemm_phase<pg8::EpiBf16<0>, pg8::StaticOrder, false>((PG8_LAS unsigned char*)smem, g, So, E, nullptr); }
        grid.sync();
#ifndef REP_RWKV
#define REP_RWKV 1
#endif
#ifndef REP_HGRN
#define REP_HGRN 1
#endif
#ifndef REP_ATTN
#define REP_ATTN 1
#endif
#pragma unroll 1
        for (int rep = 0; rep < REP_RWKV; ++rep) rwkv_phase(P, layer, smem);
#pragma unroll 1
        for (int rep = 0; rep < REP_HGRN; ++rep) hgrn_phase(P, layer, smem);
        { const int tb = opaque_bid();
          if (tb >= 128 && tb < 192) {
              pg8::Gemm g; g.A = U; g.Bt = (const bf16_t*)(P.ws + OFF_WIN) + (size_t)(PW - 256) * D; g.M = opaque_s(M); g.N = opaque_s(256); g.K = opaque_s(D);
              pg8::StaticOrder So; So.init(g.M, g.N, (int)gridDim.x, tb - 128);
              pg8::EpiBf16<0> E; E.O = (bf16_t*)(P.ws + OFF_PROJ) + (PW - 256); E.ldc = opaque_s(PW); E.bias = nullptr; E.split_cols = 0; E.split_stride = 0;
              pg8::gemm_phase<pg8::EpiBf16<0>, pg8::StaticOrder, false>((PG8_LAS unsigned char*)smem, g, So, E, nullptr);
          } }

#pragma unroll 1
        for (int rep = 0; rep < REP_ATTN; ++rep) attn_phase(P, layer, smem, ctl + 64 * layer + 128 * rep);
        if (layer + 1 < DEPTH) convert_fill(P, layer + 1, smem, ctl + 64 * layer + 32);
        grid.sync();
#ifndef REP_FIN
#define REP_FIN 1
#endif
#pragma unroll 1
        for (int rep = 0; rep < REP_FIN; ++rep) finish_phase(P, layer);
        grid.sync();
#ifndef REP_G2
#define REP_G2 1
#endif
#pragma unroll 1
        for (int rep = 0; rep < REP_G2; ++rep) { pg8::Gemm g; g.A = (const bf16_t*)(P.ws + OFF_MIXED); g.Bt = (const bf16_t*)(P.ws + OFF_WOUT); g.M = opaque_s(M); g.N = opaque_s(D); g.K = opaque_s(MIXW);
          pg8::StaticOrder So; So.init(g.M, g.N, (int)gridDim.x, opaque_bid());
          pg8::EpiBf16<0> E; E.O = Y; E.ldc = g.N; E.bias = nullptr; E.split_cols = 0; E.split_stride = 0;
          pg8::gemm_phase<pg8::EpiBf16<0>, pg8::StaticOrder, false>((PG8_LAS unsigned char*)smem, g, So, E, nullptr); }
        grid.sync();
        if (layer + 1 < DEPTH) {
            postnorm_rows(Y, layer == 0 ? P.in[0] : P.out, P.out, P.in[3] + layer * D, P.in[2] + (layer + 1) * D, U);
            convert_weights(P, layer + 1, smem, true);
            grid.sync();
        } else {
            postnorm_rows(Y, layer == 0 ? P.in[0] : P.out, P.out, P.in[3] + layer * D, nullptr, U);
        }
    }
}
}

extern "C" void kernel_launch(void* const* d_in, const int* in_sizes, int n_in, void* d_out, int out_size, void* d_ws, size_t ws_size, hipStream_t stream) {
    static int grid_blocks = 0;
    if (grid_blocks == 0) {
        int dev = 0, cus = 0, per_cu = 0;
        hipGetDevice(&dev);
        hipDeviceGetAttribute(&cus, hipDeviceAttributeMultiprocessorCount, dev);
        if (hipFuncSetAttribute((const void*)mk::fwd_megakernel, hipFuncAttributeMaxDynamicSharedMemorySize, mk::LDS_BYTES) != hipSuccess) fprintf(stderr, "hipFuncSetAttribute failed\n");
        if (hipOccupancyMaxActiveBlocksPerMultiprocessor(&per_cu, (const void*)mk::fwd_megakernel, mk::NTHR, mk::LDS_BYTES) != hipSuccess || per_cu < 1) { fprintf(stderr, "occupancy query: %d\n", per_cu); per_cu = 1; }
        (void)hipGetLastError();
        grid_blocks = cus * 1;
        if (ws_size < mk::WS_END) fprintf(stderr, "workspace too small: %zu < %zu\n", ws_size, (size_t)mk::WS_END);
    }
    hipMemsetAsync((unsigned char*)d_ws + mk::OFF_CTL, 0, 4096, stream);
    mk::Params p{};
    for (int i = 0; i < 23; ++i) p.in[i] = (const float*)d_in[i];
    p.out = (float*)d_out; p.ws = (unsigned char*)d_ws;
    void* args[] = {&p};
    hipError_t e = hipLaunchCooperativeKernel((const void*)mk::fwd_megakernel, dim3(grid_blocks), dim3(mk::NTHR), args, mk::LDS_BYTES, stream);
    if (e != hipSuccess) fprintf(stderr, "cooperative launch failed: %s (grid %d)\n", hipGetErrorString(e), grid_blocks);
}
```

```cpp
#include <hip/hip_runtime.h>
#include <hip/hip_cooperative_groups.h>
#include <cstdio>
#include <cstdint>
namespace cg = cooperative_groups;
namespace pg8 {
#define PG8_LAS __attribute__((address_space(3)))
typedef unsigned short bf16_t;
typedef short bf16x8 __attribute__((ext_vector_type(8)));
typedef float f32x4 __attribute__((ext_vector_type(4)));
typedef unsigned u32x4 __attribute__((ext_vector_type(4)));
constexpr int BM = 256, BK = 64, HALF = 128, HTB = HALF * BK * 2  , STAGE_BYTES = 8 * HTB, NXCD = 8, WGM = 8;

__host__ __device__ __forceinline__ int lds_byte(int r, int c) { const int st = (r >> 4) * 2 + (c >> 5), rr = r & 15, cc = c & 31, ob = rr * 64 + cc * 2; return st * 1024 + (ob ^ (((ob >> 9) & 1) << 5)); }
__host__ __device__ __forceinline__ void stage_rc(int b, int& R, int& C) { const int st = b / 1024, sb = b % 1024, swz = sb ^ (((sb >> 9) & 1) << 5); R = (st >> 1) * 16 + swz / 64; C = (st & 1) * 32 + (swz % 64) / 2; }
__host__ __device__ __forceinline__ int perm32(int rho) { const int n = rho >> 4, i = rho & 15; return 8 * (i >> 2) + 4 * n + (i & 3); }

struct Unit { int pm, pn; };
struct Gemm { const bf16_t* A; const bf16_t* Bt; int M, N, K; };

struct StaticOrder {
    int nM, nN, nwg, G, c;
    __host__ __device__ void init(int M, int N, int G_, int c_) { nM = M / BM; nN = N / BM; nwg = nM * nN; G = G_; c = c_; }
    __host__ __device__ bool next(int i, Unit& u) const {
        const long L = (long)i * G + c; if (L >= nwg) return false;
        int wgid = (int)L; { const int q = nwg / NXCD, r = nwg % NXCD, xcd = wgid % NXCD, off = wgid / NXCD; wgid = (xcd < r ? xcd * (q + 1) : r * (q + 1) + (xcd - r) * q) + off; }
        const int nig = WGM * nN, gid = wgid / nig, fm = gid * WGM, gsz = (nM - fm) < WGM ? (nM - fm) : WGM;
        u.pm = fm + ((wgid % nig) % gsz); u.pn = (wgid % nig) / gsz; return true;
    }
    __device__ __forceinline__ void a_ready(const Unit&) const {}
    __device__ __forceinline__ void done(const Unit&) const {}
};
struct CountedOrder : StaticOrder {
    const unsigned* ready; unsigned need; unsigned* tmo;
    __device__ __forceinline__ void a_ready(const Unit& u) const {
        if (threadIdx.x < 64) {
            const unsigned long long t0 = __builtin_amdgcn_s_memrealtime(); unsigned polls = 0;
            while ((unsigned)__builtin_amdgcn_readfirstlane(__hip_atomic_load(ready + 64 * u.pm, __ATOMIC_RELAXED, __HIP_MEMORY_SCOPE_AGENT)) < need) {
                if ((++polls & 255u) == 0u && __builtin_amdgcn_readfirstlane(__hip_atomic_load(tmo, __ATOMIC_RELAXED, __HIP_MEMORY_SCOPE_AGENT)) != 0u) break;
                if (__builtin_amdgcn_s_memrealtime() - t0 > 2000000ull) {
                    if (threadIdx.x == 0) { unsigned expect = 0u; __hip_atomic_compare_exchange_strong(tmo + 1, &expect, 0x600u | (unsigned)(u.pm & 0xff), __ATOMIC_RELAXED, __ATOMIC_RELAXED, __HIP_MEMORY_SCOPE_AGENT); __hip_atomic_store(tmo, 1u, __ATOMIC_RELAXED, __HIP_MEMORY_SCOPE_AGENT); }
                    break; }
                __builtin_amdgcn_s_sleep(2); }
            __builtin_amdgcn_fence(__ATOMIC_ACQUIRE, "agent");
            asm volatile("s_waitcnt vmcnt(0)" ::: "memory");
        }
#if !defined(BROKEN_HOOK_NO_BARRIER)
        asm volatile("" ::: "memory"); __builtin_amdgcn_s_barrier(); asm volatile("" ::: "memory");
#endif
    }
};

typedef __bf16 bf16x2_t __attribute__((ext_vector_type(2)));
typedef float f32x2c __attribute__((ext_vector_type(2)));
__device__ __forceinline__ unsigned cvt_pk_bf16(float lo, float hi) { f32x2c v = {lo, hi}; bf16x2_t b = __builtin_convertvector(v, bf16x2_t); return __builtin_bit_cast(unsigned, b); }
typedef float f32x2 __attribute__((ext_vector_type(2)));
__device__ __forceinline__ f32x2 gelu_pk(f32x2 v) {
    const f32x2 av = __builtin_elementwise_abs(v), d = av * 0.2316418882f + 1.0f;
    f32x2 t; t.x = __builtin_amdgcn_rcpf(d.x); t.y = __builtin_amdgcn_rcpf(d.y);
    f32x2 q = t * 0.5307027145f + (-0.7265760135f); q = q * t + 0.7107068705f; q = q * t + (-0.142248368f); q = q * t + 0.127414796f; q = q * t;
    const f32x2 s = (v * v) * (-0.72134752044f);
    f32x2 e; e.x = __builtin_amdgcn_exp2f(s.x); e.y = __builtin_amdgcn_exp2f(s.y);
    const f32x2 m = v * (q * e), r = v - m;
    f32x2 o; o.x = v.x < 0.f ? m.x : r.x; o.y = v.y < 0.f ? m.y : r.y; return o;
}

struct EpiF32 {
    static constexpr bool PERM = false, AFTER_DRAIN = false;
    float* C; int ldc; const float* bias;
    __device__ __forceinline__ void operator()(const f32x4 (&acc)[2][2][4][2], const Unit& u, int wr, int wc, int fr, int fq) const {
        const int row0 = u.pm * BM + wr * 64 + fr, col0 = u.pn * BM + wc * 32 + 4 * fq;
        f32x4 bv[2][2];
#pragma unroll
        for (int bj = 0; bj < 2; ++bj)
#pragma unroll
            for (int n = 0; n < 2; ++n) bv[bj][n] = bias ? *(const f32x4*)(bias + col0 + bj * HALF + n * 16) : (f32x4){0.f, 0.f, 0.f, 0.f};
#pragma unroll
        for (int ai = 0; ai < 2; ++ai)
#pragma unroll
            for (int m = 0; m < 4; ++m) { float* rowp = C + (size_t)(row0 + ai * HALF + m * 16) * ldc + col0;
#pragma unroll
                for (int bj = 0; bj < 2; ++bj)
#pragma unroll
                    for (int n = 0; n < 2; ++n) *(f32x4*)(rowp + bj * HALF + n * 16) = acc[ai][bj][m][n] + bv[bj][n]; }
    }
};
template <int ACT  > struct EpiBf16 {
    static constexpr bool PERM = true, AFTER_DRAIN = false;
    bf16_t* O; int ldc; const float* bias; int split_cols; size_t split_stride;
    __device__ __forceinline__ void operator()(const f32x4 (&acc)[2][2][4][2], const Unit& u, int wr, int wc, int fr, int fq) const {
        const int row0 = u.pm * BM + wr * 64 + fr; int colt = u.pn * BM; bf16_t* base = O;
        if (split_cols) { const int t = colt / split_cols; base += (size_t)t * split_stride; colt -= t * split_cols; }
        const int col0 = colt + wc * 32 + 8 * fq, bcol0 = u.pn * BM + wc * 32 + 8 * fq;
        f32x4 bv[2][2];
#pragma unroll
        for (int bj = 0; bj < 2; ++bj)
#pragma unroll
            for (int n = 0; n < 2; ++n) bv[bj][n] = bias ? *(const f32x4*)(bias + bcol0 + bj * HALF + 4 * n) : (f32x4){0.f, 0.f, 0.f, 0.f};
#pragma unroll
        for (int ai = 0; ai < 2; ++ai)
#pragma unroll
            for (int m = 0; m < 4; ++m) { bf16_t* rowp = base + (size_t)(row0 + ai * HALF + m * 16) * ldc + col0;
#pragma unroll
                for (int bj = 0; bj < 2; ++bj) { f32x4 v0 = acc[ai][bj][m][0] + bv[bj][0], v1 = acc[ai][bj][m][1] + bv[bj][1];
                    if (ACT == 1) { f32x2 a = gelu_pk((f32x2){v0[0], v0[1]}), b = gelu_pk((f32x2){v0[2], v0[3]}), c = gelu_pk((f32x2){v1[0], v1[1]}), d = gelu_pk((f32x2){v1[2], v1[3]});
                        v0 = (f32x4){a.x, a.y, b.x, b.y}; v1 = (f32x4){c.x, c.y, d.x, d.y}; }
                    if (ACT == 2) {
#pragma unroll
                        for (int j = 0; j < 4; ++j) { v0[j] = 0.5f * v0[j] * (1.0f + erff(v0[j] * 0.70710678f)); v1[j] = 0.5f * v1[j] * (1.0f + erff(v1[j] * 0.70710678f)); } }
                    u32x4 w; w.x = cvt_pk_bf16(v0[0], v0[1]); w.y = cvt_pk_bf16(v0[2], v0[3]); w.z = cvt_pk_bf16(v1[0], v1[1]); w.w = cvt_pk_bf16(v1[2], v1[3]);
                    *(u32x4*)(rowp + bj * HALF) = w; } }
    }
};


template <class Epi, class Sched, bool STAMP = false>
__device__ __forceinline__ void gemm_phase(PG8_LAS unsigned char* lds, const Gemm g, const Sched& S, const Epi& E, unsigned long long* stamps) {
    int tid_o = threadIdx.x; asm volatile("" : "+v"(tid_o));
    const int tid = tid_o, wid = __builtin_amdgcn_readfirstlane(tid >> 6), lane = tid & 63, wr = wid >> 2, wc = wid & 3, fr = lane & 15, fq = lane >> 4;
    const int K = g.K, nt = K / BK;
    int ts_lo = 0, ts_hi = 0, nts = 0; const unsigned long long rt_entry = STAMP ? (unsigned long long)wall_clock64() : 0ull;
#define PG8_STAMP() do { if (STAMP && wid == 0 && nts < 64) { const unsigned long long _c = (unsigned long long)clock64(); \
        ts_lo = (lane == nts) ? (int)(unsigned)_c : ts_lo; ts_hi = (lane == nts) ? (int)(unsigned)(_c >> 32) : ts_hi; ++nts; } } while (0)
    PG8_STAMP();
    unsigned voffA[2], voffB[2];
#pragma unroll
    for (int i = 0; i < 2; ++i) { int R, C; stage_rc(tid * 16 + i * 8192, R, C); const int Rb = Epi::PERM ? ((R & ~31) + perm32(R & 31)) : R;
        voffA[i] = (unsigned)(R * K + C) * 2u; voffB[i] = (unsigned)(Rb * K + C) * 2u; }
    const size_t kstep = (size_t)(BK * 2);
    const size_t hstep = (size_t)HALF * K * 2;
    const size_t tstep = 2 * hstep;
    const unsigned ldsw = (unsigned)wid * 1024u;
    const int aoff = lds_byte(wr * 64 + fr, fq * 8), boff = lds_byte(wc * 32 + fr, fq * 8);
#define PG8_SA(b, h) (((b) * 2 + (h)) * HTB)
#define PG8_SB(b, h) ((4 + (b) * 2 + (h)) * HTB)
#define PG8_STAGE(bufoff, gbase, voff) do { _Pragma("unroll") for (int _i = 0; _i < 2; ++_i) \
        __builtin_amdgcn_global_load_lds((const unsigned*)((const char*)(gbase) + (voff)[_i]), (PG8_LAS unsigned*)(lds + (bufoff) + ldsw + _i * 8192), 16, 0, 0); } while (0)
#define PG8_LDA(dst, b, h) do { _Pragma("unroll") for (int m = 0; m < 4; ++m) _Pragma("unroll") for (int k = 0; k < 2; ++k) dst[m][k] = *(const PG8_LAS bf16x8*)(lds + PG8_SA(b, h) + aoff + m * 2048 + k * 1024); } while (0)
#define PG8_LDB(dst, b, h) do { _Pragma("unroll") for (int n = 0; n < 2; ++n) _Pragma("unroll") for (int k = 0; k < 2; ++k) dst[n][k] = *(const PG8_LAS bf16x8*)(lds + PG8_SB(b, h) + boff + n * 2048 + k * 1024); } while (0)
#define PG8_MMA(ai, bj, At, Bt) do { __builtin_amdgcn_s_setprio(1); _Pragma("unroll") for (int m = 0; m < 4; ++m) _Pragma("unroll") for (int n = 0; n < 2; ++n) _Pragma("unroll") for (int k = 0; k < 2; ++k) \
        acc[ai][bj][m][n] = __builtin_amdgcn_mfma_f32_16x16x32_bf16(Bt[n][k], At[m][k], acc[ai][bj][m][n], 0, 0, 0); __builtin_amdgcn_s_setprio(0); } while (0)
#define PG8_WAIT_V(n) asm volatile("s_waitcnt vmcnt(" #n ")" ::: "memory")
#define PG8_WAIT_L(n) asm volatile("s_waitcnt lgkmcnt(" #n ")" ::: "memory")
#define PG8_BAR __builtin_amdgcn_s_barrier()
#define PG8_SCHED __builtin_amdgcn_sched_barrier(0)
    Unit cur, nxt; int ui = 0;
    if (!S.next(0, cur)) return;
    f32x4 acc[2][2][4][2];
#pragma unroll
    for (int a = 0; a < 2; ++a)
#pragma unroll
        for (int b = 0; b < 2; ++b)
#pragma unroll
            for (int m = 0; m < 4; ++m)
#pragma unroll
                for (int n = 0; n < 2; ++n) acc[a][b][m][n] = (f32x4){0.f, 0.f, 0.f, 0.f};
    bf16x8 At[4][2], B0[2][2], B1[2][2];
    const char* cA = (const char*)g.A + (size_t)cur.pm * tstep; const char* cB = (const char*)g.Bt + (size_t)cur.pn * tstep;
    S.a_ready(cur);
    PG8_STAGE(PG8_SB(0, 0), cB, voffB); PG8_STAGE(PG8_SA(0, 0), cA, voffA); PG8_STAGE(PG8_SB(0, 1), cB + hstep, voffB); PG8_STAGE(PG8_SA(0, 1), cA + hstep, voffA);
    if (wr == 1) PG8_BAR;
    PG8_WAIT_V(4); PG8_BAR;
    PG8_STAGE(PG8_SB(1, 0), cB + kstep, voffB); PG8_STAGE(PG8_SA(1, 0), cA + kstep, voffA); PG8_STAGE(PG8_SB(1, 1), cB + hstep + kstep, voffB);
    PG8_WAIT_V(6); PG8_BAR;
    PG8_STAMP();
    for (;;) {
        const bool has_next = S.next(ui + 1, nxt);
        const char* nA = has_next ? (const char*)g.A + (size_t)nxt.pm * tstep : cA; const char* nB = has_next ? (const char*)g.Bt + (size_t)nxt.pn * tstep : cB;
        for (int t = 0; t < nt; t += 2) {
            const bool last = (t == nt - 2);
            const char* a1 = cA + (size_t)(t + 1) * kstep;
            const char* a2 = last ? nA : cA + (size_t)(t + 2) * kstep; const char* b2 = last ? nB : cB + (size_t)(t + 2) * kstep;
            const char* a3 = a2 + kstep; const char* b3 = b2 + kstep;
            if (last && has_next) S.a_ready(nxt);
            PG8_LDB(B0, 0, 0); PG8_SCHED; PG8_LDA(At, 0, 0); PG8_STAGE(PG8_SA(1, 1), a1 + hstep, voffA);
            PG8_WAIT_L(8); PG8_BAR; PG8_WAIT_L(0); PG8_MMA(0, 0, At, B0); PG8_BAR; PG8_SCHED;
            PG8_LDB(B1, 0, 1); PG8_STAGE(PG8_SB(0, 0), b2, voffB);
            PG8_BAR; PG8_WAIT_L(0); PG8_MMA(0, 1, At, B1); PG8_BAR;
            PG8_LDA(At, 0, 1); PG8_STAGE(PG8_SA(0, 0), a2, voffA);
            PG8_BAR; PG8_WAIT_L(0); PG8_MMA(1, 0, At, B0); PG8_BAR; PG8_SCHED;
            PG8_STAGE(PG8_SB(0, 1), b2 + hstep, voffB);
            PG8_WAIT_V(6); PG8_BAR; PG8_MMA(1, 1, At, B1); PG8_BAR;
            PG8_LDB(B0, 1, 0); PG8_SCHED; PG8_LDA(At, 1, 0); PG8_STAGE(PG8_SA(0, 1), a2 + hstep, voffA);
            PG8_WAIT_L(8); PG8_BAR; PG8_WAIT_L(0); PG8_MMA(0, 0, At, B0); PG8_BAR; PG8_SCHED;
            PG8_LDB(B1, 1, 1); PG8_STAGE(PG8_SB(1, 0), b3, voffB);
            PG8_BAR; PG8_WAIT_L(0); PG8_MMA(0, 1, At, B1); PG8_BAR;
            PG8_LDA(At, 1, 1); PG8_STAGE(PG8_SA(1, 0), a3, voffA);
            PG8_BAR; PG8_WAIT_L(0); PG8_MMA(1, 0, At, B0); PG8_BAR; PG8_SCHED;
            PG8_STAGE(PG8_SB(1, 1), b3 + hstep, voffB);
            PG8_WAIT_V(6); PG8_BAR; PG8_MMA(1, 1, At, B1); PG8_BAR;
        }
        PG8_STAMP();
        if constexpr (!Epi::AFTER_DRAIN) { E(acc, cur, wr, wc, fr, fq); S.done(cur); }
        PG8_STAMP();
        if (!has_next) break;
#pragma unroll
        for (int a = 0; a < 2; ++a)
#pragma unroll
            for (int b = 0; b < 2; ++b)
#pragma unroll
                for (int m = 0; m < 4; ++m)
#pragma unroll
                    for (int n = 0; n < 2; ++n) acc[a][b][m][n] = (f32x4){0.f, 0.f, 0.f, 0.f};
        cur = nxt; cA = nA; cB = nB; ++ui;
    }
    PG8_WAIT_V(0);
    if (wr == 0) PG8_BAR;
    PG8_BAR;
    if constexpr (Epi::AFTER_DRAIN) { E.fused(acc, cur, wr, wc, fr, fq, lds, wid, lane); S.done(cur); }
    PG8_STAMP();
    if (STAMP && wid == 0) { stamps[lane] = lane < nts ? (((unsigned long long)(unsigned)ts_hi << 32) | (unsigned)ts_lo) : 0ull;
        if (lane == 62) stamps[62] = rt_entry; if (lane == 63) stamps[63] = (unsigned long long)wall_clock64(); }
#undef PG8_STAMP
#undef PG8_SA
#undef PG8_SB
#undef PG8_STAGE
#undef PG8_LDA
#undef PG8_LDB
#undef PG8_MMA
#undef PG8_WAIT_V
#undef PG8_WAIT_L
#undef PG8_BAR
#undef PG8_SCHED
}
}

namespace mk {
using pg8::bf16_t; using pg8::bf16x8; using pg8::f32x4; using pg8::u32x4;
typedef short s16x4 __attribute__((ext_vector_type(4)));
typedef unsigned u32x2 __attribute__((ext_vector_type(2)));

constexpr int D = 2048, NB = 8, S = 2048, M = NB * S, BW = 1024, MIXW = 3072, PW = 13568, DEPTH = 2;
constexpr int C_AQ = 0, C_AK = 1024, C_AV = 2048, C_AG = 3072, C_B = 4096, C_BG = 7424, C_CQ = 8448, C_CI = 9472, C_CF = 10496, C_CG = 12544;
constexpr int NTHR = 512;
constexpr int LDS_BYTES = 147456;
constexpr float LOG2E = 1.4426950408889634f;

constexpr size_t OFF_CTL = 0;
constexpr size_t OFF_WIN = 4096;
constexpr size_t OFF_WOUT = OFF_WIN + (size_t)PW * D * 2;
constexpr size_t OFF_U = OFF_WOUT + (size_t)D * MIXW * 2;
constexpr size_t OFF_PROJ = OFF_U + (size_t)M * D * 2;
constexpr size_t OFF_MIXED = OFF_PROJ + (size_t)M * PW * 2;
constexpr size_t OFF_OC = OFF_MIXED + (size_t)M * MIXW * 2;
constexpr size_t OFF_AO = OFF_OC + (size_t)2 * M * BW * 2;
constexpr size_t OFF_BON = OFF_AO + (size_t)2 * M * BW * 2;
constexpr size_t OFF_YB = OFF_BON + (size_t)2 * M * 16 * 4;
constexpr size_t WS_END = OFF_YB + (size_t)2 * M * BW * 2;

struct Params { const float* in[23]; float* out; unsigned char* ws; };
__device__ __forceinline__ int opaque_tid() { int t = threadIdx.x; asm volatile("" : "+v"(t)); return t; }
__device__ __forceinline__ int opaque_s(int t) { asm volatile("" : "+s"(t)); return t; }
__device__ __forceinline__ int opaque_bid() { int t = blockIdx.x; asm volatile("" : "+s"(t)); return t; }


__device__ __forceinline__ float bf2f(bf16_t v) { return __uint_as_float(((unsigned)v) << 16); }
__device__ __forceinline__ bf16_t f2bf(float f) { unsigned u = __float_as_uint(f); u += 0x7FFFu + ((u >> 16) & 1u); return (bf16_t)(u >> 16); }
typedef __bf16 bf16x2_t __attribute__((ext_vector_type(2)));
typedef float f32x2c __attribute__((ext_vector_type(2)));
__device__ __forceinline__ unsigned pk2(float lo, float hi) { f32x2c v = {lo, hi}; bf16x2_t b = __builtin_convertvector(v, bf16x2_t); return __builtin_bit_cast(unsigned, b); }
__device__ __forceinline__ float wave_sum(float v) {
#pragma unroll
    for (int o = 1; o < 64; o <<= 1) v += __shfl_xor(v, o);
    return v;
}
__device__ __forceinline__ float sigmoidf_(float x) { return 1.f / (1.f + __expf(-x)); }
__device__ __forceinline__ float siluf_(float x) { return x / (1.f + __expf(-x)); }
__device__ __forceinline__ float dpp_xor1(float v) { return __int_as_float(__builtin_amdgcn_mov_dpp(__float_as_int(v), 0xB1, 0xF, 0xF, true)); }
__device__ __forceinline__ float dpp_xor2(float v) { return __int_as_float(__builtin_amdgcn_mov_dpp(__float_as_int(v), 0x4E, 0xF, 0xF, true)); }
__device__ __forceinline__ float dpp_hmir(float v) { return __int_as_float(__builtin_amdgcn_mov_dpp(__float_as_int(v), 0x141, 0xF, 0xF, true)); }
__device__ __forceinline__ float dpp_mir(float v) { return __int_as_float(__builtin_amdgcn_mov_dpp(__float_as_int(v), 0x140, 0xF, 0xF, true)); }
__device__ __forceinline__ float wave_sum_fast(float v) {
    v += dpp_xor1(v); v += dpp_xor2(v); v += dpp_hmir(v); v += dpp_mir(v);
    v += __shfl_xor(v, 16); v += __shfl_xor(v, 32);
    return v;
}
__device__ __forceinline__ float fast_tanh(float x) { return 1.f - 2.f * __builtin_amdgcn_rcpf(1.f + __expf(2.f * x)); }
__device__ __forceinline__ float fast_sigmoid(float x) { return __builtin_amdgcn_rcpf(1.f + __expf(-x)); }
typedef float f32x2 __attribute__((ext_vector_type(2)));
#define MFMA16(a, b, c) __builtin_amdgcn_mfma_f32_16x16x32_bf16((a), (b), (c), 0, 0, 0)
__device__ __forceinline__ bf16x8 join8(s16x4 lo, s16x4 hi) { return __builtin_shufflevector(lo, hi, 0, 1, 2, 3, 4, 5, 6, 7); }
__device__ __forceinline__ bf16x8 pack8(f32x4 a, f32x4 b) {
    u32x4 w; w.x = pk2(a[0], a[1]); w.y = pk2(a[2], a[3]); w.z = pk2(b[0], b[1]); w.w = pk2(b[2], b[3]);
    return __builtin_bit_cast(bf16x8, w);
}

__device__ __forceinline__ void transpose_tile(const float* __restrict__ W, int K, int N, bf16_t* __restrict__ WT, float* tile, int it) {
    const int tid = opaque_tid();
    const int ntn = N >> 6; const int kb = it / ntn, nbk = it - kb * ntn; const int k0 = kb * 64, n0 = nbk * 64;
#pragma unroll
    for (int rr = 0; rr < 2; ++rr) { const int idx = tid + rr * 512; const int kk = idx >> 4, n4 = (idx & 15) * 4;
        const float4 v = *(const float4*)(W + (size_t)(k0 + kk) * N + n0 + n4);
        float* tp = tile + kk * 65 + n4; tp[0] = v.x; tp[1] = v.y; tp[2] = v.z; tp[3] = v.w; }
    __syncthreads();
    { const int n = tid >> 3, kc = (tid & 7) * 8; const float* tp = tile + kc * 65 + n;
      u32x4 o; o.x = pk2(tp[0], tp[65]); o.y = pk2(tp[2 * 65], tp[3 * 65]); o.z = pk2(tp[4 * 65], tp[5 * 65]); o.w = pk2(tp[6 * 65], tp[7 * 65]);
      *(u32x4*)(WT + (size_t)(n0 + n) * K + k0 + kc) = o; }
    __syncthreads();
}
__device__ __forceinline__ void convert_weights(const Params& P, int layer, unsigned char* smem) {
    float* tile = (float*)smem;
    const float* win = P.in[4] + (size_t)layer * D * PW; const float* wout = P.in[5] + (size_t)layer * MIXW * D;
    bf16_t* WinT = (bf16_t*)(P.ws + OFF_WIN); bf16_t* WoutT = (bf16_t*)(P.ws + OFF_WOUT);
    constexpr int T_IN = (D / 64) * (PW / 64), T_OUT = (MIXW / 64) * (D / 64);
    for (int it = opaque_bid(); it < T_IN + T_OUT; it += gridDim.x) {
        if (it < T_IN) transpose_tile(win, D, PW, WinT, tile, it);
        else transpose_tile(wout, MIXW, D, WoutT, tile, it - T_IN);
    }
}
__device__ __forceinline__ void prenorm_rows(const float* __restrict__ x, const float* __restrict__ g, bf16_t* __restrict__ U) {
    const int tid_ = opaque_tid(); const int lane = tid_ & 63, gw = opaque_bid() * 8 + (tid_ >> 6), ngw = gridDim.x * 8;
    for (int row = gw; row < M; row += ngw) {
        const float4* xr = (const float4*)(x + (size_t)row * D) + lane;
        float4 v[8]; float ss = 0.f;
#pragma unroll
        for (int j = 0; j < 8; ++j) { v[j] = xr[64 * j]; ss += v[j].x * v[j].x + v[j].y * v[j].y + v[j].z * v[j].z + v[j].w * v[j].w; }
        const float rstd = rsqrtf(wave_sum(ss) * (1.f / D) + 1e-6f);
        u32x2* o = (u32x2*)(U + (size_t)row * D) + lane;
#pragma unroll
        for (int j = 0; j < 8; ++j) { const float4 gg = ((const float4*)g)[64 * j + lane];
            u32x2 w; w.x = pk2(v[j].x * rstd * gg.x, v[j].y * rstd * gg.y); w.y = pk2(v[j].z * rstd * gg.z, v[j].w * rstd * gg.w); o[64 * j] = w; }
    }
}
__device__ __forceinline__ void postnorm_rows(const bf16_t* __restrict__ y, const float* xin, float* xout, const float* __restrict__ gpost, const float* __restrict__ gpre, bf16_t* __restrict__ U) {
    const int tid_ = opaque_tid(); const int lane = tid_ & 63, gw = opaque_bid() * 8 + (tid_ >> 6), ngw = gridDim.x * 8;
    for (int row = gw; row < M; row += ngw) {
        const u32x2* yr = (const u32x2*)(y + (size_t)row * D) + lane;
        const float4* xr = (const float4*)(xin + (size_t)row * D) + lane;
        float4* xo = (float4*)(xout + (size_t)row * D) + lane;
        float4 v[8]; float ss = 0.f;
#pragma unroll
        for (int j = 0; j < 8; ++j) { const u32x2 w = yr[64 * j]; v[j].x = __uint_as_float(w.x << 16); v[j].y = __uint_as_float(w.x & 0xFFFF0000u); v[j].z = __uint_as_float(w.y << 16); v[j].w = __uint_as_float(w.y & 0xFFFF0000u);
            ss += v[j].x * v[j].x + v[j].y * v[j].y + v[j].z * v[j].z + v[j].w * v[j].w; }
        const float rstd = rsqrtf(wave_sum(ss) * (1.f / D) + 1e-6f);
        float s2 = 0.f;
#pragma unroll
        for (int j = 0; j < 8; ++j) { const float4 gg = ((const float4*)gpost)[64 * j + lane]; const float4 xv = xr[64 * j];
            v[j].x = xv.x + v[j].x * rstd * gg.x; v[j].y = xv.y + v[j].y * rstd * gg.y; v[j].z = xv.z + v[j].z * rstd * gg.z; v[j].w = xv.w + v[j].w * rstd * gg.w;
            xo[64 * j] = v[j]; s2 += v[j].x * v[j].x + v[j].y * v[j].y + v[j].z * v[j].z + v[j].w * v[j].w; }
        if (gpre) {
            const float r2 = rsqrtf(wave_sum(s2) * (1.f / D) + 1e-6f);
            u32x2* o = (u32x2*)(U + (size_t)row * D) + lane;
#pragma unroll
            for (int j = 0; j < 8; ++j) { const float4 gg = ((const float4*)gpre)[64 * j + lane];
                u32x2 w; w.x = pk2(v[j].x * r2 * gg.x, v[j].y * r2 * gg.y); w.y = pk2(v[j].z * r2 * gg.z, v[j].w * r2 * gg.w); o[64 * j] = w; }
        }
    }
}

#define RWKV_LOAD_RAW(cc) do { const int n0_ = (cc) * TCH + pw * TPW; const int T0_ = d ? (S - 1 - n0_) : n0_; const int dstep_ = d ? -1 : 1; \
    _Pragma("unroll") for (int j = 0; j < TPW + 2; ++j) { const int tj = T0_ + (j - 1) * dstep_; const bool ok = (tj >= 0) && (tj < S); \
        const bf16_t* row = proj + ((size_t)b * S + (ok ? tj : T0_)) * PW + C_B; \
        raw[j][0] = row[cr]; raw[j][1] = row[ck]; raw[j][2] = row[cv]; raw[j][3] = row[cw]; raw[j][4] = row[ca]; \
        if (!ok) { raw[j][0] = 0; raw[j][1] = 0; raw[j][2] = 0; raw[j][3] = 0; raw[j][4] = 0; } } } while (0)
__device__ __forceinline__ void rwkv_phase(const Params& P, int layer, unsigned char* smem) {
    constexpr int TCH = 16, TPW = 4, NCH = S / TCH;
    float* VEC = (float*)smem;
    bf16_t* UPT = (bf16_t*)(smem + 49152);
    unsigned char* pbase = smem + 49152 + 18432;
    unsigned char* obase = smem + 49152 + 18432 + 12800;
    unsigned char* nbase = obase + 2 * 18176;
    const int tid = opaque_tid(), wid = __builtin_amdgcn_readfirstlane(tid >> 6), lane = tid & 63, r16 = lane & 15, quad = lane >> 4;
    const bf16_t* proj = (const bf16_t*)(P.ws + OFF_PROJ);
    bf16_t* YB = (bf16_t*)(P.ws + OFF_YB);
    float* BON = (float*)(P.ws + OFF_BON);
    const float* mu = P.in[11] + (size_t)layer * 2 * 3328;
    for (int chain = opaque_bid(); chain < 256; chain += gridDim.x) {
        const int d = chain >> 7, b = (chain >> 4) & 7, h = chain & 15;
        __syncthreads();
        { const float* wup = P.in[13] + ((size_t)(layer * 2 + d) * 64) * 1024 + h * 64; const float* aup = P.in[15] + ((size_t)(layer * 2 + d) * 64) * 1024 + h * 64;
#pragma unroll
          for (int it = 0; it < 16; ++it) { const int e = tid + 512 * it; const int mat = e >> 12, lora = (e >> 6) & 63, ch = e & 63;
              const float v = (mat ? aup : wup)[(size_t)lora * 1024 + ch]; UPT[mat * 4608 + ch * 72 + lora] = f2bf(v); } }
        __syncthreads();
        if (wid < 4) {
            const int cw = wid;
            float* Nm = (float*)(nbase + cw * 1024);
            const int jl = lane & 15, tg = lane >> 4, jcol = cw * 16 + jl;
            const float rkc = P.in[18][(size_t)layer * 1024 + h * 64 + jcol];
            const f32x4 z4 = {0.f, 0.f, 0.f, 0.f};
            f32x4 ST[4];
#pragma unroll
            for (int mt = 0; mt < 4; ++mt) ST[mt] = z4;
            asm volatile("s_waitcnt lgkmcnt(0)" ::: "memory"); __builtin_amdgcn_s_barrier(); asm volatile("" ::: "memory");
            asm volatile("s_waitcnt lgkmcnt(0)" ::: "memory"); __builtin_amdgcn_s_barrier(); asm volatile("" ::: "memory");
            for (int c = 0; c < NCH; ++c) {
                const float* vb = VEC + (c & 1) * (TCH * 384);
                unsigned char* ob = obase + (c & 1) * 18176;
                bf16_t* Pm = (bf16_t*)ob; bf16_t* Rm = (bf16_t*)(ob + 2304); bf16_t* Qm = (bf16_t*)(ob + 4608); bf16_t* Mm = (bf16_t*)(ob + 6912);
                bf16_t* QT = (bf16_t*)(ob + 9216); bf16_t* MT = (bf16_t*)(ob + 12288); float* GT = (float*)(ob + 15360); bf16_t* Bm = (bf16_t*)(ob + 15872);
                {
                    float nk[4], ww[4], ka[4], km[4], rr[4];
#pragma unroll
                    for (int u = 0; u < 4; ++u) { const float* vt = vb + (4 * tg + u) * 384 + jcol; nk[u] = vt[0]; ww[u] = vt[64]; ka[u] = vt[128]; km[u] = vt[192]; rr[u] = vt[256]; }
                    float gl[4];
                    gl[0] = ww[0]; gl[1] = gl[0] * ww[1]; gl[2] = gl[1] * ww[2]; gl[3] = gl[2] * ww[3];
                    const float G0 = __shfl(gl[3], jl), G1 = __shfl(gl[3], jl + 16), G2 = __shfl(gl[3], jl + 32);
                    const float pre = (tg == 0) ? 1.f : (tg == 1) ? G0 : (tg == 2) ? G0 * G1 : (G0 * G1) * G2;
                    float pv[4], rv[4], qv[4], mv[4];
#pragma unroll
                    for (int u = 0; u < 4; ++u) {
                        const float gprev = (u == 0) ? pre : pre * gl[u - 1], gcur = pre * gl[u];
                        const float ig = __builtin_amdgcn_rcpf(gcur);
                        pv[u] = gprev * nk[u]; qv[u] = ka[u] * ig; mv[u] = km[u] * ig; rv[u] = gcur * rr[u];
                    }
                    const unsigned wp0 = pk2(pv[0], pv[1]), wp1 = pk2(pv[2], pv[3]), wr0 = pk2(rv[0], rv[1]), wr1 = pk2(rv[2], rv[3]);
                    const unsigned wq0 = pk2(qv[0], qv[1]), wq1 = pk2(qv[2], qv[3]), wm0 = pk2(mv[0], mv[1]), wm1 = pk2(mv[2], mv[3]);
                    const int t0 = 4 * tg;
                    Pm[(t0) * 72 + jcol] = (bf16_t)(wp0 & 0xFFFFu); Pm[(t0 + 1) * 72 + jcol] = (bf16_t)(wp0 >> 16); Pm[(t0 + 2) * 72 + jcol] = (bf16_t)(wp1 & 0xFFFFu); Pm[(t0 + 3) * 72 + jcol] = (bf16_t)(wp1 >> 16);
                    Rm[(t0) * 72 + jcol] = (bf16_t)(wr0 & 0xFFFFu); Rm[(t0 + 1) * 72 + jcol] = (bf16_t)(wr0 >> 16); Rm[(t0 + 2) * 72 + jcol] = (bf16_t)(wr1 & 0xFFFFu); Rm[(t0 + 3) * 72 + jcol] = (bf16_t)(wr1 >> 16);
                    Qm[(t0) * 72 + jcol] = (bf16_t)(wq0 & 0xFFFFu); Qm[(t0 + 1) * 72 + jcol] = (bf16_t)(wq0 >> 16); Qm[(t0 + 2) * 72 + jcol] = (bf16_t)(wq1 & 0xFFFFu); Qm[(t0 + 3) * 72 + jcol] = (bf16_t)(wq1 >> 16);
                    Mm[(t0) * 72 + jcol] = (bf16_t)(wm0 & 0xFFFFu); Mm[(t0 + 1) * 72 + jcol] = (bf16_t)(wm0 >> 16); Mm[(t0 + 2) * 72 + jcol] = (bf16_t)(wm1 & 0xFFFFu); Mm[(t0 + 3) * 72 + jcol] = (bf16_t)(wm1 >> 16);
                    u32x2 tq; tq.x = wq0; tq.y = wq1; *(u32x2*)(QT + jcol * 24 + t0) = tq;
                    u32x2 tm; tm.x = wm0; tm.y = wm1; *(u32x2*)(MT + jcol * 24 + t0) = tm;
                    { const unsigned wb0 = pk2(rv[0] * rkc, rv[1] * rkc), wb1 = pk2(rv[2] * rkc, rv[3] * rkc);
                      Bm[(t0) * 72 + jcol] = (bf16_t)(wb0 & 0xFFFFu); Bm[(t0 + 1) * 72 + jcol] = (bf16_t)(wb0 >> 16); Bm[(t0 + 2) * 72 + jcol] = (bf16_t)(wb1 & 0xFFFFu); Bm[(t0 + 3) * 72 + jcol] = (bf16_t)(wb1 >> 16); }
                    if (tg == 3) GT[jcol] = pre * gl[3];
                }
                asm volatile("s_waitcnt lgkmcnt(0)" ::: "memory"); __builtin_amdgcn_s_barrier(); asm volatile("" ::: "memory");
                f32x4 Gqp = z4, Gmp = z4, Gqr = z4, Gmr = z4, Npq = z4;
#pragma unroll
                for (int ks = 0; ks < 2; ++ks) {
                    const bf16x8 aQ = *(const bf16x8*)(Qm + r16 * 72 + ks * 32 + quad * 8), aM = *(const bf16x8*)(Mm + r16 * 72 + ks * 32 + quad * 8);
                    const bf16x8 bP = *(const bf16x8*)(Pm + r16 * 72 + ks * 32 + quad * 8), bR = *(const bf16x8*)(Rm + r16 * 72 + ks * 32 + quad * 8);
                    Gqp = MFMA16(aQ, bP, Gqp); Gmp = MFMA16(aM, bP, Gmp); Gqr = MFMA16(aQ, bR, Gqr); Gmr = MFMA16(aM, bR, Gmr); Npq = MFMA16(bP, aQ, Npq);
                }
                if (cw == 0) {
                    f32x4 Gmb = z4;
#pragma unroll
                    for (int ks = 0; ks < 2; ++ks) Gmb = MFMA16(*(const bf16x8*)(Mm + r16 * 72 + ks * 32 + quad * 8), *(const bf16x8*)(Bm + r16 * 72 + ks * 32 + quad * 8), Gmb);
                    if (quad == (r16 >> 2)) {
                        const int rsel = r16 & 3;
                        const float bon = (rsel == 0) ? Gmb[0] : (rsel == 1) ? Gmb[1] : (rsel == 2) ? Gmb[2] : Gmb[3];
                        const int n = c * TCH + r16; const int t = d ? (S - 1 - n) : n;
                        BON[(((size_t)d * NB + b) * 16 + h) * S + t] = bon;
                    }
                }
#pragma unroll
                for (int rg = 0; rg < 4; ++rg) { const int sI = quad * 4 + rg;
                    if (sI >= r16) { Gqp[rg] = 0.f; Gmp[rg] = 0.f; }
                    if (sI > r16) { Gqr[rg] = 0.f; Gmr[rg] = 0.f; }
                    if (sI <= r16) Npq[rg] = 0.f; }
                f32x4 SA0 = z4, Y0 = z4;
#pragma unroll
                for (int ks = 0; ks < 2; ++ks) {
                    const bf16x8 sb = pack8(ST[2 * ks], ST[2 * ks + 1]);
                    const bf16_t* pp = Pm + r16 * 72 + ks * 32 + quad * 4; const bf16_t* rp = Rm + r16 * 72 + ks * 32 + quad * 4;
                    const bf16x8 pa = join8(*(const s16x4*)pp, *(const s16x4*)(pp + 16)), ra = join8(*(const s16x4*)rp, *(const s16x4*)(rp + 16));
                    SA0 = MFMA16(pa, sb, SA0); Y0 = MFMA16(ra, sb, Y0);
                }
                f32x4 Vv;
#pragma unroll
                for (int jj = 0; jj < 4; ++jj) Vv[jj] = vb[(quad * 4 + jj) * 384 + 320 + cw * 16 + r16];
                const f32x4 Cc = MFMA16(pack8(Gmp, z4), pack8(Vv, z4), SA0);
                const bf16x8 m1 = pack8(Gqp, z4), n1 = pack8(Npq, z4);
                const f32x4 Mc2 = MFMA16(n1, m1, z4), Nc2 = MFMA16(m1, n1, z4);
                const bf16x8 m2 = pack8(Mc2, z4), n2 = pack8(Nc2, z4);
                const f32x4 Mc4 = MFMA16(n2, m2, z4), Nc4 = MFMA16(m2, n2, z4);
                const bf16x8 m4 = pack8(Mc4, z4), n4 = pack8(Nc4, z4);
                const f32x4 Mc8 = MFMA16(n4, m4, z4);
                f32x4 SAc = MFMA16(pack8(Mc8, z4), pack8(Cc, z4), Cc);
                SAc = MFMA16(m4, pack8(SAc, z4), SAc);
                SAc = MFMA16(m2, pack8(SAc, z4), SAc);
                SAc = MFMA16(m1, pack8(SAc, z4), SAc);
                const bf16x8 Bsv = pack8(SAc, Vv);
                const f32x4 Yc = MFMA16(pack8(Gqr, Gmr), Bsv, Y0);
#pragma unroll
                for (int rg = 0; rg < 4; ++rg) { const int n = c * TCH + quad * 4 + rg; const int t = d ? (S - 1 - n) : n;
                    YB[((size_t)d * M + (size_t)b * S + t) * 1024 + h * 64 + cw * 16 + r16] = f2bf(Yc[rg]); }
#pragma unroll
                for (int mt = 0; mt < 4; ++mt) {
                    const bf16_t* qp = QT + (mt * 16 + r16) * 24 + quad * 4; const bf16_t* mp = MT + (mt * 16 + r16) * 24 + quad * 4;
                    const f32x4 acc = MFMA16(join8(*(const s16x4*)qp, *(const s16x4*)mp), Bsv, ST[mt]);
                    const f32x4 gt = *(const f32x4*)(GT + mt * 16 + quad * 4);
                    ST[mt] = acc * gt;
                }
                asm volatile("s_waitcnt lgkmcnt(0)" ::: "memory"); __builtin_amdgcn_s_barrier(); asm volatile("" ::: "memory");
            }
        } else {
            const int pw = wid - 4;
            bf16_t* Aw = (bf16_t*)(pbase + pw * 3200); bf16_t* Aa = Aw + TPW * 72; float* X = (float*)(pbase + pw * 3200 + 1152);
            const int cr = h * 64 + lane, ck = 1024 + h * 64 + lane, cv = 2048 + h * 64 + lane, cw = 3072 + d * 64 + lane, ca = 3200 + d * 64 + lane;
            const int mo0 = d ? 3328 : 0, mo1 = d ? 0 : 3328;
            const float mr0 = mu[mo0 + cr], mr1 = mu[mo1 + cr], mk0 = mu[mo0 + ck], mk1 = mu[mo1 + ck], mv0 = mu[mo0 + cv], mv1 = mu[mo1 + cv];
            const float mw0 = mu[mo0 + cw], mw1 = mu[mo1 + cw], ma0 = mu[mo0 + ca], ma1 = mu[mo1 + ca];
            const int chn = h * 64 + lane;
            const float w0v = P.in[12][(size_t)(layer * 2 + d) * 1024 + chn], a0v = P.in[14][(size_t)(layer * 2 + d) * 1024 + chn];
            const float kkw = P.in[16][(size_t)layer * 1024 + chn], kaw = P.in[17][(size_t)layer * 1024 + chn], rkw = P.in[18][(size_t)layer * 1024 + chn];
            unsigned short raw[TPW + 2][5];
            RWKV_LOAD_RAW(0);
            for (int c = 0; c < NCH + 1; ++c) {
                if (c < NCH) {
                    float* vb = VEC + (c & 1) * (TCH * 384);
                    float rr[TPW], kv[TPW], vv[TPW], kk[TPW];
                    {
                        float fr[TPW + 2][5];
#pragma unroll
                        for (int j = 0; j < TPW + 2; ++j)
#pragma unroll
                            for (int st = 0; st < 5; ++st) fr[j][st] = bf2f(raw[j][st]);
                        if (c + 1 < NCH) { RWKV_LOAD_RAW(c + 1); }
#pragma unroll
                        for (int i = 0; i < TPW; ++i) {
                            float p0, pa, pb;
                            p0 = fr[i + 1][0]; pa = fr[i][0]; pb = fr[i + 2][0]; rr[i] = p0 + mr0 * (pa - p0) + mr1 * (pb - p0);
                            p0 = fr[i + 1][1]; pa = fr[i][1]; pb = fr[i + 2][1]; kv[i] = p0 + mk0 * (pa - p0) + mk1 * (pb - p0);
                            p0 = fr[i + 1][2]; pa = fr[i][2]; pb = fr[i + 2][2]; vv[i] = p0 + mv0 * (pa - p0) + mv1 * (pb - p0);
                            p0 = fr[i + 1][3]; pa = fr[i][3]; pb = fr[i + 2][3]; const float wd = p0 + mw0 * (pa - p0) + mw1 * (pb - p0);
                            p0 = fr[i + 1][4]; pa = fr[i][4]; pb = fr[i + 2][4]; const float ad = p0 + ma0 * (pa - p0) + ma1 * (pb - p0);
                            Aw[i * 72 + lane] = f2bf(fast_tanh(wd)); Aa[i * 72 + lane] = f2bf(ad);
                            const float k2 = kv[i] * kkw; const float n2 = wave_sum_fast(k2 * k2);
                            kk[i] = k2 * __builtin_amdgcn_rsqf(fmaxf(n2, 1e-24f));
                        }
                    }
                    asm volatile("s_waitcnt lgkmcnt(0)" ::: "memory"); __builtin_amdgcn_s_barrier(); asm volatile("" ::: "memory");
#pragma unroll
                    for (int mat = 0; mat < 2; ++mat) {
                        const bf16_t* A = mat ? Aa : Aw;
                        const bf16x8 a0f = *(const bf16x8*)(A + (r16 & (TPW - 1)) * 72 + quad * 8), a1f = *(const bf16x8*)(A + (r16 & (TPW - 1)) * 72 + 32 + quad * 8);
#pragma unroll
                        for (int nt = 0; nt < 4; ++nt) {
                            const bf16_t* B = UPT + mat * 4608 + (nt * 16 + r16) * 72 + quad * 8;
                            f32x4 acc = {0.f, 0.f, 0.f, 0.f};
                            acc = MFMA16(a0f, *(const bf16x8*)B, acc); acc = MFMA16(a1f, *(const bf16x8*)(B + 32), acc);
                            if (quad == 0) {
#pragma unroll
                                for (int rg = 0; rg < 4; ++rg) X[mat * 256 + rg * 64 + nt * 16 + r16] = acc[rg];
                            }
                        }
                    }
                    asm volatile("s_waitcnt lgkmcnt(0)" ::: "memory");
#pragma unroll
                    for (int i = 0; i < TPW; ++i) {
                        const int s = pw * TPW + i; const int n = c * TCH + s; const int t = d ? (S - 1 - n) : n;
                        const float xw = X[i * 64 + lane] + w0v, xa = X[256 + i * 64 + lane] + a0v;
                        const float dec = __expf(-0.6065306597126334f * fast_sigmoid(xw)); const float av = fast_sigmoid(xa);
                        const float kmod = kv[i] * (1.f + (av - 1.f) * kaw); const float kka = kk[i] * av;
                        float* o = vb + s * 384 + lane;
                        o[0] = -kk[i]; o[64] = dec; o[128] = kka; o[192] = kmod; o[256] = rr[i]; o[320] = vv[i];
                    }
                }
                if (c == NCH) { asm volatile("s_waitcnt lgkmcnt(0)" ::: "memory"); __builtin_amdgcn_s_barrier(); asm volatile("" ::: "memory"); }
                asm volatile("s_waitcnt lgkmcnt(0)" ::: "memory"); __builtin_amdgcn_s_barrier(); asm volatile("" ::: "memory");
            }
        }
    }
}

__device__ __forceinline__ int swz40(int row, int s) { return row * 40 + ((((s >> 3) ^ (row >> 3)) & 3) << 3) + (s & 7); }
__device__ __forceinline__ void hgrn_phase(const Params& P, int layer, unsigned char* smem) {
    bf16_t* QE = (bf16_t*)smem; bf16_t* KE = (bf16_t*)(smem + 8704); bf16_t* KLT = (bf16_t*)(smem + 17408); bf16_t* VT = (bf16_t*)(smem + 27648);
    float* LF = (float*)(smem + 37888); float* EL = (float*)(smem + 54272);
    const int tid = opaque_tid(), wid = __builtin_amdgcn_readfirstlane(tid >> 6), lane = tid & 63, r16 = lane & 15, quad = lane >> 4;
    const bf16_t* proj = (const bf16_t*)(P.ws + OFF_PROJ);
    bf16_t* OC = (bf16_t*)(P.ws + OFF_OC);
    const int es = tid >> 4, ekc = (tid & 15) * 8;
    for (int chain = opaque_bid(); chain < 128; chain += gridDim.x) {
        const int d = chain >> 6, b = (chain >> 3) & 7, h = chain & 7;
        float lb[8];
#pragma unroll
        for (int j = 0; j < 8; ++j) lb[j] = 0.f;
        if (layer > 0) {
#pragma unroll
            for (int j = 0; j < 8; ++j) { const float l0 = P.in[21][(size_t)(d * 2 + 0) * 1024 + h * 128 + ekc + j], l1 = P.in[21][(size_t)(d * 2 + 1) * 1024 + h * 128 + ekc + j]; lb[j] = 1.f / (1.f + __expf(l0 - l1)); }
        }
        f32x4 Sacc[8];
#pragma unroll
        for (int mt = 0; mt < 8; ++mt) Sacc[mt] = (f32x4){0.f, 0.f, 0.f, 0.f};
        u32x4 zraw, qraw, vraw;
        { const int t = d ? (S - 1 - es) : es; const bf16_t* row = proj + ((size_t)b * S + t) * PW + h * 128 + ekc;
          zraw = *(const u32x4*)(row + C_CF + d * 1024); qraw = *(const u32x4*)(row + C_CQ); vraw = *(const u32x4*)(row + C_CI); }
        for (int c = 0; c < 64; ++c) {
            __syncthreads();
            { const int n = c * 32 + es; const int t = d ? (S - 1 - n) : n; const bf16_t* row = proj + ((size_t)b * S + t) * PW + h * 128 + ekc;
              zraw = *(const u32x4*)(row + C_CF + d * 1024); qraw = *(const u32x4*)(row + C_CQ); vraw = *(const u32x4*)(row + C_CI); }
            float kval[8];
            {
                float lf[8];
#pragma unroll
                for (int j = 0; j < 8; ++j) {
                    const unsigned wv = zraw[j >> 1]; const float z = (j & 1) ? __uint_as_float(wv & 0xFFFF0000u) : __uint_as_float(wv << 16);
                    const float e = __expf(-fabsf(z));
                    const float ls = fminf(z, 0.f) - __logf(1.f + e);
                    const float sg = (z >= 0.f ? 1.f : e) * __builtin_amdgcn_rcpf(1.f + e);
                    lf[j] = (lb[j] > 0.f) ? __logf(lb[j] + (1.f - lb[j]) * sg) : ls;
                    kval[j] = (1.f - lb[j]) * (1.f - sg);
                }
                *(f32x4*)(LF + es * 128 + ekc) = (f32x4){lf[0], lf[1], lf[2], lf[3]}; *(f32x4*)(LF + es * 128 + ekc + 4) = (f32x4){lf[4], lf[5], lf[6], lf[7]};
#pragma unroll
                for (int j = 0; j < 8; ++j) { const unsigned wv = vraw[j >> 1]; VT[swz40(ekc + j, es)] = (bf16_t)((j & 1) ? (wv >> 16) : (wv & 0xFFFFu)); }
            }
            __syncthreads();
            if (tid < 128) {
                float cum = 0.f;
#pragma unroll
                for (int s = 0; s < 32; ++s) { cum += LF[s * 128 + tid]; LF[s * 128 + tid] = cum; }
                EL[tid] = __expf(cum);
            }
            __syncthreads();
            {
                const f32x4 c0 = *(const f32x4*)(LF + es * 128 + ekc), c1v = *(const f32x4*)(LF + es * 128 + ekc + 4);
                const f32x4 l0 = *(const f32x4*)(LF + 31 * 128 + ekc), l1 = *(const f32x4*)(LF + 31 * 128 + ekc + 4);
                float qe[8], ke[8];
#pragma unroll
                for (int j = 0; j < 8; ++j) {
                    const unsigned wv = qraw[j >> 1]; const float qv = (j & 1) ? __uint_as_float(wv & 0xFFFF0000u) : __uint_as_float(wv << 16);
                    const float cum = (j < 4) ? c0[j & 3] : c1v[j & 3], last = (j < 4) ? l0[j & 3] : l1[j & 3];
                    qe[j] = qv * __expf(cum); ke[j] = kval[j] * __expf(-cum);
                    KLT[swz40(ekc + j, es)] = f2bf(kval[j] * __expf(last - cum));
                }
                u32x4 w; w.x = pk2(qe[0], qe[1]); w.y = pk2(qe[2], qe[3]); w.z = pk2(qe[4], qe[5]); w.w = pk2(qe[6], qe[7]); *(u32x4*)(QE + es * 136 + ekc) = w;
                w.x = pk2(ke[0], ke[1]); w.y = pk2(ke[2], ke[3]); w.z = pk2(ke[4], ke[5]); w.w = pk2(ke[6], ke[7]); *(u32x4*)(KE + es * 136 + ekc) = w;
            }
            if (false) { const int n = (c + 1) * 32 + es; const int t = d ? (S - 1 - n) : n; const bf16_t* row = proj + ((size_t)b * S + t) * PW + h * 128 + ekc;
                zraw = *(const u32x4*)(row + C_CF + d * 1024); qraw = *(const u32x4*)(row + C_CQ); vraw = *(const u32x4*)(row + C_CI); }
            __syncthreads();
            f32x4 sc00 = {0.f, 0.f, 0.f, 0.f}, sc01 = sc00, sc11 = sc00;
#pragma unroll
            for (int ks = 0; ks < 4; ++ks) {
                const bf16x8 ke0 = *(const bf16x8*)(KE + r16 * 136 + ks * 32 + quad * 8), ke1 = *(const bf16x8*)(KE + (16 + r16) * 136 + ks * 32 + quad * 8);
                const bf16x8 qe0 = *(const bf16x8*)(QE + r16 * 136 + ks * 32 + quad * 8), qe1 = *(const bf16x8*)(QE + (16 + r16) * 136 + ks * 32 + quad * 8);
                sc00 = MFMA16(ke0, qe0, sc00); sc01 = MFMA16(ke0, qe1, sc01); sc11 = MFMA16(ke1, qe1, sc11);
            }
#pragma unroll
            for (int rg = 0; rg < 4; ++rg) { if (quad * 4 + rg > r16) { sc00[rg] = 0.f; sc11[rg] = 0.f; } }
            const f32x4 zero4 = {0.f, 0.f, 0.f, 0.f};
            const bf16x8 p0 = pack8(sc00, zero4), p1 = pack8(sc01, sc11);
            const int vrow_i = wid * 16 + r16;
            const bf16x8 vperm = join8(*(const s16x4*)(VT + swz40(vrow_i, quad * 4)), *(const s16x4*)(VT + swz40(vrow_i, 16 + quad * 4)));
            f32x4 o0 = MFMA16(p0, vperm, zero4), o1 = MFMA16(p1, vperm, zero4);
#pragma unroll
            for (int ks = 0; ks < 4; ++ks) {
                const bf16x8 sb = pack8(Sacc[2 * ks], Sacc[2 * ks + 1]);
                const bf16_t* q0p = QE + r16 * 136 + ks * 32 + quad * 4; const bf16_t* q1p = QE + (16 + r16) * 136 + ks * 32 + quad * 4;
                const bf16x8 qa0 = join8(*(const s16x4*)q0p, *(const s16x4*)(q0p + 16)), qa1 = join8(*(const s16x4*)q1p, *(const s16x4*)(q1p + 16));
                o0 = MFMA16(qa0, sb, o0); o1 = MFMA16(qa1, sb, o1);
            }
#pragma unroll
            for (int rg = 0; rg < 4; ++rg) {
                { const int n = c * 32 + quad * 4 + rg; const int t = d ? (S - 1 - n) : n; OC[((size_t)d * M + (size_t)b * S + t) * 1024 + h * 128 + wid * 16 + r16] = f2bf(o0[rg]); }
                { const int n = c * 32 + 16 + quad * 4 + rg; const int t = d ? (S - 1 - n) : n; OC[((size_t)d * M + (size_t)b * S + t) * 1024 + h * 128 + wid * 16 + r16] = f2bf(o1[rg]); }
            }
            const bf16x8 vnat = *(const bf16x8*)(VT + swz40(vrow_i, quad * 8));
#pragma unroll
            for (int mt = 0; mt < 8; ++mt) {
                const f32x4 el = *(const f32x4*)(EL + mt * 16 + quad * 4);
                f32x4 sa = Sacc[mt] * el;
                const bf16x8 kl = *(const bf16x8*)(KLT + swz40(mt * 16 + r16, quad * 8));
                Sacc[mt] = MFMA16(kl, vnat, sa);
            }
        }
    }
}

__device__ __forceinline__ void attn_phase(const Params& P, int layer, unsigned char* smem, unsigned* counter) {
    float* TAB = (float*)smem; bf16_t* KT = (bf16_t*)(smem + 16384); bf16_t* VTt = (bf16_t*)(smem + 16384 + 9216); int* sh_unit = (int*)(smem + 16384 + 9216 + 18432);
    const int tid = opaque_tid(), wid = __builtin_amdgcn_readfirstlane(tid >> 6), lane = tid & 63, r16 = lane & 15, quad = lane >> 4;
    const bf16_t* proj = (const bf16_t*)(P.ws + OFF_PROJ);
    bf16_t* AO = (bf16_t*)(P.ws + OFF_AO);
    const float* rel_bias = P.in[1];
    const float c1 = 0.125f * LOG2E;
    const int xcd = opaque_bid() & 7;
    for (;;) {
        __syncthreads();
        if (tid == 0) *sh_unit = (int)atomicAdd(counter + xcd, 1u);
        __syncthreads();
        const int li = *sh_unit;
        if (li >= 128) break;
        const int qb = li & 7, grp = (li >> 3) * 8 + xcd;
        const int m = grp & 1, h = (grp >> 1) & 7, b = grp >> 4;
        for (int e = tid; e < 4095; e += 512) { const int rel = e - 2047; const int n = rel < 0 ? -rel : rel; int bk;
            if (n < 8) bk = n; else { const int lg = 31 - __clz(n * n); bk = 2 + lg; if (bk > 15) bk = 15; }
            if (rel > 0) bk += 16; TAB[e] = rel_bias[bk * 8 + h] * LOG2E; }
        const int qrow0 = qb * 256 + wid * 32;
        bf16x8 Qf[2][2];
#pragma unroll
        for (int nq = 0; nq < 2; ++nq)
#pragma unroll
            for (int ks = 0; ks < 2; ++ks) Qf[nq][ks] = *(const bf16x8*)(proj + ((size_t)b * S + qrow0 + nq * 16 + r16) * PW + C_AQ + h * 128 + m * 64 + ks * 32 + quad * 8);
        f32x4 O[2][8];
#pragma unroll
        for (int nq = 0; nq < 2; ++nq)
#pragma unroll
            for (int dt = 0; dt < 8; ++dt) O[nq][dt] = (f32x4){0.f, 0.f, 0.f, 0.f};
        float mrun[2] = {-1e30f, -1e30f}, lrun[2] = {0.f, 0.f};
        const int kkey = tid >> 3, kchunk = tid & 7;
        const int vkp = tid & 31, vchunk = tid >> 5;
        const bf16_t* kbase = proj + ((size_t)b * S + kkey) * PW + C_AK + h * 128 + m * 64 + kchunk * 8;
        const bf16_t* vbase = proj + ((size_t)b * S + 2 * vkp) * PW + C_AV + h * 128 + vchunk * 8;
        u32x4 kreg = *(const u32x4*)kbase, vreg0 = *(const u32x4*)vbase, vreg1 = *(const u32x4*)(vbase + PW);
        for (int kt = 0; kt < 32; ++kt) {
            __syncthreads();
            *(u32x4*)(KT + kkey * 72 + kchunk * 8) = kreg;
            { unsigned* vd = (unsigned*)(VTt + (vchunk * 8) * 72 + 2 * vkp);
#pragma unroll
              for (int i2 = 0; i2 < 4; ++i2) { const unsigned a = vreg0[i2], bq = vreg1[i2];
                  vd[(2 * i2) * 36] = (a & 0xFFFFu) | (bq << 16); vd[(2 * i2 + 1) * 36] = (a >> 16) | (bq & 0xFFFF0000u); } }
            __syncthreads();
            if (kt + 1 < 32) { const size_t adv = (size_t)(kt + 1) * 64 * PW; kreg = *(const u32x4*)(kbase + adv); vreg0 = *(const u32x4*)(vbase + adv); vreg1 = *(const u32x4*)(vbase + adv + PW); }
            const int k0 = kt * 64;
            f32x4 st[2][4];
#pragma unroll
            for (int mt = 0; mt < 4; ++mt) {
                const bf16x8 ka = *(const bf16x8*)(KT + (mt * 16 + r16) * 72 + quad * 8), kb2 = *(const bf16x8*)(KT + (mt * 16 + r16) * 72 + 32 + quad * 8);
#pragma unroll
                for (int nq = 0; nq < 2; ++nq) { f32x4 a = {0.f, 0.f, 0.f, 0.f}; a = MFMA16(ka, Qf[nq][0], a); a = MFMA16(kb2, Qf[nq][1], a); st[nq][mt] = a; }
            }
            const bool posfar = (k0 - (qrow0 + 31)) >= 96, negfar = (qrow0 - (k0 + 63)) >= 96;
            if (posfar || negfar) {
                const float cb = posfar ? TAB[2047 + 128] : TAB[2047 - 128];
#pragma unroll
                for (int nq = 0; nq < 2; ++nq)
#pragma unroll
                    for (int mt = 0; mt < 4; ++mt) st[nq][mt] = st[nq][mt] * c1 + cb;
            } else {
#pragma unroll
                for (int nq = 0; nq < 2; ++nq)
#pragma unroll
                    for (int mt = 0; mt < 4; ++mt) { const float* tp = TAB + (k0 + mt * 16 + quad * 4) - (qrow0 + nq * 16 + r16) + 2047;
#pragma unroll
                        for (int rg = 0; rg < 4; ++rg) st[nq][mt][rg] = st[nq][mt][rg] * c1 + tp[rg]; }
            }
            bf16x8 pf[2][2];
#pragma unroll
            for (int nq = 0; nq < 2; ++nq) {
                float mx = st[nq][0][0];
#pragma unroll
                for (int mt = 0; mt < 4; ++mt)
#pragma unroll
                    for (int rg = 0; rg < 4; ++rg) mx = fmaxf(mx, st[nq][mt][rg]);
                mx = fmaxf(mx, __shfl_xor(mx, 16)); mx = fmaxf(mx, __shfl_xor(mx, 32));
                const float mnew = fmaxf(mrun[nq], mx); const float alpha = __builtin_amdgcn_exp2f(mrun[nq] - mnew); mrun[nq] = mnew;
                float ps = 0.f;
#pragma unroll
                for (int mt = 0; mt < 4; ++mt)
#pragma unroll
                    for (int rg = 0; rg < 4; ++rg) { const float pv = __builtin_amdgcn_exp2f(st[nq][mt][rg] - mnew); st[nq][mt][rg] = pv; ps += pv; }
                lrun[nq] = lrun[nq] * alpha + ps;
#pragma unroll
                for (int dt = 0; dt < 8; ++dt) O[nq][dt] = O[nq][dt] * alpha;
                pf[nq][0] = pack8(st[nq][0], st[nq][1]); pf[nq][1] = pack8(st[nq][2], st[nq][3]);
            }
#pragma unroll
            for (int dt = 0; dt < 8; ++dt) {
                const bf16_t* vr = VTt + (dt * 16 + r16) * 72 + quad * 4;
                const bf16x8 va0 = join8(*(const s16x4*)vr, *(const s16x4*)(vr + 16)), va1 = join8(*(const s16x4*)(vr + 32), *(const s16x4*)(vr + 48));
#pragma unroll
                for (int nq = 0; nq < 2; ++nq) { O[nq][dt] = MFMA16(va0, pf[nq][0], O[nq][dt]); O[nq][dt] = MFMA16(va1, pf[nq][1], O[nq][dt]); }
            }
        }
#pragma unroll
        for (int nq = 0; nq < 2; ++nq) {
            float l = lrun[nq]; l += __shfl_xor(l, 16); l += __shfl_xor(l, 32);
            const float inv = 1.f / l;
            bf16_t* orow = AO + ((size_t)m * M + (size_t)b * S + qrow0 + nq * 16 + r16) * 1024 + h * 128 + quad * 4;
#pragma unroll
            for (int dt = 0; dt < 8; ++dt) { u32x2 w; w.x = pk2(O[nq][dt][0] * inv, O[nq][dt][1] * inv); w.y = pk2(O[nq][dt][2] * inv, O[nq][dt][3] * inv); *(u32x2*)(orow + dt * 16) = w; }
        }
    }
}

__device__ __forceinline__ void load16(const bf16_t* p, float* o) {
    const u32x4 a = *(const u32x4*)p, b = *(const u32x4*)(p + 8);
#pragma unroll
    for (int i = 0; i < 4; ++i) { o[2 * i] = __uint_as_float(a[i] << 16); o[2 * i + 1] = __uint_as_float(a[i] & 0xFFFF0000u); o[8 + 2 * i] = __uint_as_float(b[i] << 16); o[8 + 2 * i + 1] = __uint_as_float(b[i] & 0xFFFF0000u); }
}
__device__ __forceinline__ void store16(bf16_t* p, const float* v) {
    u32x4 a, b; a.x = pk2(v[0], v[1]); a.y = pk2(v[2], v[3]); a.z = pk2(v[4], v[5]); a.w = pk2(v[6], v[7]); b.x = pk2(v[8], v[9]); b.y = pk2(v[10], v[11]); b.z = pk2(v[12], v[13]); b.w = pk2(v[14], v[15]);
    *(u32x4*)p = a; *(u32x4*)(p + 8) = b;
}
__device__ __forceinline__ void loadf16(const float* p, float* o) {
#pragma unroll
    for (int i = 0; i < 4; ++i) { const float4 v = ((const float4*)p)[i]; o[4 * i] = v.x; o[4 * i + 1] = v.y; o[4 * i + 2] = v.z; o[4 * i + 3] = v.w; }
}
__device__ __forceinline__ void finish_phase(const Params& P, int layer) {
    const int tid_ = opaque_tid(); const int lane = tid_ & 63, gw = opaque_bid() * 8 + (tid_ >> 6), ngw = gridDim.x * 8;
    const bf16_t* proj = (const bf16_t*)(P.ws + OFF_PROJ);
    const bf16_t* AO = (const bf16_t*)(P.ws + OFF_AO); const bf16_t* YB = (const bf16_t*)(P.ws + OFF_YB); const bf16_t* OC = (const bf16_t*)(P.ws + OFF_OC);
    const float* BON = (const float*)(P.ws + OFF_BON);
    bf16_t* MIX = (bf16_t*)(P.ws + OFF_MIXED);
    const float lam_init = 0.8f - 0.6f * expf(-0.3f * (float)layer);
    const float s1 = wave_sum(P.in[6][layer * 64 + lane] * P.in[7][layer * 64 + lane]), s2 = wave_sum(P.in[8][layer * 64 + lane] * P.in[9][layer * 64 + lane]);
    const float lam = expf(s1) - expf(s2) + lam_init;
    const int c0 = lane * 16;
    const float* mu0p = P.in[11] + (size_t)layer * 2 * 3328 + 2048 + c0; const float* mu1p = mu0p + 3328;
    for (int tok = gw; tok < M; tok += ngw) {
        const bf16_t* prow = proj + (size_t)tok * PW;
        bf16_t* mrow = MIX + (size_t)tok * MIXW;
        float a[16], bb[16], g[16], pr[16];
        load16(AO + (size_t)tok * 1024 + c0, a); load16(AO + ((size_t)M + tok) * 1024 + c0, bb); load16(prow + C_AG + c0, g);
        { float ss = 0.f;
#pragma unroll
          for (int i = 0; i < 16; ++i) { a[i] = a[i] - lam * bb[i]; ss += a[i] * a[i]; }
          ss += __shfl_xor(ss, 1); ss += __shfl_xor(ss, 2); ss += __shfl_xor(ss, 4);
          const float rstd = rsqrtf(ss * (1.f / 128.f) + 1e-5f) * (1.f - lam_init);
          loadf16(P.in[10] + layer * 128 + (c0 & 127), pr);
#pragma unroll
          for (int i = 0; i < 16; ++i) a[i] = a[i] * rstd * pr[i] * siluf_(g[i]);
          store16(mrow + c0, a); }
        load16(YB + (size_t)tok * 1024 + c0, a); load16(YB + ((size_t)M + tok) * 1024 + c0, bb); load16(prow + C_BG + c0, g);
        { float sm = 0.f;
#pragma unroll
          for (int i = 0; i < 16; ++i) { a[i] += bb[i]; sm += a[i]; }
          sm += __shfl_xor(sm, 1); sm += __shfl_xor(sm, 2);
          const float mean = sm * (1.f / 64.f); float vs = 0.f;
#pragma unroll
          for (int i = 0; i < 16; ++i) { a[i] -= mean; vs += a[i] * a[i]; }
          vs += __shfl_xor(vs, 1); vs += __shfl_xor(vs, 2);
          const float rstd = rsqrtf(vs * (1.f / 64.f) + 64e-5f);
          const int head = lane >> 2;
          const float bon = BON[(((size_t)(tok >> 11)) * 16 + head) * S + (tok & (S - 1))] + BON[(((size_t)NB + (tok >> 11)) * 16 + head) * S + (tok & (S - 1))];
          const int sp = tok & (S - 1);
          loadf16(P.in[19] + layer * 1024 + c0, pr);
#pragma unroll
          for (int i = 0; i < 16; ++i) a[i] = a[i] * rstd * pr[i];
          loadf16(P.in[20] + layer * 1024 + c0, pr);
#pragma unroll
          for (int i = 0; i < 16; ++i) a[i] += pr[i];
          load16(prow + C_B + 2048 + c0, bb);
          float vsft[16];
          { float nb[16];
            if (sp > 0) load16(prow - PW + C_B + 2048 + c0, nb); else {
#pragma unroll
                for (int i = 0; i < 16; ++i) nb[i] = 0.f; }
            loadf16(mu0p, pr);
#pragma unroll
            for (int i = 0; i < 16; ++i) vsft[i] = bb[i] + pr[i] * (nb[i] - bb[i]);
            if (sp < S - 1) load16(prow + PW + C_B + 2048 + c0, nb); else {
#pragma unroll
                for (int i = 0; i < 16; ++i) nb[i] = 0.f; }
            loadf16(mu1p, pr);
#pragma unroll
            for (int i = 0; i < 16; ++i) vsft[i] += pr[i] * (nb[i] - bb[i]); }
#pragma unroll
          for (int i = 0; i < 16; ++i) a[i] = (a[i] + bon * vsft[i]) * siluf_(g[i]);
          store16(mrow + 1024 + c0, a); }
        load16(OC + (size_t)tok * 1024 + c0, a); load16(OC + ((size_t)M + tok) * 1024 + c0, bb); load16(prow + C_CG + c0, g);
        { float ss = 0.f;
#pragma unroll
          for (int i = 0; i < 16; ++i) { a[i] += bb[i]; ss += a[i] * a[i]; }
          ss += __shfl_xor(ss, 1); ss += __shfl_xor(ss, 2); ss += __shfl_xor(ss, 4);
          const float rstd = rsqrtf(ss * (1.f / 128.f) + 1e-6f);
          loadf16(P.in[22] + layer * 128 + (c0 & 127), pr);
#pragma unroll
          for (int i = 0; i < 16; ++i) a[i] = a[i] * rstd * pr[i] * siluf_(g[i]);
          store16(mrow + 2048 + c0, a); }
    }
}

__global__ void __launch_bounds__(NTHR, 2) fwd_megakernel(Params P) {
    extern __shared__ __attribute__((aligned(16))) unsigned char smem[];
    cg::grid_group grid = cg::this_grid();
    unsigned* ctl = (unsigned*)(P.ws + OFF_CTL);
    if (blockIdx.x == 0 && threadIdx.x < 256) ctl[threadIdx.x] = 0u;
    bf16_t* U = (bf16_t*)(P.ws + OFF_U);
    bf16_t* Y = (bf16_t*)(P.ws + OFF_PROJ);
#ifndef REP_P0
#define REP_P0 1
#endif
#pragma unroll 1
    for (int rep = 0; rep < REP_P0; ++rep) { convert_weights(P, 0, smem);
    prenorm_rows(P.in[0], P.in[2], U); }
    grid.sync();
#pragma unroll 1
    for (int layer = 0; layer < DEPTH; ++layer) {
#ifndef REP_G1
#define REP_G1 1
#endif
#pragma unroll 1
        for (int rep = 0; rep < REP_G1; ++rep) { pg8::Gemm g; g.A = U; g.Bt = (const bf16_t*)(P.ws + OFF_WIN); g.M = opaque_s(M); g.N = opaque_s(PW - 256); g.K = opaque_s(D);
          pg8::StaticOrder So; So.init(g.M, g.N, (int)gridDim.x, opaque_bid());
          pg8::EpiBf16<0> E; E.O = (bf16_t*)(P.ws + OFF_PROJ); E.ldc = opaque_s(PW); E.bias = nullptr; E.split_cols = 0; E.split_stride = 0;
          pg8::gemm_phase<pg8::EpiBf16<0>, pg8::StaticOrder, false>((PG8_LAS unsigned char*)smem, g, So, E, nullptr); }
        grid.sync();
#ifndef REP_RWKV
#define REP_RWKV 1
#endif
#ifndef REP_HGRN
#define REP_HGRN 1
#endif
#ifndef REP_ATTN
#define REP_ATTN 1
#endif
#pragma unroll 1
        for (int rep = 0; rep < REP_RWKV; ++rep) rwkv_phase(P, layer, smem);
#pragma unroll 1
        for (int rep = 0; rep < REP_HGRN; ++rep) hgrn_phase(P, layer, smem);
        { const int tb = opaque_bid();
          if (tb >= 128 && tb < 192) {
              pg8::Gemm g; g.A = U; g.Bt = (const bf16_t*)(P.ws + OFF_WIN) + (size_t)(PW - 256) * D; g.M = opaque_s(M); g.N = opaque_s(256); g.K = opaque_s(D);
              pg8::StaticOrder So; So.init(g.M, g.N, (int)gridDim.x, tb - 128);
              pg8::EpiBf16<0> E; E.O = (bf16_t*)(P.ws + OFF_PROJ) + (PW - 256); E.ldc = opaque_s(PW); E.bias = nullptr; E.split_cols = 0; E.split_stride = 0;
              pg8::gemm_phase<pg8::EpiBf16<0>, pg8::StaticOrder, false>((PG8_LAS unsigned char*)smem, g, So, E, nullptr);
          } }

#pragma unroll 1
        for (int rep = 0; rep < REP_ATTN; ++rep) attn_phase(P, layer, smem, ctl + 64 * layer + 128 * rep);
        grid.sync();
#ifndef REP_FIN
#define REP_FIN 1
#endif
#pragma unroll 1
        for (int rep = 0; rep < REP_FIN; ++rep) finish_phase(P, layer);
        grid.sync();
#ifndef REP_G2
#define REP_G2 1
#endif
#pragma unroll 1
        for (int rep = 0; rep < REP_G2; ++rep) { pg8::Gemm g; g.A = (const bf16_t*)(P.ws + OFF_MIXED); g.Bt = (const bf16_t*)(P.ws + OFF_WOUT); g.M = opaque_s(M); g.N = opaque_s(D); g.K = opaque_s(MIXW);
          pg8::StaticOrder So; So.init(g.M, g.N, (int)gridDim.x, opaque_bid());
          pg8::EpiBf16<0> E; E.O = Y; E.ldc = g.N; E.bias = nullptr; E.split_cols = 0; E.split_stride = 0;
          pg8::gemm_phase<pg8::EpiBf16<0>, pg8::StaticOrder, false>((PG8_LAS unsigned char*)smem, g, So, E, nullptr); }
        grid.sync();
        if (layer + 1 < DEPTH) {
            postnorm_rows(Y, layer == 0 ? P.in[0] : P.out, P.out, P.in[3] + layer * D, P.in[2] + (layer + 1) * D, U);
            convert_weights(P, layer + 1, smem);
            grid.sync();
        } else {
            postnorm_rows(Y, layer == 0 ? P.in[0] : P.out, P.out, P.in[3] + layer * D, nullptr, U);
        }
    }
}
}

extern "C" void kernel_launch(void* const* d_in, const int* in_sizes, int n_in, void* d_out, int out_size, void* d_ws, size_t ws_size, hipStream_t stream) {
    static int grid_blocks = 0;
    if (grid_blocks == 0) {
        int dev = 0, cus = 0, per_cu = 0;
        hipGetDevice(&dev);
        hipDeviceGetAttribute(&cus, hipDeviceAttributeMultiprocessorCount, dev);
        if (hipFuncSetAttribute((const void*)mk::fwd_megakernel, hipFuncAttributeMaxDynamicSharedMemorySize, mk::LDS_BYTES) != hipSuccess) fprintf(stderr, "hipFuncSetAttribute failed\n");
        if (hipOccupancyMaxActiveBlocksPerMultiprocessor(&per_cu, (const void*)mk::fwd_megakernel, mk::NTHR, mk::LDS_BYTES) != hipSuccess || per_cu < 1) { fprintf(stderr, "occupancy query: %d\n", per_cu); per_cu = 1; }
        (void)hipGetLastError();
        grid_blocks = cus * 1;
        if (ws_size < mk::WS_END) fprintf(stderr, "workspace too small: %zu < %zu\n", ws_size, (size_t)mk::WS_END);
    }
    mk::Params p{};
    for (int i = 0; i < 23; ++i) p.in[i] = (const float*)d_in[i];
    p.out = (float*)d_out; p.ws = (unsigned char*)d_ws;
    void* args[] = {&p};
    hipError_t e = hipLaunchCooperativeKernel((const void*)mk::fwd_megakernel, dim3(grid_blocks), dim3(mk::NTHR), args, mk::LDS_BYTES, stream);
    if (e != hipSuccess) fprintf(stderr, "cooperative launch failed: %s (grid %d)\n", hipGetErrorString(e), grid_blocks);
}
```
